# Optimizing an MI355X kernel written in HIP

```python
import math
import jax, jax.numpy as jnp
from jax import lax
import numpy as np

D_MODEL = 1024
BATCH = 8
SEQ = 2048
DEPTH = 1

GDN_HEADS = 8
GDN_HEAD_DIM = 128
GDN_WIDTH = GDN_HEADS * GDN_HEAD_DIM
CONV_K = 5
GLA_HEADS = 4
GLA_KEY_DIM = D_MODEL // 2
GLA_VAL_DIM = D_MODEL
GLA_HEAD_K = GLA_KEY_DIM // GLA_HEADS
GLA_HEAD_V = GLA_VAL_DIM // GLA_HEADS
GLA_GATE_RANK = 16
GLA_GATE_NORMALIZER = 16.0
CHUNK = 64
NORM_EPS = 1e-6

IN_SIZES = [
    3 * GDN_WIDTH,
    GDN_WIDTH,
    GDN_HEADS,
    GDN_HEADS,
    GDN_HEADS,
    GDN_HEADS,
    GLA_KEY_DIM,
    GLA_KEY_DIM,
    GLA_VAL_DIM,
    GLA_VAL_DIM,
    GLA_GATE_RANK,
    GLA_GATE_RANK,
    D_MODEL,
    D_MODEL,
]
N_IN = int(sum(IN_SIZES))
IN_SPLITS = [int(s) for s in np.cumsum(IN_SIZES)[:-1]]

kernel_name = "bidir_gdn_gla_gated_hybrid"


def rmsnorm(x, w):
    xf = x.astype(jnp.float32)
    y = xf * lax.rsqrt(jnp.mean(xf * xf, axis=-1, keepdims=True) + NORM_EPS)
    return (y * w.astype(jnp.float32)).astype(x.dtype)


def l2norm(x):
    return x * lax.rsqrt(jnp.sum(x * x, axis=-1, keepdims=True) + NORM_EPS)


def to_heads(x, n_heads):
    b, t, _ = x.shape
    return x.reshape(b, t, n_heads, -1).transpose(0, 2, 1, 3)


def from_heads(x):
    return x.transpose(0, 2, 1, 3)


def to_chunks(x):
    b, h, t = x.shape[:3]
    return x.reshape(b, h, t // CHUNK, CHUNK, *x.shape[3:])


def centred_depthwise_conv(x, w):
    c = x.shape[-1]
    return lax.conv_general_dilated(
        x, w[:, None, :].astype(x.dtype), window_strides=(1,),
        padding=[(CONV_K // 2, CONV_K // 2)],
        dimension_numbers=("NWC", "WIO", "NWC"), feature_group_count=c)


def gated_delta_rule(q, k, v, g, beta):
    bsz, nh, t, dk = q.shape
    dv = v.shape[-1]
    q = to_chunks(q * (dk ** -0.5))
    k = to_chunks(k)
    v = to_chunks(v)
    beta = to_chunks(beta)
    g = jnp.cumsum(to_chunks(g), axis=-1)
    incl = jnp.tril(jnp.ones((CHUNK, CHUNK), dtype=bool))
    strict = jnp.tril(jnp.ones((CHUNK, CHUNK), dtype=bool), -1)
    diff = g[..., :, None] - g[..., None, :]
    decay = jnp.where(incl, jnp.exp(jnp.where(incl, diff, 0.0)), 0.0)
    kb = k * beta[..., None]
    lower = jnp.where(strict, jnp.einsum("bhnid,bhnjd->bhnij", kb, k) * decay, 0.0)
    rhs = jnp.concatenate([v * beta[..., None], kb * jnp.exp(g)[..., None]], axis=-1)
    sol = lax.linalg.triangular_solve(lower, rhs, left_side=True, lower=True,
                                      unit_diagonal=True)
    u, w = sol[..., :dv], sol[..., dv:]
    attn = jnp.einsum("bhnid,bhnjd->bhnij", q, k) * decay
    q_dec = q * jnp.exp(g)[..., None]
    g_last = g[..., -1]
    k_dec = k * jnp.exp(g_last[..., None] - g)[..., None]

    def step(S, inp):
        u_n, w_n, attn_n, qd_n, kd_n, gl_n = inp
        v_new = u_n - jnp.einsum("bhcd,bhde->bhce", w_n, S)
        o = (jnp.einsum("bhcd,bhde->bhce", qd_n, S)
             + jnp.einsum("bhij,bhje->bhie", attn_n, v_new))
        S = S * jnp.exp(gl_n)[..., None, None] + jnp.einsum("bhcd,bhce->bhde", kd_n, v_new)
        return S, o

    xs = tuple(jnp.moveaxis(a, 2, 0) for a in (u, w, attn, q_dec, k_dec, g_last))
    S0 = jnp.zeros((bsz, nh, dk, dv), q.dtype)
    _, o = lax.scan(step, S0, xs)
    return jnp.moveaxis(o, 0, 2).reshape(bsz, nh, t, dv)


def gla_chunked(q, k, v, gk):
    bsz, nh, t, dk = q.shape
    dv = v.shape[-1]
    q = to_chunks(q * (dk ** -0.5))
    k = to_chunks(k)
    v = to_chunks(v)
    G = jnp.cumsum(to_chunks(gk), axis=3)
    qg = q * jnp.exp(G)
    kg = k * jnp.exp(-G)
    incl = jnp.tril(jnp.ones((CHUNK, CHUNK), dtype=bool))
    attn = jnp.where(incl, jnp.einsum("bhnid,bhnjd->bhnij", qg, kg), 0.0)
    intra = jnp.einsum("bhnij,bhnje->bhnie", attn, v)
    G_last = G[..., -1, :]
    k_dec = k * jnp.exp(G_last[..., None, :] - G)

    def step(S, inp):
        qg_n, kd_n, v_n, gl_n = inp
        o = jnp.einsum("bhcd,bhde->bhce", qg_n, S)
        S = S * jnp.exp(gl_n)[..., :, None] + jnp.einsum("bhcd,bhce->bhde", kd_n, v_n)
        return S, o

    xs = tuple(jnp.moveaxis(a, 2, 0) for a in (qg, k_dec, v, G_last))
    S0 = jnp.zeros((bsz, nh, dk, dv), q.dtype)
    _, inter = lax.scan(step, S0, xs)
    o = jnp.moveaxis(inter, 0, 2) + intra
    return o.reshape(bsz, nh, t, dv)


def flip_t(a):
    return jnp.flip(a, axis=2)


def hybrid_layer(x, ln_pre_w, w_in, conv_w, a_log_fwd, a_log_bwd, dt_bias_fwd, dt_bias_bwd,
                 gdn_norm_w, w_proj_gdn, gk_w2_fwd, gk_b2_fwd, gk_w2_bwd, gk_b2_bwd,
                 gla_norm_w, w_proj_gla, w_out, ln_post_w):
    f32 = jnp.float32
    h = rmsnorm(x, ln_pre_w)
    proj = h @ w_in
    (qkv_a, z_a, a_f, a_b, b_f, b_b, q_b, k_b, v_b, g_b,
     r_f, r_b, gate_a, gate_b) = jnp.split(proj, IN_SPLITS, axis=-1)

    qkv_a = jax.nn.silu(centred_depthwise_conv(qkv_a, conv_w)).astype(f32)
    q_a, k_a, v_a = jnp.split(qkv_a, 3, axis=-1)
    q_a = l2norm(to_heads(q_a, GDN_HEADS))
    k_a = l2norm(to_heads(k_a, GDN_HEADS))
    v_a = to_heads(v_a, GDN_HEADS)
    lg_f = (-jnp.exp(a_log_fwd.astype(f32)) * jax.nn.softplus(a_f.astype(f32) + dt_bias_fwd.astype(f32))).transpose(0, 2, 1)
    lg_b = (-jnp.exp(a_log_bwd.astype(f32)) * jax.nn.softplus(a_b.astype(f32) + dt_bias_bwd.astype(f32))).transpose(0, 2, 1)
    beta_f = jax.nn.sigmoid(b_f.astype(f32)).transpose(0, 2, 1)
    beta_b = jax.nn.sigmoid(b_b.astype(f32)).transpose(0, 2, 1)
    o_a = (gated_delta_rule(q_a, k_a, v_a, lg_f, beta_f)
           + flip_t(gated_delta_rule(flip_t(q_a), flip_t(k_a), flip_t(v_a),
                                     flip_t(lg_b), flip_t(beta_b))))
    o_a = rmsnorm(from_heads(o_a), gdn_norm_w)
    o_a = o_a * jax.nn.silu(z_a.astype(f32)).reshape(o_a.shape)
    y_a = o_a.reshape(x.shape[0], x.shape[1], GDN_WIDTH).astype(x.dtype) @ w_proj_gdn

    q_bh = to_heads(q_b.astype(f32), GLA_HEADS)
    k_bh = to_heads(k_b.astype(f32), GLA_HEADS)
    v_bh = to_heads(v_b.astype(f32), GLA_HEADS)
    gk_f = jax.nn.log_sigmoid((r_f @ gk_w2_fwd + gk_b2_fwd).astype(f32)) / GLA_GATE_NORMALIZER
    gk_b = jax.nn.log_sigmoid((r_b @ gk_w2_bwd + gk_b2_bwd).astype(f32)) / GLA_GATE_NORMALIZER
    gk_f = to_heads(gk_f, GLA_HEADS)
    gk_b = to_heads(gk_b, GLA_HEADS)
    o_b = (gla_chunked(q_bh, k_bh, v_bh, gk_f)
           + flip_t(gla_chunked(flip_t(q_bh), flip_t(k_bh), flip_t(v_bh), flip_t(gk_b))))
    o_b = rmsnorm(from_heads(o_b), gla_norm_w)
    o_b = o_b * jax.nn.silu(g_b.astype(f32)).reshape(o_b.shape)
    y_b = o_b.reshape(x.shape[0], x.shape[1], GLA_VAL_DIM).astype(x.dtype) @ w_proj_gla

    merged = jax.nn.sigmoid(gate_a) * y_a + jax.nn.sigmoid(gate_b) * y_b
    out = merged @ w_out
    return x + rmsnorm(out, ln_post_w)


def setup_inputs(seed: int = 0) -> dict:
    key = jax.random.key(seed)
    ks = jax.random.split(key, 20)
    L, D = DEPTH, D_MODEL

    def nrm(k, shape, scale):
        return jax.random.normal(k, shape, jnp.float32) * scale

    def dt_bias(k):
        u = jax.random.uniform(k, (L, GDN_HEADS), jnp.float32)
        dt = jnp.exp(u * (math.log(0.1) - math.log(0.001)) + math.log(0.001))
        return dt + jnp.log(-jnp.expm1(-dt))

    def a_log(k):
        return jnp.log(jax.random.uniform(k, (L, GDN_HEADS), jnp.float32, 1.0, 16.0))

    return {
        "x": nrm(ks[0], (BATCH, SEQ, D), 1.0),
        "ln_pre_w": 1.0 + nrm(ks[1], (L, D), 0.02),
        "w_in": nrm(ks[2], (L, D, N_IN), D ** -0.5),
        "conv_w": nrm(ks[3], (L, CONV_K, 3 * GDN_WIDTH), CONV_K ** -0.5),
        "a_log_fwd": a_log(ks[4]),
        "a_log_bwd": a_log(ks[5]),
        "dt_bias_fwd": dt_bias(ks[6]),
        "dt_bias_bwd": dt_bias(ks[7]),
        "gdn_norm_w": 1.0 + nrm(ks[8], (L, GDN_HEAD_DIM), 0.02),
        "w_proj_gdn": nrm(ks[9], (L, GDN_WIDTH, D), GDN_WIDTH ** -0.5),
        "gk_w2_fwd": nrm(ks[10], (L, GLA_GATE_RANK, GLA_KEY_DIM), GLA_GATE_RANK ** -0.5),
        "gk_b2_fwd": nrm(ks[11], (L, GLA_KEY_DIM), 0.01),
        "gk_w2_bwd": nrm(ks[12], (L, GLA_GATE_RANK, GLA_KEY_DIM), GLA_GATE_RANK ** -0.5),
        "gk_b2_bwd": nrm(ks[13], (L, GLA_KEY_DIM), 0.01),
        "gla_norm_w": 1.0 + nrm(ks[14], (L, GLA_HEAD_V), 0.02),
        "w_proj_gla": nrm(ks[15], (L, GLA_VAL_DIM, D), GLA_VAL_DIM ** -0.5),
        "w_out": nrm(ks[16], (L, D, D), D ** -0.5),
        "ln_post_w": 1.0 + nrm(ks[17], (L, D), 0.02),
    }


def reference(x, ln_pre_w, w_in, conv_w, a_log_fwd, a_log_bwd, dt_bias_fwd, dt_bias_bwd,
              gdn_norm_w, w_proj_gdn, gk_w2_fwd, gk_b2_fwd, gk_w2_bwd, gk_b2_bwd,
              gla_norm_w, w_proj_gla, w_out, ln_post_w):
    h = x
    for l in range(DEPTH):
        h = hybrid_layer(h, ln_pre_w[l], w_in[l], conv_w[l], a_log_fwd[l], a_log_bwd[l],
                         dt_bias_fwd[l], dt_bias_bwd[l], gdn_norm_w[l], w_proj_gdn[l],
                         gk_w2_fwd[l], gk_b2_fwd[l], gk_w2_bwd[l], gk_b2_bwd[l],
                         gla_norm_w[l], w_proj_gla[l], w_out[l], ln_post_w[l])
    return h
```

```cpp
#include <hip/hip_runtime.h>
#include <cstdio>
#include <cstdint>

#define GAS __attribute__((address_space(1)))
#define LAS __attribute__((address_space(3)))
typedef unsigned short bf16;
typedef unsigned v4u __attribute__((ext_vector_type(4)));
typedef unsigned v2u __attribute__((ext_vector_type(2)));
typedef float f32x4 __attribute__((ext_vector_type(4)));
#define LDS_WAIT() asm volatile("s_waitcnt lgkmcnt(0)" ::: "memory")

constexpr int BATCH = 8, SEQ = 2048, D = 1024, M = BATCH * SEQ, NIN = 9280;
constexpr float EPS = 1e-6f;
constexpr size_t MiB = 1 << 20;
constexpr int SRC_QKVA = 0, SRC_ZA = 3072, SRC_AF = 4096, SRC_QB = 4128, SRC_KB = 4640, SRC_VB = 5152, SRC_GB = 6176, SRC_RF = 7200, SRC_GA = 7232, SRC_GBm = 8256;

__device__ __forceinline__ unsigned f2bf(float f) { unsigned u = __builtin_bit_cast(unsigned, f); return (u + 0x7fffu + ((u >> 16) & 1u)) >> 16; }
__device__ __forceinline__ unsigned pk2(float lo, float hi) { return f2bf(lo) | (f2bf(hi) << 16); }
__device__ __forceinline__ float bf2f(unsigned short b) { return __builtin_bit_cast(float, (unsigned)b << 16); }
__device__ __forceinline__ float bflo(unsigned w) { return __builtin_bit_cast(float, w << 16); }
__device__ __forceinline__ float bfhi(unsigned w) { return __builtin_bit_cast(float, w & 0xffff0000u); }
__device__ __forceinline__ float sigmoidf_(float x) { return 1.0f / (1.0f + __expf(-x)); }
__device__ __forceinline__ float siluf_(float x) { return x / (1.0f + __expf(-x)); }
__device__ __forceinline__ float wave_sum(float v) {
#pragma unroll
    for (int o = 1; o < 64; o <<= 1) v += __shfl_xor(v, o);
    return v;
}
namespace pg8 {
#define PG8_LAS __attribute__((address_space(3)))
typedef unsigned short bf16_t;
typedef short bf16x8 __attribute__((ext_vector_type(8)));
typedef float f32x4 __attribute__((ext_vector_type(4)));
typedef unsigned u32x4 __attribute__((ext_vector_type(4)));
constexpr int BM = 256, BK = 64, HALF = 128, HTB = HALF * BK * 2  , STAGE_BYTES = 8 * HTB, NXCD = 8, WGM = 8;

__host__ __device__ __forceinline__ int lds_byte(int r, int c) { const int st = (r >> 4) * 2 + (c >> 5), rr = r & 15, cc = c & 31, ob = rr * 64 + cc * 2; return st * 1024 + (ob ^ (((ob >> 9) & 1) << 5)); }
__host__ __device__ __forceinline__ void stage_rc(int b, int& R, int& C) { const int st = b / 1024, sb = b % 1024, swz = sb ^ (((sb >> 9) & 1) << 5); R = (st >> 1) * 16 + swz / 64; C = (st & 1) * 32 + (swz % 64) / 2; }
__host__ __device__ __forceinline__ int perm32(int rho) { const int n = rho >> 4, i = rho & 15; return 8 * (i >> 2) + 4 * n + (i & 3); }

struct Unit { int pm, pn; };
struct Gemm { const bf16_t* A; const bf16_t* Bt; int M, N, K, pad_; };

struct StaticOrder {
    int nM, nN, nwg, G, c;
    __host__ __device__ void init(int M, int N, int G_, int c_) { nM = M / BM; nN = N / BM; nwg = nM * nN; G = G_; c = c_; }
    __host__ __device__ bool next(int i, Unit& u) const {
        const long L = (long)i * G + c; if (L >= nwg) return false;
        int wgid = (int)L; { const int q = nwg / NXCD, r = nwg % NXCD, xcd = wgid % NXCD, off = wgid / NXCD; wgid = (xcd < r ? xcd * (q + 1) : r * (q + 1) + (xcd - r) * q) + off; }
        const int nig = WGM * nN, gid = wgid / nig, fm = gid * WGM, gsz = (nM - fm) < WGM ? (nM - fm) : WGM;
        u.pm = fm + ((wgid % nig) % gsz); u.pn = (wgid % nig) / gsz; return true;
    }
    __device__ __forceinline__ void a_ready(const Unit&) const {}
    __device__ __forceinline__ void done(const Unit&) const {}
};

__device__ __forceinline__ unsigned cvt_pk_bf16(float lo, float hi) { unsigned r; asm volatile("v_cvt_pk_bf16_f32 %0, %1, %2" : "=v"(r) : "v"(lo), "v"(hi)); return r; }
struct EpiBf16 {
    static constexpr bool PERM = true, AFTER_DRAIN = false;
    bf16_t* O; int ldc; int split_cols; size_t split_stride;
    __device__ __forceinline__ void operator()(const f32x4 (&acc)[2][2][4][2], const Unit& u, int wr, int wc, int fr, int fq) const {
        const int row0 = u.pm * BM + wr * 64 + fr; int colt = u.pn * BM; bf16_t* base = O;
        if (split_cols) { const int t = colt / split_cols; base += (size_t)t * split_stride; colt -= t * split_cols; }
        const int col0 = colt + wc * 32 + 8 * fq;
#pragma unroll
        for (int ai = 0; ai < 2; ++ai)
#pragma unroll
            for (int m = 0; m < 4; ++m) { bf16_t* rowp = base + (size_t)(row0 + ai * HALF + m * 16) * ldc + col0;
#pragma unroll
                for (int bj = 0; bj < 2; ++bj) { const f32x4 v0 = acc[ai][bj][m][0], v1 = acc[ai][bj][m][1];
                    u32x4 w; w.x = cvt_pk_bf16(v0[0], v0[1]); w.y = cvt_pk_bf16(v0[2], v0[3]); w.z = cvt_pk_bf16(v1[0], v1[1]); w.w = cvt_pk_bf16(v1[2], v1[3]);
                    *(u32x4*)(rowp + bj * HALF) = w; } }
    }
};
template <int MODE> struct EpiGate {
    static constexpr bool PERM = true, AFTER_DRAIN = false;
    bf16_t* O; const bf16_t* G; const bf16_t* Add; int ldc, pad_;
    __device__ __forceinline__ void operator()(const f32x4 (&acc)[2][2][4][2], const Unit& u, int wr, int wc, int fr, int fq) const {
        const int row0 = u.pm * BM + wr * 64 + fr; const int col0 = u.pn * BM + wc * 32 + 8 * fq;
#pragma unroll
        for (int ai = 0; ai < 2; ++ai)
#pragma unroll
            for (int m = 0; m < 4; ++m) { const size_t ro = (size_t)(row0 + ai * HALF + m * 16) * ldc + col0;
#pragma unroll
                for (int bj = 0; bj < 2; ++bj) { const f32x4 v0 = acc[ai][bj][m][0], v1 = acc[ai][bj][m][1];
                    const u32x4 gw = *(const u32x4*)(G + ro + bj * HALF);
                    float r[8]; const float a[8] = {v0[0], v0[1], v0[2], v0[3], v1[0], v1[1], v1[2], v1[3]};
#pragma unroll
                    for (int i = 0; i < 4; ++i) { const unsigned w = gw[i]; const float g0 = __builtin_bit_cast(float, w << 16), g1 = __builtin_bit_cast(float, w & 0xffff0000u);
                        if (MODE == 0) { r[2 * i] = a[2 * i] / (1.0f + __expf(-g0)); r[2 * i + 1] = a[2 * i + 1] / (1.0f + __expf(-g1)); }
                        else { r[2 * i] = g0 * a[2 * i] / (1.0f + __expf(-a[2 * i])); r[2 * i + 1] = g1 * a[2 * i + 1] / (1.0f + __expf(-a[2 * i + 1])); } }
                    if (Add) { const u32x4 aw = *(const u32x4*)(Add + ro + bj * HALF);
#pragma unroll
                        for (int i = 0; i < 4; ++i) { const unsigned w = aw[i]; r[2 * i] += __builtin_bit_cast(float, w << 16); r[2 * i + 1] += __builtin_bit_cast(float, w & 0xffff0000u); } }
                    u32x4 w; w.x = cvt_pk_bf16(r[0], r[1]); w.y = cvt_pk_bf16(r[2], r[3]); w.z = cvt_pk_bf16(r[4], r[5]); w.w = cvt_pk_bf16(r[6], r[7]);
                    *(u32x4*)(O + ro + bj * HALF) = w; } }
    }
};
struct EpiF32 {
    static constexpr bool PERM = false, AFTER_DRAIN = false;
    float* O; int ldc, pad_;
    __device__ __forceinline__ void operator()(const f32x4 (&acc)[2][2][4][2], const Unit& u, int wr, int wc, int fr, int fq) const {
        const int row0 = u.pm * BM + wr * 64 + fr; const int col0 = u.pn * BM + wc * 32 + 4 * fq;
#pragma unroll
        for (int ai = 0; ai < 2; ++ai)
#pragma unroll
            for (int m = 0; m < 4; ++m) { float* rowp = O + (size_t)(row0 + ai * HALF + m * 16) * ldc + col0;
#pragma unroll
                for (int bj = 0; bj < 2; ++bj)
#pragma unroll
                    for (int n = 0; n < 2; ++n) *(f32x4*)(rowp + bj * HALF + n * 16) = acc[ai][bj][m][n]; }
    }
};
struct EpiP1b {
    static constexpr bool PERM = true, AFTER_DRAIN = false;
    const bf16_t* ob; bf16_t* gates; size_t gate_stride; bf16_t* ob_out;
    __device__ __forceinline__ void operator()(const f32x4 (&acc)[2][2][4][2], const Unit& u, int wr, int wc, int fr, int fq) const {
        if (u.pn < 4) { EpiGate<1> E{ob_out, ob, nullptr, 1024, 0}; E(acc, u, wr, wc, fr, fq); }
        else { Unit v = u; v.pn = (u.pn - 4) & 3; EpiBf16 E{gates + (size_t)((u.pn - 4) >> 2) * gate_stride, 1024, 0, 0}; E(acc, v, wr, wc, fr, fq); }
    }
};
struct EpiRmsRes {
    static constexpr bool PERM = false, AFTER_DRAIN = true;
    const float* xres; const float* w; float* out; float* xbuf; unsigned* cnt;
    __device__ __forceinline__ void fused(f32x4 (&acc)[2][2][4][2], const Unit& u, int wr, int wc, int fr, int fq, PG8_LAS unsigned char* lds, int wid, int lane) const {
        PG8_LAS float* P = (PG8_LAS float*)lds;
        PG8_LAS float* R = (PG8_LAS float*)(lds + 4096);
#pragma unroll
        for (int ai = 0; ai < 2; ++ai)
#pragma unroll
            for (int m = 0; m < 4; ++m) { float s = 0.f;
#pragma unroll
                for (int bj = 0; bj < 2; ++bj)
#pragma unroll
                    for (int n = 0; n < 2; ++n) { const f32x4 x = acc[ai][bj][m][n]; s += (x[0] * x[0] + x[1] * x[1]) + (x[2] * x[2] + x[3] * x[3]); }
                s += __shfl_xor(s, 16); s += __shfl_xor(s, 32);
                if (fq == 0) P[(ai * HALF + wr * 64 + m * 16 + fr) * 4 + wc] = s; }
        asm volatile("s_waitcnt lgkmcnt(0)" ::: "memory"); __builtin_amdgcn_s_barrier(); asm volatile("" ::: "memory");
        const int row = wid * 32 + (lane & 31);
        if (lane < 32) { const f32x4 p = *(const PG8_LAS f32x4*)(P + row * 4);
            __hip_atomic_store(xbuf + (size_t)(u.pm * BM + row) * 4 + u.pn, (p[0] + p[1]) + (p[2] + p[3]), __ATOMIC_RELAXED, __HIP_MEMORY_SCOPE_AGENT); }
        asm volatile("s_waitcnt vmcnt(0)" ::: "memory");
        if (lane == 0) __hip_atomic_fetch_add(cnt + 64 * u.pm, 1u, __ATOMIC_RELAXED, __HIP_MEMORY_SCOPE_AGENT);
        if (wid == 0) {
            for (unsigned sp = 0; (unsigned)__builtin_amdgcn_readfirstlane((int)__hip_atomic_load(cnt + 64 * u.pm, __ATOMIC_RELAXED, __HIP_MEMORY_SCOPE_AGENT)) < 32u && sp < (1u << 22); ++sp) __builtin_amdgcn_s_sleep(2);
        }
        asm volatile("s_waitcnt vmcnt(0) lgkmcnt(0)" ::: "memory"); __builtin_amdgcn_s_barrier(); asm volatile("" ::: "memory");
        if (lane < 32) { const float* sl = xbuf + (size_t)(u.pm * BM + row) * 4; float t = 0.f;
#pragma unroll
            for (int i = 0; i < 4; ++i) t += __hip_atomic_load(sl + i, __ATOMIC_RELAXED, __HIP_MEMORY_SCOPE_AGENT);
            R[row] = 1.0f / sqrtf(t * (1.0f / 1024.0f) + 1e-6f); }
        asm volatile("s_waitcnt vmcnt(0) lgkmcnt(0)" ::: "memory"); __builtin_amdgcn_s_barrier(); asm volatile("" ::: "memory");
        const int col0 = u.pn * BM + wc * 32 + 4 * fq;
#pragma unroll
        for (int ai = 0; ai < 2; ++ai)
#pragma unroll
            for (int m = 0; m < 4; ++m) { const int r = ai * HALF + wr * 64 + m * 16 + fr; const float rs = R[r]; const size_t off = (size_t)(u.pm * BM + r) * 1024 + col0;
#pragma unroll
                for (int bj = 0; bj < 2; ++bj)
#pragma unroll
                    for (int n = 0; n < 2; ++n) { const int c = bj * HALF + n * 16; const f32x4 xv = *(const f32x4*)(xres + off + c); const f32x4 wv = *(const f32x4*)(w + col0 + c);
                        *(f32x4*)(out + off + c) = xv + acc[ai][bj][m][n] * rs * wv; }
                if (m & 1) asm volatile("" ::: "memory"); }
    }
};
struct PairOrder {
    StaticOrder S; int nM, nN;
    __host__ __device__ void init(int M, int N, int G_, int c_) { S.init(M, N, G_, c_); nM = M / BM; nN = N / BM; }
    __host__ __device__ bool next(int i, Unit& u) const { if (i > 1) return false; Unit b; if (!S.next(0, b)) return false; u.pm = b.pm + i * nM; u.pn = b.pn + i * nN; return true; }
    __device__ __forceinline__ void a_ready(const Unit&) const {}
    __device__ __forceinline__ void done(const Unit&) const {}
};
struct EpiMerge {
    static constexpr bool PERM = true, AFTER_DRAIN = false;
    bf16_t* m1; bf16_t* merged; const bf16_t* gates; size_t gate_stride; int nM, nN;
    __device__ __forceinline__ void operator()(const f32x4 (&acc)[2][2][4][2], const Unit& u, int wr, int wc, int fr, int fq) const {
        if (u.pm < nM) { EpiGate<0> E{m1, gates, nullptr, 1024, 0}; E(acc, u, wr, wc, fr, fq); }
        else { Unit v; v.pm = u.pm - nM; v.pn = u.pn - nN; EpiGate<0> E{merged, gates + gate_stride, m1, 1024, 0}; E(acc, v, wr, wc, fr, fq); }
    }
};
template <class Epi, class Sched, bool ALIGN_EPI = false, bool SP2 = false>
__device__ __forceinline__ void gemm_phase(PG8_LAS unsigned char* lds, const Gemm g, const Sched& S, const Epi& E) {
    int tid_l = threadIdx.x; asm volatile("" : "+v"(tid_l));
    const int tid = tid_l, wid = __builtin_amdgcn_readfirstlane(tid >> 6), lane = tid & 63, wr = wid >> 2, wc = wid & 3, fr = lane & 15, fq = lane >> 4;
    const int K = g.K, nt = K / BK;
    unsigned voffA[2], voffB[2];
#pragma unroll
    for (int i = 0; i < 2; ++i) { int R, C; stage_rc(tid * 16 + i * 8192, R, C); const int Rb = Epi::PERM ? ((R & ~31) + perm32(R & 31)) : R;
        voffA[i] = (unsigned)(R * K + C) * 2u; voffB[i] = (unsigned)(Rb * K + C) * 2u; }
    const size_t kstep = (size_t)(BK * 2);
    const size_t hstep = (size_t)HALF * K * 2;
    const size_t tstep = 2 * hstep;
    const unsigned ldsw = (unsigned)wid * 1024u;
    const int aoff = lds_byte(wr * 64 + fr, fq * 8), boff = lds_byte(wc * 32 + fr, fq * 8);
#define PG8_SA(b, h) (((b) * 2 + (h)) * HTB)
#define PG8_SB(b, h) ((4 + (b) * 2 + (h)) * HTB)
#define PG8_STAGE(bufoff, gbase, voff) do { _Pragma("unroll") for (int _i = 0; _i < 2; ++_i) \
        __builtin_amdgcn_global_load_lds((const unsigned*)((const char*)(gbase) + (voff)[_i]), (PG8_LAS unsigned*)(lds + (bufoff) + ldsw + _i * 8192), 16, 0, 0); } while (0)
#define PG8_LDA(dst, b, h) do { _Pragma("unroll") for (int m = 0; m < 4; ++m) _Pragma("unroll") for (int k = 0; k < 2; ++k) dst[m][k] = *(const PG8_LAS bf16x8*)(lds + PG8_SA(b, h) + aoff + m * 2048 + k * 1024); } while (0)
#define PG8_LDB(dst, b, h) do { _Pragma("unroll") for (int n = 0; n < 2; ++n) _Pragma("unroll") for (int k = 0; k < 2; ++k) dst[n][k] = *(const PG8_LAS bf16x8*)(lds + PG8_SB(b, h) + boff + n * 2048 + k * 1024); } while (0)
#define PG8_MMA(ai, bj, At, Bt) do { __builtin_amdgcn_s_setprio(1); _Pragma("unroll") for (int m = 0; m < 4; ++m) _Pragma("unroll") for (int n = 0; n < 2; ++n) _Pragma("unroll") for (int k = 0; k < 2; ++k) \
        acc[ai][bj][m][n] = __builtin_amdgcn_mfma_f32_16x16x32_bf16(Bt[n][k], At[m][k], acc[ai][bj][m][n], 0, 0, 0); __builtin_amdgcn_s_setprio(0); } while (0)
#define PG8_WAIT_V(n) asm volatile("s_waitcnt vmcnt(" #n ")" ::: "memory")
#define PG8_WAIT_L(n) asm volatile("s_waitcnt lgkmcnt(" #n ")" ::: "memory")
#define PG8_BAR __builtin_amdgcn_s_barrier()
#define PG8_SCHED __builtin_amdgcn_sched_barrier(0)
    Unit cur, nxt; int ui = 0;
    if (!S.next(0, cur)) return;
    f32x4 acc[2][2][4][2];
#pragma unroll
    for (int a = 0; a < 2; ++a)
#pragma unroll
        for (int b = 0; b < 2; ++b)
#pragma unroll
            for (int m = 0; m < 4; ++m)
#pragma unroll
                for (int n = 0; n < 2; ++n) acc[a][b][m][n] = (f32x4){0.f, 0.f, 0.f, 0.f};
    bf16x8 At[4][2], B0[2][2], B1[2][2];
    const char* cA = (const char*)g.A + (size_t)cur.pm * tstep; const char* cB = (const char*)g.Bt + (size_t)cur.pn * tstep;
    S.a_ready(cur);
    if constexpr (SP2) {
        PG8_STAGE(PG8_SB(0, 0), cB, voffB); PG8_STAGE(PG8_SB(0, 1), cB + hstep, voffB); PG8_STAGE(PG8_SA(0, 0), cA, voffA); PG8_STAGE(PG8_SA(0, 1), cA + hstep, voffA);
        if (wr == 1) PG8_BAR;
        PG8_WAIT_V(2); PG8_BAR;
        PG8_STAGE(PG8_SB(1, 0), cB + kstep, voffB); PG8_STAGE(PG8_SA(1, 0), cA + kstep, voffA); PG8_STAGE(PG8_SB(1, 1), cB + hstep + kstep, voffB);
        PG8_WAIT_V(6); PG8_BAR;
    } else {
        PG8_STAGE(PG8_SB(0, 0), cB, voffB); PG8_STAGE(PG8_SA(0, 0), cA, voffA); PG8_STAGE(PG8_SB(0, 1), cB + hstep, voffB); PG8_STAGE(PG8_SA(0, 1), cA + hstep, voffA);
        if (wr == 1) PG8_BAR;
        PG8_WAIT_V(4); PG8_BAR;
        PG8_STAGE(PG8_SB(1, 0), cB + kstep, voffB); PG8_STAGE(PG8_SA(1, 0), cA + kstep, voffA); PG8_STAGE(PG8_SB(1, 1), cB + hstep + kstep, voffB);
        PG8_WAIT_V(6); PG8_BAR;
    }
    for (;;) {
        const bool has_next = S.next(ui + 1, nxt);
        const char* nA = has_next ? (const char*)g.A + (size_t)nxt.pm * tstep : cA; const char* nB = has_next ? (const char*)g.Bt + (size_t)nxt.pn * tstep : cB;
        for (int t = 0; t < nt; t += 2) {
            const bool last = (t == nt - 2);
            const char* a1 = cA + (size_t)(t + 1) * kstep;
            const char* a2 = last ? nA : cA + (size_t)(t + 2) * kstep; const char* b2 = last ? nB : cB + (size_t)(t + 2) * kstep;
            const char* a3 = a2 + kstep; const char* b3 = b2 + kstep;
            if (last && has_next) S.a_ready(nxt);
            if constexpr (SP2) {
            PG8_LDB(B0, 0, 0); PG8_LDB(B1, 0, 1); PG8_SCHED; PG8_LDA(At, 0, 0); PG8_STAGE(PG8_SA(1, 1), a1 + hstep, voffA);
            PG8_WAIT_V(8); PG8_WAIT_L(0); PG8_BAR; PG8_MMA(0, 0, At, B0); PG8_MMA(0, 1, At, B1); PG8_BAR; PG8_SCHED;
            PG8_LDA(At, 0, 1); PG8_STAGE(PG8_SB(0, 0), b2, voffB); PG8_STAGE(PG8_SB(0, 1), b2 + hstep, voffB); PG8_STAGE(PG8_SA(0, 0), a2, voffA);
            PG8_WAIT_V(8); PG8_WAIT_L(0); PG8_BAR; PG8_MMA(1, 0, At, B0); PG8_MMA(1, 1, At, B1); PG8_BAR; PG8_SCHED;
            PG8_LDB(B0, 1, 0); PG8_LDB(B1, 1, 1); PG8_SCHED; PG8_LDA(At, 1, 0); PG8_STAGE(PG8_SA(0, 1), a2 + hstep, voffA);
            PG8_WAIT_V(8); PG8_WAIT_L(0); PG8_BAR; PG8_MMA(0, 0, At, B0); PG8_MMA(0, 1, At, B1); PG8_BAR; PG8_SCHED;
            PG8_LDA(At, 1, 1); PG8_STAGE(PG8_SB(1, 0), b3, voffB); PG8_STAGE(PG8_SB(1, 1), b3 + hstep, voffB); PG8_STAGE(PG8_SA(1, 0), a3, voffA);
            PG8_WAIT_V(8); PG8_WAIT_L(0); PG8_BAR; PG8_MMA(1, 0, At, B0); PG8_MMA(1, 1, At, B1); PG8_BAR; PG8_SCHED;
            } else {
            PG8_LDB(B0, 0, 0); PG8_SCHED; PG8_LDA(At, 0, 0); PG8_STAGE(PG8_SA(1, 1), a1 + hstep, voffA);
            PG8_WAIT_L(8); PG8_BAR; PG8_WAIT_L(0); PG8_MMA(0, 0, At, B0); PG8_BAR; PG8_SCHED;
            PG8_LDB(B1, 0, 1); PG8_STAGE(PG8_SB(0, 0), b2, voffB);
            PG8_BAR; PG8_WAIT_L(0); PG8_MMA(0, 1, At, B1); PG8_BAR;
            PG8_LDA(At, 0, 1); PG8_STAGE(PG8_SA(0, 0), a2, voffA);
            PG8_BAR; PG8_WAIT_L(0); PG8_MMA(1, 0, At, B0); PG8_BAR; PG8_SCHED;
            PG8_STAGE(PG8_SB(0, 1), b2 + hstep, voffB);
            PG8_WAIT_V(6); PG8_BAR; PG8_MMA(1, 1, At, B1); PG8_BAR;
            PG8_LDB(B0, 1, 0); PG8_SCHED; PG8_LDA(At, 1, 0); PG8_STAGE(PG8_SA(0, 1), a2 + hstep, voffA);
            PG8_WAIT_L(8); PG8_BAR; PG8_WAIT_L(0); PG8_MMA(0, 0, At, B0); PG8_BAR; PG8_SCHED;
            PG8_LDB(B1, 1, 1); PG8_STAGE(PG8_SB(1, 0), b3, voffB);
            PG8_BAR; PG8_WAIT_L(0); PG8_MMA(0, 1, At, B1); PG8_BAR;
            PG8_LDA(At, 1, 1); PG8_STAGE(PG8_SA(1, 0), a3, voffA);
            PG8_BAR; PG8_WAIT_L(0); PG8_MMA(1, 0, At, B0); PG8_BAR; PG8_SCHED;
            PG8_STAGE(PG8_SB(1, 1), b3 + hstep, voffB);
            PG8_WAIT_V(6); PG8_BAR; PG8_MMA(1, 1, At, B1); PG8_BAR;
            }
        }
        if constexpr (ALIGN_EPI) { if (wr == 0) PG8_BAR; }
        if constexpr (!Epi::AFTER_DRAIN) { E(acc, cur, wr, wc, fr, fq); S.done(cur); }
        if (!has_next) break;
#pragma unroll
        for (int a = 0; a < 2; ++a)
#pragma unroll
            for (int b = 0; b < 2; ++b)
#pragma unroll
                for (int m = 0; m < 4; ++m)
#pragma unroll
                    for (int n = 0; n < 2; ++n) acc[a][b][m][n] = (f32x4){0.f, 0.f, 0.f, 0.f};
        cur = nxt; cA = nA; cB = nB; ++ui;
        if constexpr (ALIGN_EPI) { if (wr == 1) PG8_BAR; }
    }
    PG8_WAIT_V(0);
    if constexpr (!ALIGN_EPI) { if (wr == 0) PG8_BAR; }
    PG8_BAR;
    if constexpr (Epi::AFTER_DRAIN) { E.fused(acc, cur, wr, wc, fr, fq, lds, wid, lane); S.done(cur); }
#undef PG8_SA
#undef PG8_SB
#undef PG8_STAGE
#undef PG8_LDA
#undef PG8_LDB
#undef PG8_MMA
#undef PG8_WAIT_V
#undef PG8_WAIT_L
#undef PG8_BAR
#undef PG8_SCHED
}
}
typedef __bf16 bf16x2_t __attribute__((ext_vector_type(2)));
typedef float f32x2_t __attribute__((ext_vector_type(2)));
typedef short bf16x8 __attribute__((ext_vector_type(8)));
typedef float f32x16 __attribute__((ext_vector_type(16)));
#define MFMA32(a, b, c) __builtin_amdgcn_mfma_f32_32x32x16_bf16((a), (b), (c), 0, 0, 0)
__device__ __forceinline__ unsigned pkbf(float a, float b) { bf16x2_t v = __builtin_convertvector((f32x2_t){a, b}, bf16x2_t); return __builtin_bit_cast(unsigned, v); }
__device__ __forceinline__ bf16x8 pack8(const f32x16& x, int s) { v4u p; p.x = pkbf(x[8 * s], x[8 * s + 1]); p.y = pkbf(x[8 * s + 2], x[8 * s + 3]); p.z = pkbf(x[8 * s + 4], x[8 * s + 5]); p.w = pkbf(x[8 * s + 6], x[8 * s + 7]); return __builtin_bit_cast(bf16x8, p); }
__device__ __forceinline__ f32x16 zero16() { f32x16 z;
#pragma unroll
    for (int i = 0; i < 16; ++i) z[i] = 0.f; return z; }
constexpr int CHUNK = 64, NCH = SEQ / CHUNK;
constexpr float QSCALE = 0.08838834764831845f;
__device__ __forceinline__ void glds_blocks(LAS unsigned char* dst, const unsigned char* src, int nblk, int wv, int nw, int lane) {
    for (int b = wv; b < nblk; b += nw)
        __builtin_amdgcn_global_load_lds((const unsigned*)(src + (size_t)b * 1024 + lane * 16), (LAS unsigned*)(dst + b * 1024), 16, 0, 0);
}
__device__ __forceinline__ bf16x8 lds_frag(const LAS unsigned char* base, int blk, int lane) { return *(const LAS bf16x8*)(base + blk * 1024 + lane * 16); }

namespace gdn {
constexpr int B_KA = 0, B_QA = 16384, B_SC = 32768, B_KT = 34816, B_TBF = 51200, B_AF = 59392, B_TBB = 67584, B_AB = 75776, B_VT = 83968, BLOB = 100352;
constexpr int XBLK = 34, YBLK = 32;
}

__device__ __forceinline__ float row16_sum(float v) {
    v += __builtin_bit_cast(float, __builtin_amdgcn_mov_dpp(__builtin_bit_cast(int, v), 0xB1, 0xF, 0xF, true));
    v += __builtin_bit_cast(float, __builtin_amdgcn_mov_dpp(__builtin_bit_cast(int, v), 0x4E, 0xF, 0xF, true));
    v += __builtin_bit_cast(float, __builtin_amdgcn_mov_dpp(__builtin_bit_cast(int, v), 0x141, 0xF, 0xF, true));
    v += __builtin_bit_cast(float, __builtin_amdgcn_mov_dpp(__builtin_bit_cast(int, v), 0x140, 0xF, 0xF, true));
    return v;
}
__device__ __forceinline__ float quad_sum(float v) {
    v += __builtin_bit_cast(float, __builtin_amdgcn_mov_dpp(__builtin_bit_cast(int, v), 0xB1, 0xF, 0xF, true));
    v += __builtin_bit_cast(float, __builtin_amdgcn_mov_dpp(__builtin_bit_cast(int, v), 0x4E, 0xF, 0xF, true));
    return v;
}
struct GdnPrepArgs {
    const bf16 *pq, *pk, *pv;
    const float* small;
    const float* conv_w;
    const float *a_log_f, *a_log_b, *dtb_f, *dtb_b;
    unsigned char* blob;
    int nseq, pad_;
};
namespace gdn {
constexpr int L_PRE = 0, L_QN = 52224, L_KN = L_QN + 17408, L_SC = L_KN + 17408, L_LPF = L_SC + 1024, L_LPB = L_LPF + 16384, L_AF = L_LPB + 16384, L_AB = L_AF + 9216, L_TBF = L_AB + 9216, L_TBB = L_TBF + 9216, L_END = L_TBB + 9216;
static_assert(L_END <= 160 * 1024 - 256, "gdn prep LDS");
constexpr int QS_ = 272, AS_ = 144;

__device__ __forceinline__ v4u frag_rm_perm(const LAS unsigned char* img, int st, int rt, int ks, int lane) {
    const int r = lane & 31, hh = lane >> 5; const LAS unsigned char* p = img + (32 * rt + r) * st + (16 * ks + 4 * hh) * 2;
    const v2u lo = *(const LAS v2u*)p, hi = *(const LAS v2u*)(p + 16);
    return (v4u){lo.x, lo.y, hi.x, hi.y};
}
__device__ __forceinline__ v4u frag_tr_perm(const LAS unsigned char* img, int st, int rt, int ks, int lane) {
    const int r = lane & 31, hh = lane >> 5; const LAS unsigned char* p = img + (16 * ks + 4 * hh) * st + (32 * rt + r) * 2;
    unsigned short e[8];
#pragma unroll
    for (int j = 0; j < 8; ++j) e[j] = *(const LAS unsigned short*)(p + (8 * (j >> 2) + (j & 3)) * st);
    return (v4u){(unsigned)e[0] | ((unsigned)e[1] << 16), (unsigned)e[2] | ((unsigned)e[3] << 16), (unsigned)e[4] | ((unsigned)e[5] << 16), (unsigned)e[6] | ((unsigned)e[7] << 16)};
}
__device__ __forceinline__ v4u frag16_rm(const LAS unsigned char* img, int st, int rt, int ks, int lane) {
    const int r = lane & 15, q = lane >> 4; const LAS unsigned char* p = img + (16 * rt + r) * st + (32 * ks + 4 * q) * 2;
    const v2u lo = *(const LAS v2u*)p, hi = *(const LAS v2u*)(p + 32);
    return (v4u){lo.x, lo.y, hi.x, hi.y};
}
__device__ __forceinline__ v4u frag16_tr(const LAS unsigned char* img, int st, int rt, int ks, int lane) {
    const int r = lane & 15, q = lane >> 4; const LAS unsigned char* p = img + (32 * ks + 4 * q) * st + (16 * rt + r) * 2;
    unsigned short e[8];
#pragma unroll
    for (int j = 0; j < 8; ++j) e[j] = *(const LAS unsigned short*)(p + (16 * (j >> 2) + (j & 3)) * st);
    return (v4u){(unsigned)e[0] | ((unsigned)e[1] << 16), (unsigned)e[2] | ((unsigned)e[3] << 16), (unsigned)e[4] | ((unsigned)e[5] << 16), (unsigned)e[6] | ((unsigned)e[7] << 16)};
}
}

#define LBAR() do { asm volatile("s_waitcnt lgkmcnt(0)" ::: "memory"); __builtin_amdgcn_s_barrier(); asm volatile("" ::: "memory"); } while (0)
__device__ __forceinline__ void gdn_prep_issue(LAS unsigned char* lds, const GdnPrepArgs& A, int unit, int w, int lane, const unsigned char* zero_page) {
    using namespace gdn;
    const int n = unit % NCH, h = (unit / NCH) % 8, sq = unit / (NCH * 8); const size_t row0 = (size_t)sq * SEQ; const int t0 = n * CHUNK;
    for (int q4 = w; q4 < 51; q4 += 8) {
        const int seg = q4 * 4 + (lane >> 4), r = seg / 3, m = seg % 3, tl = t0 - 2 + r;
        const bf16* pmat = A.pq + (size_t)m * (size_t)(A.pk - A.pq);
        const unsigned char* src = (tl >= 0 && tl < SEQ) ? (const unsigned char*)(pmat + (row0 + tl) * 1024 + h * 128) : zero_page;
        __builtin_amdgcn_global_load_lds((const unsigned*)(src + (lane & 15) * 16), (LAS unsigned*)(lds + L_PRE + q4 * 1024), 16, 0, 0);
    }
}
__device__ __forceinline__ f32x4 gdn_prep_scal(const GdnPrepArgs& A, int unit, int lane) {
    const int n = unit % NCH, h = (unit / NCH) % 8, sq = unit / (NCH * 8);
    const float* sm = A.small + ((size_t)sq * SEQ + n * CHUNK + lane) * 64;
    return (f32x4){sm[h], sm[8 + h], sm[16 + h], sm[24 + h]};
}
__device__ __forceinline__ void gdn_prep_phase(LAS unsigned char* lds, const GdnPrepArgs& A, int bid, int G, const unsigned char* zero_page) {
    using namespace gdn;
    int tid_l = threadIdx.x; asm volatile("" : "+v"(tid_l));
    const int tid = tid_l, lane = tid & 63, w = __builtin_amdgcn_readfirstlane(tid >> 6);
    const int nunits = A.nseq * 8 * NCH; const int pflg = A.pad_;
    int unit = bid;
    f32x4 smn = (f32x4){0.f, 0.f, 0.f, 0.f};
    if (unit < nunits) { gdn_prep_issue(lds, A, unit, w, lane, zero_page); if (w == 0) smn = gdn_prep_scal(A, unit, lane); }
  for (; unit < nunits; unit += G) {
    const int h = (unit / NCH) % 8;
    unsigned char* blob = A.blob + (size_t)unit * BLOB;
    if (w == 0) {
        const float xf = smn.x + A.dtb_f[h], xb = smn.y + A.dtb_b[h];
        const float spf = xf > 20.f ? xf : log1pf(__expf(xf)), spb = xb > 20.f ? xb : log1pf(__expf(xb));
        const float gf = -__expf(A.a_log_f[h]) * spf, gb = -__expf(A.a_log_b[h]) * spb;
        float pf = gf, pb = gb;
#pragma unroll
        for (int o = 1; o < 64; o <<= 1) { const float yf = __shfl_up(pf, o), yb = __shfl_up(pb, o); if (lane >= o) { pf += yf; pb += yb; } }
        const float totb = __shfl(pb, 63);
        const float gcf = pf, gcb = totb - pb + gb;
        LAS float* sc = (LAS float*)(lds + L_SC);
        sc[lane] = gcf; sc[64 + lane] = gcb; sc[128 + lane] = sigmoidf_(smn.z); sc[192 + lane] = sigmoidf_(smn.w);
        float* gsc = (float*)(blob + B_SC); if (pflg & 8) gsc = (float*)(lds + L_LPF);
        const float glf = __shfl(pf, 63), glb = totb;
        gsc[lane] = gcf; gsc[64 + lane] = gcb; gsc[128 + lane] = __expf(gcf); gsc[192 + lane] = __expf(gcb); gsc[256 + lane] = __expf(glf - gcf); gsc[320 + lane] = __expf(glb - gcb);
        if (lane < 2) gsc[384 + lane] = __expf(lane ? glb : glf);
    }
    __syncthreads();
    if (!(pflg & 32)) {
        const int p0 = 8 * w;
#pragma unroll
        for (int m = 0; m < 3; ++m) {
            float wc[5][2];
#pragma unroll
            for (int tau = 0; tau < 5; ++tau) { const f32x2_t t2 = *(const f32x2_t*)(A.conv_w + tau * 3072 + m * 1024 + h * 128 + 2 * lane); wc[tau][0] = t2.x; wc[tau][1] = t2.y; }
            float in[12][2];
#pragma unroll
            for (int i = 0; i < 12; ++i) { const unsigned u = *(const LAS unsigned*)(lds + L_PRE + ((p0 + i) * 3 + m) * 256 + lane * 4); in[i][0] = bflo(u); in[i][1] = bfhi(u); }
            float y[8][2];
#pragma unroll
            for (int pp = 0; pp < 8; ++pp)
#pragma unroll
                for (int c = 0; c < 2; ++c) { float s = 0.f;
#pragma unroll
                    for (int tau = 0; tau < 5; ++tau) s += wc[tau][c] * in[pp + tau][c];
                    y[pp][c] = s * __builtin_amdgcn_rcpf(1.0f + __builtin_amdgcn_exp2f(-1.4426950408889634f * s)); }
            if (m < 2) {
#pragma unroll
                for (int pp = 0; pp < 8; ++pp) { float ss = row16_sum(y[pp][0] * y[pp][0] + y[pp][1] * y[pp][1]); ss += __shfl_xor(ss, 16); ss += __shfl_xor(ss, 32); const float rn = __builtin_amdgcn_rsqf(ss + EPS);
                    *(LAS unsigned*)(lds + (m == 0 ? L_QN : L_KN) + (p0 + pp) * QS_ + lane * 4) = pkbf(y[pp][0] * rn, y[pp][1] * rn); }
            } else {
#pragma unroll
                for (int c = 0; c < 2; ++c) { v4u o; o.x = pkbf(y[0][c], y[1][c]); o.y = pkbf(y[2][c], y[3][c]); o.z = pkbf(y[4][c], y[5][c]); o.w = pkbf(y[6][c], y[7][c]);
                    if (!(pflg & 8)) *(v4u*)(blob + B_VT + (2 * lane + c) * 128 + p0 * 2) = o; }
            }
        }
    }
    __syncthreads();
    { const int un = unit + G; if (un < nunits) { gdn_prep_issue(lds, A, un, w, lane, zero_page); if (w == 0) smn = gdn_prep_scal(A, un, lane); } }
    {
        const int which = w >> 2, rt = (w >> 1) & 1, ct = w & 1, r = lane & 31, hh = lane >> 5;
        const LAS unsigned char* ia = lds + (which ? L_QN : L_KN) + (32 * rt + r) * QS_ + 16 * hh;
        const LAS unsigned char* ib = lds + L_KN + (32 * ct + r) * QS_ + 16 * hh;
        f32x16 acc = zero16();
#pragma unroll
        for (int ks = 0; ks < 8; ++ks) acc = MFMA32(*(const LAS bf16x8*)(ia + 32 * ks), *(const LAS bf16x8*)(ib + 32 * ks), acc);
        const LAS float* sc = (const LAS float*)(lds + L_SC);
        const int j = 32 * ct + r; const float gfj = sc[j], gbj = sc[64 + j];
#pragma unroll
        for (int reg = 0; reg < 16; ++reg) {
            const int i = 32 * rt + (reg & 3) + 8 * (reg >> 2) + 4 * hh; const float val = acc[reg];
            const float ef = __expf(sc[i] - gfj), eb = __expf(sc[64 + i] - gbj);
            if (which == 0) {
                const float lf = (i > j) ? sc[128 + i] * val * ef : 0.f, lb = (i < j) ? sc[192 + i] * val * eb : 0.f;
                ((LAS float*)(lds + L_LPF))[i * 64 + (j & 3) * 16 + (j >> 2)] = lf;
                const int i2 = 63 - i, j2 = 63 - j;
                ((LAS float*)(lds + L_LPB))[i2 * 64 + (j2 & 3) * 16 + (j2 >> 2)] = lb;
            } else {
                const float af = (i >= j) ? QSCALE * val * ef : 0.f, ab = (i <= j) ? QSCALE * val * eb : 0.f;
                *(LAS unsigned short*)(lds + L_AF + i * AS_ + j * 2) = (unsigned short)(pkbf(af, 0.f) & 0xffffu);
                *(LAS unsigned short*)(lds + L_AB + i * AS_ + j * 2) = (unsigned short)(pkbf(ab, 0.f) & 0xffffu);
            }
        }
    }
    LBAR();
    if (!(pflg & 16)) {
        const int dir = w >> 2, li = (w & 3) * 64 + lane, j = li >> 2, q = li & 3;
        const LAS float* LP = (const LAS float*)(lds + (dir ? L_LPB : L_LPF)) + q * 16;
        float t[16];
#pragma unroll
        for (int a = 0; a < 16; ++a) t[a] = 0.f;
#pragma unroll
        for (int i = 0; i < 64; ++i) {
            float p = 0.f;
#pragma unroll
            for (int a4 = 0; a4 < (i + 15) / 16; ++a4) { const f32x4 lv = *(const LAS f32x4*)(LP + i * 64 + 4 * a4);
                p += lv.x * t[4 * a4] + lv.y * t[4 * a4 + 1] + lv.z * t[4 * a4 + 2] + lv.w * t[4 * a4 + 3]; }
            p = quad_sum(p);
            const float ti = (i == j ? 1.f : 0.f) - p;
            if (q == (i & 3)) t[i >> 2] = ti;
        }
        const LAS float* sc = (const LAS float*)(lds + L_SC);
        if (dir == 0) { const float bj = sc[128 + j];
#pragma unroll
            for (int a = 0; a < 16; ++a) *(LAS unsigned short*)(lds + L_TBF + (4 * a + q) * AS_ + j * 2) = (unsigned short)(pkbf(t[a] * bj, 0.f) & 0xffffu);
        } else { const int jo = 63 - j; const float bj = sc[192 + jo];
#pragma unroll
            for (int a = 0; a < 16; ++a) *(LAS unsigned short*)(lds + L_TBB + (63 - (4 * a + q)) * AS_ + jo * 2) = (unsigned short)(pkbf(t[a] * bj, 0.f) & 0xffffu);
        }
    }
    LBAR();
    if (!(pflg & 64)) for (int blk = w; blk < 80; blk += 8) {
        v4u f; int off;
        if (blk < 16)      { f = frag16_rm(lds + L_KN, QS_, blk >> 2, blk & 3, lane); off = B_KA + blk * 1024; }
        else if (blk < 32) { const int b = blk - 16; f = frag16_rm(lds + L_QN, QS_, b >> 2, b & 3, lane); off = B_QA + b * 1024; }
        else if (blk < 48) { const int b = blk - 32; f = frag16_tr(lds + L_KN, QS_, b >> 1, b & 1, lane); off = B_KT + b * 1024; }
        else { const int b = blk - 48, wh = b >> 3, bb = b & 7; const int lo = wh == 0 ? L_TBF : wh == 1 ? L_AF : wh == 2 ? L_TBB : L_AB;
               f = frag16_rm(lds + lo, AS_, bb >> 1, bb & 1, lane); off = B_TBF + b * 1024; }
        if (!(pflg & 8)) *(v4u*)(blob + off + lane * 16) = f; else asm volatile("" :: "v"(f));
    }
    LBAR();
  }
}
struct GdnChainArgs {
    const unsigned char* blob;
    unsigned char* stg;
    unsigned* flag;
    int nseq, flags;
};
namespace gdn { constexpr int C_Y = XBLK * 1024, C_BUF = C_Y + YBLK * 1024, C_END = 2 * C_BUF; }
#define CHAIN_SPIN_CAP (1u << 22)
#define MFMA16(a, b, c) __builtin_amdgcn_mfma_f32_16x16x32_bf16((a), (b), (c), 0, 0, 0)
__device__ __forceinline__ bf16x8 pack16(const f32x4& a, const f32x4& b) { v4u p; p.x = pkbf(a.x, a.y); p.y = pkbf(a.z, a.w); p.z = pkbf(b.x, b.y); p.w = pkbf(b.z, b.w); return __builtin_bit_cast(bf16x8, p); }

__device__ __forceinline__ void gdn_chain_unit(LAS unsigned char* lds, const GdnChainArgs& A, int item) {
    using namespace gdn;
    int tid_l = threadIdx.x; asm volatile("" : "+v"(tid_l));
    const int tid = tid_l, lane = tid & 63, w = __builtin_amdgcn_readfirstlane(tid >> 6);
    const int r = lane & 15, q = lane >> 4;
    const int c = item & 1, h = (item >> 1) & 7, sq = item >> 4; const int flags = A.flags;
    const size_t unit0 = (size_t)(sq * 8 + h) * NCH;
    const f32x4 z4 = (f32x4){0.f, 0.f, 0.f, 0.f};
    f32x4 S[8];
#pragma unroll
    for (int t = 0; t < 8; ++t) S[t] = z4;
    v2u vnext[4];
    unsigned long long pwn[4]; bool have = false; unsigned fnext = 0u;
#define GDN_ISSUE(s_, buf_) do { const int n_ = c ? NCH - 1 - (s_) : (s_); const unsigned char* bl_ = A.blob + (unit0 + n_) * BLOB; LAS unsigned char* d_ = lds + (buf_) * C_BUF; \
        { const unsigned char* vp_ = bl_ + B_VT + (16 * w + r) * 128 + 8 * q; _Pragma("unroll") for (int i = 0; i < 4; ++i) vnext[i] = *(const v2u*)(vp_ + 32 * i); } \
        if (!(flags & 4)) { glds_blocks(d_, bl_, XBLK, w, 8, lane); \
            if (c == 0) glds_blocks(d_ + C_Y, bl_ + B_KT, YBLK, w, 8, lane); \
            else { glds_blocks(d_ + C_Y, bl_ + B_KT, 16, w, 8, lane); glds_blocks(d_ + C_Y + 16384, bl_ + B_TBB, 16, w, 8, lane); } } } while (0)
    GDN_ISSUE(0, 0);
    __syncthreads();
    for (int s = 0; s < NCH; ++s) {
        const int n = c ? NCH - 1 - s : s;
        v2u vcur[4];
#pragma unroll
        for (int i = 0; i < 4; ++i) vcur[i] = vnext[i];
        unsigned long long* sp = (unsigned long long*)(A.stg + (unit0 + n) * 16384 + w * 2048) + lane;
        unsigned* fl = A.flag + (unit0 + n) * 8 + w;
        unsigned long long pw[4];
        if (s >= NCH / 2 && !(flags & 1)) {
            if (have) {
#pragma unroll
                for (int i = 0; i < 4; ++i) pw[i] = pwn[i];
            } else {
                for (unsigned sp_ = 0; __builtin_amdgcn_readfirstlane((int)__hip_atomic_load(fl, __ATOMIC_RELAXED, __HIP_MEMORY_SCOPE_AGENT)) == 0 && sp_ < CHAIN_SPIN_CAP; ++sp_) __builtin_amdgcn_s_sleep(2);
#pragma unroll
                for (int i = 0; i < 4; ++i) pw[i] = __hip_atomic_load(sp + i * 64, __ATOMIC_RELAXED, __HIP_MEMORY_SCOPE_AGENT);
            }
        }
        have = false;
        if (s + 1 >= NCH / 2 && s + 1 < NCH && !(flags & 1) && __builtin_amdgcn_readfirstlane((int)fnext) != 0) {
            const int n1 = c ? NCH - 2 - s : s + 1; const unsigned long long* sp1 = (const unsigned long long*)(A.stg + (unit0 + n1) * 16384 + w * 2048) + lane;
#pragma unroll
            for (int i = 0; i < 4; ++i) pwn[i] = __hip_atomic_load(sp1 + i * 64, __ATOMIC_RELAXED, __HIP_MEMORY_SCOPE_AGENT);
            have = true;
        }
        if (s + 2 >= NCH / 2 && s + 2 < NCH && !(flags & 1)) { const int n2 = c ? NCH - 3 - s : s + 2; fnext = __hip_atomic_load(A.flag + (unit0 + n2) * 8 + w, __ATOMIC_RELAXED, __HIP_MEMORY_SCOPE_AGENT); }
        if (s + 1 < NCH) GDN_ISSUE(s + 1, (s + 1) & 1);
        const LAS unsigned char* X = lds + (s & 1) * C_BUF; const LAS unsigned char* Y = X + C_Y; const LAS unsigned char* YT = Y + 16384;
        const LAS float* sc = (const LAS float*)(X + B_SC);
        bf16x8 sb[4];
#pragma unroll
        for (int k = 0; k < 4; ++k) sb[k] = pack16(S[2 * k], S[2 * k + 1]);
        f32x4 KS[4], QS[4];
#pragma unroll
        for (int rt = 0; rt < 4; ++rt) { KS[rt] = z4; QS[rt] = z4; }
        {
            constexpr int R = 8; bf16x8 ring[R];
#define G1_LD(i_) lds_frag(X + (((i_) & 1) ? B_QA : B_KA), ((i_) >> 3) * 4 + (((i_) >> 1) & 3), lane)
#pragma unroll
            for (int i = 0; i < R; ++i) ring[i] = G1_LD(i);
#pragma unroll
            for (int i = 0; i < 32; ++i) { const int rt = i >> 3, ks = (i >> 1) & 3;
                if (i & 1) QS[rt] = MFMA16(ring[i % R], sb[ks], QS[rt]); else KS[rt] = MFMA16(ring[i % R], sb[ks], KS[rt]);
                if (i + R < 32) ring[i % R] = G1_LD(i + R);
                __builtin_amdgcn_sched_barrier(0); }
#undef G1_LD
        }
#pragma unroll
        for (int rt = 0; rt < 4; ++rt) { const v2u vv = vcur[rt]; const f32x4 ev = *(const LAS f32x4*)(sc + 128 + c * 64 + 16 * rt + 4 * q);
            KS[rt].x = bflo(vv.x) - ev.x * KS[rt].x; KS[rt].y = bfhi(vv.x) - ev.y * KS[rt].y; KS[rt].z = bflo(vv.y) - ev.z * KS[rt].z; KS[rt].w = bfhi(vv.y) - ev.w * KS[rt].w; }
        bf16x8 rb[2] = {pack16(KS[0], KS[1]), pack16(KS[2], KS[3])};
        f32x4 vn[4];
#pragma unroll
        for (int rt = 0; rt < 4; ++rt) vn[rt] = z4;
        {   constexpr int R = 8; bf16x8 ring[R];
#pragma unroll
            for (int i = 0; i < R; ++i) ring[i] = lds_frag(YT, i, lane);
#pragma unroll
            for (int i = 0; i < 8; ++i) { vn[i >> 1] = MFMA16(ring[i], rb[i & 1], vn[i >> 1]); __builtin_amdgcn_sched_barrier(0); }
        }
        bf16x8 vb[2] = {pack16(vn[0], vn[1]), pack16(vn[2], vn[3])};
        f32x4 (&o)[4] = QS;
#pragma unroll
        for (int rt = 0; rt < 4; ++rt) { const f32x4 ev = *(const LAS f32x4*)(sc + 128 + c * 64 + 16 * rt + 4 * q);
            o[rt].x *= QSCALE * ev.x; o[rt].y *= QSCALE * ev.y; o[rt].z *= QSCALE * ev.z; o[rt].w *= QSCALE * ev.w; }
        {   constexpr int R = 8; bf16x8 ring[R];
#pragma unroll
            for (int i = 0; i < R; ++i) ring[i] = lds_frag(YT + 8192, i, lane);
#pragma unroll
            for (int i = 0; i < 8; ++i) { o[i >> 1] = MFMA16(ring[i], vb[i & 1], o[i >> 1]); __builtin_amdgcn_sched_barrier(0); }
        }
        if (!(flags & 1)) {
            if (s < NCH / 2) {
#pragma unroll
                for (int rt = 0; rt < 4; ++rt) __hip_atomic_store(sp + rt * 64, (unsigned long long)pkbf(o[rt].x, o[rt].y) | ((unsigned long long)pkbf(o[rt].z, o[rt].w) << 32), __ATOMIC_RELAXED, __HIP_MEMORY_SCOPE_AGENT);
            } else {
#pragma unroll
                for (int rt = 0; rt < 4; ++rt) { const unsigned plo = (unsigned)pw[rt], phi = (unsigned)(pw[rt] >> 32);
                    __hip_atomic_store(sp + rt * 64, (unsigned long long)pkbf(o[rt].x + bflo(plo), o[rt].y + bfhi(plo)) | ((unsigned long long)pkbf(o[rt].z + bflo(phi), o[rt].w + bfhi(phi)) << 32), __ATOMIC_RELAXED, __HIP_MEMORY_SCOPE_AGENT); }
            }
        }
#pragma unroll
        for (int rt = 0; rt < 4; ++rt) { const f32x4 ev = *(const LAS f32x4*)(sc + 256 + c * 64 + 16 * rt + 4 * q);
            vn[rt].x *= ev.x; vn[rt].y *= ev.y; vn[rt].z *= ev.z; vn[rt].w *= ev.w; }
        vb[0] = pack16(vn[0], vn[1]); vb[1] = pack16(vn[2], vn[3]);
        const float egl = sc[384 + c];
#pragma unroll
        for (int t = 0; t < 8; ++t) { S[t].x *= egl; S[t].y *= egl; S[t].z *= egl; S[t].w *= egl; }
        {   constexpr int R = 8; bf16x8 ring[R];
#pragma unroll
            for (int i = 0; i < R; ++i) ring[i] = lds_frag(Y, i, lane);
#pragma unroll
            for (int i = 0; i < 16; ++i) { S[i >> 1] = MFMA16(ring[i % R], vb[i & 1], S[i >> 1]); if (i + R < 16) ring[i % R] = lds_frag(Y, i + R, lane); __builtin_amdgcn_sched_barrier(0); }
        }
        if (!(flags & 1)) { asm volatile("s_waitcnt vmcnt(0)" ::: "memory"); if (lane == 0) __hip_atomic_store(fl, s < NCH / 2 ? 1u : 2u, __ATOMIC_RELAXED, __HIP_MEMORY_SCOPE_AGENT); }
        __syncthreads();
    }
#undef GDN_ISSUE
}
namespace gla {
constexpr int B_QGF = 0, B_QGB = 16384, B_SC = 32768, B_KDTF = 33792, B_KDTB = 50176, BLOBA = 66560;
constexpr int B_VB = 0, B_INTRA = 32768, BLOBB = 65536;
constexpr int L_R = 0, L_QGF = 8192, L_KGF = L_QGF + 17408, L_KDF = L_KGF + 17408, L_QGB = L_KDF + 17408, L_KGB = L_QGB + 17408, L_KDB = L_KGB + 17408, L_V = L_KDB + 17408, L_TOT = L_V + 33792, L_AS = L_TOT + 4096, L_END = L_AS + 9216;
static_assert(L_END <= 160 * 1024 - 256, "gla prep LDS");
constexpr int QS_ = 272, VS_ = 528, AS_ = 144;
constexpr int C_X = 0, C_Y = 17408, C_CHAIN = 66560, C_EG = 2 * C_CHAIN, C_END = C_EG + 1024;
__device__ __forceinline__ v4u frag_tr_nat(const LAS unsigned char* img, int st, int colbase, int ks, int lane) {
    const int r = lane & 31, hh = lane >> 5; const LAS unsigned char* p = img + (16 * ks + 8 * hh) * st + (colbase + r) * 2;
    unsigned short e[8];
#pragma unroll
    for (int j = 0; j < 8; ++j) e[j] = *(const LAS unsigned short*)(p + j * st);
    return (v4u){(unsigned)e[0] | ((unsigned)e[1] << 16), (unsigned)e[2] | ((unsigned)e[3] << 16), (unsigned)e[4] | ((unsigned)e[5] << 16), (unsigned)e[6] | ((unsigned)e[7] << 16)};
}
__device__ __forceinline__ float logsig2(float x) { const float xc = fminf(fmaxf(x, -60.f), 60.f); return -__builtin_amdgcn_logf(1.0f + __builtin_amdgcn_exp2f(-1.4426950408889634f * xc)); }
}

struct GlaPrepArgs {
    const bf16* qk;
    const bf16* vb;
    const float* small;
    const float *w2f, *b2f, *w2b, *b2b;
    unsigned char* blobA;
    unsigned char* blobB;
    int nseq, pad_;
};

__device__ __forceinline__ void gla_prep_phase(LAS unsigned char* lds, const GlaPrepArgs& A, int bid, int G) {
    using namespace gla;
    int tid_l = threadIdx.x; asm volatile("" : "+v"(tid_l));
    const int tid = tid_l, lane = tid & 63, w = __builtin_amdgcn_readfirstlane(tid >> 6);
    const int nunits = A.nseq * 4 * NCH;
    f32x4 pr; v4u pv[4], pq[2], pk[2];
#define GLA_PREFETCH(u_) do { const int n_ = (u_) % NCH, h_ = ((u_) / NCH) % 4, sq_ = (u_) / (NCH * 4); const size_t r_ = (size_t)sq_ * SEQ + n_ * CHUNK; \
        pr = *(const f32x4*)(A.small + (r_ + (tid >> 3)) * 64 + 32 + (tid & 7) * 4); \
        _Pragma("unroll") for (int i = 0; i < 4; ++i) { const int id = i * 512 + tid; pv[i] = *(const v4u*)(A.vb + (r_ + (id >> 5)) * 1024 + h_ * 256 + (id & 31) * 8); } \
        _Pragma("unroll") for (int i = 0; i < 2; ++i) { const int id = i * 512 + tid; const bf16* qp_ = A.qk + (r_ + (id >> 4)) * 1024 + h_ * 128 + (id & 15) * 8; pq[i] = *(const v4u*)qp_; pk[i] = *(const v4u*)(qp_ + 512); } } while (0)
    int unit = bid;
    if (unit < nunits) GLA_PREFETCH(unit);
  for (; unit < nunits; unit += G) {
    const int h = (unit / NCH) % 4;
    unsigned char* blob = A.blobA + (size_t)unit * BLOBA; unsigned char* blobB = A.blobB + (size_t)unit * BLOBB;
    *(LAS f32x4*)(lds + L_R + (tid >> 3) * 128 + (tid & 7) * 16) = pr;
#pragma unroll
    for (int i = 0; i < 4; ++i) { const int id = i * 512 + tid; *(LAS v4u*)(lds + L_V + (id >> 5) * VS_ + (id & 31) * 16) = pv[i]; }
#pragma unroll
    for (int i = 0; i < 2; ++i) { const int id = i * 512 + tid; *(LAS v4u*)(lds + L_QGF + (id >> 4) * QS_ + (id & 15) * 16) = pq[i]; *(LAS v4u*)(lds + L_KGF + (id >> 4) * QS_ + (id & 15) * 16) = pk[i]; }
    LBAR();
    {
        const int dd = tid & 127, pg = tid >> 7, d = h * 128 + dd;
        float wf[16], wb[16];
#pragma unroll
        for (int i = 0; i < 16; ++i) { wf[i] = A.w2f[i * 512 + d]; wb[i] = A.w2b[i * 512 + d]; }
        const float bf_ = A.b2f[d], bb_ = A.b2b[d];
        float lf[16], lb[16];
#pragma unroll
        for (int pp = 0; pp < 16; ++pp) {
            const LAS float* rr = (const LAS float*)(lds + L_R) + (pg * 16 + pp) * 32;
            float xf = bf_, xb = bb_;
#pragma unroll
            for (int i4 = 0; i4 < 4; ++i4) { const f32x4 a = *(const LAS f32x4*)(rr + 4 * i4), b = *(const LAS f32x4*)(rr + 16 + 4 * i4);
                xf += a.x * wf[4 * i4] + a.y * wf[4 * i4 + 1] + a.z * wf[4 * i4 + 2] + a.w * wf[4 * i4 + 3];
                xb += b.x * wb[4 * i4] + b.y * wb[4 * i4 + 1] + b.z * wb[4 * i4 + 2] + b.w * wb[4 * i4 + 3]; }
            lf[pp] = logsig2(xf) * (1.f / 16.f); lb[pp] = logsig2(xb) * (1.f / 16.f);
        }
#pragma unroll
        for (int pp = 1; pp < 16; ++pp) lf[pp] += lf[pp - 1];
#pragma unroll
        for (int pp = 14; pp >= 0; --pp) lb[pp] += lb[pp + 1];
        LAS float* tot = (LAS float*)(lds + L_TOT);
        tot[pg * 128 + dd] = lf[15]; tot[512 + pg * 128 + dd] = lb[0];
        LBAR();
        float offf = 0.f, offb = 0.f, glf = 0.f, glb = 0.f;
#pragma unroll
        for (int g = 0; g < 4; ++g) { const float tf = tot[g * 128 + dd], tb = tot[512 + g * 128 + dd]; glf += tf; glb += tb; if (g < pg) offf += tf; if (g > pg) offb += tb; }
        const float eglf = __builtin_amdgcn_exp2f(glf), eglb = __builtin_amdgcn_exp2f(glb);
        if (pg == 0) { float* sc = (float*)(blob + B_SC); sc[dd] = eglf; sc[128 + dd] = eglb; }
#pragma unroll
        for (int pp = 0; pp < 16; ++pp) {
            const int o = (pg * 16 + pp) * QS_ + dd * 2;
            const float qv = bf2f(*(const LAS unsigned short*)(lds + L_QGF + o)) * QSCALE, kv = bf2f(*(const LAS unsigned short*)(lds + L_KGF + o));
            const float ef = __builtin_amdgcn_exp2f(lf[pp] + offf), eb = __builtin_amdgcn_exp2f(lb[pp] + offb);
            const float rf = __builtin_amdgcn_rcpf(ef), rb = __builtin_amdgcn_rcpf(eb);
            *(LAS unsigned short*)(lds + L_QGF + o) = (unsigned short)(pkbf(qv * ef, 0.f) & 0xffffu);
            *(LAS unsigned short*)(lds + L_KGF + o) = (unsigned short)(pkbf(kv * rf, 0.f) & 0xffffu);
            *(LAS unsigned short*)(lds + L_KDF + o) = (unsigned short)(pkbf(kv * rf * eglf, 0.f) & 0xffffu);
            *(LAS unsigned short*)(lds + L_QGB + o) = (unsigned short)(pkbf(qv * eb, 0.f) & 0xffffu);
            *(LAS unsigned short*)(lds + L_KGB + o) = (unsigned short)(pkbf(kv * rb, 0.f) & 0xffffu);
            *(LAS unsigned short*)(lds + L_KDB + o) = (unsigned short)(pkbf(kv * rb * eglb, 0.f) & 0xffffu);
        }
    }
    LBAR();
    { const int un = unit + G; if (un < nunits) GLA_PREFETCH(un); }
    if (w < 4) {
        const int rt = w >> 1, ct = w & 1, r = lane & 31, hh = lane >> 5;
        f32x16 af = zero16(), ab = zero16();
        if (rt >= ct) { const LAS unsigned char* ia = lds + L_QGF + (32 * rt + r) * QS_ + 16 * hh; const LAS unsigned char* ib = lds + L_KGF + (32 * ct + r) * QS_ + 16 * hh;
#pragma unroll
            for (int ks = 0; ks < 8; ++ks) af = MFMA32(*(const LAS bf16x8*)(ia + 32 * ks), *(const LAS bf16x8*)(ib + 32 * ks), af); }
        if (rt <= ct) { const LAS unsigned char* ia = lds + L_QGB + (32 * rt + r) * QS_ + 16 * hh; const LAS unsigned char* ib = lds + L_KGB + (32 * ct + r) * QS_ + 16 * hh;
#pragma unroll
            for (int ks = 0; ks < 8; ++ks) ab = MFMA32(*(const LAS bf16x8*)(ia + 32 * ks), *(const LAS bf16x8*)(ib + 32 * ks), ab); }
        const int j = 32 * ct + r;
#pragma unroll
        for (int reg = 0; reg < 16; ++reg) { const int i = 32 * rt + (reg & 3) + 8 * (reg >> 2) + 4 * hh;
            const float val = (i >= j ? af[reg] : 0.f) + (i <= j ? ab[reg] : 0.f);
            *(LAS unsigned short*)(lds + L_AS + i * AS_ + j * 2) = (unsigned short)(pkbf(val, 0.f) & 0xffffu); }
    } else {
        for (int blk = w - 4; blk < 64; blk += 4) {
            const int wh = blk >> 4, b = blk & 15; v4u f; int off;
            if (wh == 0)      { f = gdn::frag_rm_perm(lds + L_QGF, QS_, b >> 3, b & 7, lane); off = B_QGF; }
            else if (wh == 1) { f = gdn::frag_rm_perm(lds + L_QGB, QS_, b >> 3, b & 7, lane); off = B_QGB; }
            else if (wh == 2) { f = frag_tr_nat(lds + L_KDF, QS_, 32 * (b >> 2), b & 3, lane); off = B_KDTF; }
            else              { f = frag_tr_nat(lds + L_KDB, QS_, 32 * (b >> 2), b & 3, lane); off = B_KDTB; }
            *(v4u*)(blob + off + b * 1024 + lane * 16) = f;
        }
    }
    LBAR();
    {
        const int ct = w, r = lane & 31, hh = lane >> 5;
        f32x16 o[2] = {zero16(), zero16()};
#pragma unroll
        for (int ks = 0; ks < 4; ++ks) {
            const v4u fb = frag_tr_nat(lds + L_V, VS_, 32 * ct, ks, lane);
            *(v4u*)(blobB + B_VB + (ct * 4 + ks) * 1024 + lane * 16) = fb;
            const bf16x8 bfr = __builtin_bit_cast(bf16x8, fb);
#pragma unroll
            for (int rt = 0; rt < 2; ++rt) o[rt] = MFMA32(*(const LAS bf16x8*)(lds + L_AS + (32 * rt + r) * AS_ + (16 * ks + 8 * hh) * 2), bfr, o[rt]);
        }
        unsigned long long* ip = (unsigned long long*)(blobB + B_INTRA) + (size_t)ct * 512 + lane;
#pragma unroll
        for (int rt = 0; rt < 2; ++rt)
#pragma unroll
            for (int g = 0; g < 4; ++g) ip[(rt * 4 + g) * 64] = (unsigned long long)pkbf(o[rt][4 * g], o[rt][4 * g + 1]) | ((unsigned long long)pkbf(o[rt][4 * g + 2], o[rt][4 * g + 3]) << 32);
    }
    LBAR();
  }
#undef GLA_PREFETCH
}

struct GlaChainArgs {
    const unsigned char* blobA;
    const unsigned char* blobB;
    unsigned char* stg;
    unsigned* flag;
    int nseq, flags;
};
namespace gla { constexpr int CB_Y = 17408, CB_BUF = 66560, CB_END = 2 * CB_BUF; }
__device__ __forceinline__ void gla_chain_unit(LAS unsigned char* lds, const GlaChainArgs& A, int item) {
    using namespace gla;
    int tid_l = threadIdx.x; asm volatile("" : "+v"(tid_l));
    const int tid = tid_l, lane = tid & 63, w = __builtin_amdgcn_readfirstlane(tid >> 6);
    const int hh = lane >> 5;
    const int c = item & 1, h = (item >> 1) & 3, sq = item >> 3; const int flags = A.flags;
    const size_t unit0 = (size_t)(sq * 4 + h) * NCH;
    f32x16 S[4];
#pragma unroll
    for (int t = 0; t < 4; ++t) S[t] = zero16();
    unsigned long long pwn[8]; bool have = false; unsigned fnext = 0u;
#define GLA_ISSUE(s_, buf_) do { if (!(flags & 4)) { const int n_ = c ? NCH - 1 - (s_) : (s_); const unsigned char* bl_ = A.blobA + (unit0 + n_) * BLOBA; const unsigned char* bb_ = A.blobB + (unit0 + n_) * BLOBB; \
        LAS unsigned char* d_ = lds + (buf_) * CB_BUF; glds_blocks(d_, bl_ + (c ? B_QGB : B_QGF), 16, w, 8, lane); if (w == 7) glds_blocks(d_ + 16384, bl_ + B_SC, 1, 0, 1, lane); \
        glds_blocks(d_ + CB_Y, bl_ + (c ? B_KDTB : B_KDTF), 16, w, 8, lane); glds_blocks(d_ + CB_Y + 16384, bb_ + B_VB, 32, w, 8, lane); } } while (0)
    GLA_ISSUE(0, 0);
    __syncthreads();
    for (int s = 0; s < NCH; ++s) {
        const int n = c ? NCH - 1 - s : s;
        unsigned long long* sp = (unsigned long long*)(A.stg + (unit0 + n) * 32768) + (size_t)w * 512 + lane;
        unsigned* fl = A.flag + (unit0 + n) * 8 + w;
        unsigned long long pw[8];
        if (s >= NCH / 2 && !(flags & 1)) {
            if (have) {
#pragma unroll
                for (int i = 0; i < 8; ++i) pw[i] = pwn[i];
            } else {
                for (unsigned sp_ = 0; __builtin_amdgcn_readfirstlane((int)__hip_atomic_load(fl, __ATOMIC_RELAXED, __HIP_MEMORY_SCOPE_AGENT)) == 0 && sp_ < CHAIN_SPIN_CAP; ++sp_) __builtin_amdgcn_s_sleep(2);
#pragma unroll
                for (int i = 0; i < 8; ++i) pw[i] = __hip_atomic_load(sp + i * 64, __ATOMIC_RELAXED, __HIP_MEMORY_SCOPE_AGENT);
            }
        }
        have = false;
        if (s + 1 >= NCH / 2 && s + 1 < NCH && !(flags & 1) && __builtin_amdgcn_readfirstlane((int)fnext) != 0) {
            const int n1 = c ? NCH - 2 - s : s + 1; const unsigned long long* sp1 = (const unsigned long long*)(A.stg + (unit0 + n1) * 32768) + (size_t)w * 512 + lane;
#pragma unroll
            for (int i = 0; i < 8; ++i) pwn[i] = __hip_atomic_load(sp1 + i * 64, __ATOMIC_RELAXED, __HIP_MEMORY_SCOPE_AGENT);
            have = true;
        }
        if (s + 2 >= NCH / 2 && s + 2 < NCH && !(flags & 1)) { const int n2 = c ? NCH - 3 - s : s + 2; fnext = __hip_atomic_load(A.flag + (unit0 + n2) * 8 + w, __ATOMIC_RELAXED, __HIP_MEMORY_SCOPE_AGENT); }
        if (s + 1 < NCH) GLA_ISSUE(s + 1, (s + 1) & 1);
        const LAS unsigned char* X = lds + (s & 1) * CB_BUF; const LAS unsigned char* Y = X + CB_Y;
        const LAS float* EG = (const LAS float*)(X + 16384) + c * 128;
        bf16x8 sb[8];
#pragma unroll
        for (int t = 0; t < 4; ++t) { sb[2 * t] = pack8(S[t], 0); sb[2 * t + 1] = pack8(S[t], 1); }
        f32x16 o[2] = {zero16(), zero16()};
        {   constexpr int R = 6; bf16x8 ring[R];
#pragma unroll
            for (int i = 0; i < R; ++i) ring[i] = lds_frag(X, i, lane);
#pragma unroll
            for (int i = 0; i < 16; ++i) { o[i >> 3] = MFMA32(ring[i % R], sb[i & 7], o[i >> 3]); if (i + R < 16) ring[i % R] = lds_frag(X, i + R, lane); __builtin_amdgcn_sched_barrier(0); }
        }
        if (!(flags & 1)) {
            if (s < NCH / 2) {
#pragma unroll
                for (int rt = 0; rt < 2; ++rt)
#pragma unroll
                    for (int g = 0; g < 4; ++g) __hip_atomic_store(sp + (rt * 4 + g) * 64, (unsigned long long)pkbf(o[rt][4 * g], o[rt][4 * g + 1]) | ((unsigned long long)pkbf(o[rt][4 * g + 2], o[rt][4 * g + 3]) << 32), __ATOMIC_RELAXED, __HIP_MEMORY_SCOPE_AGENT);
            } else {
#pragma unroll
                for (int rt = 0; rt < 2; ++rt)
#pragma unroll
                    for (int g = 0; g < 4; ++g) { const unsigned plo = (unsigned)pw[rt * 4 + g], phi = (unsigned)(pw[rt * 4 + g] >> 32);
                        __hip_atomic_store(sp + (rt * 4 + g) * 64, (unsigned long long)pkbf(o[rt][4 * g] + bflo(plo), o[rt][4 * g + 1] + bfhi(plo)) | ((unsigned long long)pkbf(o[rt][4 * g + 2] + bflo(phi), o[rt][4 * g + 3] + bfhi(phi)) << 32), __ATOMIC_RELAXED, __HIP_MEMORY_SCOPE_AGENT); }
            }
        }
        {
            bf16x8 bfr[4];
#pragma unroll
            for (int ks = 0; ks < 4; ++ks) bfr[ks] = lds_frag(Y + 16384, w * 4 + ks, lane);
#pragma unroll
            for (int t = 0; t < 4; ++t)
#pragma unroll
                for (int g = 0; g < 4; ++g) { const f32x4 ev = *(const LAS f32x4*)(EG + 32 * t + 8 * g + 4 * hh);
                    S[t][4 * g] *= ev.x; S[t][4 * g + 1] *= ev.y; S[t][4 * g + 2] *= ev.z; S[t][4 * g + 3] *= ev.w; }
            constexpr int R = 5; bf16x8 ring[R];
#pragma unroll
            for (int i = 0; i < R; ++i) ring[i] = lds_frag(Y, i, lane);
#pragma unroll
            for (int i = 0; i < 16; ++i) { S[i >> 2] = MFMA32(ring[i % R], bfr[i & 3], S[i >> 2]); if (i + R < 16) ring[i % R] = lds_frag(Y, i + R, lane); __builtin_amdgcn_sched_barrier(0); }
        }
        if (!(flags & 1)) { asm volatile("s_waitcnt vmcnt(0)" ::: "memory"); if (lane == 0) __hip_atomic_store(fl, s < NCH / 2 ? 1u : 2u, __ATOMIC_RELAXED, __HIP_MEMORY_SCOPE_AGENT); }
        __syncthreads();
    }
#undef GLA_ISSUE
}

template <int NC, bool S16>
__device__ __forceinline__ void p4_unit(LAS unsigned char* lds, const unsigned char* slot, const unsigned char* intra, const bf16* zg, const float* nw, bf16* out, const unsigned* done) {
    int tid_l = threadIdx.x; asm volatile("" : "+v"(tid_l));
    const int tid = tid_l, lane = tid & 63, w = __builtin_amdgcn_readfirstlane(tid >> 6), r = lane & 31, hh = lane >> 5;
    constexpr int ST = NC * 2 + 16, NB = (NC / 32) * 8, CPR = NC / 8;
    if (done) {
        for (unsigned sp_ = 0; sp_ < (1u << 22); ++sp_) { const unsigned f = lane < 8 ? __hip_atomic_load(done + lane, __ATOMIC_RELAXED, __HIP_MEMORY_SCOPE_AGENT) : 2u; if (__all(f == 2u)) break; __builtin_amdgcn_s_sleep(8); }
    }
    for (int b = w; b < NB; b += 8) {
        const unsigned long long v = __hip_atomic_load((const unsigned long long*)slot + b * 64 + lane, __ATOMIC_RELAXED, __HIP_MEMORY_SCOPE_AGENT);
        float x0 = bflo((unsigned)v), x1 = bfhi((unsigned)v), x2 = bflo((unsigned)(v >> 32)), x3 = bfhi((unsigned)(v >> 32));
        if (intra) { const unsigned long long iv = ((const unsigned long long*)intra)[b * 64 + lane];
            x0 += bflo((unsigned)iv); x1 += bfhi((unsigned)iv); x2 += bflo((unsigned)(iv >> 32)); x3 += bfhi((unsigned)(iv >> 32)); }
        int row, col;
        if (S16) { row = 16 * (b & 3) + 4 * (lane >> 4); col = 16 * (b >> 2) + (lane & 15); }
        else { row = 32 * ((b >> 2) & 1) + 8 * (b & 3) + 4 * hh; col = 32 * (b >> 3) + r; }
        LAS unsigned char* p = lds + row * ST + col * 2;
        const unsigned a = pkbf(x0, x1), bq = pkbf(x2, x3);
        *(LAS unsigned short*)p = (unsigned short)(a & 0xffffu); *(LAS unsigned short*)(p + ST) = (unsigned short)(a >> 16);
        *(LAS unsigned short*)(p + 2 * ST) = (unsigned short)(bq & 0xffffu); *(LAS unsigned short*)(p + 3 * ST) = (unsigned short)(bq >> 16);
    }
    __syncthreads();
#pragma unroll
    for (int it = 0; it < (64 * CPR) / 512; ++it) {
        const int idx = it * 512 + tid, row = idx / CPR, ch = idx % CPR;
        const v4u xw = *(const LAS v4u*)(lds + row * ST + ch * 16);
        float x[8] = {bflo(xw.x), bfhi(xw.x), bflo(xw.y), bfhi(xw.y), bflo(xw.z), bfhi(xw.z), bflo(xw.w), bfhi(xw.w)};
        float ss = 0.f;
#pragma unroll
        for (int i = 0; i < 8; ++i) ss += x[i] * x[i];
        ss = row16_sum(ss);
        if (NC == 256) ss += __shfl_xor(ss, 16);
        const float rstd = 1.0f / sqrtf(ss * (1.0f / NC) + EPS);
        f32x4 w0 = *(const f32x4*)(nw + ch * 8), w1 = *(const f32x4*)(nw + ch * 8 + 4);
        if (zg) { const v4u zw = *(const v4u*)(zg + (size_t)row * 1024 + ch * 8);
            const float z[8] = {bflo(zw.x), bfhi(zw.x), bflo(zw.y), bfhi(zw.y), bflo(zw.z), bfhi(zw.z), bflo(zw.w), bfhi(zw.w)};
            w0.x *= z[0] * __builtin_amdgcn_rcpf(1.0f + __expf(-z[0])); w0.y *= z[1] * __builtin_amdgcn_rcpf(1.0f + __expf(-z[1])); w0.z *= z[2] * __builtin_amdgcn_rcpf(1.0f + __expf(-z[2])); w0.w *= z[3] * __builtin_amdgcn_rcpf(1.0f + __expf(-z[3]));
            w1.x *= z[4] * __builtin_amdgcn_rcpf(1.0f + __expf(-z[4])); w1.y *= z[5] * __builtin_amdgcn_rcpf(1.0f + __expf(-z[5])); w1.z *= z[6] * __builtin_amdgcn_rcpf(1.0f + __expf(-z[6])); w1.w *= z[7] * __builtin_amdgcn_rcpf(1.0f + __expf(-z[7])); }
        v4u o; o.x = pkbf(x[0] * rstd * w0.x, x[1] * rstd * w0.y); o.y = pkbf(x[2] * rstd * w0.z, x[3] * rstd * w0.w); o.z = pkbf(x[4] * rstd * w1.x, x[5] * rstd * w1.y); o.w = pkbf(x[6] * rstd * w1.z, x[7] * rstd * w1.w);
        *(v4u*)(out + (size_t)row * 1024 + ch * 8) = o;
    }
    __syncthreads();
}
#define XB_TMO      128
#define XB_XCNT(j)  (256  + 64 * (j))
#define XB_XSUB(j)  (1280 + 64 * (j))
#define XB_XGEN(j)  (2304 + 64 * (j))
#define XB_TOP      3328
#define XB_TOPGEN   3392
#define XCD_BAR_WORDS 3456
#define XB_SPIN_CAP (1u << 18)

__device__ __forceinline__ unsigned xb_ld(unsigned* p)              { return __hip_atomic_load(p, __ATOMIC_RELAXED, __HIP_MEMORY_SCOPE_AGENT); }
__device__ __forceinline__ unsigned xb_add(unsigned* p, unsigned v) { return __hip_atomic_fetch_add(p, v, __ATOMIC_RELAXED, __HIP_MEMORY_SCOPE_AGENT); }
__device__ __forceinline__ unsigned xb_xcc_id() { return (unsigned)__builtin_amdgcn_s_getreg((3 << 11) | 20) & 0xFu; }
#define XB_SPIN(cond, bar) do { unsigned _sp = 0; while (cond) { __builtin_amdgcn_s_sleep(1); \
    if ((++_sp & 255u) == 0u) { if (xb_ld(&(bar)[XB_TMO])) break; if (_sp > XB_SPIN_CAP) { atomicAdd(&(bar)[XB_TMO], 1u); break; } } } } while (0)

struct XcdBarrier {
    unsigned* bar; unsigned x;
    volatile LAS unsigned* st;
};

__device__ __forceinline__ XcdBarrier xcd_barrier_post(unsigned* bar, volatile LAS unsigned* st) {
    XcdBarrier b; b.bar = bar; b.x = xb_xcc_id(); b.st = st;
    if (threadIdx.x == 0) (void)xb_add(&bar[XB_XCNT(b.x)], 1u);
    return b;
}
__device__ __forceinline__ void xcd_barrier_complete(unsigned* bar, unsigned x, unsigned& nloc, unsigned& nx) {
    const unsigned G = gridDim.x * gridDim.y * gridDim.z;
    unsigned sum, cnt, mine, sp = 0u;
    for (;;) {
        sum = 0u; cnt = 0u; mine = 0u;
#pragma unroll
        for (unsigned j = 0; j < 16; ++j) { const unsigned c = xb_ld(&bar[XB_XCNT(j)]); sum += c; cnt += (c > 0u) ? 1u : 0u; mine = (j == x) ? c : mine; }
        if (sum == G) break;
        __builtin_amdgcn_s_sleep(1);
        if ((++sp & 255u) == 0u) { if (xb_ld(&bar[XB_TMO])) break; if (sp > XB_SPIN_CAP) { atomicAdd(&bar[XB_TMO], 1u); break; } }
    }
    nloc = mine > 0u ? mine : 1u; nx = cnt > 0u ? cnt : 1u;
}

__device__ __forceinline__ void xcd_barrier(const XcdBarrier& b) {
    asm volatile("s_waitcnt vmcnt(0)" ::: "memory");
    __syncthreads();
    if (threadIdx.x == 0) {
        unsigned* bar = b.bar;
        __builtin_amdgcn_s_waitcnt(0);
        unsigned nloc = b.st[0], nx = b.st[1];
        if (nloc == 0u) { xcd_barrier_complete(bar, b.x, nloc, nx); b.st[0] = nloc; b.st[1] = nx; }
        const unsigned old = xb_add(&bar[XB_XSUB(b.x)], 1u);
        const unsigned gen = old / nloc;
        if (old + 1u == (gen + 1u) * nloc) {
            __builtin_amdgcn_fence(__ATOMIC_RELEASE, "agent");
            asm volatile("s_waitcnt vmcnt(0)" ::: "memory");
            const unsigned og = xb_add(&bar[XB_TOP], 1u);
            const unsigned tg = og / nx;
            if (og + 1u == (tg + 1u) * nx) xb_add(&bar[XB_TOPGEN], 1u);
            else XB_SPIN(xb_ld(&bar[XB_TOPGEN]) == tg, bar);
            __builtin_amdgcn_fence(__ATOMIC_ACQUIRE, "agent");
            xb_add(&bar[XB_XGEN(b.x)], 1u);
            asm volatile("s_waitcnt vmcnt(0)" ::: "memory");
        } else {
            XB_SPIN(xb_ld(&bar[XB_XGEN(b.x)]) == gen, bar);
            __builtin_amdgcn_fence(__ATOMIC_ACQUIRE, "agent");
            asm volatile("s_waitcnt vmcnt(0)" ::: "memory");
        }
    }
    __syncthreads();
}
__device__ __forceinline__ void transpose_item(const float* W, int ldw, int src_col0, int K, int ncols, bf16* WT, int dst_row0, LAS float* scr, int item, int lane) {
    asm volatile("" : "+v"(lane));
    const int nblk = ncols / 32, kb = item / nblk, nb = item % nblk, k0 = 64 * kb, n0 = 32 * nb;
#pragma unroll 8
    for (int i = 0; i < 32; ++i) { const int kk = 2 * i + (lane >> 5); scr[kk * 33 + (lane & 31)] = W[(size_t)(k0 + kk) * ldw + src_col0 + n0 + (lane & 31)]; }
    LDS_WAIT();
    const int c = lane & 7;
#pragma unroll
    for (int j = 0; j < 4; ++j) { const int n = (lane >> 3) + 8 * j; const LAS float* s = scr + (8 * c) * 33 + n;
        v4u o; o.x = pk2(s[0 * 33], s[1 * 33]); o.y = pk2(s[2 * 33], s[3 * 33]); o.z = pk2(s[4 * 33], s[5 * 33]); o.w = pk2(s[6 * 33], s[7 * 33]);
        *(v4u*)(WT + (size_t)(dst_row0 + n0 + n) * K + k0 + 8 * c) = o; }
    LDS_WAIT();
}
__device__ __forceinline__ void h_rows(const float* x, const float* w, bf16* h, int nrows, int gw, int ngw, int lane) {
    asm volatile("" : "+v"(lane));
    for (int m = gw; m < nrows; m += ngw) {
        const f32x4* xr = (const f32x4*)(x + (size_t)m * D) + lane; f32x4 v[4]; float s = 0.f;
#pragma unroll
        for (int j = 0; j < 4; ++j) { v[j] = xr[64 * j]; s += (v[j].x * v[j].x + v[j].y * v[j].y) + (v[j].z * v[j].z + v[j].w * v[j].w); }
        const float rstd = 1.0f / sqrtf(wave_sum(s) * (1.f / D) + EPS);
        unsigned long long* o8 = (unsigned long long*)(h + (size_t)m * D) + lane;
#pragma unroll
        for (int j = 0; j < 4; ++j) { const f32x4 ww = ((const f32x4*)w)[lane + 64 * j];
            o8[64 * j] = (unsigned long long)pkbf(v[j].x * rstd * ww.x, v[j].y * rstd * ww.y) | ((unsigned long long)pkbf(v[j].z * rstd * ww.z, v[j].w * rstd * ww.w) << 32); }
    }
}
__device__ __forceinline__ void final_rows(const float* x, const float* pre, const float* w, float* out, int nrows, int gw, int ngw, int lane) {
    asm volatile("" : "+v"(lane));
    for (int m = gw; m < nrows; m += ngw) {
        const f32x4* pr = (const f32x4*)(pre + (size_t)m * D) + lane; const f32x4* xr = (const f32x4*)(x + (size_t)m * D) + lane; f32x4 v[4]; float s = 0.f;
#pragma unroll
        for (int j = 0; j < 4; ++j) { v[j] = pr[64 * j]; s += (v[j].x * v[j].x + v[j].y * v[j].y) + (v[j].z * v[j].z + v[j].w * v[j].w); }
        const float rstd = 1.0f / sqrtf(wave_sum(s) * (1.f / D) + EPS);
        f32x4* orow = (f32x4*)(out + (size_t)m * D) + lane;
#pragma unroll
        for (int j = 0; j < 4; ++j) { const f32x4 ww = ((const f32x4*)w)[lane + 64 * j]; const f32x4 xv = xr[64 * j]; orow[64 * j] = xv + v[j] * rstd * ww; }
    }
}
__device__ __forceinline__ void small_unit(LAS unsigned char* lds, const bf16* h, const bf16* wsm, float* out, int unit) {
    int tid_l = threadIdx.x; asm volatile("" : "+v"(tid_l));
    const int tid = tid_l, lane = tid & 63, w = __builtin_amdgcn_readfirstlane(tid >> 6), r = lane & 31, hh = lane >> 5;
    const int rt = (w >> 1) & 1, ct = w & 1, kh = w >> 2;
    const bf16* ap = h + (size_t)(unit * 64 + 32 * rt + r) * D + kh * 512 + 8 * hh;
    const bf16* bp = wsm + (size_t)(32 * ct + r) * D + kh * 512 + 8 * hh;
    f32x16 acc = zero16();
#pragma unroll 8
    for (int ks = 0; ks < 32; ++ks) acc = MFMA32(*(const bf16x8*)(ap + 16 * ks), *(const bf16x8*)(bp + 16 * ks), acc);
    LAS float* red = (LAS float*)lds + (w & 3) * 1024 + lane;
    if (kh == 1) {
#pragma unroll
        for (int i = 0; i < 16; ++i) red[i * 64] = acc[i]; }
    __syncthreads();
    if (kh == 0) {
        float* op = out + (size_t)(unit * 64 + 32 * rt + 4 * hh) * 64 + 32 * ct + r;
#pragma unroll
        for (int i = 0; i < 16; ++i) op[((i & 3) + 8 * (i >> 2)) * 64] = acc[i] + red[i * 64]; }
    __syncthreads();
}

constexpr int NG = 2, MG = M / NG, NSEQG = BATCH / NG;
constexpr size_t KiB = 1024;
constexpr size_t WS_CTL = 0  , WS_WTIN = 320 * KiB, WS_WTA = WS_WTIN + 18560 * KiB, WS_WTB = WS_WTA + 2 * MiB, WS_WTO = WS_WTB + 2 * MiB, WS_SMALL = WS_WTO + 2 * MiB  ,
    WS_Z = WS_SMALL + 2 * MiB  , WS_PG = WS_Z + 16 * MiB  , WS_GBLOB = WS_PG + 80 * MiB  , WS_LBLOBB = WS_GBLOB + 98 * MiB  , WS_END = WS_LBLOBB + 32 * MiB;
static_assert(WS_END <= 256 * MiB, "workspace");
constexpr size_t WS_H = WS_GBLOB  , WS_M1 = WS_H, WS_MERGED = WS_H + 32 * MiB  , WS_PRE = WS_MERGED + 32 * MiB  , WS_GATES = WS_Z  ;
static_assert(WS_PRE + 64 * MiB <= WS_END && WS_GATES + 64 * MiB <= WS_GBLOB, "overlays");
constexpr size_t PGMAT = (size_t)MG * 1024 * 2;
static_assert((size_t)NSEQG * 4 * NCH * gla::BLOBA <= 3 * PGMAT && (size_t)NSEQG * 4 * NCH * 32768 <= PGMAT && (size_t)NSEQG * 8 * NCH * 16384 <= PGMAT, "overlays");
static_assert((size_t)NSEQG * 8 * NCH * gdn::BLOB <= 98 * MiB && (size_t)NSEQG * 4 * NCH * gla::BLOBB <= 32 * MiB, "blobs");
constexpr int LDS_BYTES = 160 * 1024, LDS_BAR = LDS_BYTES - 16;
static_assert(gla::L_END <= LDS_BAR && gdn::L_END <= LDS_BAR && gdn::C_END <= LDS_BAR && gla::CB_END <= LDS_BAR && pg8::STAGE_BYTES <= LDS_BAR, "LDS");
constexpr int N_PHASES = 13;

struct MegaArgs { const float* in[18]; float* out; unsigned char* ws; int ph_lo, ph_hi; };

__global__ void __launch_bounds__(512, 2) mega(MegaArgs a) {
    extern __shared__ __attribute__((aligned(16))) unsigned char lds_raw[];
    LAS unsigned char* lds = (LAS unsigned char*)lds_raw;
    const int tid = threadIdx.x, lane = tid & 63, wave = __builtin_amdgcn_readfirstlane(tid >> 6);
    const int G = gridDim.x, bid = blockIdx.x, gw = bid * 8 + wave, ngw = G * 8;
    unsigned char* ws = a.ws;
    const float* x = a.in[0]; const float* ln_pre_w = a.in[1]; const float* w_in = a.in[2]; const float* conv_w = a.in[3];
    if (tid < 4) ((LAS unsigned*)(lds + LDS_BAR))[tid] = 0u;
    __syncthreads();
    XcdBarrier bar = xcd_barrier_post((unsigned*)(ws + WS_CTL), (volatile LAS unsigned*)(lds + LDS_BAR));
    const int lo = a.ph_lo, hi = a.ph_hi;
#define IN(k) (lo <= (k) && (k) < hi)
#define SEAM(k) do { if (IN(k) && IN((k) + 1)) xcd_barrier(bar); } while (0)
#ifndef PROBE_REPEAT
#define PROBE_REPEAT 0
#endif
#ifndef PROBE_FLAGS
#define PROBE_FLAGS 0
#endif
#define PH(k) if (IN(k)) for (int rep_ = 0; rep_ <= ((PROBE_REPEAT >> (k)) & 1); ++rep_)
#define REPBAR() do { if (rep_) xcd_barrier(bar); } while (0)
    bf16* WT_IN = (bf16*)(ws + WS_WTIN); bf16* WT_A = (bf16*)(ws + WS_WTA); bf16* WT_B = (bf16*)(ws + WS_WTB); bf16* WT_O = (bf16*)(ws + WS_WTO);
    bf16* PG = (bf16*)(ws + WS_PG); float* SMALL = (float*)(ws + WS_SMALL);
    bf16* ORAWA = (bf16*)a.out; bf16* ORAWB = (bf16*)a.out + (size_t)M * 1024;

    PH(0) { REPBAR();
        LAS float* scr = (LAS float*)lds + wave * (64 * 33);
        constexpr int NSEG = 8;
        const int sdst[NSEG] = {0, 1024, 4096, 5120, 6144, 7168, 9216, 9248}, ssrc[NSEG] = {SRC_ZA, SRC_QKVA, SRC_QB, SRC_VB, SRC_GB, SRC_GA, SRC_AF, SRC_RF}, sn[NSEG] = {1024, 3072, 1024, 1024, 1024, 2048, 32, 32};
#pragma unroll
        for (int sgi = 0; sgi < NSEG; ++sgi) { const int nit = 16 * (sn[sgi] / 32);
            for (int it = gw; it < nit; it += ngw) transpose_item(w_in, NIN, ssrc[sgi], D, sn[sgi], WT_IN, sdst[sgi], scr, it, lane); }
        for (int it = gw; it < 512; it += ngw) transpose_item(a.in[9], D, 0, D, D, WT_A, 0, scr, it, lane);
        for (int it = gw; it < 512; it += ngw) transpose_item(a.in[15], D, 0, D, D, WT_B, 0, scr, it, lane);
        for (int it = gw; it < 512; it += ngw) transpose_item(a.in[16], D, 0, D, D, WT_O, 0, scr, it, lane);
        h_rows(x, ln_pre_w, ORAWB + (size_t)MG * 1024, MG, gw, ngw, lane);
    }
    SEAM(0);
#ifdef PROBE_BARRIERS
    for (int i = 0; i < PROBE_BARRIERS; ++i) xcd_barrier(bar);
#endif
    for (int g = 0; g < NG; ++g) {
        const int pb = 1 + 4 * g;
        const size_t r0 = (size_t)g * MG;
        const bf16* hsrc = (g == 0 ? ORAWB : ORAWA) + (size_t)MG * 1024;
        PH(pb) { REPBAR();
            for (int u = bid; u < MG / 64; u += G) small_unit(lds, hsrc, WT_IN + (size_t)9216 * D, SMALL, u);
            pg8::Gemm gm{hsrc, WT_IN, MG, 6144, D, 0}; pg8::StaticOrder S; S.init(MG, 6144, G, bid);
            pg8::EpiBf16 E{(bf16*)(ws + WS_Z), 1024, 1024, (size_t)MG * 1024};
            pg8::gemm_phase<pg8::EpiBf16, pg8::StaticOrder, true, true>(lds, gm, S, E);
        }
        SEAM(pb);
        PH(pb + 1) { REPBAR();
            GdnPrepArgs pa{PG, PG + (size_t)MG * 1024, PG + (size_t)2 * MG * 1024, SMALL, conv_w, a.in[4], a.in[5], a.in[6], a.in[7], ws + WS_GBLOB, NSEQG, rep_ ? PROBE_FLAGS : 0};
            gdn_prep_phase(lds, pa, bid, G, ws + WS_CTL + 300 * KiB);
        }
        SEAM(pb + 1);
        PH(pb + 2) { REPBAR();
            GlaPrepArgs pa{PG + (size_t)3 * MG * 1024, PG + (size_t)4 * MG * 1024, SMALL, a.in[10], a.in[11], a.in[12], a.in[13], ws + WS_PG, ws + WS_LBLOBB, NSEQG, 0};
            gla_prep_phase(lds, pa, bid, G);
        }
        SEAM(pb + 2);
        PH(pb + 3) { REPBAR();
            constexpr int NGI = NSEQG * 8 * 2, NLI = NSEQG * 4 * 2;
            unsigned* gflag = (unsigned*)(ws + WS_CTL + 32 * KiB) + (size_t)g * (NSEQG * 8 * NCH * 8); unsigned* lflag = (unsigned*)(ws + WS_CTL + 96 * KiB) + (size_t)g * (NSEQG * 4 * NCH * 8);
            if (rep_) { gflag += 32 * 1024; lflag += 32 * 1024; }
            if (bid < NGI) { if (!(rep_ && (PROBE_FLAGS & 16))) { GdnChainArgs ca{ws + WS_GBLOB, ws + WS_PG + 4 * PGMAT, gflag, NSEQG, rep_ ? PROBE_FLAGS : 0}; gdn_chain_unit(lds, ca, bid); } }
            else if (bid < NGI + NLI) { if (!(rep_ && (PROBE_FLAGS & 32))) { GlaChainArgs ca{ws + WS_PG, ws + WS_LBLOBB, ws + WS_PG + 3 * PGMAT, lflag, NSEQG, rep_ ? PROBE_FLAGS : 0}; gla_chain_unit(lds, ca, bid - NGI); } }
            else if (!rep_) {
                const int wk = bid - NGI - NLI, nwk = G - NGI - NLI;
                if (g == 0) h_rows(x + (size_t)MG * D, ln_pre_w, ORAWA + (size_t)MG * 1024, MG, wk * 8 + wave, nwk * 8, lane);
                constexpr int NPG = NSEQG * 8, NPL = NSEQG * 4;
                for (int j = wk; j < NCH * (NPG + NPL); j += nwk) {
                    const int rk = j / (NPG + NPL), idx = j % (NPG + NPL), n = (rk & 1) ? (NCH / 2 - 1 - (rk >> 1)) : (NCH / 2 + (rk >> 1));
                    if (idx < NPG) { const int u = idx * NCH + n, hd = idx % 8, sq = idx / 8;
                        p4_unit<128, true>(lds, ws + WS_PG + 4 * PGMAT + (size_t)u * 16384, nullptr, (const bf16*)(ws + WS_Z) + ((size_t)sq * SEQ + n * CHUNK) * 1024 + hd * 128, a.in[8], ORAWA + (r0 + (size_t)sq * SEQ + n * CHUNK) * 1024 + hd * 128, gflag + (size_t)u * 8); }
                    else { const int pi = idx - NPG, u = pi * NCH + n, hd = pi % 4, sq = pi / 4;
                        p4_unit<256, false>(lds, ws + WS_PG + 3 * PGMAT + (size_t)u * 32768, ws + WS_LBLOBB + (size_t)u * gla::BLOBB + gla::B_INTRA, nullptr, a.in[14], ORAWB + (r0 + (size_t)sq * SEQ + n * CHUNK) * 1024 + hd * 256, lflag + (size_t)u * 8); }
                }
            }
        }
        SEAM(pb + 3);
    }
    PH(9) { REPBAR(); h_rows(x, ln_pre_w, (bf16*)(ws + WS_H), M, gw, ngw, lane); }
    SEAM(9);
    PH(10) { REPBAR();
        pg8::Gemm gm{(const bf16*)(ws + WS_H), WT_IN + (size_t)6144 * D, M, 3072, D, 0}; pg8::StaticOrder S; S.init(M, 3072, G, bid);
        if (rep_ == 0) { pg8::EpiP1b E{ORAWB, (bf16*)(ws + WS_GATES), (size_t)M * 1024, ORAWB};
            pg8::gemm_phase<pg8::EpiP1b, pg8::StaticOrder, true, true>(lds, gm, S, E); }
        else { pg8::EpiP1b E{ORAWB, (bf16*)(ws + WS_GATES), (size_t)M * 1024, (bf16*)(ws + WS_MERGED)};
            pg8::gemm_phase<pg8::EpiP1b, pg8::StaticOrder, true, true>(lds, gm, S, E); }
    }
    SEAM(10);
    PH(11) { REPBAR();
        pg8::Gemm gm{ORAWA, WT_A, 2 * M, 2 * D, D, 0}; pg8::PairOrder S; S.init(M, D, G, bid);
        pg8::EpiMerge E{(bf16*)(ws + WS_M1), (bf16*)(ws + WS_MERGED), (const bf16*)(ws + WS_GATES), (size_t)M * 1024, M / 256, D / 256};
        pg8::gemm_phase<pg8::EpiMerge, pg8::PairOrder, true, true>(lds, gm, S, E);
    }
    SEAM(11);
    if (IN(12)) {
        pg8::Gemm gm{(const bf16*)(ws + WS_MERGED), WT_O, M, D, D, 0}; pg8::StaticOrder S; S.init(M, D, G, bid);
        pg8::EpiRmsRes E{x, a.in[17], a.out, (float*)(ws + WS_PRE), (unsigned*)(ws + WS_CTL + 304 * KiB)};
        pg8::gemm_phase<pg8::EpiRmsRes, pg8::StaticOrder, false, true>(lds, gm, S, E);
    }
#undef IN
#undef SEAM
}

#ifndef MK_N_LAUNCHES
#define MK_N_LAUNCHES 1
#endif
extern "C" void kernel_launch(void* const* d_in, const int* in_sizes, int n_in, void* d_out, int out_size, void* d_ws, size_t ws_size, hipStream_t stream) {
    static int ready = 0;
    if (!ready) {
        if (n_in != 18 || ws_size < WS_END || out_size != M * D) { fprintf(stderr, "kernel_launch: unexpected problem shape / workspace (%d inputs, ws %zu)\n", n_in, ws_size); ready = -1; return; }
        if (hipFuncSetAttribute((const void*)mega, hipFuncAttributeMaxDynamicSharedMemorySize, LDS_BYTES) != hipSuccess) { fprintf(stderr, "kernel_launch: hipFuncSetAttribute failed\n"); ready = -1; return; }
        ready = 1;
    }
    if (ready < 0) return;
    (void)hipMemsetAsync((char*)d_ws + WS_CTL, 0, 320 * 1024, stream);
    MegaArgs a{};
    for (int i = 0; i < 18; ++i) a.in[i] = (const float*)d_in[i];
    a.out = (float*)d_out; a.ws = (unsigned char*)d_ws;
#if MK_N_LAUNCHES == 1
    a.ph_lo = 0; a.ph_hi = N_PHASES;
    hipLaunchKernelGGL(mega, dim3(256), dim3(512), LDS_BYTES, stream, a);
#else
    for (int p = 0; p < N_PHASES; ++p) { a.ph_lo = p; a.ph_hi = p + 1; hipLaunchKernelGGL(mega, dim3(256), dim3(512), LDS_BYTES, stream, a); }
#endif
}
```

```cpp
#include <hip/hip_runtime.h>
#include <cstdio>
#include <cstdint>

#define GAS __attribute__((address_space(1)))
#define LAS __attribute__((address_space(3)))
typedef unsigned short bf16;
typedef unsigned v4u __attribute__((ext_vector_type(4)));
typedef unsigned v2u __attribute__((ext_vector_type(2)));
typedef float f32x4 __attribute__((ext_vector_type(4)));
#define LDS_WAIT() asm volatile("s_waitcnt lgkmcnt(0)" ::: "memory")

constexpr int BATCH = 8, SEQ = 2048, D = 1024, M = BATCH * SEQ, NIN = 9280;
constexpr float EPS = 1e-6f;
constexpr size_t MiB = 1 << 20;
constexpr int SRC_QKVA = 0, SRC_ZA = 3072, SRC_AF = 4096, SRC_QB = 4128, SRC_KB = 4640, SRC_VB = 5152, SRC_GB = 6176, SRC_RF = 7200, SRC_GA = 7232, SRC_GBm = 8256;

__device__ __forceinline__ unsigned f2bf(float f) { unsigned u = __builtin_bit_cast(unsigned, f); return (u + 0x7fffu + ((u >> 16) & 1u)) >> 16; }
__device__ __forceinline__ unsigned pk2(float lo, float hi) { return f2bf(lo) | (f2bf(hi) << 16); }
__device__ __forceinline__ float bf2f(unsigned short b) { return __builtin_bit_cast(float, (unsigned)b << 16); }
__device__ __forceinline__ float bflo(unsigned w) { return __builtin_bit_cast(float, w << 16); }
__device__ __forceinline__ float bfhi(unsigned w) { return __builtin_bit_cast(float, w & 0xffff0000u); }
__device__ __forceinline__ float sigmoidf_(float x) { return 1.0f / (1.0f + __expf(-x)); }
__device__ __forceinline__ float siluf_(float x) { return x / (1.0f + __expf(-x)); }
__device__ __forceinline__ float wave_sum(float v) {
#pragma unroll
    for (int o = 1; o < 64; o <<= 1) v += __shfl_xor(v, o);
    return v;
}
namespace pg8 {
#define PG8_LAS __attribute__((address_space(3)))
typedef unsigned short bf16_t;
typedef short bf16x8 __attribute__((ext_vector_type(8)));
typedef float f32x4 __attribute__((ext_vector_type(4)));
typedef unsigned u32x4 __attribute__((ext_vector_type(4)));
constexpr int BM = 256, BK = 64, HALF = 128, HTB = HALF * BK * 2  , STAGE_BYTES = 8 * HTB, NXCD = 8, WGM = 8;

__host__ __device__ __forceinline__ int lds_byte(int r, int c) { const int st = (r >> 4) * 2 + (c >> 5), rr = r & 15, cc = c & 31, ob = rr * 64 + cc * 2; return st * 1024 + (ob ^ (((ob >> 9) & 1) << 5)); }
__host__ __device__ __forceinline__ void stage_rc(int b, int& R, int& C) { const int st = b / 1024, sb = b % 1024, swz = sb ^ (((sb >> 9) & 1) << 5); R = (st >> 1) * 16 + swz / 64; C = (st & 1) * 32 + (swz % 64) / 2; }
__host__ __device__ __forceinline__ int perm32(int rho) { const int n = rho >> 4, i = rho & 15; return 8 * (i >> 2) + 4 * n + (i & 3); }

struct Unit { int pm, pn; };
struct Gemm { const bf16_t* A; const bf16_t* Bt; int M, N, K, pad_;
    const bf16_t* A1 = nullptr; const bf16_t* A2 = nullptr; const bf16_t* A3 = nullptr; int t1 = 1 << 30, t2 = 1 << 30, t3 = 1 << 30;
    __host__ __device__ __forceinline__ const char* atile(int pm, size_t tstep) const {
        if (pm < t1) return (const char*)A + (size_t)pm * tstep;
        if (pm < t2) return (const char*)A1 + (size_t)(pm - t1) * tstep;
        if (pm < t3) return (const char*)A2 + (size_t)(pm - t2) * tstep;
        return (const char*)A3 + (size_t)(pm - t3) * tstep; }
};

struct StaticOrder {
    int nM, nN, nwg, G, c;
    __host__ __device__ void init(int M, int N, int G_, int c_) { nM = M / BM; nN = N / BM; nwg = nM * nN; G = G_; c = c_; }
    __host__ __device__ bool next(int i, Unit& u) const {
        const long L = (long)i * G + c; if (L >= nwg) return false;
        int wgid = (int)L; { const int q = nwg / NXCD, r = nwg % NXCD, xcd = wgid % NXCD, off = wgid / NXCD; wgid = (xcd < r ? xcd * (q + 1) : r * (q + 1) + (xcd - r) * q) + off; }
        const int nig = WGM * nN, gid = wgid / nig, fm = gid * WGM, gsz = (nM - fm) < WGM ? (nM - fm) : WGM;
        u.pm = fm + ((wgid % nig) % gsz); u.pn = (wgid % nig) / gsz; return true;
    }
    __device__ __forceinline__ void a_ready(const Unit&) const {}
    __device__ __forceinline__ void done(const Unit&) const {}
};

__device__ __forceinline__ unsigned cvt_pk_bf16(float lo, float hi) { unsigned r; asm volatile("v_cvt_pk_bf16_f32 %0, %1, %2" : "=v"(r) : "v"(lo), "v"(hi)); return r; }
struct EpiBf16 {
    static constexpr bool PERM = true, AFTER_DRAIN = false;
    bf16_t* O; int ldc; int split_cols; size_t split_stride;
    __device__ __forceinline__ void operator()(const f32x4 (&acc)[2][2][4][2], const Unit& u, int wr, int wc, int fr, int fq) const {
        const int row0 = u.pm * BM + wr * 64 + fr; int colt = u.pn * BM; bf16_t* base = O;
        if (split_cols) { const int t = colt / split_cols; base += (size_t)t * split_stride; colt -= t * split_cols; }
        const int col0 = colt + wc * 32 + 8 * fq;
#pragma unroll
        for (int ai = 0; ai < 2; ++ai)
#pragma unroll
            for (int m = 0; m < 4; ++m) { bf16_t* rowp = base + (size_t)(row0 + ai * HALF + m * 16) * ldc + col0;
#pragma unroll
                for (int bj = 0; bj < 2; ++bj) { const f32x4 v0 = acc[ai][bj][m][0], v1 = acc[ai][bj][m][1];
                    u32x4 w; w.x = cvt_pk_bf16(v0[0], v0[1]); w.y = cvt_pk_bf16(v0[2], v0[3]); w.z = cvt_pk_bf16(v1[0], v1[1]); w.w = cvt_pk_bf16(v1[2], v1[3]);
                    *(u32x4*)(rowp + bj * HALF) = w; } }
    }
};
template <int MODE> struct EpiGate {
    static constexpr bool PERM = true, AFTER_DRAIN = false;
    bf16_t* O; const bf16_t* G; const bf16_t* Add; int ldc, pad_;
    __device__ __forceinline__ void operator()(const f32x4 (&acc)[2][2][4][2], const Unit& u, int wr, int wc, int fr, int fq) const {
        const int row0 = u.pm * BM + wr * 64 + fr; const int col0 = u.pn * BM + wc * 32 + 8 * fq;
#pragma unroll
        for (int ai = 0; ai < 2; ++ai)
#pragma unroll
            for (int m = 0; m < 4; ++m) { const size_t ro = (size_t)(row0 + ai * HALF + m * 16) * ldc + col0;
#pragma unroll
                for (int bj = 0; bj < 2; ++bj) { const f32x4 v0 = acc[ai][bj][m][0], v1 = acc[ai][bj][m][1];
                    const u32x4 gw = *(const u32x4*)(G + ro + bj * HALF);
                    float r[8]; const float a[8] = {v0[0], v0[1], v0[2], v0[3], v1[0], v1[1], v1[2], v1[3]};
#pragma unroll
                    for (int i = 0; i < 4; ++i) { const unsigned w = gw[i]; const float g0 = __builtin_bit_cast(float, w << 16), g1 = __builtin_bit_cast(float, w & 0xffff0000u);
                        if (MODE == 0) { r[2 * i] = a[2 * i] / (1.0f + __expf(-g0)); r[2 * i + 1] = a[2 * i + 1] / (1.0f + __expf(-g1)); }
                        else { r[2 * i] = g0 * a[2 * i] / (1.0f + __expf(-a[2 * i])); r[2 * i + 1] = g1 * a[2 * i + 1] / (1.0f + __expf(-a[2 * i + 1])); } }
                    if (Add) { const u32x4 aw = *(const u32x4*)(Add + ro + bj * HALF);
#pragma unroll
                        for (int i = 0; i < 4; ++i) { const unsigned w = aw[i]; r[2 * i] += __builtin_bit_cast(float, w << 16); r[2 * i + 1] += __builtin_bit_cast(float, w & 0xffff0000u); } }
                    u32x4 w; w.x = cvt_pk_bf16(r[0], r[1]); w.y = cvt_pk_bf16(r[2], r[3]); w.z = cvt_pk_bf16(r[4], r[5]); w.w = cvt_pk_bf16(r[6], r[7]);
                    *(u32x4*)(O + ro + bj * HALF) = w; } }
    }
};
struct EpiF32 {
    static constexpr bool PERM = false, AFTER_DRAIN = false;
    float* O; int ldc, pad_;
    __device__ __forceinline__ void operator()(const f32x4 (&acc)[2][2][4][2], const Unit& u, int wr, int wc, int fr, int fq) const {
        const int row0 = u.pm * BM + wr * 64 + fr; const int col0 = u.pn * BM + wc * 32 + 4 * fq;
#pragma unroll
        for (int ai = 0; ai < 2; ++ai)
#pragma unroll
            for (int m = 0; m < 4; ++m) { float* rowp = O + (size_t)(row0 + ai * HALF + m * 16) * ldc + col0;
#pragma unroll
                for (int bj = 0; bj < 2; ++bj)
#pragma unroll
                    for (int n = 0; n < 2; ++n) *(f32x4*)(rowp + bj * HALF + n * 16) = acc[ai][bj][m][n]; }
    }
};
struct EpiP1b {
    static constexpr bool PERM = true, AFTER_DRAIN = false;
    const bf16_t* ob; bf16_t* gates; size_t gate_stride; bf16_t* ob_out;
    __device__ __forceinline__ void operator()(const f32x4 (&acc)[2][2][4][2], const Unit& u, int wr, int wc, int fr, int fq) const {
        if (u.pn < 4) { EpiGate<1> E{ob_out, ob, nullptr, 1024, 0}; E(acc, u, wr, wc, fr, fq); }
        else { Unit v = u; v.pn = (u.pn - 4) & 3; EpiBf16 E{gates + (size_t)((u.pn - 4) >> 2) * gate_stride, 1024, 0, 0}; E(acc, v, wr, wc, fr, fq); }
    }
};
struct EpiRmsRes {
    static constexpr bool PERM = false, AFTER_DRAIN = true;
    const float* xres; const float* w; float* out; float* xbuf; unsigned* cnt;
    __device__ __forceinline__ void fused(f32x4 (&acc)[2][2][4][2], const Unit& u, int wr, int wc, int fr, int fq, PG8_LAS unsigned char* lds, int wid, int lane) const {
        PG8_LAS float* P = (PG8_LAS float*)lds;
        PG8_LAS float* R = (PG8_LAS float*)(lds + 4096);
#pragma unroll
        for (int ai = 0; ai < 2; ++ai)
#pragma unroll
            for (int m = 0; m < 4; ++m) { float s = 0.f;
#pragma unroll
                for (int bj = 0; bj < 2; ++bj)
#pragma unroll
                    for (int n = 0; n < 2; ++n) { const f32x4 x = acc[ai][bj][m][n]; s += (x[0] * x[0] + x[1] * x[1]) + (x[2] * x[2] + x[3] * x[3]); }
                s += __shfl_xor(s, 16); s += __shfl_xor(s, 32);
                if (fq == 0) P[(ai * HALF + wr * 64 + m * 16 + fr) * 4 + wc] = s; }
        asm volatile("s_waitcnt lgkmcnt(0)" ::: "memory"); __builtin_amdgcn_s_barrier(); asm volatile("" ::: "memory");
        const int row = wid * 32 + (lane & 31);
        if (lane < 32) { const f32x4 p = *(const PG8_LAS f32x4*)(P + row * 4);
            __hip_atomic_store(xbuf + (size_t)(u.pm * BM + row) * 4 + u.pn, (p[0] + p[1]) + (p[2] + p[3]), __ATOMIC_RELAXED, __HIP_MEMORY_SCOPE_AGENT); }
        asm volatile("s_waitcnt vmcnt(0)" ::: "memory");
        if (lane == 0) __hip_atomic_fetch_add(cnt + 64 * u.pm, 1u, __ATOMIC_RELAXED, __HIP_MEMORY_SCOPE_AGENT);
        if (wid == 0) {
            for (unsigned sp = 0; (unsigned)__builtin_amdgcn_readfirstlane((int)__hip_atomic_load(cnt + 64 * u.pm, __ATOMIC_RELAXED, __HIP_MEMORY_SCOPE_AGENT)) < 32u && sp < (1u << 22); ++sp) __builtin_amdgcn_s_sleep(2);
        }
        asm volatile("s_waitcnt vmcnt(0) lgkmcnt(0)" ::: "memory"); __builtin_amdgcn_s_barrier(); asm volatile("" ::: "memory");
        if (lane < 32) { const float* sl = xbuf + (size_t)(u.pm * BM + row) * 4; float t = 0.f;
#pragma unroll
            for (int i = 0; i < 4; ++i) t += __hip_atomic_load(sl + i, __ATOMIC_RELAXED, __HIP_MEMORY_SCOPE_AGENT);
            R[row] = 1.0f / sqrtf(t * (1.0f / 1024.0f) + 1e-6f); }
        asm volatile("s_waitcnt vmcnt(0) lgkmcnt(0)" ::: "memory"); __builtin_amdgcn_s_barrier(); asm volatile("" ::: "memory");
        const int col0 = u.pn * BM + wc * 32 + 4 * fq;
#pragma unroll
        for (int ai = 0; ai < 2; ++ai)
#pragma unroll
            for (int m = 0; m < 4; ++m) { const int r = ai * HALF + wr * 64 + m * 16 + fr; const float rs = R[r]; const size_t off = (size_t)(u.pm * BM + r) * 1024 + col0;
#pragma unroll
                for (int bj = 0; bj < 2; ++bj)
#pragma unroll
                    for (int n = 0; n < 2; ++n) { const int c = bj * HALF + n * 16; const f32x4 xv = *(const f32x4*)(xres + off + c); const f32x4 wv = *(const f32x4*)(w + col0 + c);
                        *(f32x4*)(out + off + c) = xv + acc[ai][bj][m][n] * rs * wv; }
                if (m & 1) asm volatile("" ::: "memory"); }
    }
};
struct PairOrder {
    StaticOrder S; int nM, nN;
    __host__ __device__ void init(int M, int N, int G_, int c_) { S.init(M, N, G_, c_); nM = M / BM; nN = N / BM; }
    __host__ __device__ bool next(int i, Unit& u) const { if (i > 1) return false; Unit b; if (!S.next(0, b)) return false; u.pm = b.pm + i * nM; u.pn = b.pn + i * nN; return true; }
    __device__ __forceinline__ void a_ready(const Unit&) const {}
    __device__ __forceinline__ void done(const Unit&) const {}
};
struct EpiMerge {
    static constexpr bool PERM = true, AFTER_DRAIN = false;
    bf16_t* m1; bf16_t* merged; const bf16_t* gates; size_t gate_stride; int nM, nN;
    __device__ __forceinline__ void operator()(const f32x4 (&acc)[2][2][4][2], const Unit& u, int wr, int wc, int fr, int fq) const {
        if (u.pm < nM) { EpiGate<0> E{m1, gates, nullptr, 1024, 0}; E(acc, u, wr, wc, fr, fq); }
        else { Unit v; v.pm = u.pm - nM; v.pn = u.pn - nN; EpiGate<0> E{merged, gates + gate_stride, m1, 1024, 0}; E(acc, v, wr, wc, fr, fq); }
    }
};
template <class Epi, class Sched, bool ALIGN_EPI = false, bool SP2 = false>
__device__ __forceinline__ void gemm_phase(PG8_LAS unsigned char* lds, const Gemm g, const Sched& S, const Epi& E) {
    int tid_l = threadIdx.x; asm volatile("" : "+v"(tid_l));
    const int tid = tid_l, wid = __builtin_amdgcn_readfirstlane(tid >> 6), lane = tid & 63, wr = wid >> 2, wc = wid & 3, fr = lane & 15, fq = lane >> 4;
    const int K = g.K, nt = K / BK;
    unsigned voffA[2], voffB[2];
#pragma unroll
    for (int i = 0; i < 2; ++i) { int R, C; stage_rc(tid * 16 + i * 8192, R, C); const int Rb = Epi::PERM ? ((R & ~31) + perm32(R & 31)) : R;
        voffA[i] = (unsigned)(R * K + C) * 2u; voffB[i] = (unsigned)(Rb * K + C) * 2u; }
    const size_t kstep = (size_t)(BK * 2);
    const size_t hstep = (size_t)HALF * K * 2;
    const size_t tstep = 2 * hstep;
    const unsigned ldsw = (unsigned)wid * 1024u;
    const int aoff = lds_byte(wr * 64 + fr, fq * 8), boff = lds_byte(wc * 32 + fr, fq * 8);
#define PG8_SA(b, h) (((b) * 2 + (h)) * HTB)
#define PG8_SB(b, h) ((4 + (b) * 2 + (h)) * HTB)
#define PG8_STAGE(bufoff, gbase, voff) do { _Pragma("unroll") for (int _i = 0; _i < 2; ++_i) \
        __builtin_amdgcn_global_load_lds((const unsigned*)((const char*)(gbase) + (voff)[_i]), (PG8_LAS unsigned*)(lds + (bufoff) + ldsw + _i * 8192), 16, 0, 0); } while (0)
#define PG8_LDA(dst, b, h) do { _Pragma("unroll") for (int m = 0; m < 4; ++m) _Pragma("unroll") for (int k = 0; k < 2; ++k) dst[m][k] = *(const PG8_LAS bf16x8*)(lds + PG8_SA(b, h) + aoff + m * 2048 + k * 1024); } while (0)
#define PG8_LDB(dst, b, h) do { _Pragma("unroll") for (int n = 0; n < 2; ++n) _Pragma("unroll") for (int k = 0; k < 2; ++k) dst[n][k] = *(const PG8_LAS bf16x8*)(lds + PG8_SB(b, h) + boff + n * 2048 + k * 1024); } while (0)
#define PG8_MMA(ai, bj, At, Bt) do { __builtin_amdgcn_s_setprio(1); _Pragma("unroll") for (int m = 0; m < 4; ++m) _Pragma("unroll") for (int n = 0; n < 2; ++n) _Pragma("unroll") for (int k = 0; k < 2; ++k) \
        acc[ai][bj][m][n] = __builtin_amdgcn_mfma_f32_16x16x32_bf16(Bt[n][k], At[m][k], acc[ai][bj][m][n], 0, 0, 0); __builtin_amdgcn_s_setprio(0); } while (0)
#define PG8_WAIT_V(n) asm volatile("s_waitcnt vmcnt(" #n ")" ::: "memory")
#define PG8_WAIT_L(n) asm volatile("s_waitcnt lgkmcnt(" #n ")" ::: "memory")
#define PG8_BAR __builtin_amdgcn_s_barrier()
#define PG8_SCHED __builtin_amdgcn_sched_barrier(0)
    Unit cur, nxt; int ui = 0;
    if (!S.next(0, cur)) return;
    f32x4 acc[2][2][4][2];
#pragma unroll
    for (int a = 0; a < 2; ++a)
#pragma unroll
        for (int b = 0; b < 2; ++b)
#pragma unroll
            for (int m = 0; m < 4; ++m)
#pragma unroll
                for (int n = 0; n < 2; ++n) acc[a][b][m][n] = (f32x4){0.f, 0.f, 0.f, 0.f};
    bf16x8 At[4][2], B0[2][2], B1[2][2];
    const char* cA = g.atile(cur.pm, tstep); const char* cB = (const char*)g.Bt + (size_t)cur.pn * tstep;
    S.a_ready(cur);
    if constexpr (SP2) {
        PG8_STAGE(PG8_SB(0, 0), cB, voffB); PG8_STAGE(PG8_SB(0, 1), cB + hstep, voffB); PG8_STAGE(PG8_SA(0, 0), cA, voffA); PG8_STAGE(PG8_SA(0, 1), cA + hstep, voffA);
        if (wr == 1) PG8_BAR;
        PG8_WAIT_V(2); PG8_BAR;
        PG8_STAGE(PG8_SB(1, 0), cB + kstep, voffB); PG8_STAGE(PG8_SA(1, 0), cA + kstep, voffA); PG8_STAGE(PG8_SB(1, 1), cB + hstep + kstep, voffB);
        PG8_WAIT_V(6); PG8_BAR;
    } else {
        PG8_STAGE(PG8_SB(0, 0), cB, voffB); PG8_STAGE(PG8_SA(0, 0), cA, voffA); PG8_STAGE(PG8_SB(0, 1), cB + hstep, voffB); PG8_STAGE(PG8_SA(0, 1), cA + hstep, voffA);
        if (wr == 1) PG8_BAR;
        PG8_WAIT_V(4); PG8_BAR;
        PG8_STAGE(PG8_SB(1, 0), cB + kstep, voffB); PG8_STAGE(PG8_SA(1, 0), cA + kstep, voffA); PG8_STAGE(PG8_SB(1, 1), cB + hstep + kstep, voffB);
        PG8_WAIT_V(6); PG8_BAR;
    }
    for (;;) {
        const bool has_next = S.next(ui + 1, nxt);
        const char* nA = has_next ? g.atile(nxt.pm, tstep) : cA; const char* nB = has_next ? (const char*)g.Bt + (size_t)nxt.pn * tstep : cB;
        for (int t = 0; t < nt; t += 2) {
            const bool last = (t == nt - 2);
            const char* a1 = cA + (size_t)(t + 1) * kstep;
            const char* a2 = last ? nA : cA + (size_t)(t + 2) * kstep; const char* b2 = last ? nB : cB + (size_t)(t + 2) * kstep;
            const char* a3 = a2 + kstep; const char* b3 = b2 + kstep;
            if (last && has_next) S.a_ready(nxt);
            if constexpr (SP2) {
            PG8_LDB(B0, 0, 0); PG8_LDB(B1, 0, 1); PG8_SCHED; PG8_LDA(At, 0, 0); PG8_STAGE(PG8_SA(1, 1), a1 + hstep, voffA);
            PG8_WAIT_V(8); PG8_WAIT_L(0); PG8_BAR; PG8_MMA(0, 0, At, B0); PG8_MMA(0, 1, At, B1); PG8_BAR; PG8_SCHED;
            PG8_LDA(At, 0, 1); PG8_STAGE(PG8_SB(0, 0), b2, voffB); PG8_STAGE(PG8_SB(0, 1), b2 + hstep, voffB); PG8_STAGE(PG8_SA(0, 0), a2, voffA);
            PG8_WAIT_V(8); PG8_WAIT_L(0); PG8_BAR; PG8_MMA(1, 0, At, B0); PG8_MMA(1, 1, At, B1); PG8_BAR; PG8_SCHED;
            PG8_LDB(B0, 1, 0); PG8_LDB(B1, 1, 1); PG8_SCHED; PG8_LDA(At, 1, 0); PG8_STAGE(PG8_SA(0, 1), a2 + hstep, voffA);
            PG8_WAIT_V(8); PG8_WAIT_L(0); PG8_BAR; PG8_MMA(0, 0, At, B0); PG8_MMA(0, 1, At, B1); PG8_BAR; PG8_SCHED;
            PG8_LDA(At, 1, 1); PG8_STAGE(PG8_SB(1, 0), b3, voffB); PG8_STAGE(PG8_SB(1, 1), b3 + hstep, voffB); PG8_STAGE(PG8_SA(1, 0), a3, voffA);
            PG8_WAIT_V(8); PG8_WAIT_L(0); PG8_BAR; PG8_MMA(1, 0, At, B0); PG8_MMA(1, 1, At, B1); PG8_BAR; PG8_SCHED;
            } else {
            PG8_LDB(B0, 0, 0); PG8_SCHED; PG8_LDA(At, 0, 0); PG8_STAGE(PG8_SA(1, 1), a1 + hstep, voffA);
            PG8_WAIT_L(8); PG8_BAR; PG8_WAIT_L(0); PG8_MMA(0, 0, At, B0); PG8_BAR; PG8_SCHED;
            PG8_LDB(B1, 0, 1); PG8_STAGE(PG8_SB(0, 0), b2, voffB);
            PG8_BAR; PG8_WAIT_L(0); PG8_MMA(0, 1, At, B1); PG8_BAR;
            PG8_LDA(At, 0, 1); PG8_STAGE(PG8_SA(0, 0), a2, voffA);
            PG8_BAR; PG8_WAIT_L(0); PG8_MMA(1, 0, At, B0); PG8_BAR; PG8_SCHED;
            PG8_STAGE(PG8_SB(0, 1), b2 + hstep, voffB);
            PG8_WAIT_V(6); PG8_BAR; PG8_MMA(1, 1, At, B1); PG8_BAR;
            PG8_LDB(B0, 1, 0); PG8_SCHED; PG8_LDA(At, 1, 0); PG8_STAGE(PG8_SA(0, 1), a2 + hstep, voffA);
            PG8_WAIT_L(8); PG8_BAR; PG8_WAIT_L(0); PG8_MMA(0, 0, At, B0); PG8_BAR; PG8_SCHED;
            PG8_LDB(B1, 1, 1); PG8_STAGE(PG8_SB(1, 0), b3, voffB);
            PG8_BAR; PG8_WAIT_L(0); PG8_MMA(0, 1, At, B1); PG8_BAR;
            PG8_LDA(At, 1, 1); PG8_STAGE(PG8_SA(1, 0), a3, voffA);
            PG8_BAR; PG8_WAIT_L(0); PG8_MMA(1, 0, At, B0); PG8_BAR; PG8_SCHED;
            PG8_STAGE(PG8_SB(1, 1), b3 + hstep, voffB);
            PG8_WAIT_V(6); PG8_BAR; PG8_MMA(1, 1, At, B1); PG8_BAR;
            }
        }
        if constexpr (ALIGN_EPI) { if (wr == 0) PG8_BAR; }
        if constexpr (!Epi::AFTER_DRAIN) { E(acc, cur, wr, wc, fr, fq); S.done(cur); }
        if (!has_next) break;
#pragma unroll
        for (int a = 0; a < 2; ++a)
#pragma unroll
            for (int b = 0; b < 2; ++b)
#pragma unroll
                for (int m = 0; m < 4; ++m)
#pragma unroll
                    for (int n = 0; n < 2; ++n) acc[a][b][m][n] = (f32x4){0.f, 0.f, 0.f, 0.f};
        cur = nxt; cA = nA; cB = nB; ++ui;
        if constexpr (ALIGN_EPI) { if (wr == 1) PG8_BAR; }
    }
    PG8_WAIT_V(0);
    if constexpr (!ALIGN_EPI) { if (wr == 0) PG8_BAR; }
    PG8_BAR;
    if constexpr (Epi::AFTER_DRAIN) { E.fused(acc, cur, wr, wc, fr, fq, lds, wid, lane); S.done(cur); }
#undef PG8_SA
#undef PG8_SB
#undef PG8_STAGE
#undef PG8_LDA
#undef PG8_LDB
#undef PG8_MMA
#undef PG8_WAIT_V
#undef PG8_WAIT_L
#undef PG8_BAR
#undef PG8_SCHED
}
}
typedef __bf16 bf16x2_t __attribute__((ext_vector_type(2)));
typedef float f32x2_t __attribute__((ext_vector_type(2)));
typedef short bf16x8 __attribute__((ext_vector_type(8)));
typedef float f32x16 __attribute__((ext_vector_type(16)));
#define MFMA32(a, b, c) __builtin_amdgcn_mfma_f32_32x32x16_bf16((a), (b), (c), 0, 0, 0)
__device__ __forceinline__ unsigned pkbf(float a, float b) { bf16x2_t v = __builtin_convertvector((f32x2_t){a, b}, bf16x2_t); return __builtin_bit_cast(unsigned, v); }
__device__ __forceinline__ bf16x8 pack8(const f32x16& x, int s) { v4u p; p.x = pkbf(x[8 * s], x[8 * s + 1]); p.y = pkbf(x[8 * s + 2], x[8 * s + 3]); p.z = pkbf(x[8 * s + 4], x[8 * s + 5]); p.w = pkbf(x[8 * s + 6], x[8 * s + 7]); return __builtin_bit_cast(bf16x8, p); }
__device__ __forceinline__ f32x16 zero16() { f32x16 z;
#pragma unroll
    for (int i = 0; i < 16; ++i) z[i] = 0.f; return z; }
constexpr int CHUNK = 64, NCH = SEQ / CHUNK;
constexpr float QSCALE = 0.08838834764831845f;
__device__ __forceinline__ void glds_blocks(LAS unsigned char* dst, const unsigned char* src, int nblk, int wv, int nw, int lane) {
    for (int b = wv; b < nblk; b += nw)
        __builtin_amdgcn_global_load_lds((const unsigned*)(src + (size_t)b * 1024 + lane * 16), (LAS unsigned*)(dst + b * 1024), 16, 0, 0);
}
__device__ __forceinline__ bf16x8 lds_frag(const LAS unsigned char* base, int blk, int lane) { return *(const LAS bf16x8*)(base + blk * 1024 + lane * 16); }

namespace gdn {
constexpr int B_KA = 0, B_QA = 16384, B_SC = 32768, B_KT = 34816, B_TBF = 51200, B_AF = 59392, B_TBB = 67584, B_AB = 75776, B_VT = 83968, BLOB = 100352;
constexpr int XBLK = 34, YBLK = 32;
}

__device__ __forceinline__ float row16_sum(float v) {
    v += __builtin_bit_cast(float, __builtin_amdgcn_mov_dpp(__builtin_bit_cast(int, v), 0xB1, 0xF, 0xF, true));
    v += __builtin_bit_cast(float, __builtin_amdgcn_mov_dpp(__builtin_bit_cast(int, v), 0x4E, 0xF, 0xF, true));
    v += __builtin_bit_cast(float, __builtin_amdgcn_mov_dpp(__builtin_bit_cast(int, v), 0x141, 0xF, 0xF, true));
    v += __builtin_bit_cast(float, __builtin_amdgcn_mov_dpp(__builtin_bit_cast(int, v), 0x140, 0xF, 0xF, true));
    return v;
}
__device__ __forceinline__ float quad_sum(float v) {
    v += __builtin_bit_cast(float, __builtin_amdgcn_mov_dpp(__builtin_bit_cast(int, v), 0xB1, 0xF, 0xF, true));
    v += __builtin_bit_cast(float, __builtin_amdgcn_mov_dpp(__builtin_bit_cast(int, v), 0x4E, 0xF, 0xF, true));
    return v;
}
struct GdnPrepArgs {
    const bf16 *pq, *pk, *pv;
    const float* small;
    const float* conv_w;
    const float *a_log_f, *a_log_b, *dtb_f, *dtb_b;
    unsigned char* blob;
    int nseq, pad_;
};
namespace gdn {
constexpr int L_PRE = 0, L_QN = 52224, L_KN = L_QN + 17408, L_SC = L_KN + 17408, L_LPF = L_SC + 1024, L_LPB = L_LPF + 16384, L_AF = L_LPB + 16384, L_AB = L_AF + 9216, L_TBF = L_AB + 9216, L_TBB = L_TBF + 9216, L_END = L_TBB + 9216;
static_assert(L_END <= 160 * 1024 - 256, "gdn prep LDS");
constexpr int QS_ = 272, AS_ = 144;

__device__ __forceinline__ v4u frag_rm_perm(const LAS unsigned char* img, int st, int rt, int ks, int lane) {
    const int r = lane & 31, hh = lane >> 5; const LAS unsigned char* p = img + (32 * rt + r) * st + (16 * ks + 4 * hh) * 2;
    const v2u lo = *(const LAS v2u*)p, hi = *(const LAS v2u*)(p + 16);
    return (v4u){lo.x, lo.y, hi.x, hi.y};
}
__device__ __forceinline__ v4u frag_tr_perm(const LAS unsigned char* img, int st, int rt, int ks, int lane) {
    const int r = lane & 31, hh = lane >> 5; const LAS unsigned char* p = img + (16 * ks + 4 * hh) * st + (32 * rt + r) * 2;
    unsigned short e[8];
#pragma unroll
    for (int j = 0; j < 8; ++j) e[j] = *(const LAS unsigned short*)(p + (8 * (j >> 2) + (j & 3)) * st);
    return (v4u){(unsigned)e[0] | ((unsigned)e[1] << 16), (unsigned)e[2] | ((unsigned)e[3] << 16), (unsigned)e[4] | ((unsigned)e[5] << 16), (unsigned)e[6] | ((unsigned)e[7] << 16)};
}
__device__ __forceinline__ v4u frag16_rm(const LAS unsigned char* img, int st, int rt, int ks, int lane) {
    const int r = lane & 15, q = lane >> 4; const LAS unsigned char* p = img + (16 * rt + r) * st + (32 * ks + 4 * q) * 2;
    const v2u lo = *(const LAS v2u*)p, hi = *(const LAS v2u*)(p + 32);
    return (v4u){lo.x, lo.y, hi.x, hi.y};
}
__device__ __forceinline__ v4u frag16_tr(const LAS unsigned char* img, int st, int rt, int ks, int lane) {
    const int r = lane & 15, q = lane >> 4; const LAS unsigned char* p = img + (32 * ks + 4 * q) * st + (16 * rt + r) * 2;
    unsigned short e[8];
#pragma unroll
    for (int j = 0; j < 8; ++j) e[j] = *(const LAS unsigned short*)(p + (16 * (j >> 2) + (j & 3)) * st);
    return (v4u){(unsigned)e[0] | ((unsigned)e[1] << 16), (unsigned)e[2] | ((unsigned)e[3] << 16), (unsigned)e[4] | ((unsigned)e[5] << 16), (unsigned)e[6] | ((unsigned)e[7] << 16)};
}
}

#define LBAR() do { asm volatile("s_waitcnt lgkmcnt(0)" ::: "memory"); __builtin_amdgcn_s_barrier(); asm volatile("" ::: "memory"); } while (0)
__device__ __forceinline__ void gdn_prep_issue(LAS unsigned char* lds, const GdnPrepArgs& A, int unit, int w, int lane, const unsigned char* zero_page) {
    using namespace gdn;
    const int n = unit % NCH, h = (unit / NCH) % 8, sq = unit / (NCH * 8); const size_t row0 = (size_t)sq * SEQ; const int t0 = n * CHUNK;
    for (int q4 = w; q4 < 51; q4 += 8) {
        const int seg = q4 * 4 + (lane >> 4), r = seg / 3, m = seg % 3, tl = t0 - 2 + r;
        const bf16* pmat = A.pq + (size_t)m * (size_t)(A.pk - A.pq);
        const unsigned char* src = (tl >= 0 && tl < SEQ) ? (const unsigned char*)(pmat + (row0 + tl) * 1024 + h * 128) : zero_page;
        __builtin_amdgcn_global_load_lds((const unsigned*)(src + (lane & 15) * 16), (LAS unsigned*)(lds + L_PRE + q4 * 1024), 16, 0, 0);
    }
}
__device__ __forceinline__ f32x4 gdn_prep_scal(const GdnPrepArgs& A, int unit, int lane) {
    const int n = unit % NCH, h = (unit / NCH) % 8, sq = unit / (NCH * 8);
    const float* sm = A.small + ((size_t)sq * SEQ + n * CHUNK + lane) * 64;
    return (f32x4){sm[h], sm[8 + h], sm[16 + h], sm[24 + h]};
}
__device__ __forceinline__ void gdn_prep_phase(LAS unsigned char* lds, const GdnPrepArgs& A, int bid, int G, const unsigned char* zero_page) {
    using namespace gdn;
    int tid_l = threadIdx.x; asm volatile("" : "+v"(tid_l));
    const int tid = tid_l, lane = tid & 63, w = __builtin_amdgcn_readfirstlane(tid >> 6);
    const int nunits = A.nseq * 8 * NCH; const int pflg = A.pad_;
    int unit = bid;
    f32x4 smn = (f32x4){0.f, 0.f, 0.f, 0.f};
    if (unit < nunits) { gdn_prep_issue(lds, A, unit, w, lane, zero_page); if (w == 0) smn = gdn_prep_scal(A, unit, lane); }
  for (; unit < nunits; unit += G) {
    const int h = (unit / NCH) % 8;
    unsigned char* blob = A.blob + (size_t)unit * BLOB;
    if (w == 0) {
        const float xf = smn.x + A.dtb_f[h], xb = smn.y + A.dtb_b[h];
        const float spf = xf > 20.f ? xf : log1pf(__expf(xf)), spb = xb > 20.f ? xb : log1pf(__expf(xb));
        const float gf = -__expf(A.a_log_f[h]) * spf, gb = -__expf(A.a_log_b[h]) * spb;
        float pf = gf, pb = gb;
#pragma unroll
        for (int o = 1; o < 64; o <<= 1) { const float yf = __shfl_up(pf, o), yb = __shfl_up(pb, o); if (lane >= o) { pf += yf; pb += yb; } }
        const float totb = __shfl(pb, 63);
        const float gcf = pf, gcb = totb - pb + gb;
        LAS float* sc = (LAS float*)(lds + L_SC);
        sc[lane] = gcf; sc[64 + lane] = gcb; sc[128 + lane] = sigmoidf_(smn.z); sc[192 + lane] = sigmoidf_(smn.w);
        float* gsc = (float*)(blob + B_SC); if (pflg & 8) gsc = (float*)(lds + L_LPF);
        const float glf = __shfl(pf, 63), glb = totb;
        gsc[lane] = gcf; gsc[64 + lane] = gcb; gsc[128 + lane] = __expf(gcf); gsc[192 + lane] = __expf(gcb); gsc[256 + lane] = __expf(glf - gcf); gsc[320 + lane] = __expf(glb - gcb);
        if (lane < 2) gsc[384 + lane] = __expf(lane ? glb : glf);
    }
    __syncthreads();
    if (!(pflg & 32)) {
        const int p0 = 8 * w;
#pragma unroll
        for (int m = 0; m < 3; ++m) {
            float wc[5][2];
#pragma unroll
            for (int tau = 0; tau < 5; ++tau) { const f32x2_t t2 = *(const f32x2_t*)(A.conv_w + tau * 3072 + m * 1024 + h * 128 + 2 * lane); wc[tau][0] = t2.x; wc[tau][1] = t2.y; }
            float in[12][2];
#pragma unroll
            for (int i = 0; i < 12; ++i) { const unsigned u = *(const LAS unsigned*)(lds + L_PRE + ((p0 + i) * 3 + m) * 256 + lane * 4); in[i][0] = bflo(u); in[i][1] = bfhi(u); }
            float y[8][2];
#pragma unroll
            for (int pp = 0; pp < 8; ++pp)
#pragma unroll
                for (int c = 0; c < 2; ++c) { float s = 0.f;
#pragma unroll
                    for (int tau = 0; tau < 5; ++tau) s += wc[tau][c] * in[pp + tau][c];
                    y[pp][c] = s * __builtin_amdgcn_rcpf(1.0f + __builtin_amdgcn_exp2f(-1.4426950408889634f * s)); }
            if (m < 2) {
#pragma unroll
                for (int pp = 0; pp < 8; ++pp) { float ss = row16_sum(y[pp][0] * y[pp][0] + y[pp][1] * y[pp][1]); ss += __shfl_xor(ss, 16); ss += __shfl_xor(ss, 32); const float rn = __builtin_amdgcn_rsqf(ss + EPS);
                    *(LAS unsigned*)(lds + (m == 0 ? L_QN : L_KN) + (p0 + pp) * QS_ + lane * 4) = pkbf(y[pp][0] * rn, y[pp][1] * rn); }
            } else {
#pragma unroll
                for (int c = 0; c < 2; ++c) { v4u o; o.x = pkbf(y[0][c], y[1][c]); o.y = pkbf(y[2][c], y[3][c]); o.z = pkbf(y[4][c], y[5][c]); o.w = pkbf(y[6][c], y[7][c]);
                    if (!(pflg & 8)) *(v4u*)(blob + B_VT + (2 * lane + c) * 128 + p0 * 2) = o; }
            }
        }
    }
    __syncthreads();
    { const int un = unit + G; if (un < nunits) { gdn_prep_issue(lds, A, un, w, lane, zero_page); if (w == 0) smn = gdn_prep_scal(A, un, lane); } }
    {
        const int which = w >> 2, rt = (w >> 1) & 1, ct = w & 1, r = lane & 31, hh = lane >> 5;
        const LAS unsigned char* ia = lds + (which ? L_QN : L_KN) + (32 * rt + r) * QS_ + 16 * hh;
        const LAS unsigned char* ib = lds + L_KN + (32 * ct + r) * QS_ + 16 * hh;
        f32x16 acc = zero16();
#pragma unroll
        for (int ks = 0; ks < 8; ++ks) acc = MFMA32(*(const LAS bf16x8*)(ia + 32 * ks), *(const LAS bf16x8*)(ib + 32 * ks), acc);
        const LAS float* sc = (const LAS float*)(lds + L_SC);
        const int j = 32 * ct + r; const float gfj = sc[j], gbj = sc[64 + j];
#pragma unroll
        for (int reg = 0; reg < 16; ++reg) {
            const int i = 32 * rt + (reg & 3) + 8 * (reg >> 2) + 4 * hh; const float val = acc[reg];
            const float ef = __expf(sc[i] - gfj), eb = __expf(sc[64 + i] - gbj);
            if (which == 0) {
                const float lf = (i > j) ? sc[128 + i] * val * ef : 0.f, lb = (i < j) ? sc[192 + i] * val * eb : 0.f;
                ((LAS float*)(lds + L_LPF))[i * 64 + (j & 3) * 16 + (j >> 2)] = lf;
                const int i2 = 63 - i, j2 = 63 - j;
                ((LAS float*)(lds + L_LPB))[i2 * 64 + (j2 & 3) * 16 + (j2 >> 2)] = lb;
            } else {
                const float af = (i >= j) ? QSCALE * val * ef : 0.f, ab = (i <= j) ? QSCALE * val * eb : 0.f;
                *(LAS unsigned short*)(lds + L_AF + i * AS_ + j * 2) = (unsigned short)(pkbf(af, 0.f) & 0xffffu);
                *(LAS unsigned short*)(lds + L_AB + i * AS_ + j * 2) = (unsigned short)(pkbf(ab, 0.f) & 0xffffu);
            }
        }
    }
    LBAR();
    if (!(pflg & 16)) {
        const int dir = w >> 2, li = (w & 3) * 64 + lane, j = li >> 2, q = li & 3;
        const LAS float* LP = (const LAS float*)(lds + (dir ? L_LPB : L_LPF)) + q * 16;
        float t[16];
#pragma unroll
        for (int a = 0; a < 16; ++a) t[a] = 0.f;
#pragma unroll
        for (int i = 0; i < 64; ++i) {
            float p = 0.f;
#pragma unroll
            for (int a4 = 0; a4 < (i + 15) / 16; ++a4) { const f32x4 lv = *(const LAS f32x4*)(LP + i * 64 + 4 * a4);
                p += lv.x * t[4 * a4] + lv.y * t[4 * a4 + 1] + lv.z * t[4 * a4 + 2] + lv.w * t[4 * a4 + 3]; }
            p = quad_sum(p);
            const float ti = (i == j ? 1.f : 0.f) - p;
            if (q == (i & 3)) t[i >> 2] = ti;
        }
        const LAS float* sc = (const LAS float*)(lds + L_SC);
        if (dir == 0) { const float bj = sc[128 + j];
#pragma unroll
            for (int a = 0; a < 16; ++a) *(LAS unsigned short*)(lds + L_TBF + (4 * a + q) * AS_ + j * 2) = (unsigned short)(pkbf(t[a] * bj, 0.f) & 0xffffu);
        } else { const int jo = 63 - j; const float bj = sc[192 + jo];
#pragma unroll
            for (int a = 0; a < 16; ++a) *(LAS unsigned short*)(lds + L_TBB + (63 - (4 * a + q)) * AS_ + jo * 2) = (unsigned short)(pkbf(t[a] * bj, 0.f) & 0xffffu);
        }
    }
    LBAR();
    if (!(pflg & 64)) for (int blk = w; blk < 80; blk += 8) {
        v4u f; int off;
        if (blk < 16)      { f = frag16_rm(lds + L_KN, QS_, blk >> 2, blk & 3, lane); off = B_KA + blk * 1024; }
        else if (blk < 32) { const int b = blk - 16; f = frag16_rm(lds + L_QN, QS_, b >> 2, b & 3, lane); off = B_QA + b * 1024; }
        else if (blk < 48) { const int b = blk - 32; f = frag16_tr(lds + L_KN, QS_, b >> 1, b & 1, lane); off = B_KT + b * 1024; }
        else { const int b = blk - 48, wh = b >> 3, bb = b & 7; const int lo = wh == 0 ? L_TBF : wh == 1 ? L_AF : wh == 2 ? L_TBB : L_AB;
               f = frag16_rm(lds + lo, AS_, bb >> 1, bb & 1, lane); off = B_TBF + b * 1024; }
        if (!(pflg & 8)) *(v4u*)(blob + off + lane * 16) = f; else asm volatile("" :: "v"(f));
    }
    LBAR();
  }
}
struct GdnChainArgs {
    const unsigned char* blob;
    unsigned char* stg;
    unsigned* flag;
    int nseq, flags;
};
namespace gdn { constexpr int C_Y = XBLK * 1024, C_BUF = C_Y + YBLK * 1024, C_END = 2 * C_BUF; }
#define CHAIN_SPIN_CAP (1u << 22)
#define MFMA16(a, b, c) __builtin_amdgcn_mfma_f32_16x16x32_bf16((a), (b), (c), 0, 0, 0)
__device__ __forceinline__ bf16x8 pack16(const f32x4& a, const f32x4& b) { v4u p; p.x = pkbf(a.x, a.y); p.y = pkbf(a.z, a.w); p.z = pkbf(b.x, b.y); p.w = pkbf(b.z, b.w); return __builtin_bit_cast(bf16x8, p); }

__device__ __forceinline__ void gdn_chain_unit(LAS unsigned char* lds, const GdnChainArgs& A, int item) {
    using namespace gdn;
    int tid_l = threadIdx.x; asm volatile("" : "+v"(tid_l));
    const int tid = tid_l, lane = tid & 63, w = __builtin_amdgcn_readfirstlane(tid >> 6);
    const int r = lane & 15, q = lane >> 4;
    const int c = item & 1, h = (item >> 1) & 7, sq = item >> 4; const int flags = A.flags;
    const size_t unit0 = (size_t)(sq * 8 + h) * NCH;
    const f32x4 z4 = (f32x4){0.f, 0.f, 0.f, 0.f};
    f32x4 S[8];
#pragma unroll
    for (int t = 0; t < 8; ++t) S[t] = z4;
    v2u vnext[4];
    unsigned long long pwn[4]; bool have = false; unsigned fnext = 0u;
#define GDN_ISSUE(s_, buf_) do { const int n_ = c ? NCH - 1 - (s_) : (s_); const unsigned char* bl_ = A.blob + (unit0 + n_) * BLOB; LAS unsigned char* d_ = lds + (buf_) * C_BUF; \
        { const unsigned char* vp_ = bl_ + B_VT + (16 * w + r) * 128 + 8 * q; _Pragma("unroll") for (int i = 0; i < 4; ++i) vnext[i] = *(const v2u*)(vp_ + 32 * i); } \
        if (!(flags & 4)) { glds_blocks(d_, bl_, XBLK, w, 8, lane); \
            if (c == 0) glds_blocks(d_ + C_Y, bl_ + B_KT, YBLK, w, 8, lane); \
            else { glds_blocks(d_ + C_Y, bl_ + B_KT, 16, w, 8, lane); glds_blocks(d_ + C_Y + 16384, bl_ + B_TBB, 16, w, 8, lane); } } } while (0)
    GDN_ISSUE(0, 0);
    __syncthreads();
    for (int s = 0; s < NCH; ++s) {
        const int n = c ? NCH - 1 - s : s;
        v2u vcur[4];
#pragma unroll
        for (int i = 0; i < 4; ++i) vcur[i] = vnext[i];
        unsigned long long* sp = (unsigned long long*)(A.stg + (unit0 + n) * 16384 + w * 2048) + lane;
        unsigned* fl = A.flag + (unit0 + n) * 8 + w;
        unsigned long long pw[4];
        if (s >= NCH / 2 && !(flags & 1)) {
            if (have) {
#pragma unroll
                for (int i = 0; i < 4; ++i) pw[i] = pwn[i];
            } else {
                for (unsigned sp_ = 0; __builtin_amdgcn_readfirstlane((int)__hip_atomic_load(fl, __ATOMIC_RELAXED, __HIP_MEMORY_SCOPE_AGENT)) == 0 && sp_ < CHAIN_SPIN_CAP; ++sp_) __builtin_amdgcn_s_sleep(2);
#pragma unroll
                for (int i = 0; i < 4; ++i) pw[i] = __hip_atomic_load(sp + i * 64, __ATOMIC_RELAXED, __HIP_MEMORY_SCOPE_AGENT);
            }
        }
        have = false;
        if (s + 1 >= NCH / 2 && s + 1 < NCH && !(flags & 1) && __builtin_amdgcn_readfirstlane((int)fnext) != 0) {
            const int n1 = c ? NCH - 2 - s : s + 1; const unsigned long long* sp1 = (const unsigned long long*)(A.stg + (unit0 + n1) * 16384 + w * 2048) + lane;
#pragma unroll
            for (int i = 0; i < 4; ++i) pwn[i] = __hip_atomic_load(sp1 + i * 64, __ATOMIC_RELAXED, __HIP_MEMORY_SCOPE_AGENT);
            have = true;
        }
        if (s + 2 >= NCH / 2 && s + 2 < NCH && !(flags & 1)) { const int n2 = c ? NCH - 3 - s : s + 2; fnext = __hip_atomic_load(A.flag + (unit0 + n2) * 8 + w, __ATOMIC_RELAXED, __HIP_MEMORY_SCOPE_AGENT); }
        if (s + 1 < NCH) GDN_ISSUE(s + 1, (s + 1) & 1);
        const LAS unsigned char* X = lds + (s & 1) * C_BUF; const LAS unsigned char* Y = X + C_Y; const LAS unsigned char* YT = Y + 16384;
        const LAS float* sc = (const LAS float*)(X + B_SC);
        bf16x8 sb[4];
#pragma unroll
        for (int k = 0; k < 4; ++k) sb[k] = pack16(S[2 * k], S[2 * k + 1]);
        f32x4 KS[4], QS[4];
#pragma unroll
        for (int rt = 0; rt < 4; ++rt) { KS[rt] = z4; QS[rt] = z4; }
        {
            constexpr int R = 8; bf16x8 ring[R];
#define G1_LD(i_) lds_frag(X + (((i_) & 1) ? B_QA : B_KA), ((i_) >> 3) * 4 + (((i_) >> 1) & 3), lane)
#pragma unroll
            for (int i = 0; i < R; ++i) ring[i] = G1_LD(i);
#pragma unroll
            for (int i = 0; i < 32; ++i) { const int rt = i >> 3, ks = (i >> 1) & 3;
                if (i & 1) QS[rt] = MFMA16(ring[i % R], sb[ks], QS[rt]); else KS[rt] = MFMA16(ring[i % R], sb[ks], KS[rt]);
                if (i + R < 32) ring[i % R] = G1_LD(i + R);
                __builtin_amdgcn_sched_barrier(0); }
#undef G1_LD
        }
#pragma unroll
        for (int rt = 0; rt < 4; ++rt) { const v2u vv = vcur[rt]; const f32x4 ev = *(const LAS f32x4*)(sc + 128 + c * 64 + 16 * rt + 4 * q);
            KS[rt].x = bflo(vv.x) - ev.x * KS[rt].x; KS[rt].y = bfhi(vv.x) - ev.y * KS[rt].y; KS[rt].z = bflo(vv.y) - ev.z * KS[rt].z; KS[rt].w = bfhi(vv.y) - ev.w * KS[rt].w; }
        bf16x8 rb[2] = {pack16(KS[0], KS[1]), pack16(KS[2], KS[3])};
        f32x4 vn[4];
#pragma unroll
        for (int rt = 0; rt < 4; ++rt) vn[rt] = z4;
        {   constexpr int R = 8; bf16x8 ring[R];
#pragma unroll
            for (int i = 0; i < R; ++i) ring[i] = lds_frag(YT, i, lane);
#pragma unroll
            for (int i = 0; i < 8; ++i) { vn[i >> 1] = MFMA16(ring[i], rb[i & 1], vn[i >> 1]); __builtin_amdgcn_sched_barrier(0); }
        }
        bf16x8 vb[2] = {pack16(vn[0], vn[1]), pack16(vn[2], vn[3])};
        f32x4 (&o)[4] = QS;
#pragma unroll
        for (int rt = 0; rt < 4; ++rt) { const f32x4 ev = *(const LAS f32x4*)(sc + 128 + c * 64 + 16 * rt + 4 * q);
            o[rt].x *= QSCALE * ev.x; o[rt].y *= QSCALE * ev.y; o[rt].z *= QSCALE * ev.z; o[rt].w *= QSCALE * ev.w; }
        {   constexpr int R = 8; bf16x8 ring[R];
#pragma unroll
            for (int i = 0; i < R; ++i) ring[i] = lds_frag(YT + 8192, i, lane);
#pragma unroll
            for (int i = 0; i < 8; ++i) { o[i >> 1] = MFMA16(ring[i], vb[i & 1], o[i >> 1]); __builtin_amdgcn_sched_barrier(0); }
        }
        if (!(flags & 1)) {
            if (s < NCH / 2) {
#pragma unroll
                for (int rt = 0; rt < 4; ++rt) __hip_atomic_store(sp + rt * 64, (unsigned long long)pkbf(o[rt].x, o[rt].y) | ((unsigned long long)pkbf(o[rt].z, o[rt].w) << 32), __ATOMIC_RELAXED, __HIP_MEMORY_SCOPE_AGENT);
            } else {
#pragma unroll
                for (int rt = 0; rt < 4; ++rt) { const unsigned plo = (unsigned)pw[rt], phi = (unsigned)(pw[rt] >> 32);
                    __hip_atomic_store(sp + rt * 64, (unsigned long long)pkbf(o[rt].x + bflo(plo), o[rt].y + bfhi(plo)) | ((unsigned long long)pkbf(o[rt].z + bflo(phi), o[rt].w + bfhi(phi)) << 32), __ATOMIC_RELAXED, __HIP_MEMORY_SCOPE_AGENT); }
            }
        }
#pragma unroll
        for (int rt = 0; rt < 4; ++rt) { const f32x4 ev = *(const LAS f32x4*)(sc + 256 + c * 64 + 16 * rt + 4 * q);
            vn[rt].x *= ev.x; vn[rt].y *= ev.y; vn[rt].z *= ev.z; vn[rt].w *= ev.w; }
        vb[0] = pack16(vn[0], vn[1]); vb[1] = pack16(vn[2], vn[3]);
        const float egl = sc[384 + c];
#pragma unroll
        for (int t = 0; t < 8; ++t) { S[t].x *= egl; S[t].y *= egl; S[t].z *= egl; S[t].w *= egl; }
        {   constexpr int R = 8; bf16x8 ring[R];
#pragma unroll
            for (int i = 0; i < R; ++i) ring[i] = lds_frag(Y, i, lane);
#pragma unroll
            for (int i = 0; i < 16; ++i) { S[i >> 1] = MFMA16(ring[i % R], vb[i & 1], S[i >> 1]); if (i + R < 16) ring[i % R] = lds_frag(Y, i + R, lane); __builtin_amdgcn_sched_barrier(0); }
        }
        if (!(flags & 1)) { asm volatile("s_waitcnt vmcnt(0)" ::: "memory"); if (lane == 0) __hip_atomic_store(fl, s < NCH / 2 ? 1u : 2u, __ATOMIC_RELAXED, __HIP_MEMORY_SCOPE_AGENT); }
        __syncthreads();
    }
#undef GDN_ISSUE
}
namespace gla {
constexpr int B_QGF = 0, B_QGB = 16384, B_SC = 32768, B_KDTF = 33792, B_KDTB = 50176, BLOBA = 66560;
constexpr int B_VB = 0, B_INTRA = 32768, BLOBB = 65536;
constexpr int L_R = 0, L_QGF = 8192, L_KGF = L_QGF + 17408, L_KDF = L_KGF + 17408, L_QGB = L_KDF + 17408, L_KGB = L_QGB + 17408, L_KDB = L_KGB + 17408, L_V = L_KDB + 17408, L_TOT = L_V + 33792, L_AS = L_TOT + 4096, L_END = L_AS + 9216;
static_assert(L_END <= 160 * 1024 - 256, "gla prep LDS");
constexpr int QS_ = 272, VS_ = 528, AS_ = 144;
constexpr int C_X = 0, C_Y = 17408, C_CHAIN = 66560, C_EG = 2 * C_CHAIN, C_END = C_EG + 1024;
__device__ __forceinline__ v4u frag_tr_nat(const LAS unsigned char* img, int st, int colbase, int ks, int lane) {
    const int r = lane & 31, hh = lane >> 5; const LAS unsigned char* p = img + (16 * ks + 8 * hh) * st + (colbase + r) * 2;
    unsigned short e[8];
#pragma unroll
    for (int j = 0; j < 8; ++j) e[j] = *(const LAS unsigned short*)(p + j * st);
    return (v4u){(unsigned)e[0] | ((unsigned)e[1] << 16), (unsigned)e[2] | ((unsigned)e[3] << 16), (unsigned)e[4] | ((unsigned)e[5] << 16), (unsigned)e[6] | ((unsigned)e[7] << 16)};
}
__device__ __forceinline__ float logsig2(float x) { const float xc = fminf(fmaxf(x, -60.f), 60.f); return -__builtin_amdgcn_logf(1.0f + __builtin_amdgcn_exp2f(-1.4426950408889634f * xc)); }
}

struct GlaPrepArgs {
    const bf16* qk;
    const bf16* vb;
    const float* small;
    const float *w2f, *b2f, *w2b, *b2b;
    unsigned char* blobA;
    unsigned char* blobB;
    int nseq, pad_;
};

__device__ __forceinline__ void gla_prep_phase(LAS unsigned char* lds, const GlaPrepArgs& A, int bid, int G) {
    using namespace gla;
    int tid_l = threadIdx.x; asm volatile("" : "+v"(tid_l));
    const int tid = tid_l, lane = tid & 63, w = __builtin_amdgcn_readfirstlane(tid >> 6);
    const int nunits = A.nseq * 4 * NCH;
    f32x4 pr; v4u pv[4], pq[2], pk[2];
#define GLA_PREFETCH(u_) do { const int n_ = (u_) % NCH, h_ = ((u_) / NCH) % 4, sq_ = (u_) / (NCH * 4); const size_t r_ = (size_t)sq_ * SEQ + n_ * CHUNK; \
        pr = *(const f32x4*)(A.small + (r_ + (tid >> 3)) * 64 + 32 + (tid & 7) * 4); \
        _Pragma("unroll") for (int i = 0; i < 4; ++i) { const int id = i * 512 + tid; pv[i] = *(const v4u*)(A.vb + (r_ + (id >> 5)) * 1024 + h_ * 256 + (id & 31) * 8); } \
        _Pragma("unroll") for (int i = 0; i < 2; ++i) { const int id = i * 512 + tid; const bf16* qp_ = A.qk + (r_ + (id >> 4)) * 1024 + h_ * 128 + (id & 15) * 8; pq[i] = *(const v4u*)qp_; pk[i] = *(const v4u*)(qp_ + 512); } } while (0)
    int unit = bid;
    if (unit < nunits) GLA_PREFETCH(unit);
  for (; unit < nunits; unit += G) {
    const int h = (unit / NCH) % 4;
    unsigned char* blob = A.blobA + (size_t)unit * BLOBA; unsigned char* blobB = A.blobB + (size_t)unit * BLOBB;
    *(LAS f32x4*)(lds + L_R + (tid >> 3) * 128 + (tid & 7) * 16) = pr;
#pragma unroll
    for (int i = 0; i < 4; ++i) { const int id = i * 512 + tid; *(LAS v4u*)(lds + L_V + (id >> 5) * VS_ + (id & 31) * 16) = pv[i]; }
#pragma unroll
    for (int i = 0; i < 2; ++i) { const int id = i * 512 + tid; *(LAS v4u*)(lds + L_QGF + (id >> 4) * QS_ + (id & 15) * 16) = pq[i]; *(LAS v4u*)(lds + L_KGF + (id >> 4) * QS_ + (id & 15) * 16) = pk[i]; }
    LBAR();
    {
        const int dd = tid & 127, pg = tid >> 7, d = h * 128 + dd;
        float wf[16], wb[16];
#pragma unroll
        for (int i = 0; i < 16; ++i) { wf[i] = A.w2f[i * 512 + d]; wb[i] = A.w2b[i * 512 + d]; }
        const float bf_ = A.b2f[d], bb_ = A.b2b[d];
        float lf[16], lb[16];
#pragma unroll
        for (int pp = 0; pp < 16; ++pp) {
            const LAS float* rr = (const LAS float*)(lds + L_R) + (pg * 16 + pp) * 32;
            float xf = bf_, xb = bb_;
#pragma unroll
            for (int i4 = 0; i4 < 4; ++i4) { const f32x4 a = *(const LAS f32x4*)(rr + 4 * i4), b = *(const LAS f32x4*)(rr + 16 + 4 * i4);
                xf += a.x * wf[4 * i4] + a.y * wf[4 * i4 + 1] + a.z * wf[4 * i4 + 2] + a.w * wf[4 * i4 + 3];
                xb += b.x * wb[4 * i4] + b.y * wb[4 * i4 + 1] + b.z * wb[4 * i4 + 2] + b.w * wb[4 * i4 + 3]; }
            lf[pp] = logsig2(xf) * (1.f / 16.f); lb[pp] = logsig2(xb) * (1.f / 16.f);
        }
#pragma unroll
        for (int pp = 1; pp < 16; ++pp) lf[pp] += lf[pp - 1];
#pragma unroll
        for (int pp = 14; pp >= 0; --pp) lb[pp] += lb[pp + 1];
        LAS float* tot = (LAS float*)(lds + L_TOT);
        tot[pg * 128 + dd] = lf[15]; tot[512 + pg * 128 + dd] = lb[0];
        LBAR();
        float offf = 0.f, offb = 0.f, glf = 0.f, glb = 0.f;
#pragma unroll
        for (int g = 0; g < 4; ++g) { const float tf = tot[g * 128 + dd], tb = tot[512 + g * 128 + dd]; glf += tf; glb += tb; if (g < pg) offf += tf; if (g > pg) offb += tb; }
        const float eglf = __builtin_amdgcn_exp2f(glf), eglb = __builtin_amdgcn_exp2f(glb);
        if (pg == 0) { float* sc = (float*)(blob + B_SC); sc[dd] = eglf; sc[128 + dd] = eglb; }
#pragma unroll
        for (int pp = 0; pp < 16; ++pp) {
            const int o = (pg * 16 + pp) * QS_ + dd * 2;
            const float qv = bf2f(*(const LAS unsigned short*)(lds + L_QGF + o)) * QSCALE, kv = bf2f(*(const LAS unsigned short*)(lds + L_KGF + o));
            const float ef = __builtin_amdgcn_exp2f(lf[pp] + offf), eb = __builtin_amdgcn_exp2f(lb[pp] + offb);
            const float rf = __builtin_amdgcn_rcpf(ef), rb = __builtin_amdgcn_rcpf(eb);
            *(LAS unsigned short*)(lds + L_QGF + o) = (unsigned short)(pkbf(qv * ef, 0.f) & 0xffffu);
            *(LAS unsigned short*)(lds + L_KGF + o) = (unsigned short)(pkbf(kv * rf, 0.f) & 0xffffu);
            *(LAS unsigned short*)(lds + L_KDF + o) = (unsigned short)(pkbf(kv * rf * eglf, 0.f) & 0xffffu);
            *(LAS unsigned short*)(lds + L_QGB + o) = (unsigned short)(pkbf(qv * eb, 0.f) & 0xffffu);
            *(LAS unsigned short*)(lds + L_KGB + o) = (unsigned short)(pkbf(kv * rb, 0.f) & 0xffffu);
            *(LAS unsigned short*)(lds + L_KDB + o) = (unsigned short)(pkbf(kv * rb * eglb, 0.f) & 0xffffu);
        }
    }
    LBAR();
    { const int un = unit + G; if (un < nunits) GLA_PREFETCH(un); }
    if (w < 4) {
        const int rt = w >> 1, ct = w & 1, r = lane & 31, hh = lane >> 5;
        f32x16 af = zero16(), ab = zero16();
        if (rt >= ct) { const LAS unsigned char* ia = lds + L_QGF + (32 * rt + r) * QS_ + 16 * hh; const LAS unsigned char* ib = lds + L_KGF + (32 * ct + r) * QS_ + 16 * hh;
#pragma unroll
            for (int ks = 0; ks < 8; ++ks) af = MFMA32(*(const LAS bf16x8*)(ia + 32 * ks), *(const LAS bf16x8*)(ib + 32 * ks), af); }
        if (rt <= ct) { const LAS unsigned char* ia = lds + L_QGB + (32 * rt + r) * QS_ + 16 * hh; const LAS unsigned char* ib = lds + L_KGB + (32 * ct + r) * QS_ + 16 * hh;
#pragma unroll
            for (int ks = 0; ks < 8; ++ks) ab = MFMA32(*(const LAS bf16x8*)(ia + 32 * ks), *(const LAS bf16x8*)(ib + 32 * ks), ab); }
        const int j = 32 * ct + r;
#pragma unroll
        for (int reg = 0; reg < 16; ++reg) { const int i = 32 * rt + (reg & 3) + 8 * (reg >> 2) + 4 * hh;
            const float val = (i >= j ? af[reg] : 0.f) + (i <= j ? ab[reg] : 0.f);
            *(LAS unsigned short*)(lds + L_AS + i * AS_ + j * 2) = (unsigned short)(pkbf(val, 0.f) & 0xffffu); }
    } else {
        for (int blk = w - 4; blk < 64; blk += 4) {
            const int wh = blk >> 4, b = blk & 15; v4u f; int off;
            if (wh == 0)      { f = gdn::frag_rm_perm(lds + L_QGF, QS_, b >> 3, b & 7, lane); off = B_QGF; }
            else if (wh == 1) { f = gdn::frag_rm_perm(lds + L_QGB, QS_, b >> 3, b & 7, lane); off = B_QGB; }
            else if (wh == 2) { f = frag_tr_nat(lds + L_KDF, QS_, 32 * (b >> 2), b & 3, lane); off = B_KDTF; }
            else              { f = frag_tr_nat(lds + L_KDB, QS_, 32 * (b >> 2), b & 3, lane); off = B_KDTB; }
            *(v4u*)(blob + off + b * 1024 + lane * 16) = f;
        }
    }
    LBAR();
    {
        const int ct = w, r = lane & 31, hh = lane >> 5;
        f32x16 o[2] = {zero16(), zero16()};
#pragma unroll
        for (int ks = 0; ks < 4; ++ks) {
            const v4u fb = frag_tr_nat(lds + L_V, VS_, 32 * ct, ks, lane);
            *(v4u*)(blobB + B_VB + (ct * 4 + ks) * 1024 + lane * 16) = fb;
            const bf16x8 bfr = __builtin_bit_cast(bf16x8, fb);
#pragma unroll
            for (int rt = 0; rt < 2; ++rt) o[rt] = MFMA32(*(const LAS bf16x8*)(lds + L_AS + (32 * rt + r) * AS_ + (16 * ks + 8 * hh) * 2), bfr, o[rt]);
        }
        unsigned long long* ip = (unsigned long long*)(blobB + B_INTRA) + (size_t)ct * 512 + lane;
#pragma unroll
        for (int rt = 0; rt < 2; ++rt)
#pragma unroll
            for (int g = 0; g < 4; ++g) ip[(rt * 4 + g) * 64] = (unsigned long long)pkbf(o[rt][4 * g], o[rt][4 * g + 1]) | ((unsigned long long)pkbf(o[rt][4 * g + 2], o[rt][4 * g + 3]) << 32);
    }
    LBAR();
  }
#undef GLA_PREFETCH
}

struct GlaChainArgs {
    const unsigned char* blobA;
    const unsigned char* blobB;
    unsigned char* stg;
    unsigned* flag;
    int nseq, flags;
};
namespace gla { constexpr int CB_Y = 17408, CB_BUF = 66560, CB_END = 2 * CB_BUF; }
__device__ __forceinline__ void gla_chain_unit(LAS unsigned char* lds, const GlaChainArgs& A, int item) {
    using namespace gla;
    int tid_l = threadIdx.x; asm volatile("" : "+v"(tid_l));
    const int tid = tid_l, lane = tid & 63, w = __builtin_amdgcn_readfirstlane(tid >> 6);
    const int hh = lane >> 5;
    const int c = item & 1, h = (item >> 1) & 3, sq = item >> 3; const int flags = A.flags;
    const size_t unit0 = (size_t)(sq * 4 + h) * NCH;
    f32x16 S[4];
#pragma unroll
    for (int t = 0; t < 4; ++t) S[t] = zero16();
    unsigned long long pwn[8]; bool have = false; unsigned fnext = 0u;
#define GLA_ISSUE(s_, buf_) do { if (!(flags & 4)) { const int n_ = c ? NCH - 1 - (s_) : (s_); const unsigned char* bl_ = A.blobA + (unit0 + n_) * BLOBA; const unsigned char* bb_ = A.blobB + (unit0 + n_) * BLOBB; \
        LAS unsigned char* d_ = lds + (buf_) * CB_BUF; glds_blocks(d_, bl_ + (c ? B_QGB : B_QGF), 16, w, 8, lane); if (w == 7) glds_blocks(d_ + 16384, bl_ + B_SC, 1, 0, 1, lane); \
        glds_blocks(d_ + CB_Y, bl_ + (c ? B_KDTB : B_KDTF), 16, w, 8, lane); glds_blocks(d_ + CB_Y + 16384, bb_ + B_VB, 32, w, 8, lane); } } while (0)
    GLA_ISSUE(0, 0);
    __syncthreads();
    for (int s = 0; s < NCH; ++s) {
        const int n = c ? NCH - 1 - s : s;
        unsigned long long* sp = (unsigned long long*)(A.stg + (unit0 + n) * 32768) + (size_t)w * 512 + lane;
        unsigned* fl = A.flag + (unit0 + n) * 8 + w;
        unsigned long long pw[8];
        if (s >= NCH / 2 && !(flags & 1)) {
            if (have) {
#pragma unroll
                for (int i = 0; i < 8; ++i) pw[i] = pwn[i];
            } else {
                for (unsigned sp_ = 0; __builtin_amdgcn_readfirstlane((int)__hip_atomic_load(fl, __ATOMIC_RELAXED, __HIP_MEMORY_SCOPE_AGENT)) == 0 && sp_ < CHAIN_SPIN_CAP; ++sp_) __builtin_amdgcn_s_sleep(2);
#pragma unroll
                for (int i = 0; i < 8; ++i) pw[i] = __hip_atomic_load(sp + i * 64, __ATOMIC_RELAXED, __HIP_MEMORY_SCOPE_AGENT);
            }
        }
        have = false;
        if (s + 1 >= NCH / 2 && s + 1 < NCH && !(flags & 1) && __builtin_amdgcn_readfirstlane((int)fnext) != 0) {
            const int n1 = c ? NCH - 2 - s : s + 1; const unsigned long long* sp1 = (const unsigned long long*)(A.stg + (unit0 + n1) * 32768) + (size_t)w * 512 + lane;
#pragma unroll
            for (int i = 0; i < 8; ++i) pwn[i] = __hip_atomic_load(sp1 + i * 64, __ATOMIC_RELAXED, __HIP_MEMORY_SCOPE_AGENT);
            have = true;
        }
        if (s + 2 >= NCH / 2 && s + 2 < NCH && !(flags & 1)) { const int n2 = c ? NCH - 3 - s : s + 2; fnext = __hip_atomic_load(A.flag + (unit0 + n2) * 8 + w, __ATOMIC_RELAXED, __HIP_MEMORY_SCOPE_AGENT); }
        if (s + 1 < NCH) GLA_ISSUE(s + 1, (s + 1) & 1);
        const LAS unsigned char* X = lds + (s & 1) * CB_BUF; const LAS unsigned char* Y = X + CB_Y;
        const LAS float* EG = (const LAS float*)(X + 16384) + c * 128;
        bf16x8 sb[8];
#pragma unroll
        for (int t = 0; t < 4; ++t) { sb[2 * t] = pack8(S[t], 0); sb[2 * t + 1] = pack8(S[t], 1); }
        f32x16 o[2] = {zero16(), zero16()};
        {   constexpr int R = 6; bf16x8 ring[R];
#pragma unroll
            for (int i = 0; i < R; ++i) ring[i] = lds_frag(X, i, lane);
#pragma unroll
            for (int i = 0; i < 16; ++i) { o[i >> 3] = MFMA32(ring[i % R], sb[i & 7], o[i >> 3]); if (i + R < 16) ring[i % R] = lds_frag(X, i + R, lane); __builtin_amdgcn_sched_barrier(0); }
        }
        if (!(flags & 1)) {
            if (s < NCH / 2) {
#pragma unroll
                for (int rt = 0; rt < 2; ++rt)
#pragma unroll
                    for (int g = 0; g < 4; ++g) __hip_atomic_store(sp + (rt * 4 + g) * 64, (unsigned long long)pkbf(o[rt][4 * g], o[rt][4 * g + 1]) | ((unsigned long long)pkbf(o[rt][4 * g + 2], o[rt][4 * g + 3]) << 32), __ATOMIC_RELAXED, __HIP_MEMORY_SCOPE_AGENT);
            } else {
#pragma unroll
                for (int rt = 0; rt < 2; ++rt)
#pragma unroll
                    for (int g = 0; g < 4; ++g) { const unsigned plo = (unsigned)pw[rt * 4 + g], phi = (unsigned)(pw[rt * 4 + g] >> 32);
                        __hip_atomic_store(sp + (rt * 4 + g) * 64, (unsigned long long)pkbf(o[rt][4 * g] + bflo(plo), o[rt][4 * g + 1] + bfhi(plo)) | ((unsigned long long)pkbf(o[rt][4 * g + 2] + bflo(phi), o[rt][4 * g + 3] + bfhi(phi)) << 32), __ATOMIC_RELAXED, __HIP_MEMORY_SCOPE_AGENT); }
            }
        }
        {
            bf16x8 bfr[4];
#pragma unroll
            for (int ks = 0; ks < 4; ++ks) bfr[ks] = lds_frag(Y + 16384, w * 4 + ks, lane);
#pragma unroll
            for (int t = 0; t < 4; ++t)
#pragma unroll
                for (int g = 0; g < 4; ++g) { const f32x4 ev = *(const LAS f32x4*)(EG + 32 * t + 8 * g + 4 * hh);
                    S[t][4 * g] *= ev.x; S[t][4 * g + 1] *= ev.y; S[t][4 * g + 2] *= ev.z; S[t][4 * g + 3] *= ev.w; }
            constexpr int R = 5; bf16x8 ring[R];
#pragma unroll
            for (int i = 0; i < R; ++i) ring[i] = lds_frag(Y, i, lane);
#pragma unroll
            for (int i = 0; i < 16; ++i) { S[i >> 2] = MFMA32(ring[i % R], bfr[i & 3], S[i >> 2]); if (i + R < 16) ring[i % R] = lds_frag(Y, i + R, lane); __builtin_amdgcn_sched_barrier(0); }
        }
        if (!(flags & 1)) { asm volatile("s_waitcnt vmcnt(0)" ::: "memory"); if (lane == 0) __hip_atomic_store(fl, s < NCH / 2 ? 1u : 2u, __ATOMIC_RELAXED, __HIP_MEMORY_SCOPE_AGENT); }
        __syncthreads();
    }
#undef GLA_ISSUE
}

template <int NC, bool S16>
__device__ __forceinline__ void p4_unit(LAS unsigned char* lds, const unsigned char* slot, const unsigned char* intra, const bf16* zg, const float* nw, bf16* out, const unsigned* done) {
    int tid_l = threadIdx.x; asm volatile("" : "+v"(tid_l));
    const int tid = tid_l, lane = tid & 63, w = __builtin_amdgcn_readfirstlane(tid >> 6), r = lane & 31, hh = lane >> 5;
    constexpr int ST = NC * 2 + 16, NB = (NC / 32) * 8, CPR = NC / 8;
    if (done) {
        for (unsigned sp_ = 0; sp_ < (1u << 22); ++sp_) { const unsigned f = lane < 8 ? __hip_atomic_load(done + lane, __ATOMIC_RELAXED, __HIP_MEMORY_SCOPE_AGENT) : 2u; if (__all(f == 2u)) break; __builtin_amdgcn_s_sleep(8); }
    }
    for (int b = w; b < NB; b += 8) {
        const unsigned long long v = __hip_atomic_load((const unsigned long long*)slot + b * 64 + lane, __ATOMIC_RELAXED, __HIP_MEMORY_SCOPE_AGENT);
        float x0 = bflo((unsigned)v), x1 = bfhi((unsigned)v), x2 = bflo((unsigned)(v >> 32)), x3 = bfhi((unsigned)(v >> 32));
        if (intra) { const unsigned long long iv = ((const unsigned long long*)intra)[b * 64 + lane];
            x0 += bflo((unsigned)iv); x1 += bfhi((unsigned)iv); x2 += bflo((unsigned)(iv >> 32)); x3 += bfhi((unsigned)(iv >> 32)); }
        int row, col;
        if (S16) { row = 16 * (b & 3) + 4 * (lane >> 4); col = 16 * (b >> 2) + (lane & 15); }
        else { row = 32 * ((b >> 2) & 1) + 8 * (b & 3) + 4 * hh; col = 32 * (b >> 3) + r; }
        LAS unsigned char* p = lds + row * ST + col * 2;
        const unsigned a = pkbf(x0, x1), bq = pkbf(x2, x3);
        *(LAS unsigned short*)p = (unsigned short)(a & 0xffffu); *(LAS unsigned short*)(p + ST) = (unsigned short)(a >> 16);
        *(LAS unsigned short*)(p + 2 * ST) = (unsigned short)(bq & 0xffffu); *(LAS unsigned short*)(p + 3 * ST) = (unsigned short)(bq >> 16);
    }
    __syncthreads();
#pragma unroll
    for (int it = 0; it < (64 * CPR) / 512; ++it) {
        const int idx = it * 512 + tid, row = idx / CPR, ch = idx % CPR;
        const v4u xw = *(const LAS v4u*)(lds + row * ST + ch * 16);
        float x[8] = {bflo(xw.x), bfhi(xw.x), bflo(xw.y), bfhi(xw.y), bflo(xw.z), bfhi(xw.z), bflo(xw.w), bfhi(xw.w)};
        float ss = 0.f;
#pragma unroll
        for (int i = 0; i < 8; ++i) ss += x[i] * x[i];
        ss = row16_sum(ss);
        if (NC == 256) ss += __shfl_xor(ss, 16);
        const float rstd = 1.0f / sqrtf(ss * (1.0f / NC) + EPS);
        f32x4 w0 = *(const f32x4*)(nw + ch * 8), w1 = *(const f32x4*)(nw + ch * 8 + 4);
        if (zg) { const v4u zw = *(const v4u*)(zg + (size_t)row * 1024 + ch * 8);
            const float z[8] = {bflo(zw.x), bfhi(zw.x), bflo(zw.y), bfhi(zw.y), bflo(zw.z), bfhi(zw.z), bflo(zw.w), bfhi(zw.w)};
            w0.x *= z[0] * __builtin_amdgcn_rcpf(1.0f + __expf(-z[0])); w0.y *= z[1] * __builtin_amdgcn_rcpf(1.0f + __expf(-z[1])); w0.z *= z[2] * __builtin_amdgcn_rcpf(1.0f + __expf(-z[2])); w0.w *= z[3] * __builtin_amdgcn_rcpf(1.0f + __expf(-z[3]));
            w1.x *= z[4] * __builtin_amdgcn_rcpf(1.0f + __expf(-z[4])); w1.y *= z[5] * __builtin_amdgcn_rcpf(1.0f + __expf(-z[5])); w1.z *= z[6] * __builtin_amdgcn_rcpf(1.0f + __expf(-z[6])); w1.w *= z[7] * __builtin_amdgcn_rcpf(1.0f + __expf(-z[7])); }
        v4u o; o.x = pkbf(x[0] * rstd * w0.x, x[1] * rstd * w0.y); o.y = pkbf(x[2] * rstd * w0.z, x[3] * rstd * w0.w); o.z = pkbf(x[4] * rstd * w1.x, x[5] * rstd * w1.y); o.w = pkbf(x[6] * rstd * w1.z, x[7] * rstd * w1.w);
        *(v4u*)(out + (size_t)row * 1024 + ch * 8) = o;
    }
    __syncthreads();
}
#define XB_TMO      128
#define XB_XCNT(j)  (256  + 64 * (j))
#define XB_XSUB(j)  (1280 + 64 * (j))
#define XB_XGEN(j)  (2304 + 64 * (j))
#define XB_TOP      3328
#define XB_TOPGEN   3392
#define XCD_BAR_WORDS 3456
#define XB_SPIN_CAP (1u << 18)

__device__ __forceinline__ unsigned xb_ld(unsigned* p)              { return __hip_atomic_load(p, __ATOMIC_RELAXED, __HIP_MEMORY_SCOPE_AGENT); }
__device__ __forceinline__ unsigned xb_add(unsigned* p, unsigned v) { return __hip_atomic_fetch_add(p, v, __ATOMIC_RELAXED, __HIP_MEMORY_SCOPE_AGENT); }
__device__ __forceinline__ unsigned xb_xcc_id() { return (unsigned)__builtin_amdgcn_s_getreg((3 << 11) | 20) & 0xFu; }
#define XB_SPIN(cond, bar) do { unsigned _sp = 0; while (cond) { __builtin_amdgcn_s_sleep(1); \
    if ((++_sp & 255u) == 0u) { if (xb_ld(&(bar)[XB_TMO])) break; if (_sp > XB_SPIN_CAP) { atomicAdd(&(bar)[XB_TMO], 1u); break; } } } } while (0)

struct XcdBarrier {
    unsigned* bar; unsigned x;
    volatile LAS unsigned* st;
};

__device__ __forceinline__ XcdBarrier xcd_barrier_post(unsigned* bar, volatile LAS unsigned* st) {
    XcdBarrier b; b.bar = bar; b.x = xb_xcc_id(); b.st = st;
    if (threadIdx.x == 0) (void)xb_add(&bar[XB_XCNT(b.x)], 1u);
    return b;
}
__device__ __forceinline__ void xcd_barrier_complete(unsigned* bar, unsigned x, unsigned& nloc, unsigned& nx) {
    const unsigned G = gridDim.x * gridDim.y * gridDim.z;
    unsigned sum, cnt, mine, sp = 0u;
    for (;;) {
        sum = 0u; cnt = 0u; mine = 0u;
#pragma unroll
        for (unsigned j = 0; j < 16; ++j) { const unsigned c = xb_ld(&bar[XB_XCNT(j)]); sum += c; cnt += (c > 0u) ? 1u : 0u; mine = (j == x) ? c : mine; }
        if (sum == G) break;
        __builtin_amdgcn_s_sleep(1);
        if ((++sp & 255u) == 0u) { if (xb_ld(&bar[XB_TMO])) break; if (sp > XB_SPIN_CAP) { atomicAdd(&bar[XB_TMO], 1u); break; } }
    }
    nloc = mine > 0u ? mine : 1u; nx = cnt > 0u ? cnt : 1u;
}

__device__ __forceinline__ void xcd_barrier(const XcdBarrier& b) {
    asm volatile("s_waitcnt vmcnt(0)" ::: "memory");
    __syncthreads();
    if (threadIdx.x == 0) {
        unsigned* bar = b.bar;
        __builtin_amdgcn_s_waitcnt(0);
        unsigned nloc = b.st[0], nx = b.st[1];
        if (nloc == 0u) { xcd_barrier_complete(bar, b.x, nloc, nx); b.st[0] = nloc; b.st[1] = nx; }
        const unsigned old = xb_add(&bar[XB_XSUB(b.x)], 1u);
        const unsigned gen = old / nloc;
        if (old + 1u == (gen + 1u) * nloc) {
            __builtin_amdgcn_fence(__ATOMIC_RELEASE, "agent");
            asm volatile("s_waitcnt vmcnt(0)" ::: "memory");
            const unsigned og = xb_add(&bar[XB_TOP], 1u);
            const unsigned tg = og / nx;
            if (og + 1u == (tg + 1u) * nx) xb_add(&bar[XB_TOPGEN], 1u);
            else XB_SPIN(xb_ld(&bar[XB_TOPGEN]) == tg, bar);
            __builtin_amdgcn_fence(__ATOMIC_ACQUIRE, "agent");
            xb_add(&bar[XB_XGEN(b.x)], 1u);
            asm volatile("s_waitcnt vmcnt(0)" ::: "memory");
        } else {
            XB_SPIN(xb_ld(&bar[XB_XGEN(b.x)]) == gen, bar);
            __builtin_amdgcn_fence(__ATOMIC_ACQUIRE, "agent");
            asm volatile("s_waitcnt vmcnt(0)" ::: "memory");
        }
    }
    __syncthreads();
}
__device__ __forceinline__ void transpose_item(const float* W, int ldw, int src_col0, int K, int ncols, bf16* WT, int dst_row0, LAS float* scr, int item, int lane) {
    asm volatile("" : "+v"(lane));
    const int nblk = ncols / 32, kb = item / nblk, nb = item % nblk, k0 = 64 * kb, n0 = 32 * nb;
#pragma unroll 8
    for (int i = 0; i < 32; ++i) { const int kk = 2 * i + (lane >> 5); scr[kk * 33 + (lane & 31)] = W[(size_t)(k0 + kk) * ldw + src_col0 + n0 + (lane & 31)]; }
    LDS_WAIT();
    const int c = lane & 7;
#pragma unroll
    for (int j = 0; j < 4; ++j) { const int n = (lane >> 3) + 8 * j; const LAS float* s = scr + (8 * c) * 33 + n;
        v4u o; o.x = pk2(s[0 * 33], s[1 * 33]); o.y = pk2(s[2 * 33], s[3 * 33]); o.z = pk2(s[4 * 33], s[5 * 33]); o.w = pk2(s[6 * 33], s[7 * 33]);
        *(v4u*)(WT + (size_t)(dst_row0 + n0 + n) * K + k0 + 8 * c) = o; }
    LDS_WAIT();
}
__device__ __forceinline__ void h_rows(const float* x, const float* w, bf16* h, int nrows, int gw, int ngw, int lane) {
    asm volatile("" : "+v"(lane));
    for (int m = gw; m < nrows; m += ngw) {
        const f32x4* xr = (const f32x4*)(x + (size_t)m * D) + lane; f32x4 v[4]; float s = 0.f;
#pragma unroll
        for (int j = 0; j < 4; ++j) { v[j] = xr[64 * j]; s += (v[j].x * v[j].x + v[j].y * v[j].y) + (v[j].z * v[j].z + v[j].w * v[j].w); }
        const float rstd = 1.0f / sqrtf(wave_sum(s) * (1.f / D) + EPS);
        unsigned long long* o8 = (unsigned long long*)(h + (size_t)m * D) + lane;
#pragma unroll
        for (int j = 0; j < 4; ++j) { const f32x4 ww = ((const f32x4*)w)[lane + 64 * j];
            o8[64 * j] = (unsigned long long)pkbf(v[j].x * rstd * ww.x, v[j].y * rstd * ww.y) | ((unsigned long long)pkbf(v[j].z * rstd * ww.z, v[j].w * rstd * ww.w) << 32); }
    }
}
__device__ __forceinline__ void h_rows_tiles(const float* x, const float* w, const pg8::Gemm& gt, int nrows, int gw, int ngw, int lane) {
    asm volatile("" : "+v"(lane));
    for (int m = gw; m < nrows; m += ngw) {
        const f32x4* xr = (const f32x4*)(x + (size_t)m * D) + lane; f32x4 v[4]; float s = 0.f;
#pragma unroll
        for (int j = 0; j < 4; ++j) { v[j] = xr[64 * j]; s += (v[j].x * v[j].x + v[j].y * v[j].y) + (v[j].z * v[j].z + v[j].w * v[j].w); }
        const float rstd = 1.0f / sqrtf(wave_sum(s) * (1.f / D) + EPS);
        unsigned long long* o8 = (unsigned long long*)(gt.atile(m >> 8, (size_t)256 * D * 2) + (size_t)(m & 255) * D * 2) + lane;
#pragma unroll
        for (int j = 0; j < 4; ++j) { const f32x4 ww = ((const f32x4*)w)[lane + 64 * j];
            o8[64 * j] = (unsigned long long)pkbf(v[j].x * rstd * ww.x, v[j].y * rstd * ww.y) | ((unsigned long long)pkbf(v[j].z * rstd * ww.z, v[j].w * rstd * ww.w) << 32); }
    }
}
__device__ __forceinline__ void final_rows(const float* x, const float* pre, const float* w, float* out, int nrows, int gw, int ngw, int lane) {
    asm volatile("" : "+v"(lane));
    for (int m = gw; m < nrows; m += ngw) {
        const f32x4* pr = (const f32x4*)(pre + (size_t)m * D) + lane; const f32x4* xr = (const f32x4*)(x + (size_t)m * D) + lane; f32x4 v[4]; float s = 0.f;
#pragma unroll
        for (int j = 0; j < 4; ++j) { v[j] = pr[64 * j]; s += (v[j].x * v[j].x + v[j].y * v[j].y) + (v[j].z * v[j].z + v[j].w * v[j].w); }
        const float rstd = 1.0f / sqrtf(wave_sum(s) * (1.f / D) + EPS);
        f32x4* orow = (f32x4*)(out + (size_t)m * D) + lane;
#pragma unroll
        for (int j = 0; j < 4; ++j) { const f32x4 ww = ((const f32x4*)w)[lane + 64 * j]; const f32x4 xv = xr[64 * j]; orow[64 * j] = xv + v[j] * rstd * ww; }
    }
}
__device__ __forceinline__ void small_unit(LAS unsigned char* lds, const bf16* h, const bf16* wsm, float* out, int unit) {
    int tid_l = threadIdx.x; asm volatile("" : "+v"(tid_l));
    const int tid = tid_l, lane = tid & 63, w = __builtin_amdgcn_readfirstlane(tid >> 6), r = lane & 31, hh = lane >> 5;
    const int rt = (w >> 1) & 1, ct = w & 1, kh = w >> 2;
    const bf16* ap = h + (size_t)(unit * 64 + 32 * rt + r) * D + kh * 512 + 8 * hh;
    const bf16* bp = wsm + (size_t)(32 * ct + r) * D + kh * 512 + 8 * hh;
    f32x16 acc = zero16();
#pragma unroll 8
    for (int ks = 0; ks < 32; ++ks) acc = MFMA32(*(const bf16x8*)(ap + 16 * ks), *(const bf16x8*)(bp + 16 * ks), acc);
    LAS float* red = (LAS float*)lds + (w & 3) * 1024 + lane;
    if (kh == 1) {
#pragma unroll
        for (int i = 0; i < 16; ++i) red[i * 64] = acc[i]; }
    __syncthreads();
    if (kh == 0) {
        float* op = out + (size_t)(unit * 64 + 32 * rt + 4 * hh) * 64 + 32 * ct + r;
#pragma unroll
        for (int i = 0; i < 16; ++i) op[((i & 3) + 8 * (i >> 2)) * 64] = acc[i] + red[i * 64]; }
    __syncthreads();
}

constexpr int NG = 2, MG = M / NG, NSEQG = BATCH / NG;
constexpr size_t KiB = 1024;
constexpr size_t WS_CTL = 0  , WS_WTIN = 320 * KiB, WS_WTA = WS_WTIN + 18560 * KiB, WS_WTB = WS_WTA + 2 * MiB, WS_WTO = WS_WTB + 2 * MiB, WS_SMALL = WS_WTO + 2 * MiB  ,
    WS_Z = WS_SMALL + 2 * MiB  , WS_PG = WS_Z + 16 * MiB  , WS_GBLOB = WS_PG + 80 * MiB  , WS_LBLOBB = WS_GBLOB + 98 * MiB  , WS_END = WS_LBLOBB + 32 * MiB;
static_assert(WS_END <= 256 * MiB, "workspace");
constexpr size_t WS_GATES = WS_GBLOB  , WS_M1 = WS_GATES + 64 * MiB  , WS_MERGED = WS_M1 + 32 * MiB  , WS_PRE = WS_MERGED + 32 * MiB  ;
static_assert(WS_PRE + 1 * MiB <= WS_END, "overlays");
constexpr size_t HT_TILE = 256 * 1024 * 2, WS_H0 = WS_WTIN, WS_H1 = WS_PG + (size_t)NSEQG * 4 * NCH * gla::BLOBA, WS_H2 = WS_SMALL, WS_H3 = WS_END;
constexpr int HT1 = 24, HT2 = 55, HT3 = 59;
static_assert(((size_t)NSEQG * 4 * NCH * gla::BLOBA) % HT_TILE == 0 && WS_H1 + (HT2 - HT1) * HT_TILE <= WS_PG + 3 * ((size_t)MG * 2048) && HT1 * HT_TILE <= (size_t)6144 * 2048 && (HT3 - HT2) * HT_TILE <= 2 * MiB && WS_H3 + (64 - HT3) * HT_TILE <= 256 * MiB, "h tiles");
constexpr size_t PGMAT = (size_t)MG * 1024 * 2;
static_assert((size_t)NSEQG * 4 * NCH * gla::BLOBA <= 3 * PGMAT && (size_t)NSEQG * 4 * NCH * 32768 <= PGMAT && (size_t)NSEQG * 8 * NCH * 16384 <= PGMAT, "overlays");
static_assert((size_t)NSEQG * 8 * NCH * gdn::BLOB <= 98 * MiB && (size_t)NSEQG * 4 * NCH * gla::BLOBB <= 32 * MiB, "blobs");
constexpr int LDS_BYTES = 160 * 1024, LDS_BAR = LDS_BYTES - 16;
static_assert(gla::L_END <= LDS_BAR && gdn::L_END <= LDS_BAR && gdn::C_END <= LDS_BAR && gla::CB_END <= LDS_BAR && pg8::STAGE_BYTES <= LDS_BAR, "LDS");
constexpr int N_PHASES = 12;

struct MegaArgs { const float* in[18]; float* out; unsigned char* ws; int ph_lo, ph_hi; };

__global__ void __launch_bounds__(512, 2) mega(MegaArgs a) {
    extern __shared__ __attribute__((aligned(16))) unsigned char lds_raw[];
    LAS unsigned char* lds = (LAS unsigned char*)lds_raw;
    const int tid = threadIdx.x, lane = tid & 63, wave = __builtin_amdgcn_readfirstlane(tid >> 6);
    const int G = gridDim.x, bid = blockIdx.x, gw = bid * 8 + wave, ngw = G * 8;
    unsigned char* ws = a.ws;
    const float* x = a.in[0]; const float* ln_pre_w = a.in[1]; const float* w_in = a.in[2]; const float* conv_w = a.in[3];
    if (tid < 4) ((LAS unsigned*)(lds + LDS_BAR))[tid] = 0u;
    __syncthreads();
    XcdBarrier bar = xcd_barrier_post((unsigned*)(ws + WS_CTL), (volatile LAS unsigned*)(lds + LDS_BAR));
    const int lo = a.ph_lo, hi = a.ph_hi;
#define IN(k) (lo <= (k) && (k) < hi)
#define SEAM(k) do { if (IN(k) && IN((k) + 1)) xcd_barrier(bar); } while (0)
#ifndef PROBE_REPEAT
#define PROBE_REPEAT 0
#endif
#ifndef PROBE_FLAGS
#define PROBE_FLAGS 0
#endif
#define PH(k) if (IN(k)) for (int rep_ = 0; rep_ <= ((PROBE_REPEAT >> (k)) & 1); ++rep_)
#define REPBAR() do { if (rep_) xcd_barrier(bar); } while (0)
    bf16* WT_IN = (bf16*)(ws + WS_WTIN); bf16* WT_A = (bf16*)(ws + WS_WTA); bf16* WT_B = (bf16*)(ws + WS_WTB); bf16* WT_O = (bf16*)(ws + WS_WTO);
    bf16* PG = (bf16*)(ws + WS_PG); float* SMALL = (float*)(ws + WS_SMALL);
    bf16* ORAWA = (bf16*)a.out; bf16* ORAWB = (bf16*)a.out + (size_t)M * 1024;
    pg8::Gemm gh{(const bf16*)(ws + WS_H0), WT_IN + (size_t)6144 * D, M, 3072, D, 0, (const bf16*)(ws + WS_H1), (const bf16*)(ws + WS_H2), (const bf16*)(ws + WS_H3), HT1, HT2, HT3};

    PH(0) { REPBAR();
        LAS float* scr = (LAS float*)lds + wave * (64 * 33);
        constexpr int NSEG = 8;
        const int sdst[NSEG] = {0, 1024, 4096, 5120, 6144, 7168, 9216, 9248}, ssrc[NSEG] = {SRC_ZA, SRC_QKVA, SRC_QB, SRC_VB, SRC_GB, SRC_GA, SRC_AF, SRC_RF}, sn[NSEG] = {1024, 3072, 1024, 1024, 1024, 2048, 32, 32};
#pragma unroll
        for (int sgi = 0; sgi < NSEG; ++sgi) { const int nit = 16 * (sn[sgi] / 32);
            for (int it = gw; it < nit; it += ngw) transpose_item(w_in, NIN, ssrc[sgi], D, sn[sgi], WT_IN, sdst[sgi], scr, it, lane); }
        for (int it = gw; it < 512; it += ngw) transpose_item(a.in[9], D, 0, D, D, WT_A, 0, scr, it, lane);
        for (int it = gw; it < 512; it += ngw) transpose_item(a.in[15], D, 0, D, D, WT_B, 0, scr, it, lane);
        for (int it = gw; it < 512; it += ngw) transpose_item(a.in[16], D, 0, D, D, WT_O, 0, scr, it, lane);
        h_rows(x, ln_pre_w, ORAWB + (size_t)MG * 1024, MG, gw, ngw, lane);
    }
    SEAM(0);
#ifdef PROBE_BARRIERS
    for (int i = 0; i < PROBE_BARRIERS; ++i) xcd_barrier(bar);
#endif
    for (int g = 0; g < NG; ++g) {
        const int pb = 1 + 4 * g;
        const size_t r0 = (size_t)g * MG;
        const bf16* hsrc = (g == 0 ? ORAWB : ORAWA) + (size_t)MG * 1024;
        PH(pb) { REPBAR();
            for (int u = bid; u < MG / 64; u += G) small_unit(lds, hsrc, WT_IN + (size_t)9216 * D, SMALL, u);
            pg8::Gemm gm{hsrc, WT_IN, MG, 6144, D, 0}; pg8::StaticOrder S; S.init(MG, 6144, G, bid);
            pg8::EpiBf16 E{(bf16*)(ws + WS_Z), 1024, 1024, (size_t)MG * 1024};
            pg8::gemm_phase<pg8::EpiBf16, pg8::StaticOrder, true, true>(lds, gm, S, E);
        }
        SEAM(pb);
        PH(pb + 1) { REPBAR();
            GdnPrepArgs pa{PG, PG + (size_t)MG * 1024, PG + (size_t)2 * MG * 1024, SMALL, conv_w, a.in[4], a.in[5], a.in[6], a.in[7], ws + WS_GBLOB, NSEQG, rep_ ? PROBE_FLAGS : 0};
            gdn_prep_phase(lds, pa, bid, G, ws + WS_CTL + 300 * KiB);
        }
        SEAM(pb + 1);
        PH(pb + 2) { REPBAR();
            GlaPrepArgs pa{PG + (size_t)3 * MG * 1024, PG + (size_t)4 * MG * 1024, SMALL, a.in[10], a.in[11], a.in[12], a.in[13], ws + WS_PG, ws + WS_LBLOBB, NSEQG, 0};
            gla_prep_phase(lds, pa, bid, G);
        }
        SEAM(pb + 2);
        PH(pb + 3) { REPBAR();
            constexpr int NGI = NSEQG * 8 * 2, NLI = NSEQG * 4 * 2;
            unsigned* gflag = (unsigned*)(ws + WS_CTL + 32 * KiB) + (size_t)g * (NSEQG * 8 * NCH * 8); unsigned* lflag = (unsigned*)(ws + WS_CTL + 96 * KiB) + (size_t)g * (NSEQG * 4 * NCH * 8);
            if (rep_) { gflag += 32 * 1024; lflag += 32 * 1024; }
            if (bid < NGI) { if (!(rep_ && (PROBE_FLAGS & 16))) { GdnChainArgs ca{ws + WS_GBLOB, ws + WS_PG + 4 * PGMAT, gflag, NSEQG, rep_ ? PROBE_FLAGS : 0}; gdn_chain_unit(lds, ca, bid); } }
            else if (bid < NGI + NLI) { if (!(rep_ && (PROBE_FLAGS & 32))) { GlaChainArgs ca{ws + WS_PG, ws + WS_LBLOBB, ws + WS_PG + 3 * PGMAT, lflag, NSEQG, rep_ ? PROBE_FLAGS : 0}; gla_chain_unit(lds, ca, bid - NGI); } }
            else if (!rep_) {
                const int wk = bid - NGI - NLI, nwk = G - NGI - NLI;
                if (g == 0) h_rows(x + (size_t)MG * D, ln_pre_w, ORAWA + (size_t)MG * 1024, MG, wk * 8 + wave, nwk * 8, lane);
                if (g == NG - 1) h_rows_tiles(x, ln_pre_w, gh, M, wk * 8 + wave, nwk * 8, lane);
                constexpr int NPG = NSEQG * 8, NPL = NSEQG * 4;
                for (int j = wk; j < NCH * (NPG + NPL); j += nwk) {
                    const int rk = j / (NPG + NPL), idx = j % (NPG + NPL), n = (rk & 1) ? (NCH / 2 - 1 - (rk >> 1)) : (NCH / 2 + (rk >> 1));
                    if (idx < NPG) { const int u = idx * NCH + n, hd = idx % 8, sq = idx / 8;
                        p4_unit<128, true>(lds, ws + WS_PG + 4 * PGMAT + (size_t)u * 16384, nullptr, (const bf16*)(ws + WS_Z) + ((size_t)sq * SEQ + n * CHUNK) * 1024 + hd * 128, a.in[8], ORAWA + (r0 + (size_t)sq * SEQ + n * CHUNK) * 1024 + hd * 128, gflag + (size_t)u * 8); }
                    else { const int pi = idx - NPG, u = pi * NCH + n, hd = pi % 4, sq = pi / 4;
                        p4_unit<256, false>(lds, ws + WS_PG + 3 * PGMAT + (size_t)u * 32768, ws + WS_LBLOBB + (size_t)u * gla::BLOBB + gla::B_INTRA, nullptr, a.in[14], ORAWB + (r0 + (size_t)sq * SEQ + n * CHUNK) * 1024 + hd * 256, lflag + (size_t)u * 8); }
                }
            }
        }
        SEAM(pb + 3);
    }
    PH(9) { REPBAR();
        const pg8::Gemm& gm = gh; pg8::StaticOrder S; S.init(M, 3072, G, bid);
        if (rep_ == 0) { pg8::EpiP1b E{ORAWB, (bf16*)(ws + WS_GATES), (size_t)M * 1024, ORAWB};
            pg8::gemm_phase<pg8::EpiP1b, pg8::StaticOrder, true, true>(lds, gm, S, E); }
        else { pg8::EpiP1b E{ORAWB, (bf16*)(ws + WS_GATES), (size_t)M * 1024, (bf16*)(ws + WS_MERGED)};
            pg8::gemm_phase<pg8::EpiP1b, pg8::StaticOrder, true, true>(lds, gm, S, E); }
    }
    SEAM(9);
    PH(10) { REPBAR();
        pg8::Gemm gm{ORAWA, WT_A, 2 * M, 2 * D, D, 0}; pg8::PairOrder S; S.init(M, D, G, bid);
        pg8::EpiMerge E{(bf16*)(ws + WS_M1), (bf16*)(ws + WS_MERGED), (const bf16*)(ws + WS_GATES), (size_t)M * 1024, M / 256, D / 256};
        pg8::gemm_phase<pg8::EpiMerge, pg8::PairOrder, true, true>(lds, gm, S, E);
    }
    SEAM(10);
    if (IN(11)) {
        pg8::Gemm gm{(const bf16*)(ws + WS_MERGED), WT_O, M, D, D, 0}; pg8::StaticOrder S; S.init(M, D, G, bid);
        pg8::EpiRmsRes E{x, a.in[17], a.out, (float*)(ws + WS_PRE), (unsigned*)(ws + WS_CTL + 304 * KiB)};
        pg8::gemm_phase<pg8::EpiRmsRes, pg8::StaticOrder, false, true>(lds, gm, S, E);
    }
#undef IN
#undef SEAM
}

#ifndef MK_N_LAUNCHES
#define MK_N_LAUNCHES 1
#endif
extern "C" void kernel_launch(void* const* d_in, const int* in_sizes, int n_in, void* d_out, int out_size, void* d_ws, size_t ws_size, hipStream_t stream) {
    static int ready = 0;
    if (!ready) {
        if (n_in != 18 || ws_size < 256 * MiB || out_size != M * D) { fprintf(stderr, "kernel_launch: unexpected problem shape / workspace (%d inputs, ws %zu)\n", n_in, ws_size); ready = -1; return; }
        if (hipFuncSetAttribute((const void*)mega, hipFuncAttributeMaxDynamicSharedMemorySize, LDS_BYTES) != hipSuccess) { fprintf(stderr, "kernel_launch: hipFuncSetAttribute failed\n"); ready = -1; return; }
        ready = 1;
    }
    if (ready < 0) return;
    (void)hipMemsetAsync((char*)d_ws + WS_CTL, 0, 320 * 1024, stream);
    MegaArgs a{};
    for (int i = 0; i < 18; ++i) a.in[i] = (const float*)d_in[i];
    a.out = (float*)d_out; a.ws = (unsigned char*)d_ws;
#if MK_N_LAUNCHES == 1
    a.ph_lo = 0; a.ph_hi = N_PHASES;
    hipLaunchKernelGGL(mega, dim3(256), dim3(512), LDS_BYTES, stream, a);
#else
    for (int p = 0; p < N_PHASES; ++p) { a.ph_lo = p; a.ph_hi = p + 1; hipLaunchKernelGGL(mega, dim3(256), dim3(512), LDS_BYTES, stream, a); }
#endif
}
```

```cpp
#include <hip/hip_runtime.h>
#include <cstdio>
#include <cstdint>

#define GAS __attribute__((address_space(1)))
#define LAS __attribute__((address_space(3)))
typedef unsigned short bf16;
typedef unsigned v4u __attribute__((ext_vector_type(4)));
typedef unsigned v2u __attribute__((ext_vector_type(2)));
typedef float f32x4 __attribute__((ext_vector_type(4)));
#define LDS_WAIT() asm volatile("s_waitcnt lgkmcnt(0)" ::: "memory")

constexpr int BATCH = 8, SEQ = 2048, D = 1024, M = BATCH * SEQ, NIN = 9280;
constexpr float EPS = 1e-6f;
constexpr size_t MiB = 1 << 20;
constexpr int SRC_QKVA = 0, SRC_ZA = 3072, SRC_AF = 4096, SRC_QB = 4128, SRC_KB = 4640, SRC_VB = 5152, SRC_GB = 6176, SRC_RF = 7200, SRC_GA = 7232, SRC_GBm = 8256;

__device__ __forceinline__ unsigned f2bf(float f) { unsigned u = __builtin_bit_cast(unsigned, f); return (u + 0x7fffu + ((u >> 16) & 1u)) >> 16; }
__device__ __forceinline__ unsigned pk2(float lo, float hi) { return f2bf(lo) | (f2bf(hi) << 16); }
__device__ __forceinline__ float bf2f(unsigned short b) { return __builtin_bit_cast(float, (unsigned)b << 16); }
__device__ __forceinline__ float bflo(unsigned w) { return __builtin_bit_cast(float, w << 16); }
__device__ __forceinline__ float bfhi(unsigned w) { return __builtin_bit_cast(float, w & 0xffff0000u); }
__device__ __forceinline__ float sigmoidf_(float x) { return 1.0f / (1.0f + __expf(-x)); }
__device__ __forceinline__ float siluf_(float x) { return x / (1.0f + __expf(-x)); }
__device__ __forceinline__ float wave_sum(float v) {
#pragma unroll
    for (int o = 1; o < 64; o <<= 1) v += __shfl_xor(v, o);
    return v;
}
namespace pg8 {
#define PG8_LAS __attribute__((address_space(3)))
typedef unsigned short bf16_t;
typedef short bf16x8 __attribute__((ext_vector_type(8)));
typedef float f32x4 __attribute__((ext_vector_type(4)));
typedef unsigned u32x4 __attribute__((ext_vector_type(4)));
constexpr int BM = 256, BK = 64, HALF = 128, HTB = HALF * BK * 2  , STAGE_BYTES = 8 * HTB, NXCD = 8, WGM = 8;

__host__ __device__ __forceinline__ int lds_byte(int r, int c) { const int st = (r >> 4) * 2 + (c >> 5), rr = r & 15, cc = c & 31, ob = rr * 64 + cc * 2; return st * 1024 + (ob ^ (((ob >> 9) & 1) << 5)); }
__host__ __device__ __forceinline__ void stage_rc(int b, int& R, int& C) { const int st = b / 1024, sb = b % 1024, swz = sb ^ (((sb >> 9) & 1) << 5); R = (st >> 1) * 16 + swz / 64; C = (st & 1) * 32 + (swz % 64) / 2; }
__host__ __device__ __forceinline__ int perm32(int rho) { const int n = rho >> 4, i = rho & 15; return 8 * (i >> 2) + 4 * n + (i & 3); }

struct Unit { int pm, pn; };
struct Gemm { const bf16_t* A; const bf16_t* Bt; int M, N, K, pad_;
    const bf16_t* A1 = nullptr; const bf16_t* A2 = nullptr; const bf16_t* A3 = nullptr; int t1 = 1 << 30, t2 = 1 << 30, t3 = 1 << 30;
    __host__ __device__ __forceinline__ const char* atile(int pm, size_t tstep) const {
        if (pm < t1) return (const char*)A + (size_t)pm * tstep;
        if (pm < t2) return (const char*)A1 + (size_t)(pm - t1) * tstep;
        if (pm < t3) return (const char*)A2 + (size_t)(pm - t2) * tstep;
        return (const char*)A3 + (size_t)(pm - t3) * tstep; }
};

struct StaticOrder {
    int nM, nN, nwg, G, c;
    __host__ __device__ void init(int M, int N, int G_, int c_) { nM = M / BM; nN = N / BM; nwg = nM * nN; G = G_; c = c_; }
    __host__ __device__ bool next(int i, Unit& u) const {
        const long L = (long)i * G + c; if (L >= nwg) return false;
        int wgid = (int)L; { const int q = nwg / NXCD, r = nwg % NXCD, xcd = wgid % NXCD, off = wgid / NXCD; wgid = (xcd < r ? xcd * (q + 1) : r * (q + 1) + (xcd - r) * q) + off; }
        const int nig = WGM * nN, gid = wgid / nig, fm = gid * WGM, gsz = (nM - fm) < WGM ? (nM - fm) : WGM;
        u.pm = fm + ((wgid % nig) % gsz); u.pn = (wgid % nig) / gsz; return true;
    }
    __device__ __forceinline__ void a_ready(const Unit&) const {}
    __device__ __forceinline__ void done(const Unit&) const {}
};

__device__ __forceinline__ unsigned cvt_pk_bf16(float lo, float hi) { unsigned r; asm volatile("v_cvt_pk_bf16_f32 %0, %1, %2" : "=v"(r) : "v"(lo), "v"(hi)); return r; }
struct EpiBf16 {
    static constexpr bool PERM = true, AFTER_DRAIN = false;
    bf16_t* O; int ldc; int split_cols; size_t split_stride;
    __device__ __forceinline__ void operator()(const f32x4 (&acc)[2][2][4][2], const Unit& u, int wr, int wc, int fr, int fq) const {
        const int row0 = u.pm * BM + wr * 64 + fr; int colt = u.pn * BM; bf16_t* base = O;
        if (split_cols) { const int t = colt / split_cols; base += (size_t)t * split_stride; colt -= t * split_cols; }
        const int col0 = colt + wc * 32 + 8 * fq;
#pragma unroll
        for (int ai = 0; ai < 2; ++ai)
#pragma unroll
            for (int m = 0; m < 4; ++m) { bf16_t* rowp = base + (size_t)(row0 + ai * HALF + m * 16) * ldc + col0;
#pragma unroll
                for (int bj = 0; bj < 2; ++bj) { const f32x4 v0 = acc[ai][bj][m][0], v1 = acc[ai][bj][m][1];
                    u32x4 w; w.x = cvt_pk_bf16(v0[0], v0[1]); w.y = cvt_pk_bf16(v0[2], v0[3]); w.z = cvt_pk_bf16(v1[0], v1[1]); w.w = cvt_pk_bf16(v1[2], v1[3]);
                    *(u32x4*)(rowp + bj * HALF) = w; } }
    }
};
template <int MODE> struct EpiGate {
    static constexpr bool PERM = true, AFTER_DRAIN = false;
    bf16_t* O; const bf16_t* G; const bf16_t* Add; int ldc, pad_;
    __device__ __forceinline__ void operator()(const f32x4 (&acc)[2][2][4][2], const Unit& u, int wr, int wc, int fr, int fq) const {
        const int row0 = u.pm * BM + wr * 64 + fr; const int col0 = u.pn * BM + wc * 32 + 8 * fq;
#pragma unroll
        for (int ai = 0; ai < 2; ++ai)
#pragma unroll
            for (int m = 0; m < 4; ++m) { const size_t ro = (size_t)(row0 + ai * HALF + m * 16) * ldc + col0;
#pragma unroll
                for (int bj = 0; bj < 2; ++bj) { const f32x4 v0 = acc[ai][bj][m][0], v1 = acc[ai][bj][m][1];
                    const u32x4 gw = *(const u32x4*)(G + ro + bj * HALF);
                    float r[8]; const float a[8] = {v0[0], v0[1], v0[2], v0[3], v1[0], v1[1], v1[2], v1[3]};
#pragma unroll
                    for (int i = 0; i < 4; ++i) { const unsigned w = gw[i]; const float g0 = __builtin_bit_cast(float, w << 16), g1 = __builtin_bit_cast(float, w & 0xffff0000u);
                        if (MODE == 0) { r[2 * i] = a[2 * i] / (1.0f + __expf(-g0)); r[2 * i + 1] = a[2 * i + 1] / (1.0f + __expf(-g1)); }
                        else { r[2 * i] = g0 * a[2 * i] / (1.0f + __expf(-a[2 * i])); r[2 * i + 1] = g1 * a[2 * i + 1] / (1.0f + __expf(-a[2 * i + 1])); } }
                    if (Add) { const u32x4 aw = *(const u32x4*)(Add + ro + bj * HALF);
#pragma unroll
                        for (int i = 0; i < 4; ++i) { const unsigned w = aw[i]; r[2 * i] += __builtin_bit_cast(float, w << 16); r[2 * i + 1] += __builtin_bit_cast(float, w & 0xffff0000u); } }
                    u32x4 w; w.x = cvt_pk_bf16(r[0], r[1]); w.y = cvt_pk_bf16(r[2], r[3]); w.z = cvt_pk_bf16(r[4], r[5]); w.w = cvt_pk_bf16(r[6], r[7]);
                    *(u32x4*)(O + ro + bj * HALF) = w; } }
    }
};
struct EpiF32 {
    static constexpr bool PERM = false, AFTER_DRAIN = false;
    float* O; int ldc, pad_;
    __device__ __forceinline__ void operator()(const f32x4 (&acc)[2][2][4][2], const Unit& u, int wr, int wc, int fr, int fq) const {
        const int row0 = u.pm * BM + wr * 64 + fr; const int col0 = u.pn * BM + wc * 32 + 4 * fq;
#pragma unroll
        for (int ai = 0; ai < 2; ++ai)
#pragma unroll
            for (int m = 0; m < 4; ++m) { float* rowp = O + (size_t)(row0 + ai * HALF + m * 16) * ldc + col0;
#pragma unroll
                for (int bj = 0; bj < 2; ++bj)
#pragma unroll
                    for (int n = 0; n < 2; ++n) *(f32x4*)(rowp + bj * HALF + n * 16) = acc[ai][bj][m][n]; }
    }
};
struct EpiP1b {
    static constexpr bool PERM = true, AFTER_DRAIN = false;
    const bf16_t* ob; bf16_t* gates; size_t gate_stride; bf16_t* ob_out;
    __device__ __forceinline__ void operator()(const f32x4 (&acc)[2][2][4][2], const Unit& u, int wr, int wc, int fr, int fq) const {
        if (u.pn < 4) { EpiGate<1> E{ob_out, ob, nullptr, 1024, 0}; E(acc, u, wr, wc, fr, fq); }
        else { Unit v = u; v.pn = (u.pn - 4) & 3; EpiBf16 E{gates + (size_t)((u.pn - 4) >> 2) * gate_stride, 1024, 0, 0}; E(acc, v, wr, wc, fr, fq); }
    }
};
struct EpiRmsRes {
    static constexpr bool PERM = false, AFTER_DRAIN = true;
    const float* xres; const float* w; float* out; float* xbuf; unsigned* cnt;
    __device__ __forceinline__ void fused(f32x4 (&acc)[2][2][4][2], const Unit& u, int wr, int wc, int fr, int fq, PG8_LAS unsigned char* lds, int wid, int lane) const {
        PG8_LAS float* P = (PG8_LAS float*)lds;
        PG8_LAS float* R = (PG8_LAS float*)(lds + 4096);
#pragma unroll
        for (int ai = 0; ai < 2; ++ai)
#pragma unroll
            for (int m = 0; m < 4; ++m) { float s = 0.f;
#pragma unroll
                for (int bj = 0; bj < 2; ++bj)
#pragma unroll
                    for (int n = 0; n < 2; ++n) { const f32x4 x = acc[ai][bj][m][n]; s += (x[0] * x[0] + x[1] * x[1]) + (x[2] * x[2] + x[3] * x[3]); }
                s += __shfl_xor(s, 16); s += __shfl_xor(s, 32);
                if (fq == 0) P[(ai * HALF + wr * 64 + m * 16 + fr) * 4 + wc] = s; }
        asm volatile("s_waitcnt lgkmcnt(0)" ::: "memory"); __builtin_amdgcn_s_barrier(); asm volatile("" ::: "memory");
        const int row = wid * 32 + (lane & 31);
        if (lane < 32) { const f32x4 p = *(const PG8_LAS f32x4*)(P + row * 4);
            __hip_atomic_store(xbuf + (size_t)(u.pm * BM + row) * 4 + u.pn, (p[0] + p[1]) + (p[2] + p[3]), __ATOMIC_RELAXED, __HIP_MEMORY_SCOPE_AGENT); }
        asm volatile("s_waitcnt vmcnt(0)" ::: "memory");
        if (lane == 0) __hip_atomic_fetch_add(cnt + 64 * u.pm, 1u, __ATOMIC_RELAXED, __HIP_MEMORY_SCOPE_AGENT);
        if (wid == 0) {
            for (unsigned sp = 0; (unsigned)__builtin_amdgcn_readfirstlane((int)__hip_atomic_load(cnt + 64 * u.pm, __ATOMIC_RELAXED, __HIP_MEMORY_SCOPE_AGENT)) < 32u && sp < (1u << 22); ++sp) __builtin_amdgcn_s_sleep(2);
        }
        asm volatile("s_waitcnt vmcnt(0) lgkmcnt(0)" ::: "memory"); __builtin_amdgcn_s_barrier(); asm volatile("" ::: "memory");
        if (lane < 32) { const float* sl = xbuf + (size_t)(u.pm * BM + row) * 4; float t = 0.f;
#pragma unroll
            for (int i = 0; i < 4; ++i) t += __hip_atomic_load(sl + i, __ATOMIC_RELAXED, __HIP_MEMORY_SCOPE_AGENT);
            R[row] = 1.0f / sqrtf(t * (1.0f / 1024.0f) + 1e-6f); }
        asm volatile("s_waitcnt vmcnt(0) lgkmcnt(0)" ::: "memory"); __builtin_amdgcn_s_barrier(); asm volatile("" ::: "memory");
        const int col0 = u.pn * BM + wc * 32 + 4 * fq;
#pragma unroll
        for (int ai = 0; ai < 2; ++ai)
#pragma unroll
            for (int m = 0; m < 4; ++m) { const int r = ai * HALF + wr * 64 + m * 16 + fr; const float rs = R[r]; const size_t off = (size_t)(u.pm * BM + r) * 1024 + col0;
#pragma unroll
                for (int bj = 0; bj < 2; ++bj)
#pragma unroll
                    for (int n = 0; n < 2; ++n) { const int c = bj * HALF + n * 16; const f32x4 xv = *(const f32x4*)(xres + off + c); const f32x4 wv = *(const f32x4*)(w + col0 + c);
                        *(f32x4*)(out + off + c) = xv + acc[ai][bj][m][n] * rs * wv; }
                if (m & 1) asm volatile("" ::: "memory"); }
    }
};
struct PairOrder {
    StaticOrder S; int nM, nN;
    __host__ __device__ void init(int M, int N, int G_, int c_) { S.init(M, N, G_, c_); nM = M / BM; nN = N / BM; }
    __host__ __device__ bool next(int i, Unit& u) const { if (i > 1) return false; Unit b; if (!S.next(0, b)) return false; u.pm = b.pm + i * nM; u.pn = b.pn + i * nN; return true; }
    __device__ __forceinline__ void a_ready(const Unit&) const {}
    __device__ __forceinline__ void done(const Unit&) const {}
};
struct EpiMerge {
    static constexpr bool PERM = true, AFTER_DRAIN = false;
    bf16_t* m1; bf16_t* merged; const bf16_t* gates; size_t gate_stride; int nM, nN;
    __device__ __forceinline__ void operator()(const f32x4 (&acc)[2][2][4][2], const Unit& u, int wr, int wc, int fr, int fq) const {
        if (u.pm < nM) { EpiGate<0> E{m1, gates, nullptr, 1024, 0}; E(acc, u, wr, wc, fr, fq); }
        else { Unit v; v.pm = u.pm - nM; v.pn = u.pn - nN; EpiGate<0> E{merged, gates + gate_stride, m1, 1024, 0}; E(acc, v, wr, wc, fr, fq); }
    }
};
template <class Epi, class Sched, bool ALIGN_EPI = false, bool SP2 = false>
__device__ __forceinline__ void gemm_phase(PG8_LAS unsigned char* lds, const Gemm g, const Sched& S, const Epi& E) {
    int tid_l = threadIdx.x; asm volatile("" : "+v"(tid_l));
    const int tid = tid_l, wid = __builtin_amdgcn_readfirstlane(tid >> 6), lane = tid & 63, wr = wid >> 2, wc = wid & 3, fr = lane & 15, fq = lane >> 4;
    const int K = g.K, nt = K / BK;
    unsigned voffA[2], voffB[2];
#pragma unroll
    for (int i = 0; i < 2; ++i) { int R, C; stage_rc(tid * 16 + i * 8192, R, C); const int Rb = Epi::PERM ? ((R & ~31) + perm32(R & 31)) : R;
        voffA[i] = (unsigned)(R * K + C) * 2u; voffB[i] = (unsigned)(Rb * K + C) * 2u; }
    const size_t kstep = (size_t)(BK * 2);
    const size_t hstep = (size_t)HALF * K * 2;
    const size_t tstep = 2 * hstep;
    const unsigned ldsw = (unsigned)wid * 1024u;
    const int aoff = lds_byte(wr * 64 + fr, fq * 8), boff = lds_byte(wc * 32 + fr, fq * 8);
#define PG8_SA(b, h) (((b) * 2 + (h)) * HTB)
#define PG8_SB(b, h) ((4 + (b) * 2 + (h)) * HTB)
#define PG8_STAGE(bufoff, gbase, voff) do { _Pragma("unroll") for (int _i = 0; _i < 2; ++_i) \
        __builtin_amdgcn_global_load_lds((const unsigned*)((const char*)(gbase) + (voff)[_i]), (PG8_LAS unsigned*)(lds + (bufoff) + ldsw + _i * 8192), 16, 0, 0); } while (0)
#define PG8_LDA(dst, b, h) do { _Pragma("unroll") for (int m = 0; m < 4; ++m) _Pragma("unroll") for (int k = 0; k < 2; ++k) dst[m][k] = *(const PG8_LAS bf16x8*)(lds + PG8_SA(b, h) + aoff + m * 2048 + k * 1024); } while (0)
#define PG8_LDB(dst, b, h) do { _Pragma("unroll") for (int n = 0; n < 2; ++n) _Pragma("unroll") for (int k = 0; k < 2; ++k) dst[n][k] = *(const PG8_LAS bf16x8*)(lds + PG8_SB(b, h) + boff + n * 2048 + k * 1024); } while (0)
#define PG8_MMA(ai, bj, At, Bt) do { __builtin_amdgcn_s_setprio(1); _Pragma("unroll") for (int m = 0; m < 4; ++m) _Pragma("unroll") for (int n = 0; n < 2; ++n) _Pragma("unroll") for (int k = 0; k < 2; ++k) \
        acc[ai][bj][m][n] = __builtin_amdgcn_mfma_f32_16x16x32_bf16(Bt[n][k], At[m][k], acc[ai][bj][m][n], 0, 0, 0); __builtin_amdgcn_s_setprio(0); } while (0)
#define PG8_WAIT_V(n) asm volatile("s_waitcnt vmcnt(" #n ")" ::: "memory")
#define PG8_WAIT_L(n) asm volatile("s_waitcnt lgkmcnt(" #n ")" ::: "memory")
#define PG8_BAR __builtin_amdgcn_s_barrier()
#define PG8_SCHED __builtin_amdgcn_sched_barrier(0)
    Unit cur, nxt; int ui = 0;
    if (!S.next(0, cur)) return;
    f32x4 acc[2][2][4][2];
#pragma unroll
    for (int a = 0; a < 2; ++a)
#pragma unroll
        for (int b = 0; b < 2; ++b)
#pragma unroll
            for (int m = 0; m < 4; ++m)
#pragma unroll
                for (int n = 0; n < 2; ++n) acc[a][b][m][n] = (f32x4){0.f, 0.f, 0.f, 0.f};
    bf16x8 At[4][2], B0[2][2], B1[2][2];
    const char* cA = g.atile(cur.pm, tstep); const char* cB = (const char*)g.Bt + (size_t)cur.pn * tstep;
    S.a_ready(cur);
    if constexpr (SP2) {
        PG8_STAGE(PG8_SB(0, 0), cB, voffB); PG8_STAGE(PG8_SB(0, 1), cB + hstep, voffB); PG8_STAGE(PG8_SA(0, 0), cA, voffA); PG8_STAGE(PG8_SA(0, 1), cA + hstep, voffA);
        if (wr == 1) PG8_BAR;
        PG8_WAIT_V(2); PG8_BAR;
        PG8_STAGE(PG8_SB(1, 0), cB + kstep, voffB); PG8_STAGE(PG8_SA(1, 0), cA + kstep, voffA); PG8_STAGE(PG8_SB(1, 1), cB + hstep + kstep, voffB);
        PG8_WAIT_V(6); PG8_BAR;
    } else {
        PG8_STAGE(PG8_SB(0, 0), cB, voffB); PG8_STAGE(PG8_SA(0, 0), cA, voffA); PG8_STAGE(PG8_SB(0, 1), cB + hstep, voffB); PG8_STAGE(PG8_SA(0, 1), cA + hstep, voffA);
        if (wr == 1) PG8_BAR;
        PG8_WAIT_V(4); PG8_BAR;
        PG8_STAGE(PG8_SB(1, 0), cB + kstep, voffB); PG8_STAGE(PG8_SA(1, 0), cA + kstep, voffA); PG8_STAGE(PG8_SB(1, 1), cB + hstep + kstep, voffB);
        PG8_WAIT_V(6); PG8_BAR;
    }
    for (;;) {
        const bool has_next = S.next(ui + 1, nxt);
        const char* nA = has_next ? g.atile(nxt.pm, tstep) : cA; const char* nB = has_next ? (const char*)g.Bt + (size_t)nxt.pn * tstep : cB;
        for (int t = 0; t < nt; t += 2) {
            const bool last = (t == nt - 2);
            const char* a1 = cA + (size_t)(t + 1) * kstep;
            const char* a2 = last ? nA : cA + (size_t)(t + 2) * kstep; const char* b2 = last ? nB : cB + (size_t)(t + 2) * kstep;
            const char* a3 = a2 + kstep; const char* b3 = b2 + kstep;
            if (last && has_next) S.a_ready(nxt);
            if constexpr (SP2) {
            PG8_LDB(B0, 0, 0); PG8_LDB(B1, 0, 1); PG8_SCHED; PG8_LDA(At, 0, 0); PG8_STAGE(PG8_SA(1, 1), a1 + hstep, voffA);
            PG8_WAIT_V(8); PG8_WAIT_L(0); PG8_BAR; PG8_MMA(0, 0, At, B0); PG8_MMA(0, 1, At, B1); PG8_BAR; PG8_SCHED;
            PG8_LDA(At, 0, 1); PG8_STAGE(PG8_SB(0, 0), b2, voffB); PG8_STAGE(PG8_SB(0, 1), b2 + hstep, voffB); PG8_STAGE(PG8_SA(0, 0), a2, voffA);
            PG8_WAIT_V(8); PG8_WAIT_L(0); PG8_BAR; PG8_MMA(1, 0, At, B0); PG8_MMA(1, 1, At, B1); PG8_BAR; PG8_SCHED;
            PG8_LDB(B0, 1, 0); PG8_LDB(B1, 1, 1); PG8_SCHED; PG8_LDA(At, 1, 0); PG8_STAGE(PG8_SA(0, 1), a2 + hstep, voffA);
            PG8_WAIT_V(8); PG8_WAIT_L(0); PG8_BAR; PG8_MMA(0, 0, At, B0); PG8_MMA(0, 1, At, B1); PG8_BAR; PG8_SCHED;
            PG8_LDA(At, 1, 1); PG8_STAGE(PG8_SB(1, 0), b3, voffB); PG8_STAGE(PG8_SB(1, 1), b3 + hstep, voffB); PG8_STAGE(PG8_SA(1, 0), a3, voffA);
            PG8_WAIT_V(8); PG8_WAIT_L(0); PG8_BAR; PG8_MMA(1, 0, At, B0); PG8_MMA(1, 1, At, B1); PG8_BAR; PG8_SCHED;
            } else {
            PG8_LDB(B0, 0, 0); PG8_SCHED; PG8_LDA(At, 0, 0); PG8_STAGE(PG8_SA(1, 1), a1 + hstep, voffA);
            PG8_WAIT_L(8); PG8_BAR; PG8_WAIT_L(0); PG8_MMA(0, 0, At, B0); PG8_BAR; PG8_SCHED;
            PG8_LDB(B1, 0, 1); PG8_STAGE(PG8_SB(0, 0), b2, voffB);
            PG8_BAR; PG8_WAIT_L(0); PG8_MMA(0, 1, At, B1); PG8_BAR;
            PG8_LDA(At, 0, 1); PG8_STAGE(PG8_SA(0, 0), a2, voffA);
            PG8_BAR; PG8_WAIT_L(0); PG8_MMA(1, 0, At, B0); PG8_BAR; PG8_SCHED;
            PG8_STAGE(PG8_SB(0, 1), b2 + hstep, voffB);
            PG8_WAIT_V(6); PG8_BAR; PG8_MMA(1, 1, At, B1); PG8_BAR;
            PG8_LDB(B0, 1, 0); PG8_SCHED; PG8_LDA(At, 1, 0); PG8_STAGE(PG8_SA(0, 1), a2 + hstep, voffA);
            PG8_WAIT_L(8); PG8_BAR; PG8_WAIT_L(0); PG8_MMA(0, 0, At, B0); PG8_BAR; PG8_SCHED;
            PG8_LDB(B1, 1, 1); PG8_STAGE(PG8_SB(1, 0), b3, voffB);
            PG8_BAR; PG8_WAIT_L(0); PG8_MMA(0, 1, At, B1); PG8_BAR;
            PG8_LDA(At, 1, 1); PG8_STAGE(PG8_SA(1, 0), a3, voffA);
            PG8_BAR; PG8_WAIT_L(0); PG8_MMA(1, 0, At, B0); PG8_BAR; PG8_SCHED;
            PG8_STAGE(PG8_SB(1, 1), b3 + hstep, voffB);
            PG8_WAIT_V(6); PG8_BAR; PG8_MMA(1, 1, At, B1); PG8_BAR;
            }
        }
        if constexpr (ALIGN_EPI) { if (wr == 0) PG8_BAR; }
        if constexpr (!Epi::AFTER_DRAIN) { E(acc, cur, wr, wc, fr, fq); S.done(cur); }
        if (!has_next) break;
#pragma unroll
        for (int a = 0; a < 2; ++a)
#pragma unroll
            for (int b = 0; b < 2; ++b)
#pragma unroll
                for (int m = 0; m < 4; ++m)
#pragma unroll
                    for (int n = 0; n < 2; ++n) acc[a][b][m][n] = (f32x4){0.f, 0.f, 0.f, 0.f};
        cur = nxt; cA = nA; cB = nB; ++ui;
        if constexpr (ALIGN_EPI) { if (wr == 1) PG8_BAR; }
    }
    PG8_WAIT_V(0);
    if constexpr (!ALIGN_EPI) { if (wr == 0) PG8_BAR; }
    PG8_BAR;
    if constexpr (Epi::AFTER_DRAIN) { E.fused(acc, cur, wr, wc, fr, fq, lds, wid, lane); S.done(cur); }
#undef PG8_SA
#undef PG8_SB
#undef PG8_STAGE
#undef PG8_LDA
#undef PG8_LDB
#undef PG8_MMA
#undef PG8_WAIT_V
#undef PG8_WAIT_L
#undef PG8_BAR
#undef PG8_SCHED
}
}
typedef __bf16 bf16x2_t __attribute__((ext_vector_type(2)));
typedef float f32x2_t __attribute__((ext_vector_type(2)));
typedef short bf16x8 __attribute__((ext_vector_type(8)));
typedef float f32x16 __attribute__((ext_vector_type(16)));
#define MFMA32(a, b, c) __builtin_amdgcn_mfma_f32_32x32x16_bf16((a), (b), (c), 0, 0, 0)
__device__ __forceinline__ unsigned pkbf(float a, float b) { bf16x2_t v = __builtin_convertvector((f32x2_t){a, b}, bf16x2_t); return __builtin_bit_cast(unsigned, v); }
__device__ __forceinline__ bf16x8 pack8(const f32x16& x, int s) { v4u p; p.x = pkbf(x[8 * s], x[8 * s + 1]); p.y = pkbf(x[8 * s + 2], x[8 * s + 3]); p.z = pkbf(x[8 * s + 4], x[8 * s + 5]); p.w = pkbf(x[8 * s + 6], x[8 * s + 7]); return __builtin_bit_cast(bf16x8, p); }
__device__ __forceinline__ f32x16 zero16() { f32x16 z;
#pragma unroll
    for (int i = 0; i < 16; ++i) z[i] = 0.f; return z; }
constexpr int CHUNK = 64, NCH = SEQ / CHUNK;
constexpr float QSCALE = 0.08838834764831845f;
__device__ __forceinline__ void glds_blocks(LAS unsigned char* dst, const unsigned char* src, int nblk, int wv, int nw, int lane) {
    for (int b = wv; b < nblk; b += nw)
        __builtin_amdgcn_global_load_lds((const unsigned*)(src + (size_t)b * 1024 + lane * 16), (LAS unsigned*)(dst + b * 1024), 16, 0, 0);
}
__device__ __forceinline__ bf16x8 lds_frag(const LAS unsigned char* base, int blk, int lane) { return *(const LAS bf16x8*)(base + blk * 1024 + lane * 16); }

namespace gdn {
constexpr int B_KA = 0, B_QA = 16384, B_SC = 32768, B_KT = 34816, B_TBF = 51200, B_AF = 59392, B_TBB = 67584, B_AB = 75776, B_VT = 83968, BLOB = 100352;
constexpr int XBLK = 34, YBLK = 32;
}

__device__ __forceinline__ float row16_sum(float v) {
    v += __builtin_bit_cast(float, __builtin_amdgcn_mov_dpp(__builtin_bit_cast(int, v), 0xB1, 0xF, 0xF, true));
    v += __builtin_bit_cast(float, __builtin_amdgcn_mov_dpp(__builtin_bit_cast(int, v), 0x4E, 0xF, 0xF, true));
    v += __builtin_bit_cast(float, __builtin_amdgcn_mov_dpp(__builtin_bit_cast(int, v), 0x141, 0xF, 0xF, true));
    v += __builtin_bit_cast(float, __builtin_amdgcn_mov_dpp(__builtin_bit_cast(int, v), 0x140, 0xF, 0xF, true));
    return v;
}
__device__ __forceinline__ float quad_sum(float v) {
    v += __builtin_bit_cast(float, __builtin_amdgcn_mov_dpp(__builtin_bit_cast(int, v), 0xB1, 0xF, 0xF, true));
    v += __builtin_bit_cast(float, __builtin_amdgcn_mov_dpp(__builtin_bit_cast(int, v), 0x4E, 0xF, 0xF, true));
    return v;
}
struct GdnPrepArgs {
    const bf16 *pq, *pk, *pv;
    const float* small;
    const float* conv_w;
    const float *a_log_f, *a_log_b, *dtb_f, *dtb_b;
    unsigned char* blob;
    int nseq, pad_;
};
namespace gdn {
constexpr int L_PRE = 0, L_QN = 52224, L_KN = L_QN + 17408, L_SC = L_KN + 17408, L_LPF = L_SC + 1024, L_LPB = L_LPF + 16384, L_AF = L_LPB + 16384, L_AB = L_AF + 9216, L_TBF = L_AB + 9216, L_TBB = L_TBF + 9216, L_END = L_TBB + 9216;
static_assert(L_END <= 160 * 1024 - 256, "gdn prep LDS");
constexpr int QS_ = 272, AS_ = 144;

__device__ __forceinline__ v4u frag_rm_perm(const LAS unsigned char* img, int st, int rt, int ks, int lane) {
    const int r = lane & 31, hh = lane >> 5; const LAS unsigned char* p = img + (32 * rt + r) * st + (16 * ks + 4 * hh) * 2;
    const v2u lo = *(const LAS v2u*)p, hi = *(const LAS v2u*)(p + 16);
    return (v4u){lo.x, lo.y, hi.x, hi.y};
}
__device__ __forceinline__ v4u frag_tr_perm(const LAS unsigned char* img, int st, int rt, int ks, int lane) {
    const int r = lane & 31, hh = lane >> 5; const LAS unsigned char* p = img + (16 * ks + 4 * hh) * st + (32 * rt + r) * 2;
    unsigned short e[8];
#pragma unroll
    for (int j = 0; j < 8; ++j) e[j] = *(const LAS unsigned short*)(p + (8 * (j >> 2) + (j & 3)) * st);
    return (v4u){(unsigned)e[0] | ((unsigned)e[1] << 16), (unsigned)e[2] | ((unsigned)e[3] << 16), (unsigned)e[4] | ((unsigned)e[5] << 16), (unsigned)e[6] | ((unsigned)e[7] << 16)};
}
__device__ __forceinline__ v4u frag16_rm(const LAS unsigned char* img, int st, int rt, int ks, int lane) {
    const int r = lane & 15, q = lane >> 4; const LAS unsigned char* p = img + (16 * rt + r) * st + (32 * ks + 4 * q) * 2;
    const v2u lo = *(const LAS v2u*)p, hi = *(const LAS v2u*)(p + 32);
    return (v4u){lo.x, lo.y, hi.x, hi.y};
}
__device__ __forceinline__ v4u frag16_tr(const LAS unsigned char* img, int st, int rt, int ks, int lane) {
    const int r = lane & 15, q = lane >> 4; const LAS unsigned char* p = img + (32 * ks + 4 * q) * st + (16 * rt + r) * 2;
    unsigned short e[8];
#pragma unroll
    for (int j = 0; j < 8; ++j) e[j] = *(const LAS unsigned short*)(p + (16 * (j >> 2) + (j & 3)) * st);
    return (v4u){(unsigned)e[0] | ((unsigned)e[1] << 16), (unsigned)e[2] | ((unsigned)e[3] << 16), (unsigned)e[4] | ((unsigned)e[5] << 16), (unsigned)e[6] | ((unsigned)e[7] << 16)};
}
}

#define LBAR() do { asm volatile("s_waitcnt lgkmcnt(0)" ::: "memory"); __builtin_amdgcn_s_barrier(); asm volatile("" ::: "memory"); } while (0)
__device__ __forceinline__ void gdn_prep_issue(LAS unsigned char* lds, const GdnPrepArgs& A, int unit, int w, int lane, const unsigned char* zero_page) {
    using namespace gdn;
    const int n = unit % NCH, h = (unit / NCH) % 8, sq = unit / (NCH * 8); const size_t row0 = (size_t)sq * SEQ; const int t0 = n * CHUNK;
    for (int q4 = w; q4 < 51; q4 += 8) {
        const int seg = q4 * 4 + (lane >> 4), r = seg / 3, m = seg % 3, tl = t0 - 2 + r;
        const bf16* pmat = A.pq + (size_t)m * (size_t)(A.pk - A.pq);
        const unsigned char* src = (tl >= 0 && tl < SEQ) ? (const unsigned char*)(pmat + (row0 + tl) * 1024 + h * 128) : zero_page;
        __builtin_amdgcn_global_load_lds((const unsigned*)(src + (lane & 15) * 16), (LAS unsigned*)(lds + L_PRE + q4 * 1024), 16, 0, 0);
    }
}
__device__ __forceinline__ f32x4 gdn_prep_scal(const GdnPrepArgs& A, int unit, int lane) {
    const int n = unit % NCH, h = (unit / NCH) % 8, sq = unit / (NCH * 8);
    const float* sm = A.small + ((size_t)sq * SEQ + n * CHUNK + lane) * 64;
    return (f32x4){sm[h], sm[8 + h], sm[16 + h], sm[24 + h]};
}
__device__ __forceinline__ void gdn_prep_phase(LAS unsigned char* lds, const GdnPrepArgs& A, int bid, int G, const unsigned char* zero_page) {
    using namespace gdn;
    int tid_l = threadIdx.x; asm volatile("" : "+v"(tid_l));
    const int tid = tid_l, lane = tid & 63, w = __builtin_amdgcn_readfirstlane(tid >> 6);
    const int nunits = A.nseq * 8 * NCH; const int pflg = A.pad_;
    int unit = bid;
    f32x4 smn = (f32x4){0.f, 0.f, 0.f, 0.f};
    if (unit < nunits) { gdn_prep_issue(lds, A, unit, w, lane, zero_page); if (w == 0) smn = gdn_prep_scal(A, unit, lane); }
  for (; unit < nunits; unit += G) {
    const int h = (unit / NCH) % 8;
    unsigned char* blob = A.blob + (size_t)unit * BLOB;
    if (w == 0) {
        const float xf = smn.x + A.dtb_f[h], xb = smn.y + A.dtb_b[h];
        const float spf = xf > 20.f ? xf : log1pf(__expf(xf)), spb = xb > 20.f ? xb : log1pf(__expf(xb));
        const float gf = -__expf(A.a_log_f[h]) * spf, gb = -__expf(A.a_log_b[h]) * spb;
        float pf = gf, pb = gb;
#pragma unroll
        for (int o = 1; o < 64; o <<= 1) { const float yf = __shfl_up(pf, o), yb = __shfl_up(pb, o); if (lane >= o) { pf += yf; pb += yb; } }
        const float totb = __shfl(pb, 63);
        const float gcf = pf, gcb = totb - pb + gb;
        LAS float* sc = (LAS float*)(lds + L_SC);
        sc[lane] = gcf; sc[64 + lane] = gcb; sc[128 + lane] = sigmoidf_(smn.z); sc[192 + lane] = sigmoidf_(smn.w);
        float* gsc = (float*)(blob + B_SC); if (pflg & 8) gsc = (float*)(lds + L_LPF);
        const float glf = __shfl(pf, 63), glb = totb;
        gsc[lane] = gcf; gsc[64 + lane] = gcb; gsc[128 + lane] = __expf(gcf); gsc[192 + lane] = __expf(gcb); gsc[256 + lane] = __expf(glf - gcf); gsc[320 + lane] = __expf(glb - gcb);
        if (lane < 2) gsc[384 + lane] = __expf(lane ? glb : glf);
    }
    __syncthreads();
    if (!(pflg & 32)) {
        const int p0 = 8 * w;
#pragma unroll
        for (int m = 0; m < 3; ++m) {
            float wc[5][2];
#pragma unroll
            for (int tau = 0; tau < 5; ++tau) { const f32x2_t t2 = *(const f32x2_t*)(A.conv_w + tau * 3072 + m * 1024 + h * 128 + 2 * lane); wc[tau][0] = t2.x; wc[tau][1] = t2.y; }
            float in[12][2];
#pragma unroll
            for (int i = 0; i < 12; ++i) { const unsigned u = *(const LAS unsigned*)(lds + L_PRE + ((p0 + i) * 3 + m) * 256 + lane * 4); in[i][0] = bflo(u); in[i][1] = bfhi(u); }
            float y[8][2];
#pragma unroll
            for (int pp = 0; pp < 8; ++pp)
#pragma unroll
                for (int c = 0; c < 2; ++c) { float s = 0.f;
#pragma unroll
                    for (int tau = 0; tau < 5; ++tau) s += wc[tau][c] * in[pp + tau][c];
                    y[pp][c] = s * __builtin_amdgcn_rcpf(1.0f + __builtin_amdgcn_exp2f(-1.4426950408889634f * s)); }
            if (m < 2) {
#pragma unroll
                for (int pp = 0; pp < 8; ++pp) { float ss = row16_sum(y[pp][0] * y[pp][0] + y[pp][1] * y[pp][1]); ss += __shfl_xor(ss, 16); ss += __shfl_xor(ss, 32); const float rn = __builtin_amdgcn_rsqf(ss + EPS);
                    *(LAS unsigned*)(lds + (m == 0 ? L_QN : L_KN) + (p0 + pp) * QS_ + lane * 4) = pkbf(y[pp][0] * rn, y[pp][1] * rn); }
            } else {
#pragma unroll
                for (int c = 0; c < 2; ++c) { v4u o; o.x = pkbf(y[0][c], y[1][c]); o.y = pkbf(y[2][c], y[3][c]); o.z = pkbf(y[4][c], y[5][c]); o.w = pkbf(y[6][c], y[7][c]);
                    if (!(pflg & 8)) *(v4u*)(blob + B_VT + (2 * lane + c) * 128 + p0 * 2) = o; }
            }
        }
    }
    __syncthreads();
    { const int un = unit + G; if (un < nunits) { gdn_prep_issue(lds, A, un, w, lane, zero_page); if (w == 0) smn = gdn_prep_scal(A, un, lane); } }
    {
        const int which = w >> 2, rt = (w >> 1) & 1, ct = w & 1, r = lane & 31, hh = lane >> 5;
        const LAS unsigned char* ia = lds + (which ? L_QN : L_KN) + (32 * rt + r) * QS_ + 16 * hh;
        const LAS unsigned char* ib = lds + L_KN + (32 * ct + r) * QS_ + 16 * hh;
        f32x16 acc = zero16();
#pragma unroll
        for (int ks = 0; ks < 8; ++ks) acc = MFMA32(*(const LAS bf16x8*)(ia + 32 * ks), *(const LAS bf16x8*)(ib + 32 * ks), acc);
        const LAS float* sc = (const LAS float*)(lds + L_SC);
        const int j = 32 * ct + r; const float gfj = sc[j], gbj = sc[64 + j];
#pragma unroll
        for (int reg = 0; reg < 16; ++reg) {
            const int i = 32 * rt + (reg & 3) + 8 * (reg >> 2) + 4 * hh; const float val = acc[reg];
            const float ef = __expf(sc[i] - gfj), eb = __expf(sc[64 + i] - gbj);
            if (which == 0) {
                const float lf = (i > j) ? sc[128 + i] * val * ef : 0.f, lb = (i < j) ? sc[192 + i] * val * eb : 0.f;
                ((LAS float*)(lds + L_LPF))[i * 64 + (j & 3) * 16 + (j >> 2)] = lf;
                const int i2 = 63 - i, j2 = 63 - j;
                ((LAS float*)(lds + L_LPB))[i2 * 64 + (j2 & 3) * 16 + (j2 >> 2)] = lb;
            } else {
                const float af = (i >= j) ? QSCALE * val * ef : 0.f, ab = (i <= j) ? QSCALE * val * eb : 0.f;
                *(LAS unsigned short*)(lds + L_AF + i * AS_ + j * 2) = (unsigned short)(pkbf(af, 0.f) & 0xffffu);
                *(LAS unsigned short*)(lds + L_AB + i * AS_ + j * 2) = (unsigned short)(pkbf(ab, 0.f) & 0xffffu);
            }
        }
    }
    LBAR();
    if (!(pflg & 16)) {
        const int dir = w >> 2, li = (w & 3) * 64 + lane, j = li >> 2, q = li & 3;
        const LAS float* LP = (const LAS float*)(lds + (dir ? L_LPB : L_LPF)) + q * 16;
        float t[16];
#pragma unroll
        for (int a = 0; a < 16; ++a) t[a] = 0.f;
#pragma unroll
        for (int i = 0; i < 64; ++i) {
            float p = 0.f;
#pragma unroll
            for (int a4 = 0; a4 < (i + 15) / 16; ++a4) { const f32x4 lv = *(const LAS f32x4*)(LP + i * 64 + 4 * a4);
                p += lv.x * t[4 * a4] + lv.y * t[4 * a4 + 1] + lv.z * t[4 * a4 + 2] + lv.w * t[4 * a4 + 3]; }
            p = quad_sum(p);
            const float ti = (i == j ? 1.f : 0.f) - p;
            if (q == (i & 3)) t[i >> 2] = ti;
        }
        const LAS float* sc = (const LAS float*)(lds + L_SC);
        if (dir == 0) { const float bj = sc[128 + j];
#pragma unroll
            for (int a = 0; a < 16; ++a) *(LAS unsigned short*)(lds + L_TBF + (4 * a + q) * AS_ + j * 2) = (unsigned short)(pkbf(t[a] * bj, 0.f) & 0xffffu);
        } else { const int jo = 63 - j; const float bj = sc[192 + jo];
#pragma unroll
            for (int a = 0; a < 16; ++a) *(LAS unsigned short*)(lds + L_TBB + (63 - (4 * a + q)) * AS_ + jo * 2) = (unsigned short)(pkbf(t[a] * bj, 0.f) & 0xffffu);
        }
    }
    LBAR();
    if (!(pflg & 64)) for (int blk = w; blk < 80; blk += 8) {
        v4u f; int off;
        if (blk < 16)      { f = frag16_rm(lds + L_KN, QS_, blk >> 2, blk & 3, lane); off = B_KA + blk * 1024; }
        else if (blk < 32) { const int b = blk - 16; f = frag16_rm(lds + L_QN, QS_, b >> 2, b & 3, lane); off = B_QA + b * 1024; }
        else if (blk < 48) { const int b = blk - 32; f = frag16_tr(lds + L_KN, QS_, b >> 1, b & 1, lane); off = B_KT + b * 1024; }
        else { const int b = blk - 48, wh = b >> 3, bb = b & 7; const int lo = wh == 0 ? L_TBF : wh == 1 ? L_AF : wh == 2 ? L_TBB : L_AB;
               f = frag16_rm(lds + lo, AS_, bb >> 1, bb & 1, lane); off = B_TBF + b * 1024; }
        if (!(pflg & 8)) *(v4u*)(blob + off + lane * 16) = f; else asm volatile("" :: "v"(f));
    }
    LBAR();
  }
}
struct GdnChainArgs {
    const unsigned char* blob;
    unsigned char* stg;
    unsigned* flag;
    int nseq, flags;
};
namespace gdn { constexpr int C_Y = XBLK * 1024, C_BUF = C_Y + YBLK * 1024, C_END = 2 * C_BUF; }
#define CHAIN_SPIN_CAP (1u << 22)
#define MFMA16(a, b, c) __builtin_amdgcn_mfma_f32_16x16x32_bf16((a), (b), (c), 0, 0, 0)
__device__ __forceinline__ bf16x8 pack16(const f32x4& a, const f32x4& b) { v4u p; p.x = pkbf(a.x, a.y); p.y = pkbf(a.z, a.w); p.z = pkbf(b.x, b.y); p.w = pkbf(b.z, b.w); return __builtin_bit_cast(bf16x8, p); }

__device__ __forceinline__ void gdn_chain_unit(LAS unsigned char* lds, const GdnChainArgs& A, int item) {
    using namespace gdn;
    int tid_l = threadIdx.x; asm volatile("" : "+v"(tid_l));
    const int tid = tid_l, lane = tid & 63, w = __builtin_amdgcn_readfirstlane(tid >> 6);
    const int r = lane & 15, q = lane >> 4;
    const int c = item & 1, h = (item >> 1) & 7, sq = item >> 4; const int flags = A.flags;
    const size_t unit0 = (size_t)(sq * 8 + h) * NCH;
    const f32x4 z4 = (f32x4){0.f, 0.f, 0.f, 0.f};
    f32x4 S[8];
#pragma unroll
    for (int t = 0; t < 8; ++t) S[t] = z4;
    v2u vnext[4];
    unsigned long long pwn[4]; bool have = false; unsigned fnext = 0u;
#define GDN_ISSUE(s_, buf_) do { const int n_ = c ? NCH - 1 - (s_) : (s_); const unsigned char* bl_ = A.blob + (unit0 + n_) * BLOB; LAS unsigned char* d_ = lds + (buf_) * C_BUF; \
        { const unsigned char* vp_ = bl_ + B_VT + (16 * w + r) * 128 + 8 * q; _Pragma("unroll") for (int i = 0; i < 4; ++i) vnext[i] = *(const v2u*)(vp_ + 32 * i); } \
        if (!(flags & 4)) { glds_blocks(d_, bl_, XBLK, w, 8, lane); \
            if (c == 0) glds_blocks(d_ + C_Y, bl_ + B_KT, YBLK, w, 8, lane); \
            else { glds_blocks(d_ + C_Y, bl_ + B_KT, 16, w, 8, lane); glds_blocks(d_ + C_Y + 16384, bl_ + B_TBB, 16, w, 8, lane); } } } while (0)
    GDN_ISSUE(0, 0);
    __syncthreads();
    for (int s = 0; s < NCH; ++s) {
        const int n = c ? NCH - 1 - s : s;
        v2u vcur[4];
#pragma unroll
        for (int i = 0; i < 4; ++i) vcur[i] = vnext[i];
        unsigned long long* sp = (unsigned long long*)(A.stg + (unit0 + n) * 16384 + w * 2048) + lane;
        unsigned* fl = A.flag + (unit0 + n) * 8 + w;
        unsigned long long pw[4];
        if (s >= NCH / 2 && !(flags & 1)) {
            if (have) {
#pragma unroll
                for (int i = 0; i < 4; ++i) pw[i] = pwn[i];
            } else {
                for (unsigned sp_ = 0; __builtin_amdgcn_readfirstlane((int)__hip_atomic_load(fl, __ATOMIC_RELAXED, __HIP_MEMORY_SCOPE_AGENT)) == 0 && sp_ < CHAIN_SPIN_CAP; ++sp_) __builtin_amdgcn_s_sleep(2);
#pragma unroll
                for (int i = 0; i < 4; ++i) pw[i] = __hip_atomic_load(sp + i * 64, __ATOMIC_RELAXED, __HIP_MEMORY_SCOPE_AGENT);
            }
        }
        have = false;
        if (s + 1 >= NCH / 2 && s + 1 < NCH && !(flags & 1) && __builtin_amdgcn_readfirstlane((int)fnext) != 0) {
            const int n1 = c ? NCH - 2 - s : s + 1; const unsigned long long* sp1 = (const unsigned long long*)(A.stg + (unit0 + n1) * 16384 + w * 2048) + lane;
#pragma unroll
            for (int i = 0; i < 4; ++i) pwn[i] = __hip_atomic_load(sp1 + i * 64, __ATOMIC_RELAXED, __HIP_MEMORY_SCOPE_AGENT);
            have = true;
        }
        if (s + 2 >= NCH / 2 && s + 2 < NCH && !(flags & 1)) { const int n2 = c ? NCH - 3 - s : s + 2; fnext = __hip_atomic_load(A.flag + (unit0 + n2) * 8 + w, __ATOMIC_RELAXED, __HIP_MEMORY_SCOPE_AGENT); }
        if (s + 1 < NCH) GDN_ISSUE(s + 1, (s + 1) & 1);
        const LAS unsigned char* X = lds + (s & 1) * C_BUF; const LAS unsigned char* Y = X + C_Y; const LAS unsigned char* YT = Y + 16384;
        const LAS float* sc = (const LAS float*)(X + B_SC);
        bf16x8 sb[4];
#pragma unroll
        for (int k = 0; k < 4; ++k) sb[k] = pack16(S[2 * k], S[2 * k + 1]);
        f32x4 KS[4], QS[4];
#pragma unroll
        for (int rt = 0; rt < 4; ++rt) { KS[rt] = z4; QS[rt] = z4; }
        {
            constexpr int R = 8; bf16x8 ring[R];
#define G1_LD(i_) lds_frag(X + (((i_) & 1) ? B_QA : B_KA), ((i_) >> 3) * 4 + (((i_) >> 1) & 3), lane)
#pragma unroll
            for (int i = 0; i < R; ++i) ring[i] = G1_LD(i);
#pragma unroll
            for (int i = 0; i < 32; ++i) { const int rt = i >> 3, ks = (i >> 1) & 3;
                if (i & 1) QS[rt] = MFMA16(ring[i % R], sb[ks], QS[rt]); else KS[rt] = MFMA16(ring[i % R], sb[ks], KS[rt]);
                if (i + R < 32) ring[i % R] = G1_LD(i + R);
                __builtin_amdgcn_sched_barrier(0); }
#undef G1_LD
        }
#pragma unroll
        for (int rt = 0; rt < 4; ++rt) { const v2u vv = vcur[rt]; const f32x4 ev = *(const LAS f32x4*)(sc + 128 + c * 64 + 16 * rt + 4 * q);
            KS[rt].x = bflo(vv.x) - ev.x * KS[rt].x; KS[rt].y = bfhi(vv.x) - ev.y * KS[rt].y; KS[rt].z = bflo(vv.y) - ev.z * KS[rt].z; KS[rt].w = bfhi(vv.y) - ev.w * KS[rt].w; }
        bf16x8 rb[2] = {pack16(KS[0], KS[1]), pack16(KS[2], KS[3])};
        f32x4 vn[4];
#pragma unroll
        for (int rt = 0; rt < 4; ++rt) vn[rt] = z4;
        {   constexpr int R = 8; bf16x8 ring[R];
#pragma unroll
            for (int i = 0; i < R; ++i) ring[i] = lds_frag(YT, i, lane);
#pragma unroll
            for (int i = 0; i < 8; ++i) { vn[i >> 1] = MFMA16(ring[i], rb[i & 1], vn[i >> 1]); __builtin_amdgcn_sched_barrier(0); }
        }
        bf16x8 vb[2] = {pack16(vn[0], vn[1]), pack16(vn[2], vn[3])};
        f32x4 (&o)[4] = QS;
#pragma unroll
        for (int rt = 0; rt < 4; ++rt) { const f32x4 ev = *(const LAS f32x4*)(sc + 128 + c * 64 + 16 * rt + 4 * q);
            o[rt].x *= QSCALE * ev.x; o[rt].y *= QSCALE * ev.y; o[rt].z *= QSCALE * ev.z; o[rt].w *= QSCALE * ev.w; }
        {   constexpr int R = 8; bf16x8 ring[R];
#pragma unroll
            for (int i = 0; i < R; ++i) ring[i] = lds_frag(YT + 8192, i, lane);
#pragma unroll
            for (int i = 0; i < 8; ++i) { o[i >> 1] = MFMA16(ring[i], vb[i & 1], o[i >> 1]); __builtin_amdgcn_sched_barrier(0); }
        }
        if (!(flags & 1)) {
            if (s < NCH / 2) {
#pragma unroll
                for (int rt = 0; rt < 4; ++rt) __hip_atomic_store(sp + rt * 64, (unsigned long long)pkbf(o[rt].x, o[rt].y) | ((unsigned long long)pkbf(o[rt].z, o[rt].w) << 32), __ATOMIC_RELAXED, __HIP_MEMORY_SCOPE_AGENT);
            } else {
#pragma unroll
                for (int rt = 0; rt < 4; ++rt) { const unsigned plo = (unsigned)pw[rt], phi = (unsigned)(pw[rt] >> 32);
                    __hip_atomic_store(sp + rt * 64, (unsigned long long)pkbf(o[rt].x + bflo(plo), o[rt].y + bfhi(plo)) | ((unsigned long long)pkbf(o[rt].z + bflo(phi), o[rt].w + bfhi(phi)) << 32), __ATOMIC_RELAXED, __HIP_MEMORY_SCOPE_AGENT); }
            }
        }
#pragma unroll
        for (int rt = 0; rt < 4; ++rt) { const f32x4 ev = *(const LAS f32x4*)(sc + 256 + c * 64 + 16 * rt + 4 * q);
            vn[rt].x *= ev.x; vn[rt].y *= ev.y; vn[rt].z *= ev.z; vn[rt].w *= ev.w; }
        vb[0] = pack16(vn[0], vn[1]); vb[1] = pack16(vn[2], vn[3]);
        const float egl = sc[384 + c];
#pragma unroll
        for (int t = 0; t < 8; ++t) { S[t].x *= egl; S[t].y *= egl; S[t].z *= egl; S[t].w *= egl; }
        {   constexpr int R = 8; bf16x8 ring[R];
#pragma unroll
            for (int i = 0; i < R; ++i) ring[i] = lds_frag(Y, i, lane);
#pragma unroll
            for (int i = 0; i < 16; ++i) { S[i >> 1] = MFMA16(ring[i % R], vb[i & 1], S[i >> 1]); if (i + R < 16) ring[i % R] = lds_frag(Y, i + R, lane); __builtin_amdgcn_sched_barrier(0); }
        }
        if (!(flags & 1)) { asm volatile("s_waitcnt vmcnt(0)" ::: "memory"); if (lane == 0) __hip_atomic_store(fl, s < NCH / 2 ? 1u : 2u, __ATOMIC_RELAXED, __HIP_MEMORY_SCOPE_AGENT); }
        __syncthreads();
    }
#undef GDN_ISSUE
}
namespace gla {
constexpr int B_QGF = 0, B_QGB = 16384, B_SC = 32768, B_KDTF = 33792, B_KDTB = 50176, BLOBA = 66560;
constexpr int B_VB = 0, B_INTRA = 32768, BLOBB = 65536;
constexpr int L_R = 0, L_QGF = 8192, L_KGF = L_QGF + 17408, L_KDF = L_KGF + 17408, L_QGB = L_KDF + 17408, L_KGB = L_QGB + 17408, L_KDB = L_KGB + 17408, L_V = L_KDB + 17408, L_TOT = L_V + 33792, L_AS = L_TOT + 4096, L_END = L_AS + 9216;
static_assert(L_END <= 160 * 1024 - 256, "gla prep LDS");
constexpr int QS_ = 272, VS_ = 528, AS_ = 144;
constexpr int C_X = 0, C_Y = 17408, C_CHAIN = 66560, C_EG = 2 * C_CHAIN, C_END = C_EG + 1024;
__device__ __forceinline__ v4u frag_tr_nat(const LAS unsigned char* img, int st, int colbase, int ks, int lane) {
    const int r = lane & 31, hh = lane >> 5; const LAS unsigned char* p = img + (16 * ks + 8 * hh) * st + (colbase + r) * 2;
    unsigned short e[8];
#pragma unroll
    for (int j = 0; j < 8; ++j) e[j] = *(const LAS unsigned short*)(p + j * st);
    return (v4u){(unsigned)e[0] | ((unsigned)e[1] << 16), (unsigned)e[2] | ((unsigned)e[3] << 16), (unsigned)e[4] | ((unsigned)e[5] << 16), (unsigned)e[6] | ((unsigned)e[7] << 16)};
}
__device__ __forceinline__ float logsig2(float x) { const float xc = fminf(fmaxf(x, -60.f), 60.f); return -__builtin_amdgcn_logf(1.0f + __builtin_amdgcn_exp2f(-1.4426950408889634f * xc)); }
}

struct GlaPrepArgs {
    const bf16* qk;
    const bf16* vb;
    const float* small;
    const float *w2f, *b2f, *w2b, *b2b;
    unsigned char* blobA;
    unsigned char* blobB;
    int nseq, pad_;
};

__device__ __forceinline__ void gla_prep_phase(LAS unsigned char* lds, const GlaPrepArgs& A, int bid, int G) {
    using namespace gla;
    int tid_l = threadIdx.x; asm volatile("" : "+v"(tid_l));
    const int tid = tid_l, lane = tid & 63, w = __builtin_amdgcn_readfirstlane(tid >> 6);
    const int nunits = A.nseq * 4 * NCH;
    f32x4 pr; v4u pv[4], pq[2], pk[2];
#define GLA_PREFETCH(u_) do { const int n_ = (u_) % NCH, h_ = ((u_) / NCH) % 4, sq_ = (u_) / (NCH * 4); const size_t r_ = (size_t)sq_ * SEQ + n_ * CHUNK; \
        pr = *(const f32x4*)(A.small + (r_ + (tid >> 3)) * 64 + 32 + (tid & 7) * 4); \
        _Pragma("unroll") for (int i = 0; i < 4; ++i) { const int id = i * 512 + tid; pv[i] = *(const v4u*)(A.vb + (r_ + (id >> 5)) * 1024 + h_ * 256 + (id & 31) * 8); } \
        _Pragma("unroll") for (int i = 0; i < 2; ++i) { const int id = i * 512 + tid; const bf16* qp_ = A.qk + (r_ + (id >> 4)) * 1024 + h_ * 128 + (id & 15) * 8; pq[i] = *(const v4u*)qp_; pk[i] = *(const v4u*)(qp_ + 512); } } while (0)
    int unit = bid;
    if (unit < nunits) GLA_PREFETCH(unit);
  for (; unit < nunits; unit += G) {
    const int h = (unit / NCH) % 4;
    unsigned char* blob = A.blobA + (size_t)unit * BLOBA; unsigned char* blobB = A.blobB + (size_t)unit * BLOBB;
    *(LAS f32x4*)(lds + L_R + (tid >> 3) * 128 + (tid & 7) * 16) = pr;
#pragma unroll
    for (int i = 0; i < 4; ++i) { const int id = i * 512 + tid; *(LAS v4u*)(lds + L_V + (id >> 5) * VS_ + (id & 31) * 16) = pv[i]; }
#pragma unroll
    for (int i = 0; i < 2; ++i) { const int id = i * 512 + tid; *(LAS v4u*)(lds + L_QGF + (id >> 4) * QS_ + (id & 15) * 16) = pq[i]; *(LAS v4u*)(lds + L_KGF + (id >> 4) * QS_ + (id & 15) * 16) = pk[i]; }
    LBAR();
    {
        const int dd = tid & 127, pg = tid >> 7, d = h * 128 + dd;
        float wf[16], wb[16];
#pragma unroll
        for (int i = 0; i < 16; ++i) { wf[i] = A.w2f[i * 512 + d]; wb[i] = A.w2b[i * 512 + d]; }
        const float bf_ = A.b2f[d], bb_ = A.b2b[d];
        float lf[16], lb[16];
#pragma unroll
        for (int pp = 0; pp < 16; ++pp) {
            const LAS float* rr = (const LAS float*)(lds + L_R) + (pg * 16 + pp) * 32;
            float xf = bf_, xb = bb_;
#pragma unroll
            for (int i4 = 0; i4 < 4; ++i4) { const f32x4 a = *(const LAS f32x4*)(rr + 4 * i4), b = *(const LAS f32x4*)(rr + 16 + 4 * i4);
                xf += a.x * wf[4 * i4] + a.y * wf[4 * i4 + 1] + a.z * wf[4 * i4 + 2] + a.w * wf[4 * i4 + 3];
                xb += b.x * wb[4 * i4] + b.y * wb[4 * i4 + 1] + b.z * wb[4 * i4 + 2] + b.w * wb[4 * i4 + 3]; }
            lf[pp] = logsig2(xf) * (1.f / 16.f); lb[pp] = logsig2(xb) * (1.f / 16.f);
        }
#pragma unroll
        for (int pp = 1; pp < 16; ++pp) lf[pp] += lf[pp - 1];
#pragma unroll
        for (int pp = 14; pp >= 0; --pp) lb[pp] += lb[pp + 1];
        LAS float* tot = (LAS float*)(lds + L_TOT);
        tot[pg * 128 + dd] = lf[15]; tot[512 + pg * 128 + dd] = lb[0];
        LBAR();
        float offf = 0.f, offb = 0.f, glf = 0.f, glb = 0.f;
#pragma unroll
        for (int g = 0; g < 4; ++g) { const float tf = tot[g * 128 + dd], tb = tot[512 + g * 128 + dd]; glf += tf; glb += tb; if (g < pg) offf += tf; if (g > pg) offb += tb; }
        const float eglf = __builtin_amdgcn_exp2f(glf), eglb = __builtin_amdgcn_exp2f(glb);
        if (pg == 0) { float* sc = (float*)(blob + B_SC); sc[dd] = eglf; sc[128 + dd] = eglb; }
#pragma unroll
        for (int pp = 0; pp < 16; ++pp) {
            const int o = (pg * 16 + pp) * QS_ + dd * 2;
            const float qv = bf2f(*(const LAS unsigned short*)(lds + L_QGF + o)) * QSCALE, kv = bf2f(*(const LAS unsigned short*)(lds + L_KGF + o));
            const float ef = __builtin_amdgcn_exp2f(lf[pp] + offf), eb = __builtin_amdgcn_exp2f(lb[pp] + offb);
            const float rf = __builtin_amdgcn_rcpf(ef), rb = __builtin_amdgcn_rcpf(eb);
            *(LAS unsigned short*)(lds + L_QGF + o) = (unsigned short)(pkbf(qv * ef, 0.f) & 0xffffu);
            *(LAS unsigned short*)(lds + L_KGF + o) = (unsigned short)(pkbf(kv * rf, 0.f) & 0xffffu);
            *(LAS unsigned short*)(lds + L_KDF + o) = (unsigned short)(pkbf(kv * rf * eglf, 0.f) & 0xffffu);
            *(LAS unsigned short*)(lds + L_QGB + o) = (unsigned short)(pkbf(qv * eb, 0.f) & 0xffffu);
            *(LAS unsigned short*)(lds + L_KGB + o) = (unsigned short)(pkbf(kv * rb, 0.f) & 0xffffu);
            *(LAS unsigned short*)(lds + L_KDB + o) = (unsigned short)(pkbf(kv * rb * eglb, 0.f) & 0xffffu);
        }
    }
    LBAR();
    { const int un = unit + G; if (un < nunits) GLA_PREFETCH(un); }
    if (w < 4) {
        const int rt = w >> 1, ct = w & 1, r = lane & 31, hh = lane >> 5;
        f32x16 af = zero16(), ab = zero16();
        if (rt >= ct) { const LAS unsigned char* ia = lds + L_QGF + (32 * rt + r) * QS_ + 16 * hh; const LAS unsigned char* ib = lds + L_KGF + (32 * ct + r) * QS_ + 16 * hh;
#pragma unroll
            for (int ks = 0; ks < 8; ++ks) af = MFMA32(*(const LAS bf16x8*)(ia + 32 * ks), *(const LAS bf16x8*)(ib + 32 * ks), af); }
        if (rt <= ct) { const LAS unsigned char* ia = lds + L_QGB + (32 * rt + r) * QS_ + 16 * hh; const LAS unsigned char* ib = lds + L_KGB + (32 * ct + r) * QS_ + 16 * hh;
#pragma unroll
            for (int ks = 0; ks < 8; ++ks) ab = MFMA32(*(const LAS bf16x8*)(ia + 32 * ks), *(const LAS bf16x8*)(ib + 32 * ks), ab); }
        const int j = 32 * ct + r;
#pragma unroll
        for (int reg = 0; reg < 16; ++reg) { const int i = 32 * rt + (reg & 3) + 8 * (reg >> 2) + 4 * hh;
            const float val = (i >= j ? af[reg] : 0.f) + (i <= j ? ab[reg] : 0.f);
            *(LAS unsigned short*)(lds + L_AS + i * AS_ + j * 2) = (unsigned short)(pkbf(val, 0.f) & 0xffffu); }
    } else {
        for (int blk = w - 4; blk < 64; blk += 4) {
            const int wh = blk >> 4, b = blk & 15; v4u f; int off;
            if (wh == 0)      { f = gdn::frag_rm_perm(lds + L_QGF, QS_, b >> 3, b & 7, lane); off = B_QGF; }
            else if (wh == 1) { f = gdn::frag_rm_perm(lds + L_QGB, QS_, b >> 3, b & 7, lane); off = B_QGB; }
            else if (wh == 2) { f = frag_tr_nat(lds + L_KDF, QS_, 32 * (b >> 2), b & 3, lane); off = B_KDTF; }
            else              { f = frag_tr_nat(lds + L_KDB, QS_, 32 * (b >> 2), b & 3, lane); off = B_KDTB; }
            *(v4u*)(blob + off + b * 1024 + lane * 16) = f;
        }
    }
    LBAR();
    {
        const int ct = w, r = lane & 31, hh = lane >> 5;
        f32x16 o[2] = {zero16(), zero16()};
#pragma unroll
        for (int ks = 0; ks < 4; ++ks) {
            const v4u fb = frag_tr_nat(lds + L_V, VS_, 32 * ct, ks, lane);
            *(v4u*)(blobB + B_VB + (ct * 4 + ks) * 1024 + lane * 16) = fb;
            const bf16x8 bfr = __builtin_bit_cast(bf16x8, fb);
#pragma unroll
            for (int rt = 0; rt < 2; ++rt) o[rt] = MFMA32(*(const LAS bf16x8*)(lds + L_AS + (32 * rt + r) * AS_ + (16 * ks + 8 * hh) * 2), bfr, o[rt]);
        }
        unsigned long long* ip = (unsigned long long*)(blobB + B_INTRA) + (size_t)ct * 512 + lane;
#pragma unroll
        for (int rt = 0; rt < 2; ++rt)
#pragma unroll
            for (int g = 0; g < 4; ++g) ip[(rt * 4 + g) * 64] = (unsigned long long)pkbf(o[rt][4 * g], o[rt][4 * g + 1]) | ((unsigned long long)pkbf(o[rt][4 * g + 2], o[rt][4 * g + 3]) << 32);
    }
    LBAR();
  }
#undef GLA_PREFETCH
}

struct GlaChainArgs {
    const unsigned char* blobA;
    const unsigned char* blobB;
    unsigned char* stg;
    unsigned* flag;
    int nseq, flags;
};
namespace gla { constexpr int CB_Y = 17408, CB_BUF = 66560, CB_END = 2 * CB_BUF; }
__device__ __forceinline__ void gla_chain_unit(LAS unsigned char* lds, const GlaChainArgs& A, int item) {
    using namespace gla;
    int tid_l = threadIdx.x; asm volatile("" : "+v"(tid_l));
    const int tid = tid_l, lane = tid & 63, w = __builtin_amdgcn_readfirstlane(tid >> 6);
    const int hh = lane >> 5;
    const int c = item & 1, h = (item >> 1) & 3, sq = item >> 3; const int flags = A.flags;
    const size_t unit0 = (size_t)(sq * 4 + h) * NCH;
    f32x16 S[4];
#pragma unroll
    for (int t = 0; t < 4; ++t) S[t] = zero16();
    unsigned long long pwn[8]; bool have = false; unsigned fnext = 0u;
#define GLA_ISSUE(s_, buf_) do { if (!(flags & 4)) { const int n_ = c ? NCH - 1 - (s_) : (s_); const unsigned char* bl_ = A.blobA + (unit0 + n_) * BLOBA; const unsigned char* bb_ = A.blobB + (unit0 + n_) * BLOBB; \
        LAS unsigned char* d_ = lds + (buf_) * CB_BUF; glds_blocks(d_, bl_ + (c ? B_QGB : B_QGF), 16, w, 8, lane); if (w == 7) glds_blocks(d_ + 16384, bl_ + B_SC, 1, 0, 1, lane); \
        glds_blocks(d_ + CB_Y, bl_ + (c ? B_KDTB : B_KDTF), 16, w, 8, lane); glds_blocks(d_ + CB_Y + 16384, bb_ + B_VB, 32, w, 8, lane); } } while (0)
    GLA_ISSUE(0, 0);
    __syncthreads();
    for (int s = 0; s < NCH; ++s) {
        const int n = c ? NCH - 1 - s : s;
        unsigned long long* sp = (unsigned long long*)(A.stg + (unit0 + n) * 32768) + (size_t)w * 512 + lane;
        unsigned* fl = A.flag + (unit0 + n) * 8 + w;
        unsigned long long pw[8];
        if (s >= NCH / 2 && !(flags & 1)) {
            if (have) {
#pragma unroll
                for (int i = 0; i < 8; ++i) pw[i] = pwn[i];
            } else {
                for (unsigned sp_ = 0; __builtin_amdgcn_readfirstlane((int)__hip_atomic_load(fl, __ATOMIC_RELAXED, __HIP_MEMORY_SCOPE_AGENT)) == 0 && sp_ < CHAIN_SPIN_CAP; ++sp_) __builtin_amdgcn_s_sleep(2);
#pragma unroll
                for (int i = 0; i < 8; ++i) pw[i] = __hip_atomic_load(sp + i * 64, __ATOMIC_RELAXED, __HIP_MEMORY_SCOPE_AGENT);
            }
        }
        have = false;
        if (s + 1 >= NCH / 2 && s + 1 < NCH && !(flags & 1) && __builtin_amdgcn_readfirstlane((int)fnext) != 0) {
            const int n1 = c ? NCH - 2 - s : s + 1; const unsigned long long* sp1 = (const unsigned long long*)(A.stg + (unit0 + n1) * 32768) + (size_t)w * 512 + lane;
#pragma unroll
            for (int i = 0; i < 8; ++i) pwn[i] = __hip_atomic_load(sp1 + i * 64, __ATOMIC_RELAXED, __HIP_MEMORY_SCOPE_AGENT);
            have = true;
        }
        if (s + 2 >= NCH / 2 && s + 2 < NCH && !(flags & 1)) { const int n2 = c ? NCH - 3 - s : s + 2; fnext = __hip_atomic_load(A.flag + (unit0 + n2) * 8 + w, __ATOMIC_RELAXED, __HIP_MEMORY_SCOPE_AGENT); }
        if (s + 1 < NCH) GLA_ISSUE(s + 1, (s + 1) & 1);
        const LAS unsigned char* X = lds + (s & 1) * CB_BUF; const LAS unsigned char* Y = X + CB_Y;
        const LAS float* EG = (const LAS float*)(X + 16384) + c * 128;
        bf16x8 sb[8];
#pragma unroll
        for (int t = 0; t < 4; ++t) { sb[2 * t] = pack8(S[t], 0); sb[2 * t + 1] = pack8(S[t], 1); }
        f32x16 o[2] = {zero16(), zero16()};
        {   constexpr int R = 6; bf16x8 ring[R];
#pragma unroll
            for (int i = 0; i < R; ++i) ring[i] = lds_frag(X, i, lane);
#pragma unroll
            for (int i = 0; i < 16; ++i) { o[i >> 3] = MFMA32(ring[i % R], sb[i & 7], o[i >> 3]); if (i + R < 16) ring[i % R] = lds_frag(X, i + R, lane); __builtin_amdgcn_sched_barrier(0); }
        }
        if (!(flags & 1)) {
            if (s < NCH / 2) {
#pragma unroll
                for (int rt = 0; rt < 2; ++rt)
#pragma unroll
                    for (int g = 0; g < 4; ++g) __hip_atomic_store(sp + (rt * 4 + g) * 64, (unsigned long long)pkbf(o[rt][4 * g], o[rt][4 * g + 1]) | ((unsigned long long)pkbf(o[rt][4 * g + 2], o[rt][4 * g + 3]) << 32), __ATOMIC_RELAXED, __HIP_MEMORY_SCOPE_AGENT);
            } else {
#pragma unroll
                for (int rt = 0; rt < 2; ++rt)
#pragma unroll
                    for (int g = 0; g < 4; ++g) { const unsigned plo = (unsigned)pw[rt * 4 + g], phi = (unsigned)(pw[rt * 4 + g] >> 32);
                        __hip_atomic_store(sp + (rt * 4 + g) * 64, (unsigned long long)pkbf(o[rt][4 * g] + bflo(plo), o[rt][4 * g + 1] + bfhi(plo)) | ((unsigned long long)pkbf(o[rt][4 * g + 2] + bflo(phi), o[rt][4 * g + 3] + bfhi(phi)) << 32), __ATOMIC_RELAXED, __HIP_MEMORY_SCOPE_AGENT); }
            }
        }
        {
            bf16x8 bfr[4];
#pragma unroll
            for (int ks = 0; ks < 4; ++ks) bfr[ks] = lds_frag(Y + 16384, w * 4 + ks, lane);
#pragma unroll
            for (int t = 0; t < 4; ++t)
#pragma unroll
                for (int g = 0; g < 4; ++g) { const f32x4 ev = *(const LAS f32x4*)(EG + 32 * t + 8 * g + 4 * hh);
                    S[t][4 * g] *= ev.x; S[t][4 * g + 1] *= ev.y; S[t][4 * g + 2] *= ev.z; S[t][4 * g + 3] *= ev.w; }
            constexpr int R = 5; bf16x8 ring[R];
#pragma unroll
            for (int i = 0; i < R; ++i) ring[i] = lds_frag(Y, i, lane);
#pragma unroll
            for (int i = 0; i < 16; ++i) { S[i >> 2] = MFMA32(ring[i % R], bfr[i & 3], S[i >> 2]); if (i + R < 16) ring[i % R] = lds_frag(Y, i + R, lane); __builtin_amdgcn_sched_barrier(0); }
        }
        if (!(flags & 1)) { asm volatile("s_waitcnt vmcnt(0)" ::: "memory"); if (lane == 0) __hip_atomic_store(fl, s < NCH / 2 ? 1u : 2u, __ATOMIC_RELAXED, __HIP_MEMORY_SCOPE_AGENT); }
        __syncthreads();
    }
#undef GLA_ISSUE
}

template <int NC, bool S16>
__device__ __forceinline__ void p4_unit(LAS unsigned char* lds, const unsigned char* slot, const unsigned char* intra, const bf16* zg, const float* nw, bf16* out, const unsigned* done) {
    int tid_l = threadIdx.x; asm volatile("" : "+v"(tid_l));
    const int tid = tid_l, lane = tid & 63, w = __builtin_amdgcn_readfirstlane(tid >> 6), r = lane & 31, hh = lane >> 5;
    constexpr int ST = NC * 2 + 16, NB = (NC / 32) * 8, CPR = NC / 8;
    if (done) {
        for (unsigned sp_ = 0; sp_ < (1u << 22); ++sp_) { const unsigned f = lane < 8 ? __hip_atomic_load(done + lane, __ATOMIC_RELAXED, __HIP_MEMORY_SCOPE_AGENT) : 2u; if (__all(f == 2u)) break; __builtin_amdgcn_s_sleep(8); }
    }
    for (int b = w; b < NB; b += 8) {
        const unsigned long long v = __hip_atomic_load((const unsigned long long*)slot + b * 64 + lane, __ATOMIC_RELAXED, __HIP_MEMORY_SCOPE_AGENT);
        float x0 = bflo((unsigned)v), x1 = bfhi((unsigned)v), x2 = bflo((unsigned)(v >> 32)), x3 = bfhi((unsigned)(v >> 32));
        if (intra) { const unsigned long long iv = ((const unsigned long long*)intra)[b * 64 + lane];
            x0 += bflo((unsigned)iv); x1 += bfhi((unsigned)iv); x2 += bflo((unsigned)(iv >> 32)); x3 += bfhi((unsigned)(iv >> 32)); }
        int row, col;
        if (S16) { row = 16 * (b & 3) + 4 * (lane >> 4); col = 16 * (b >> 2) + (lane & 15); }
        else { row = 32 * ((b >> 2) & 1) + 8 * (b & 3) + 4 * hh; col = 32 * (b >> 3) + r; }
        LAS unsigned char* p = lds + row * ST + col * 2;
        const unsigned a = pkbf(x0, x1), bq = pkbf(x2, x3);
        *(LAS unsigned short*)p = (unsigned short)(a & 0xffffu); *(LAS unsigned short*)(p + ST) = (unsigned short)(a >> 16);
        *(LAS unsigned short*)(p + 2 * ST) = (unsigned short)(bq & 0xffffu); *(LAS unsigned short*)(p + 3 * ST) = (unsigned short)(bq >> 16);
    }
    __syncthreads();
#pragma unroll
    for (int it = 0; it < (64 * CPR) / 512; ++it) {
        const int idx = it * 512 + tid, row = idx / CPR, ch = idx % CPR;
        const v4u xw = *(const LAS v4u*)(lds + row * ST + ch * 16);
        float x[8] = {bflo(xw.x), bfhi(xw.x), bflo(xw.y), bfhi(xw.y), bflo(xw.z), bfhi(xw.z), bflo(xw.w), bfhi(xw.w)};
        float ss = 0.f;
#pragma unroll
        for (int i = 0; i < 8; ++i) ss += x[i] * x[i];
        ss = row16_sum(ss);
        if (NC == 256) ss += __shfl_xor(ss, 16);
        const float rstd = 1.0f / sqrtf(ss * (1.0f / NC) + EPS);
        f32x4 w0 = *(const f32x4*)(nw + ch * 8), w1 = *(const f32x4*)(nw + ch * 8 + 4);
        if (zg) { const v4u zw = *(const v4u*)(zg + (size_t)row * 1024 + ch * 8);
            const float z[8] = {bflo(zw.x), bfhi(zw.x), bflo(zw.y), bfhi(zw.y), bflo(zw.z), bfhi(zw.z), bflo(zw.w), bfhi(zw.w)};
            w0.x *= z[0] * __builtin_amdgcn_rcpf(1.0f + __expf(-z[0])); w0.y *= z[1] * __builtin_amdgcn_rcpf(1.0f + __expf(-z[1])); w0.z *= z[2] * __builtin_amdgcn_rcpf(1.0f + __expf(-z[2])); w0.w *= z[3] * __builtin_amdgcn_rcpf(1.0f + __expf(-z[3]));
            w1.x *= z[4] * __builtin_amdgcn_rcpf(1.0f + __expf(-z[4])); w1.y *= z[5] * __builtin_amdgcn_rcpf(1.0f + __expf(-z[5])); w1.z *= z[6] * __builtin_amdgcn_rcpf(1.0f + __expf(-z[6])); w1.w *= z[7] * __builtin_amdgcn_rcpf(1.0f + __expf(-z[7])); }
        v4u o; o.x = pkbf(x[0] * rstd * w0.x, x[1] * rstd * w0.y); o.y = pkbf(x[2] * rstd * w0.z, x[3] * rstd * w0.w); o.z = pkbf(x[4] * rstd * w1.x, x[5] * rstd * w1.y); o.w = pkbf(x[6] * rstd * w1.z, x[7] * rstd * w1.w);
        *(v4u*)(out + (size_t)row * 1024 + ch * 8) = o;
    }
    __syncthreads();
}
#define XB_TMO      128
#define XB_XCNT(j)  (256  + 64 * (j))
#define XB_XSUB(j)  (1280 + 64 * (j))
#define XB_XGEN(j)  (2304 + 64 * (j))
#define XB_TOP      3328
#define XB_TOPGEN   3392
#define XCD_BAR_WORDS 3456
#define XB_SPIN_CAP (1u << 18)

__device__ __forceinline__ unsigned xb_ld(unsigned* p)              { return __hip_atomic_load(p, __ATOMIC_RELAXED, __HIP_MEMORY_SCOPE_AGENT); }
__device__ __forceinline__ unsigned xb_add(unsigned* p, unsigned v) { return __hip_atomic_fetch_add(p, v, __ATOMIC_RELAXED, __HIP_MEMORY_SCOPE_AGENT); }
__device__ __forceinline__ unsigned xb_xcc_id() { return (unsigned)__builtin_amdgcn_s_getreg((3 << 11) | 20) & 0xFu; }
#define XB_SPIN(cond, bar) do { unsigned _sp = 0; while (cond) { __builtin_amdgcn_s_sleep(1); \
    if ((++_sp & 255u) == 0u) { if (xb_ld(&(bar)[XB_TMO])) break; if (_sp > XB_SPIN_CAP) { atomicAdd(&(bar)[XB_TMO], 1u); break; } } } } while (0)

struct XcdBarrier {
    unsigned* bar; unsigned x;
    volatile LAS unsigned* st;
};

__device__ __forceinline__ XcdBarrier xcd_barrier_post(unsigned* bar, volatile LAS unsigned* st) {
    XcdBarrier b; b.bar = bar; b.x = xb_xcc_id(); b.st = st;
    if (threadIdx.x == 0) (void)xb_add(&bar[XB_XCNT(b.x)], 1u);
    return b;
}
__device__ __forceinline__ void xcd_barrier_complete(unsigned* bar, unsigned x, unsigned& nloc, unsigned& nx) {
    const unsigned G = gridDim.x * gridDim.y * gridDim.z;
    unsigned sum, cnt, mine, sp = 0u;
    for (;;) {
        sum = 0u; cnt = 0u; mine = 0u;
#pragma unroll
        for (unsigned j = 0; j < 16; ++j) { const unsigned c = xb_ld(&bar[XB_XCNT(j)]); sum += c; cnt += (c > 0u) ? 1u : 0u; mine = (j == x) ? c : mine; }
        if (sum == G) break;
        __builtin_amdgcn_s_sleep(1);
        if ((++sp & 255u) == 0u) { if (xb_ld(&bar[XB_TMO])) break; if (sp > XB_SPIN_CAP) { atomicAdd(&bar[XB_TMO], 1u); break; } }
    }
    nloc = mine > 0u ? mine : 1u; nx = cnt > 0u ? cnt : 1u;
}

__device__ __forceinline__ void xcd_barrier(const XcdBarrier& b) {
    asm volatile("s_waitcnt vmcnt(0)" ::: "memory");
    __syncthreads();
    if (threadIdx.x == 0) {
        unsigned* bar = b.bar;
        __builtin_amdgcn_s_waitcnt(0);
        unsigned nloc = b.st[0], nx = b.st[1];
        if (nloc == 0u) { xcd_barrier_complete(bar, b.x, nloc, nx); b.st[0] = nloc; b.st[1] = nx; }
        const unsigned old = xb_add(&bar[XB_XSUB(b.x)], 1u);
        const unsigned gen = old / nloc;
        if (old + 1u == (gen + 1u) * nloc) {
            __builtin_amdgcn_fence(__ATOMIC_RELEASE, "agent");
            asm volatile("s_waitcnt vmcnt(0)" ::: "memory");
            const unsigned og = xb_add(&bar[XB_TOP], 1u);
            const unsigned tg = og / nx;
            if (og + 1u == (tg + 1u) * nx) xb_add(&bar[XB_TOPGEN], 1u);
            else XB_SPIN(xb_ld(&bar[XB_TOPGEN]) == tg, bar);
            __builtin_amdgcn_fence(__ATOMIC_ACQUIRE, "agent");
            xb_add(&bar[XB_XGEN(b.x)], 1u);
            asm volatile("s_waitcnt vmcnt(0)" ::: "memory");
        } else {
            XB_SPIN(xb_ld(&bar[XB_XGEN(b.x)]) == gen, bar);
            __builtin_amdgcn_fence(__ATOMIC_ACQUIRE, "agent");
            asm volatile("s_waitcnt vmcnt(0)" ::: "memory");
        }
    }
    __syncthreads();
}
__device__ __forceinline__ void transpose_item(const float* W, int ldw, int src_col0, int K, int ncols, bf16* WT, int dst_row0, LAS float* scr, int item, int lane) {
    asm volatile("" : "+v"(lane));
    const int nblk = ncols / 32, kb = item / nblk, nb = item % nblk, k0 = 64 * kb, n0 = 32 * nb;
#pragma unroll 8
    for (int i = 0; i < 32; ++i) { const int kk = 2 * i + (lane >> 5); scr[kk * 33 + (lane & 31)] = W[(size_t)(k0 + kk) * ldw + src_col0 + n0 + (lane & 31)]; }
    LDS_WAIT();
    const int c = lane & 7;
#pragma unroll
    for (int j = 0; j < 4; ++j) { const int n = (lane >> 3) + 8 * j; const LAS float* s = scr + (8 * c) * 33 + n;
        v4u o; o.x = pk2(s[0 * 33], s[1 * 33]); o.y = pk2(s[2 * 33], s[3 * 33]); o.z = pk2(s[4 * 33], s[5 * 33]); o.w = pk2(s[6 * 33], s[7 * 33]);
        *(v4u*)(WT + (size_t)(dst_row0 + n0 + n) * K + k0 + 8 * c) = o; }
    LDS_WAIT();
}

constexpr int WCV_MIX = 16 * ((1024 + 3072 + 1024 + 1024 + 32 + 32) / 32), WCV_ALL = WCV_MIX + 16 * ((1024 + 2048) / 32) + 3 * 512;
__device__ __forceinline__ void wconv_item(int it, const float* w_in, const float* wa, const float* wb, const float* wo, bf16* WT_IN, bf16* WT_A, bf16* WT_B, bf16* WT_O, LAS float* scr, int lane) {
    constexpr int c0 = 512, c1 = c0 + 1536, c2 = c1 + 512, c3 = c2 + 512, c4 = c3 + 16, c5 = c4 + 16, c6 = c5 + 512, c7 = c6 + 1024, c8 = c7 + 512, c9 = c8 + 512;
    static_assert(c5 == WCV_MIX && c9 + 512 == WCV_ALL, "weight conversion item list");
    if (it < c0) transpose_item(w_in, NIN, SRC_ZA, D, 1024, WT_IN, 0, scr, it, lane);
    else if (it < c1) transpose_item(w_in, NIN, SRC_QKVA, D, 3072, WT_IN, 1024, scr, it - c0, lane);
    else if (it < c2) transpose_item(w_in, NIN, SRC_QB, D, 1024, WT_IN, 4096, scr, it - c1, lane);
    else if (it < c3) transpose_item(w_in, NIN, SRC_VB, D, 1024, WT_IN, 5120, scr, it - c2, lane);
    else if (it < c4) transpose_item(w_in, NIN, SRC_AF, D, 32, WT_IN, 9216, scr, it - c3, lane);
    else if (it < c5) transpose_item(w_in, NIN, SRC_RF, D, 32, WT_IN, 9248, scr, it - c4, lane);
    else if (it < c6) transpose_item(w_in, NIN, SRC_GB, D, 1024, WT_IN, 6144, scr, it - c5, lane);
    else if (it < c7) transpose_item(w_in, NIN, SRC_GA, D, 2048, WT_IN, 7168, scr, it - c6, lane);
    else if (it < c8) transpose_item(wa, D, 0, D, D, WT_A, 0, scr, it - c7, lane);
    else if (it < c9) transpose_item(wb, D, 0, D, D, WT_B, 0, scr, it - c8, lane);
    else transpose_item(wo, D, 0, D, D, WT_O, 0, scr, it - c9, lane);
}
__device__ __forceinline__ void h_rows(const float* x, const float* w, bf16* h, int nrows, int gw, int ngw, int lane) {
    asm volatile("" : "+v"(lane));
    for (int m = gw; m < nrows; m += ngw) {
        const f32x4* xr = (const f32x4*)(x + (size_t)m * D) + lane; f32x4 v[4]; float s = 0.f;
#pragma unroll
        for (int j = 0; j < 4; ++j) { v[j] = xr[64 * j]; s += (v[j].x * v[j].x + v[j].y * v[j].y) + (v[j].z * v[j].z + v[j].w * v[j].w); }
        const float rstd = 1.0f / sqrtf(wave_sum(s) * (1.f / D) + EPS);
        unsigned long long* o8 = (unsigned long long*)(h + (size_t)m * D) + lane;
#pragma unroll
        for (int j = 0; j < 4; ++j) { const f32x4 ww = ((const f32x4*)w)[lane + 64 * j];
            o8[64 * j] = (unsigned long long)pkbf(v[j].x * rstd * ww.x, v[j].y * rstd * ww.y) | ((unsigned long long)pkbf(v[j].z * rstd * ww.z, v[j].w * rstd * ww.w) << 32); }
    }
}
__device__ __forceinline__ void h_rows_tiles(const float* x, const float* w, const pg8::Gemm& gt, int nrows, int gw, int ngw, int lane) {
    asm volatile("" : "+v"(lane));
    for (int m = gw; m < nrows; m += ngw) {
        const f32x4* xr = (const f32x4*)(x + (size_t)m * D) + lane; f32x4 v[4]; float s = 0.f;
#pragma unroll
        for (int j = 0; j < 4; ++j) { v[j] = xr[64 * j]; s += (v[j].x * v[j].x + v[j].y * v[j].y) + (v[j].z * v[j].z + v[j].w * v[j].w); }
        const float rstd = 1.0f / sqrtf(wave_sum(s) * (1.f / D) + EPS);
        unsigned long long* o8 = (unsigned long long*)(gt.atile(m >> 8, (size_t)256 * D * 2) + (size_t)(m & 255) * D * 2) + lane;
#pragma unroll
        for (int j = 0; j < 4; ++j) { const f32x4 ww = ((const f32x4*)w)[lane + 64 * j];
            o8[64 * j] = (unsigned long long)pkbf(v[j].x * rstd * ww.x, v[j].y * rstd * ww.y) | ((unsigned long long)pkbf(v[j].z * rstd * ww.z, v[j].w * rstd * ww.w) << 32); }
    }
}
__device__ __forceinline__ void final_rows(const float* x, const float* pre, const float* w, float* out, int nrows, int gw, int ngw, int lane) {
    asm volatile("" : "+v"(lane));
    for (int m = gw; m < nrows; m += ngw) {
        const f32x4* pr = (const f32x4*)(pre + (size_t)m * D) + lane; const f32x4* xr = (const f32x4*)(x + (size_t)m * D) + lane; f32x4 v[4]; float s = 0.f;
#pragma unroll
        for (int j = 0; j < 4; ++j) { v[j] = pr[64 * j]; s += (v[j].x * v[j].x + v[j].y * v[j].y) + (v[j].z * v[j].z + v[j].w * v[j].w); }
        const float rstd = 1.0f / sqrtf(wave_sum(s) * (1.f / D) + EPS);
        f32x4* orow = (f32x4*)(out + (size_t)m * D) + lane;
#pragma unroll
        for (int j = 0; j < 4; ++j) { const f32x4 ww = ((const f32x4*)w)[lane + 64 * j]; const f32x4 xv = xr[64 * j]; orow[64 * j] = xv + v[j] * rstd * ww; }
    }
}
__device__ __forceinline__ void small_unit(LAS unsigned char* lds, const bf16* h, const bf16* wsm, float* out, int unit) {
    int tid_l = threadIdx.x; asm volatile("" : "+v"(tid_l));
    const int tid = tid_l, lane = tid & 63, w = __builtin_amdgcn_readfirstlane(tid >> 6), r = lane & 31, hh = lane >> 5;
    const int rt = (w >> 1) & 1, ct = w & 1, kh = w >> 2;
    const bf16* ap = h + (size_t)(unit * 64 + 32 * rt + r) * D + kh * 512 + 8 * hh;
    const bf16* bp = wsm + (size_t)(32 * ct + r) * D + kh * 512 + 8 * hh;
    f32x16 acc = zero16();
#pragma unroll 8
    for (int ks = 0; ks < 32; ++ks) acc = MFMA32(*(const bf16x8*)(ap + 16 * ks), *(const bf16x8*)(bp + 16 * ks), acc);
    LAS float* red = (LAS float*)lds + (w & 3) * 1024 + lane;
    if (kh == 1) {
#pragma unroll
        for (int i = 0; i < 16; ++i) red[i * 64] = acc[i]; }
    __syncthreads();
    if (kh == 0) {
        float* op = out + (size_t)(unit * 64 + 32 * rt + 4 * hh) * 64 + 32 * ct + r;
#pragma unroll
        for (int i = 0; i < 16; ++i) op[((i & 3) + 8 * (i >> 2)) * 64] = acc[i] + red[i * 64]; }
    __syncthreads();
}

constexpr int NG = 2, MG = M / NG, NSEQG = BATCH / NG;
constexpr size_t KiB = 1024;
constexpr size_t WS_CTL = 0  , WS_WTIN = 320 * KiB, WS_WTA = WS_WTIN + 18560 * KiB, WS_WTB = WS_WTA + 2 * MiB, WS_WTO = WS_WTB + 2 * MiB, WS_SMALL = WS_WTO + 2 * MiB  ,
    WS_Z = WS_SMALL + 2 * MiB  , WS_PG = WS_Z + 16 * MiB  , WS_GBLOB = WS_PG + 80 * MiB  , WS_LBLOBB = WS_GBLOB + 98 * MiB  , WS_END = WS_LBLOBB + 32 * MiB;
static_assert(WS_END <= 256 * MiB, "workspace");
constexpr size_t WS_GATES = WS_GBLOB  , WS_M1 = WS_GATES + 64 * MiB  , WS_MERGED = WS_M1 + 32 * MiB  , WS_PRE = WS_MERGED + 32 * MiB  ;
static_assert(WS_PRE + 1 * MiB <= WS_END, "overlays");
constexpr size_t HT_TILE = 256 * 1024 * 2, WS_H0 = WS_WTIN, WS_H1 = WS_PG + (size_t)NSEQG * 4 * NCH * gla::BLOBA, WS_H2 = WS_SMALL, WS_H3 = WS_END;
constexpr int HT1 = 24, HT2 = 55, HT3 = 59;
static_assert(((size_t)NSEQG * 4 * NCH * gla::BLOBA) % HT_TILE == 0 && WS_H1 + (HT2 - HT1) * HT_TILE <= WS_PG + 3 * ((size_t)MG * 2048) && HT1 * HT_TILE <= (size_t)6144 * 2048 && (HT3 - HT2) * HT_TILE <= 2 * MiB && WS_H3 + (64 - HT3) * HT_TILE <= 256 * MiB, "h tiles");
constexpr size_t PGMAT = (size_t)MG * 1024 * 2;
static_assert((size_t)NSEQG * 4 * NCH * gla::BLOBA <= 3 * PGMAT && (size_t)NSEQG * 4 * NCH * 32768 <= PGMAT && (size_t)NSEQG * 8 * NCH * 16384 <= PGMAT, "overlays");
static_assert((size_t)NSEQG * 8 * NCH * gdn::BLOB <= 98 * MiB && (size_t)NSEQG * 4 * NCH * gla::BLOBB <= 32 * MiB, "blobs");
constexpr int LDS_BYTES = 160 * 1024, LDS_BAR = LDS_BYTES - 16;
static_assert(gla::L_END <= LDS_BAR && gdn::L_END <= LDS_BAR && gdn::C_END <= LDS_BAR && gla::CB_END <= LDS_BAR && pg8::STAGE_BYTES <= LDS_BAR, "LDS");
constexpr int N_PHASES = 12;

struct MegaArgs { const float* in[18]; float* out; unsigned char* ws; int ph_lo, ph_hi; };

__global__ void __launch_bounds__(512, 2) mega(MegaArgs a) {
    extern __shared__ __attribute__((aligned(16))) unsigned char lds_raw[];
    LAS unsigned char* lds = (LAS unsigned char*)lds_raw;
    const int tid = threadIdx.x, lane = tid & 63, wave = __builtin_amdgcn_readfirstlane(tid >> 6);
    const int G = gridDim.x, bid = blockIdx.x, gw = bid * 8 + wave, ngw = G * 8;
    unsigned char* ws = a.ws;
    const float* x = a.in[0]; const float* ln_pre_w = a.in[1]; const float* w_in = a.in[2]; const float* conv_w = a.in[3];
    if (tid < 4) ((LAS unsigned*)(lds + LDS_BAR))[tid] = 0u;
    __syncthreads();
    XcdBarrier bar = xcd_barrier_post((unsigned*)(ws + WS_CTL), (volatile LAS unsigned*)(lds + LDS_BAR));
    const int lo = a.ph_lo, hi = a.ph_hi;
#define IN(k) (lo <= (k) && (k) < hi)
#define SEAM(k) do { if (IN(k) && IN((k) + 1)) xcd_barrier(bar); } while (0)
#ifndef PROBE_REPEAT
#define PROBE_REPEAT 0
#endif
#ifndef PROBE_FLAGS
#define PROBE_FLAGS 0
#endif
#define PH(k) if (IN(k)) for (int rep_ = 0; rep_ <= ((PROBE_REPEAT >> (k)) & 1); ++rep_)
#define REPBAR() do { if (rep_) xcd_barrier(bar); } while (0)
    bf16* WT_IN = (bf16*)(ws + WS_WTIN); bf16* WT_A = (bf16*)(ws + WS_WTA); bf16* WT_B = (bf16*)(ws + WS_WTB); bf16* WT_O = (bf16*)(ws + WS_WTO);
    bf16* PG = (bf16*)(ws + WS_PG); float* SMALL = (float*)(ws + WS_SMALL);
    bf16* ORAWA = (bf16*)a.out; bf16* ORAWB = (bf16*)a.out + (size_t)M * 1024;
    pg8::Gemm gh{(const bf16*)(ws + WS_H0), WT_IN + (size_t)6144 * D, M, 3072, D, 0, (const bf16*)(ws + WS_H1), (const bf16*)(ws + WS_H2), (const bf16*)(ws + WS_H3), HT1, HT2, HT3};

    PH(0) { REPBAR();
        LAS float* scr = (LAS float*)lds + wave * (64 * 33);
        for (int it = gw; it < WCV_MIX; it += ngw) wconv_item(it, w_in, a.in[9], a.in[15], a.in[16], WT_IN, WT_A, WT_B, WT_O, scr, lane);
        h_rows(x, ln_pre_w, ORAWB + (size_t)MG * 1024, MG, gw, ngw, lane);
    }
    SEAM(0);
#ifdef PROBE_BARRIERS
    for (int i = 0; i < PROBE_BARRIERS; ++i) xcd_barrier(bar);
#endif
    for (int g = 0; g < NG; ++g) {
        const int pb = 1 + 4 * g;
        const size_t r0 = (size_t)g * MG;
        const bf16* hsrc = (g == 0 ? ORAWB : ORAWA) + (size_t)MG * 1024;
        PH(pb) { REPBAR();
            for (int u = bid; u < MG / 64; u += G) small_unit(lds, hsrc, WT_IN + (size_t)9216 * D, SMALL, u);
            pg8::Gemm gm{hsrc, WT_IN, MG, 6144, D, 0}; pg8::StaticOrder S; S.init(MG, 6144, G, bid);
            pg8::EpiBf16 E{(bf16*)(ws + WS_Z), 1024, 1024, (size_t)MG * 1024};
            pg8::gemm_phase<pg8::EpiBf16, pg8::StaticOrder, true, true>(lds, gm, S, E);
        }
        SEAM(pb);
        PH(pb + 1) { REPBAR();
            GdnPrepArgs pa{PG, PG + (size_t)MG * 1024, PG + (size_t)2 * MG * 1024, SMALL, conv_w, a.in[4], a.in[5], a.in[6], a.in[7], ws + WS_GBLOB, NSEQG, rep_ ? PROBE_FLAGS : 0};
            gdn_prep_phase(lds, pa, bid, G, ws + WS_CTL + 300 * KiB);
        }
        SEAM(pb + 1);
        PH(pb + 2) { REPBAR();
            GlaPrepArgs pa{PG + (size_t)3 * MG * 1024, PG + (size_t)4 * MG * 1024, SMALL, a.in[10], a.in[11], a.in[12], a.in[13], ws + WS_PG, ws + WS_LBLOBB, NSEQG, 0};
            gla_prep_phase(lds, pa, bid, G);
        }
        SEAM(pb + 2);
        PH(pb + 3) { REPBAR();
            constexpr int NGI = NSEQG * 8 * 2, NLI = NSEQG * 4 * 2;
            unsigned* gflag = (unsigned*)(ws + WS_CTL + 32 * KiB) + (size_t)g * (NSEQG * 8 * NCH * 8); unsigned* lflag = (unsigned*)(ws + WS_CTL + 96 * KiB) + (size_t)g * (NSEQG * 4 * NCH * 8);
            if (rep_) { gflag += 32 * 1024; lflag += 32 * 1024; }
            if (bid < NGI) { if (!(rep_ && (PROBE_FLAGS & 16))) { GdnChainArgs ca{ws + WS_GBLOB, ws + WS_PG + 4 * PGMAT, gflag, NSEQG, rep_ ? PROBE_FLAGS : 0}; gdn_chain_unit(lds, ca, bid); } }
            else if (bid < NGI + NLI) { if (!(rep_ && (PROBE_FLAGS & 32))) { GlaChainArgs ca{ws + WS_PG, ws + WS_LBLOBB, ws + WS_PG + 3 * PGMAT, lflag, NSEQG, rep_ ? PROBE_FLAGS : 0}; gla_chain_unit(lds, ca, bid - NGI); } }
            else if (!rep_) {
                const int wk = bid - NGI - NLI, nwk = G - NGI - NLI;
                if (g == 0) h_rows(x + (size_t)MG * D, ln_pre_w, ORAWA + (size_t)MG * 1024, MG, wk * 8 + wave, nwk * 8, lane);
                if (g == 0) { LAS float* scr = (LAS float*)lds + wave * (64 * 33);
                    for (int it = WCV_MIX + wk * 8 + wave; it < WCV_ALL; it += nwk * 8) wconv_item(it, w_in, a.in[9], a.in[15], a.in[16], WT_IN, WT_A, WT_B, WT_O, scr, lane);
                    __syncthreads(); }
                if (g == NG - 1) h_rows_tiles(x, ln_pre_w, gh, M, wk * 8 + wave, nwk * 8, lane);
            }
            if (!rep_) {
                constexpr int NPG = NSEQG * 8, NPL = NSEQG * 4;
                unsigned* qhead = (unsigned*)(ws + WS_CTL + 301 * KiB) + 64 * g;
                for (;;) {
                    if (tid == 0) ((LAS unsigned*)(lds + LDS_BAR))[3] = __hip_atomic_fetch_add(qhead, 1u, __ATOMIC_RELAXED, __HIP_MEMORY_SCOPE_AGENT);
                    __syncthreads();
                    const int j = (int)((LAS unsigned*)(lds + LDS_BAR))[3];
                    __syncthreads();
                    if (j >= NCH * (NPG + NPL)) break;
                    const int rk = j / (NPG + NPL), idx = j % (NPG + NPL), n = (rk & 1) ? (NCH / 2 - 1 - (rk >> 1)) : (NCH / 2 + (rk >> 1));
                    if (idx < NPG) { const int u = idx * NCH + n, hd = idx % 8, sq = idx / 8;
                        p4_unit<128, true>(lds, ws + WS_PG + 4 * PGMAT + (size_t)u * 16384, nullptr, (const bf16*)(ws + WS_Z) + ((size_t)sq * SEQ + n * CHUNK) * 1024 + hd * 128, a.in[8], ORAWA + (r0 + (size_t)sq * SEQ + n * CHUNK) * 1024 + hd * 128, gflag + (size_t)u * 8); }
                    else { const int pi = idx - NPG, u = pi * NCH + n, hd = pi % 4, sq = pi / 4;
                        p4_unit<256, false>(lds, ws + WS_PG + 3 * PGMAT + (size_t)u * 32768, ws + WS_LBLOBB + (size_t)u * gla::BLOBB + gla::B_INTRA, nullptr, a.in[14], ORAWB + (r0 + (size_t)sq * SEQ + n * CHUNK) * 1024 + hd * 256, lflag + (size_t)u * 8); }
                }
            }
        }
        SEAM(pb + 3);
    }
    PH(9) { REPBAR();
        const pg8::Gemm& gm = gh; pg8::StaticOrder S; S.init(M, 3072, G, bid);
        if (rep_ == 0) { pg8::EpiP1b E{ORAWB, (bf16*)(ws + WS_GATES), (size_t)M * 1024, ORAWB};
            pg8::gemm_phase<pg8::EpiP1b, pg8::StaticOrder, true, true>(lds, gm, S, E); }
        else { pg8::EpiP1b E{ORAWB, (bf16*)(ws + WS_GATES), (size_t)M * 1024, (bf16*)(ws + WS_MERGED)};
            pg8::gemm_phase<pg8::EpiP1b, pg8::StaticOrder, true, true>(lds, gm, S, E); }
    }
    SEAM(9);
    PH(10) { REPBAR();
        pg8::Gemm gm{ORAWA, WT_A, 2 * M, 2 * D, D, 0}; pg8::PairOrder S; S.init(M, D, G, bid);
        pg8::EpiMerge E{(bf16*)(ws + WS_M1), (bf16*)(ws + WS_MERGED), (const bf16*)(ws + WS_GATES), (size_t)M * 1024, M / 256, D / 256};
        pg8::gemm_phase<pg8::EpiMerge, pg8::PairOrder, true, true>(lds, gm, S, E);
    }
    SEAM(10);
    if (IN(11)) {
        pg8::Gemm gm{(const bf16*)(ws + WS_MERGED), WT_O, M, D, D, 0}; pg8::StaticOrder S; S.init(M, D, G, bid);
        pg8::EpiRmsRes E{x, a.in[17], a.out, (float*)(ws + WS_PRE), (unsigned*)(ws + WS_CTL + 304 * KiB)};
        pg8::gemm_phase<pg8::EpiRmsRes, pg8::StaticOrder, false, true>(lds, gm, S, E);
    }
#undef IN
#undef SEAM
}

#ifndef MK_N_LAUNCHES
#define MK_N_LAUNCHES 1
#endif
extern "C" void kernel_launch(void* const* d_in, const int* in_sizes, int n_in, void* d_out, int out_size, void* d_ws, size_t ws_size, hipStream_t stream) {
    static int ready = 0;
    if (!ready) {
        if (n_in != 18 || ws_size < 256 * MiB || out_size != M * D) { fprintf(stderr, "kernel_launch: unexpected problem shape / workspace (%d inputs, ws %zu)\n", n_in, ws_size); ready = -1; return; }
        if (hipFuncSetAttribute((const void*)mega, hipFuncAttributeMaxDynamicSharedMemorySize, LDS_BYTES) != hipSuccess) { fprintf(stderr, "kernel_launch: hipFuncSetAttribute failed\n"); ready = -1; return; }
        ready = 1;
    }
    if (ready < 0) return;
    (void)hipMemsetAsync((char*)d_ws + WS_CTL, 0, 320 * 1024, stream);
    MegaArgs a{};
    for (int i = 0; i < 18; ++i) a.in[i] = (const float*)d_in[i];
    a.out = (float*)d_out; a.ws = (unsigned char*)d_ws;
#if MK_N_LAUNCHES == 1
    a.ph_lo = 0; a.ph_hi = N_PHASES;
    hipLaunchKernelGGL(mega, dim3(256), dim3(512), LDS_BYTES, stream, a);
#else
    for (int p = 0; p < N_PHASES; ++p) { a.ph_lo = p; a.ph_hi = p + 1; hipLaunchKernelGGL(mega, dim3(256), dim3(512), LDS_BYTES, stream, a); }
#endif
}
```

```cpp
#include <hip/hip_runtime.h>
#include <cstdio>
#include <cstdint>

#define GAS __attribute__((address_space(1)))
#define LAS __attribute__((address_space(3)))
typedef unsigned short bf16;
typedef unsigned v4u __attribute__((ext_vector_type(4)));
typedef unsigned v2u __attribute__((ext_vector_type(2)));
typedef float f32x4 __attribute__((ext_vector_type(4)));
#define LDS_WAIT() asm volatile("s_waitcnt lgkmcnt(0)" ::: "memory")

constexpr int BATCH = 8, SEQ = 2048, D = 1024, M = BATCH * SEQ, NIN = 9280;
constexpr float EPS = 1e-6f;
constexpr size_t MiB = 1 << 20;
constexpr int SRC_QKVA = 0, SRC_ZA = 3072, SRC_AF = 4096, SRC_QB = 4128, SRC_KB = 4640, SRC_VB = 5152, SRC_GB = 6176, SRC_RF = 7200, SRC_GA = 7232, SRC_GBm = 8256;

__device__ __forceinline__ unsigned f2bf(float f) { unsigned u = __builtin_bit_cast(unsigned, f); return (u + 0x7fffu + ((u >> 16) & 1u)) >> 16; }
__device__ __forceinline__ unsigned pk2(float lo, float hi) { return f2bf(lo) | (f2bf(hi) << 16); }
__device__ __forceinline__ float bf2f(unsigned short b) { return __builtin_bit_cast(float, (unsigned)b << 16); }
__device__ __forceinline__ float bflo(unsigned w) { return __builtin_bit_cast(float, w << 16); }
__device__ __forceinline__ float bfhi(unsigned w) { return __builtin_bit_cast(float, w & 0xffff0000u); }
__device__ __forceinline__ float sigmoidf_(float x) { return 1.0f / (1.0f + __expf(-x)); }
__device__ __forceinline__ float siluf_(float x) { return x / (1.0f + __expf(-x)); }
__device__ __forceinline__ float wave_sum(float v) {
#pragma unroll
    for (int o = 1; o < 64; o <<= 1) v += __shfl_xor(v, o);
    return v;
}
namespace pg8 {
#define PG8_LAS __attribute__((address_space(3)))
typedef unsigned short bf16_t;
typedef short bf16x8 __attribute__((ext_vector_type(8)));
typedef float f32x4 __attribute__((ext_vector_type(4)));
typedef unsigned u32x4 __attribute__((ext_vector_type(4)));
constexpr int BM = 256, BK = 64, HALF = 128, HTB = HALF * BK * 2  , STAGE_BYTES = 8 * HTB, NXCD = 8, WGM = 8;

__host__ __device__ __forceinline__ int lds_byte(int r, int c) { const int st = (r >> 4) * 2 + (c >> 5), rr = r & 15, cc = c & 31, ob = rr * 64 + cc * 2; return st * 1024 + (ob ^ (((ob >> 9) & 1) << 5)); }
__host__ __device__ __forceinline__ void stage_rc(int b, int& R, int& C) { const int st = b / 1024, sb = b % 1024, swz = sb ^ (((sb >> 9) & 1) << 5); R = (st >> 1) * 16 + swz / 64; C = (st & 1) * 32 + (swz % 64) / 2; }
__host__ __device__ __forceinline__ int perm32(int rho) { const int n = rho >> 4, i = rho & 15; return 8 * (i >> 2) + 4 * n + (i & 3); }

struct Unit { int pm, pn; };
struct Gemm { const bf16_t* A; const bf16_t* Bt; int M, N, K, pad_;
    const bf16_t* A1 = nullptr; const bf16_t* A2 = nullptr; const bf16_t* A3 = nullptr; int t1 = 1 << 30, t2 = 1 << 30, t3 = 1 << 30;
    __host__ __device__ __forceinline__ const char* atile(int pm, size_t tstep) const {
        if (pm < t1) return (const char*)A + (size_t)pm * tstep;
        if (pm < t2) return (const char*)A1 + (size_t)(pm - t1) * tstep;
        if (pm < t3) return (const char*)A2 + (size_t)(pm - t2) * tstep;
        return (const char*)A3 + (size_t)(pm - t3) * tstep; }
};

struct StaticOrder {
    int nM, nN, nwg, G, c;
    __host__ __device__ void init(int M, int N, int G_, int c_) { nM = M / BM; nN = N / BM; nwg = nM * nN; G = G_; c = c_; }
    __host__ __device__ bool next(int i, Unit& u) const {
        const long L = (long)i * G + c; if (L >= nwg) return false;
        int wgid = (int)L; { const int q = nwg / NXCD, r = nwg % NXCD, xcd = wgid % NXCD, off = wgid / NXCD; wgid = (xcd < r ? xcd * (q + 1) : r * (q + 1) + (xcd - r) * q) + off; }
        const int nig = WGM * nN, gid = wgid / nig, fm = gid * WGM, gsz = (nM - fm) < WGM ? (nM - fm) : WGM;
        u.pm = fm + ((wgid % nig) % gsz); u.pn = (wgid % nig) / gsz; return true;
    }
    __device__ __forceinline__ void a_ready(const Unit&) const {}
    __device__ __forceinline__ void done(const Unit&) const {}
};

__device__ __forceinline__ unsigned cvt_pk_bf16(float lo, float hi) { unsigned r; asm volatile("v_cvt_pk_bf16_f32 %0, %1, %2" : "=v"(r) : "v"(lo), "v"(hi)); return r; }
struct EpiBf16 {
    static constexpr bool PERM = true, AFTER_DRAIN = false;
    bf16_t* O; int ldc; int split_cols; size_t split_stride;
    __device__ __forceinline__ void operator()(const f32x4 (&acc)[2][2][4][2], const Unit& u, int wr, int wc, int fr, int fq) const {
        const int row0 = u.pm * BM + wr * 64 + fr; int colt = u.pn * BM; bf16_t* base = O;
        if (split_cols) { const int t = colt / split_cols; base += (size_t)t * split_stride; colt -= t * split_cols; }
        const int col0 = colt + wc * 32 + 8 * fq;
#pragma unroll
        for (int ai = 0; ai < 2; ++ai)
#pragma unroll
            for (int m = 0; m < 4; ++m) { bf16_t* rowp = base + (size_t)(row0 + ai * HALF + m * 16) * ldc + col0;
#pragma unroll
                for (int bj = 0; bj < 2; ++bj) { const f32x4 v0 = acc[ai][bj][m][0], v1 = acc[ai][bj][m][1];
                    u32x4 w; w.x = cvt_pk_bf16(v0[0], v0[1]); w.y = cvt_pk_bf16(v0[2], v0[3]); w.z = cvt_pk_bf16(v1[0], v1[1]); w.w = cvt_pk_bf16(v1[2], v1[3]);
                    *(u32x4*)(rowp + bj * HALF) = w; } }
    }
};
template <int MODE> struct EpiGate {
    static constexpr bool PERM = true, AFTER_DRAIN = false;
    bf16_t* O; const bf16_t* G; const bf16_t* Add; int ldc, pad_;
    __device__ __forceinline__ void operator()(const f32x4 (&acc)[2][2][4][2], const Unit& u, int wr, int wc, int fr, int fq) const {
        const int row0 = u.pm * BM + wr * 64 + fr; const int col0 = u.pn * BM + wc * 32 + 8 * fq;
#pragma unroll
        for (int ai = 0; ai < 2; ++ai)
#pragma unroll
            for (int m = 0; m < 4; ++m) { const size_t ro = (size_t)(row0 + ai * HALF + m * 16) * ldc + col0;
#pragma unroll
                for (int bj = 0; bj < 2; ++bj) { const f32x4 v0 = acc[ai][bj][m][0], v1 = acc[ai][bj][m][1];
                    const u32x4 gw = *(const u32x4*)(G + ro + bj * HALF);
                    float r[8]; const float a[8] = {v0[0], v0[1], v0[2], v0[3], v1[0], v1[1], v1[2], v1[3]};
#pragma unroll
                    for (int i = 0; i < 4; ++i) { const unsigned w = gw[i]; const float g0 = __builtin_bit_cast(float, w << 16), g1 = __builtin_bit_cast(float, w & 0xffff0000u);
                        if (MODE == 0) { r[2 * i] = a[2 * i] / (1.0f + __expf(-g0)); r[2 * i + 1] = a[2 * i + 1] / (1.0f + __expf(-g1)); }
                        else { r[2 * i] = g0 * a[2 * i] / (1.0f + __expf(-a[2 * i])); r[2 * i + 1] = g1 * a[2 * i + 1] / (1.0f + __expf(-a[2 * i + 1])); } }
                    if (Add) { const u32x4 aw = *(const u32x4*)(Add + ro + bj * HALF);
#pragma unroll
                        for (int i = 0; i < 4; ++i) { const unsigned w = aw[i]; r[2 * i] += __builtin_bit_cast(float, w << 16); r[2 * i + 1] += __builtin_bit_cast(float, w & 0xffff0000u); } }
                    u32x4 w; w.x = cvt_pk_bf16(r[0], r[1]); w.y = cvt_pk_bf16(r[2], r[3]); w.z = cvt_pk_bf16(r[4], r[5]); w.w = cvt_pk_bf16(r[6], r[7]);
                    *(u32x4*)(O + ro + bj * HALF) = w; } }
    }
};
struct EpiF32 {
    static constexpr bool PERM = false, AFTER_DRAIN = false;
    float* O; int ldc, pad_;
    __device__ __forceinline__ void operator()(const f32x4 (&acc)[2][2][4][2], const Unit& u, int wr, int wc, int fr, int fq) const {
        const int row0 = u.pm * BM + wr * 64 + fr; const int col0 = u.pn * BM + wc * 32 + 4 * fq;
#pragma unroll
        for (int ai = 0; ai < 2; ++ai)
#pragma unroll
            for (int m = 0; m < 4; ++m) { float* rowp = O + (size_t)(row0 + ai * HALF + m * 16) * ldc + col0;
#pragma unroll
                for (int bj = 0; bj < 2; ++bj)
#pragma unroll
                    for (int n = 0; n < 2; ++n) *(f32x4*)(rowp + bj * HALF + n * 16) = acc[ai][bj][m][n]; }
    }
};
struct EpiP1b {
    static constexpr bool PERM = true, AFTER_DRAIN = false;
    const bf16_t* ob; bf16_t* gates; size_t gate_stride; bf16_t* ob_out;
    __device__ __forceinline__ void operator()(const f32x4 (&acc)[2][2][4][2], const Unit& u, int wr, int wc, int fr, int fq) const {
        if (u.pn < 4) { EpiGate<1> E{ob_out, ob, nullptr, 1024, 0}; E(acc, u, wr, wc, fr, fq); }
        else { Unit v = u; v.pn = (u.pn - 4) & 3; EpiBf16 E{gates + (size_t)((u.pn - 4) >> 2) * gate_stride, 1024, 0, 0}; E(acc, v, wr, wc, fr, fq); }
    }
};
struct EpiRmsRes {
    static constexpr bool PERM = false, AFTER_DRAIN = true;
    const float* xres; const float* w; float* out; float* xbuf; unsigned* cnt;
    __device__ __forceinline__ void fused(f32x4 (&acc)[2][2][4][2], const Unit& u, int wr, int wc, int fr, int fq, PG8_LAS unsigned char* lds, int wid, int lane) const {
        PG8_LAS float* P = (PG8_LAS float*)lds;
        PG8_LAS float* R = (PG8_LAS float*)(lds + 4096);
#pragma unroll
        for (int ai = 0; ai < 2; ++ai)
#pragma unroll
            for (int m = 0; m < 4; ++m) { float s = 0.f;
#pragma unroll
                for (int bj = 0; bj < 2; ++bj)
#pragma unroll
                    for (int n = 0; n < 2; ++n) { const f32x4 x = acc[ai][bj][m][n]; s += (x[0] * x[0] + x[1] * x[1]) + (x[2] * x[2] + x[3] * x[3]); }
                s += __shfl_xor(s, 16); s += __shfl_xor(s, 32);
                if (fq == 0) P[(ai * HALF + wr * 64 + m * 16 + fr) * 4 + wc] = s; }
        asm volatile("s_waitcnt lgkmcnt(0)" ::: "memory"); __builtin_amdgcn_s_barrier(); asm volatile("" ::: "memory");
        const int row = wid * 32 + (lane & 31);
        if (lane < 32) { const f32x4 p = *(const PG8_LAS f32x4*)(P + row * 4);
            __hip_atomic_store(xbuf + (size_t)(u.pm * BM + row) * 4 + u.pn, (p[0] + p[1]) + (p[2] + p[3]), __ATOMIC_RELAXED, __HIP_MEMORY_SCOPE_AGENT); }
        asm volatile("s_waitcnt vmcnt(0)" ::: "memory");
        if (lane == 0) __hip_atomic_fetch_add(cnt + 64 * u.pm, 1u, __ATOMIC_RELAXED, __HIP_MEMORY_SCOPE_AGENT);
        if (wid == 0) {
            for (unsigned sp = 0; (unsigned)__builtin_amdgcn_readfirstlane((int)__hip_atomic_load(cnt + 64 * u.pm, __ATOMIC_RELAXED, __HIP_MEMORY_SCOPE_AGENT)) < 32u && sp < (1u << 22); ++sp) __builtin_amdgcn_s_sleep(2);
        }
        asm volatile("s_waitcnt vmcnt(0) lgkmcnt(0)" ::: "memory"); __builtin_amdgcn_s_barrier(); asm volatile("" ::: "memory");
        if (lane < 32) { const float* sl = xbuf + (size_t)(u.pm * BM + row) * 4; float t = 0.f;
#pragma unroll
            for (int i = 0; i < 4; ++i) t += __hip_atomic_load(sl + i, __ATOMIC_RELAXED, __HIP_MEMORY_SCOPE_AGENT);
            R[row] = 1.0f / sqrtf(t * (1.0f / 1024.0f) + 1e-6f); }
        asm volatile("s_waitcnt vmcnt(0) lgkmcnt(0)" ::: "memory"); __builtin_amdgcn_s_barrier(); asm volatile("" ::: "memory");
        const int col0 = u.pn * BM + wc * 32 + 4 * fq;
#pragma unroll
        for (int ai = 0; ai < 2; ++ai)
#pragma unroll
            for (int m = 0; m < 4; ++m) { const int r = ai * HALF + wr * 64 + m * 16 + fr; const float rs = R[r]; const size_t off = (size_t)(u.pm * BM + r) * 1024 + col0;
#pragma unroll
                for (int bj = 0; bj < 2; ++bj)
#pragma unroll
                    for (int n = 0; n < 2; ++n) { const int c = bj * HALF + n * 16; const f32x4 xv = *(const f32x4*)(xres + off + c); const f32x4 wv = *(const f32x4*)(w + col0 + c);
                        *(f32x4*)(out + off + c) = xv + acc[ai][bj][m][n] * rs * wv; }
                if (m & 1) asm volatile("" ::: "memory"); }
    }
};
struct PairOrder {
    StaticOrder S; int nM, nN;
    __host__ __device__ void init(int M, int N, int G_, int c_) { S.init(M, N, G_, c_); nM = M / BM; nN = N / BM; }
    __host__ __device__ bool next(int i, Unit& u) const { if (i > 1) return false; Unit b; if (!S.next(0, b)) return false; u.pm = b.pm + i * nM; u.pn = b.pn + i * nN; return true; }
    __device__ __forceinline__ void a_ready(const Unit&) const {}
    __device__ __forceinline__ void done(const Unit&) const {}
};
struct EpiMerge {
    static constexpr bool PERM = true, AFTER_DRAIN = false;
    bf16_t* m1; bf16_t* merged; const bf16_t* gates; size_t gate_stride; int nM, nN;
    __device__ __forceinline__ void operator()(const f32x4 (&acc)[2][2][4][2], const Unit& u, int wr, int wc, int fr, int fq) const {
        if (u.pm < nM) { EpiGate<0> E{m1, gates, nullptr, 1024, 0}; E(acc, u, wr, wc, fr, fq); }
        else { Unit v; v.pm = u.pm - nM; v.pn = u.pn - nN; EpiGate<0> E{merged, gates + gate_stride, m1, 1024, 0}; E(acc, v, wr, wc, fr, fq); }
    }
};
template <class Epi, class Sched, bool ALIGN_EPI = false, bool SP2 = false>
__device__ __forceinline__ void gemm_phase(PG8_LAS unsigned char* lds, const Gemm g, const Sched& S, const Epi& E) {
    int tid_l = threadIdx.x; asm volatile("" : "+v"(tid_l));
    const int tid = tid_l, wid = __builtin_amdgcn_readfirstlane(tid >> 6), lane = tid & 63, wr = wid >> 2, wc = wid & 3, fr = lane & 15, fq = lane >> 4;
    const int K = g.K, nt = K / BK;
    unsigned voffA[2], voffB[2];
#pragma unroll
    for (int i = 0; i < 2; ++i) { int R, C; stage_rc(tid * 16 + i * 8192, R, C); const int Rb = Epi::PERM ? ((R & ~31) + perm32(R & 31)) : R;
        voffA[i] = (unsigned)(R * K + C) * 2u; voffB[i] = (unsigned)(Rb * K + C) * 2u; }
    const size_t kstep = (size_t)(BK * 2);
    const size_t hstep = (size_t)HALF * K * 2;
    const size_t tstep = 2 * hstep;
    const unsigned ldsw = (unsigned)wid * 1024u;
    const int aoff = lds_byte(wr * 64 + fr, fq * 8), boff = lds_byte(wc * 32 + fr, fq * 8);
#define PG8_SA(b, h) (((b) * 2 + (h)) * HTB)
#define PG8_SB(b, h) ((4 + (b) * 2 + (h)) * HTB)
#define PG8_STAGE(bufoff, gbase, voff) do { _Pragma("unroll") for (int _i = 0; _i < 2; ++_i) \
        __builtin_amdgcn_global_load_lds((const unsigned*)((const char*)(gbase) + (voff)[_i]), (PG8_LAS unsigned*)(lds + (bufoff) + ldsw + _i * 8192), 16, 0, 0); } while (0)
#define PG8_LDA(dst, b, h) do { _Pragma("unroll") for (int m = 0; m < 4; ++m) _Pragma("unroll") for (int k = 0; k < 2; ++k) dst[m][k] = *(const PG8_LAS bf16x8*)(lds + PG8_SA(b, h) + aoff + m * 2048 + k * 1024); } while (0)
#define PG8_LDB(dst, b, h) do { _Pragma("unroll") for (int n = 0; n < 2; ++n) _Pragma("unroll") for (int k = 0; k < 2; ++k) dst[n][k] = *(const PG8_LAS bf16x8*)(lds + PG8_SB(b, h) + boff + n * 2048 + k * 1024); } while (0)
#define PG8_MMA(ai, bj, At, Bt) do { __builtin_amdgcn_s_setprio(1); _Pragma("unroll") for (int m = 0; m < 4; ++m) _Pragma("unroll") for (int n = 0; n < 2; ++n) _Pragma("unroll") for (int k = 0; k < 2; ++k) \
        acc[ai][bj][m][n] = __builtin_amdgcn_mfma_f32_16x16x32_bf16(Bt[n][k], At[m][k], acc[ai][bj][m][n], 0, 0, 0); __builtin_amdgcn_s_setprio(0); } while (0)
#define PG8_WAIT_V(n) asm volatile("s_waitcnt vmcnt(" #n ")" ::: "memory")
#define PG8_WAIT_L(n) asm volatile("s_waitcnt lgkmcnt(" #n ")" ::: "memory")
#define PG8_BAR __builtin_amdgcn_s_barrier()
#define PG8_SCHED __builtin_amdgcn_sched_barrier(0)
    Unit cur, nxt; int ui = 0;
    if (!S.next(0, cur)) return;
    f32x4 acc[2][2][4][2];
#pragma unroll
    for (int a = 0; a < 2; ++a)
#pragma unroll
        for (int b = 0; b < 2; ++b)
#pragma unroll
            for (int m = 0; m < 4; ++m)
#pragma unroll
                for (int n = 0; n < 2; ++n) acc[a][b][m][n] = (f32x4){0.f, 0.f, 0.f, 0.f};
    bf16x8 At[4][2], B0[2][2], B1[2][2];
    const char* cA = g.atile(cur.pm, tstep); const char* cB = (const char*)g.Bt + (size_t)cur.pn * tstep;
    S.a_ready(cur);
    if constexpr (SP2) {
        PG8_STAGE(PG8_SB(0, 0), cB, voffB); PG8_STAGE(PG8_SB(0, 1), cB + hstep, voffB); PG8_STAGE(PG8_SA(0, 0), cA, voffA); PG8_STAGE(PG8_SA(0, 1), cA + hstep, voffA);
        if (wr == 1) PG8_BAR;
        PG8_WAIT_V(2); PG8_BAR;
        PG8_STAGE(PG8_SB(1, 0), cB + kstep, voffB); PG8_STAGE(PG8_SA(1, 0), cA + kstep, voffA); PG8_STAGE(PG8_SB(1, 1), cB + hstep + kstep, voffB);
        PG8_WAIT_V(6); PG8_BAR;
    } else {
        PG8_STAGE(PG8_SB(0, 0), cB, voffB); PG8_STAGE(PG8_SA(0, 0), cA, voffA); PG8_STAGE(PG8_SB(0, 1), cB + hstep, voffB); PG8_STAGE(PG8_SA(0, 1), cA + hstep, voffA);
        if (wr == 1) PG8_BAR;
        PG8_WAIT_V(4); PG8_BAR;
        PG8_STAGE(PG8_SB(1, 0), cB + kstep, voffB); PG8_STAGE(PG8_SA(1, 0), cA + kstep, voffA); PG8_STAGE(PG8_SB(1, 1), cB + hstep + kstep, voffB);
        PG8_WAIT_V(6); PG8_BAR;
    }
    for (;;) {
        const bool has_next = S.next(ui + 1, nxt);
        const char* nA = has_next ? g.atile(nxt.pm, tstep) : cA; const char* nB = has_next ? (const char*)g.Bt + (size_t)nxt.pn * tstep : cB;
        for (int t = 0; t < nt; t += 2) {
            const bool last = (t == nt - 2);
            const char* a1 = cA + (size_t)(t + 1) * kstep;
            const char* a2 = last ? nA : cA + (size_t)(t + 2) * kstep; const char* b2 = last ? nB : cB + (size_t)(t + 2) * kstep;
            const char* a3 = a2 + kstep; const char* b3 = b2 + kstep;
            if (last && has_next) S.a_ready(nxt);
            if constexpr (SP2) {
            PG8_LDB(B0, 0, 0); PG8_LDB(B1, 0, 1); PG8_SCHED; PG8_LDA(At, 0, 0); PG8_STAGE(PG8_SA(1, 1), a1 + hstep, voffA);
            PG8_WAIT_V(8); PG8_WAIT_L(0); PG8_BAR; PG8_MMA(0, 0, At, B0); PG8_MMA(0, 1, At, B1); PG8_BAR; PG8_SCHED;
            PG8_LDA(At, 0, 1); PG8_STAGE(PG8_SB(0, 0), b2, voffB); PG8_STAGE(PG8_SB(0, 1), b2 + hstep, voffB); PG8_STAGE(PG8_SA(0, 0), a2, voffA);
            PG8_WAIT_V(8); PG8_WAIT_L(0); PG8_BAR; PG8_MMA(1, 0, At, B0); PG8_MMA(1, 1, At, B1); PG8_BAR; PG8_SCHED;
            PG8_LDB(B0, 1, 0); PG8_LDB(B1, 1, 1); PG8_SCHED; PG8_LDA(At, 1, 0); PG8_STAGE(PG8_SA(0, 1), a2 + hstep, voffA);
            PG8_WAIT_V(8); PG8_WAIT_L(0); PG8_BAR; PG8_MMA(0, 0, At, B0); PG8_MMA(0, 1, At, B1); PG8_BAR; PG8_SCHED;
            PG8_LDA(At, 1, 1); PG8_STAGE(PG8_SB(1, 0), b3, voffB); PG8_STAGE(PG8_SB(1, 1), b3 + hstep, voffB); PG8_STAGE(PG8_SA(1, 0), a3, voffA);
            PG8_WAIT_V(8); PG8_WAIT_L(0); PG8_BAR; PG8_MMA(1, 0, At, B0); PG8_MMA(1, 1, At, B1); PG8_BAR; PG8_SCHED;
            } else {
            PG8_LDB(B0, 0, 0); PG8_SCHED; PG8_LDA(At, 0, 0); PG8_STAGE(PG8_SA(1, 1), a1 + hstep, voffA);
            PG8_WAIT_L(8); PG8_BAR; PG8_WAIT_L(0); PG8_MMA(0, 0, At, B0); PG8_BAR; PG8_SCHED;
            PG8_LDB(B1, 0, 1); PG8_STAGE(PG8_SB(0, 0), b2, voffB);
            PG8_BAR; PG8_WAIT_L(0); PG8_MMA(0, 1, At, B1); PG8_BAR;
            PG8_LDA(At, 0, 1); PG8_STAGE(PG8_SA(0, 0), a2, voffA);
            PG8_BAR; PG8_WAIT_L(0); PG8_MMA(1, 0, At, B0); PG8_BAR; PG8_SCHED;
            PG8_STAGE(PG8_SB(0, 1), b2 + hstep, voffB);
            PG8_WAIT_V(6); PG8_BAR; PG8_MMA(1, 1, At, B1); PG8_BAR;
            PG8_LDB(B0, 1, 0); PG8_SCHED; PG8_LDA(At, 1, 0); PG8_STAGE(PG8_SA(0, 1), a2 + hstep, voffA);
            PG8_WAIT_L(8); PG8_BAR; PG8_WAIT_L(0); PG8_MMA(0, 0, At, B0); PG8_BAR; PG8_SCHED;
            PG8_LDB(B1, 1, 1); PG8_STAGE(PG8_SB(1, 0), b3, voffB);
            PG8_BAR; PG8_WAIT_L(0); PG8_MMA(0, 1, At, B1); PG8_BAR;
            PG8_LDA(At, 1, 1); PG8_STAGE(PG8_SA(1, 0), a3, voffA);
            PG8_BAR; PG8_WAIT_L(0); PG8_MMA(1, 0, At, B0); PG8_BAR; PG8_SCHED;
            PG8_STAGE(PG8_SB(1, 1), b3 + hstep, voffB);
            PG8_WAIT_V(6); PG8_BAR; PG8_MMA(1, 1, At, B1); PG8_BAR;
            }
        }
        if constexpr (ALIGN_EPI) { if (wr == 0) PG8_BAR; }
        if constexpr (!Epi::AFTER_DRAIN) { E(acc, cur, wr, wc, fr, fq); S.done(cur); }
        if (!has_next) break;
#pragma unroll
        for (int a = 0; a < 2; ++a)
#pragma unroll
            for (int b = 0; b < 2; ++b)
#pragma unroll
                for (int m = 0; m < 4; ++m)
#pragma unroll
                    for (int n = 0; n < 2; ++n) acc[a][b][m][n] = (f32x4){0.f, 0.f, 0.f, 0.f};
        cur = nxt; cA = nA; cB = nB; ++ui;
        if constexpr (ALIGN_EPI) { if (wr == 1) PG8_BAR; }
    }
    PG8_WAIT_V(0);
    if constexpr (!ALIGN_EPI) { if (wr == 0) PG8_BAR; }
    PG8_BAR;
    if constexpr (Epi::AFTER_DRAIN) { E.fused(acc, cur, wr, wc, fr, fq, lds, wid, lane); S.done(cur); }
#undef PG8_SA
#undef PG8_SB
#undef PG8_STAGE
#undef PG8_LDA
#undef PG8_LDB
#undef PG8_MMA
#undef PG8_WAIT_V
#undef PG8_WAIT_L
#undef PG8_BAR
#undef PG8_SCHED
}
}
typedef __bf16 bf16x2_t __attribute__((ext_vector_type(2)));
typedef float f32x2_t __attribute__((ext_vector_type(2)));
typedef short bf16x8 __attribute__((ext_vector_type(8)));
typedef float f32x16 __attribute__((ext_vector_type(16)));
#define MFMA32(a, b, c) __builtin_amdgcn_mfma_f32_32x32x16_bf16((a), (b), (c), 0, 0, 0)
__device__ __forceinline__ unsigned pkbf(float a, float b) { bf16x2_t v = __builtin_convertvector((f32x2_t){a, b}, bf16x2_t); return __builtin_bit_cast(unsigned, v); }
__device__ __forceinline__ bf16x8 pack8(const f32x16& x, int s) { v4u p; p.x = pkbf(x[8 * s], x[8 * s + 1]); p.y = pkbf(x[8 * s + 2], x[8 * s + 3]); p.z = pkbf(x[8 * s + 4], x[8 * s + 5]); p.w = pkbf(x[8 * s + 6], x[8 * s + 7]); return __builtin_bit_cast(bf16x8, p); }
__device__ __forceinline__ f32x16 zero16() { f32x16 z;
#pragma unroll
    for (int i = 0; i < 16; ++i) z[i] = 0.f; return z; }
constexpr int CHUNK = 64, NCH = SEQ / CHUNK;
constexpr float QSCALE = 0.08838834764831845f;
__device__ __forceinline__ void glds_blocks(LAS unsigned char* dst, const unsigned char* src, int nblk, int wv, int nw, int lane) {
    for (int b = wv; b < nblk; b += nw)
        __builtin_amdgcn_global_load_lds((const unsigned*)(src + (size_t)b * 1024 + lane * 16), (LAS unsigned*)(dst + b * 1024), 16, 0, 0);
}
__device__ __forceinline__ bf16x8 lds_frag(const LAS unsigned char* base, int blk, int lane) { return *(const LAS bf16x8*)(base + blk * 1024 + lane * 16); }

namespace gdn {
constexpr int B_KA = 0, B_QA = 16384, B_SC = 32768, B_KT = 34816, B_TBF = 51200, B_AF = 59392, B_TBB = 67584, B_AB = 75776, B_VT = 83968, BLOB = 100352;
constexpr int XBLK = 34, YBLK = 32;
}

__device__ __forceinline__ float row16_sum(float v) {
    v += __builtin_bit_cast(float, __builtin_amdgcn_mov_dpp(__builtin_bit_cast(int, v), 0xB1, 0xF, 0xF, true));
    v += __builtin_bit_cast(float, __builtin_amdgcn_mov_dpp(__builtin_bit_cast(int, v), 0x4E, 0xF, 0xF, true));
    v += __builtin_bit_cast(float, __builtin_amdgcn_mov_dpp(__builtin_bit_cast(int, v), 0x141, 0xF, 0xF, true));
    v += __builtin_bit_cast(float, __builtin_amdgcn_mov_dpp(__builtin_bit_cast(int, v), 0x140, 0xF, 0xF, true));
    return v;
}
__device__ __forceinline__ float quad_sum(float v) {
    v += __builtin_bit_cast(float, __builtin_amdgcn_mov_dpp(__builtin_bit_cast(int, v), 0xB1, 0xF, 0xF, true));
    v += __builtin_bit_cast(float, __builtin_amdgcn_mov_dpp(__builtin_bit_cast(int, v), 0x4E, 0xF, 0xF, true));
    return v;
}
struct GdnPrepArgs {
    const bf16 *pq, *pk, *pv;
    const float* small;
    const float* conv_w;
    const float *a_log_f, *a_log_b, *dtb_f, *dtb_b;
    unsigned char* blob;
    int nseq, pad_;
};
namespace gdn {
constexpr int L_PRE = 0, L_QN = 52224, L_KN = L_QN + 17408, L_SC = L_KN + 17408, L_LPF = L_SC + 1024, L_LPB = L_LPF + 16384, L_AF = L_LPB + 16384, L_AB = L_AF + 9216, L_TBF = L_AB + 9216, L_TBB = L_TBF + 9216, L_END = L_TBB + 9216;
static_assert(L_END <= 160 * 1024 - 256, "gdn prep LDS");
constexpr int QS_ = 272, AS_ = 144;

__device__ __forceinline__ v4u frag_rm_perm(const LAS unsigned char* img, int st, int rt, int ks, int lane) {
    const int r = lane & 31, hh = lane >> 5; const LAS unsigned char* p = img + (32 * rt + r) * st + (16 * ks + 4 * hh) * 2;
    const v2u lo = *(const LAS v2u*)p, hi = *(const LAS v2u*)(p + 16);
    return (v4u){lo.x, lo.y, hi.x, hi.y};
}
__device__ __forceinline__ v4u frag_tr_perm(const LAS unsigned char* img, int st, int rt, int ks, int lane) {
    const int r = lane & 31, hh = lane >> 5; const LAS unsigned char* p = img + (16 * ks + 4 * hh) * st + (32 * rt + r) * 2;
    unsigned short e[8];
#pragma unroll
    for (int j = 0; j < 8; ++j) e[j] = *(const LAS unsigned short*)(p + (8 * (j >> 2) + (j & 3)) * st);
    return (v4u){(unsigned)e[0] | ((unsigned)e[1] << 16), (unsigned)e[2] | ((unsigned)e[3] << 16), (unsigned)e[4] | ((unsigned)e[5] << 16), (unsigned)e[6] | ((unsigned)e[7] << 16)};
}
__device__ __forceinline__ v4u frag16_rm(const LAS unsigned char* img, int st, int rt, int ks, int lane) {
    const int r = lane & 15, q = lane >> 4; const LAS unsigned char* p = img + (16 * rt + r) * st + (32 * ks + 4 * q) * 2;
    const v2u lo = *(const LAS v2u*)p, hi = *(const LAS v2u*)(p + 32);
    return (v4u){lo.x, lo.y, hi.x, hi.y};
}
__device__ __forceinline__ v4u frag16_tr(const LAS unsigned char* img, int st, int rt, int ks, int lane) {
    const int r = lane & 15, q = lane >> 4; const LAS unsigned char* p = img + (32 * ks + 4 * q) * st + (16 * rt + r) * 2;
    unsigned short e[8];
#pragma unroll
    for (int j = 0; j < 8; ++j) e[j] = *(const LAS unsigned short*)(p + (16 * (j >> 2) + (j & 3)) * st);
    return (v4u){(unsigned)e[0] | ((unsigned)e[1] << 16), (unsigned)e[2] | ((unsigned)e[3] << 16), (unsigned)e[4] | ((unsigned)e[5] << 16), (unsigned)e[6] | ((unsigned)e[7] << 16)};
}
}

#define LBAR() do { asm volatile("s_waitcnt lgkmcnt(0)" ::: "memory"); __builtin_amdgcn_s_barrier(); asm volatile("" ::: "memory"); } while (0)
__device__ __forceinline__ void gdn_prep_issue(LAS unsigned char* lds, const GdnPrepArgs& A, int unit, int w, int lane, const unsigned char* zero_page) {
    using namespace gdn;
    const int n = unit % NCH, h = (unit / NCH) % 8, sq = unit / (NCH * 8); const size_t row0 = (size_t)sq * SEQ; const int t0 = n * CHUNK;
    for (int q4 = w; q4 < 51; q4 += 8) {
        const int seg = q4 * 4 + (lane >> 4), r = seg / 3, m = seg % 3, tl = t0 - 2 + r;
        const bf16* pmat = A.pq + (size_t)m * (size_t)(A.pk - A.pq);
        const unsigned char* src = (tl >= 0 && tl < SEQ) ? (const unsigned char*)(pmat + (row0 + tl) * 1024 + h * 128) : zero_page;
        __builtin_amdgcn_global_load_lds((const unsigned*)(src + (lane & 15) * 16), (LAS unsigned*)(lds + L_PRE + q4 * 1024), 16, 0, 0);
    }
}
__device__ __forceinline__ f32x4 gdn_prep_scal(const GdnPrepArgs& A, int unit, int lane) {
    const int n = unit % NCH, h = (unit / NCH) % 8, sq = unit / (NCH * 8);
    const float* sm = A.small + ((size_t)sq * SEQ + n * CHUNK + lane) * 64;
    return (f32x4){sm[h], sm[8 + h], sm[16 + h], sm[24 + h]};
}
__device__ __forceinline__ void gdn_prep_phase(LAS unsigned char* lds, const GdnPrepArgs& A, int bid, int G, const unsigned char* zero_page) {
    using namespace gdn;
    int tid_l = threadIdx.x; asm volatile("" : "+v"(tid_l));
    const int tid = tid_l, lane = tid & 63, w = __builtin_amdgcn_readfirstlane(tid >> 6);
    const int nunits = A.nseq * 8 * NCH; const int pflg = A.pad_;
    int unit = bid;
    f32x4 smn = (f32x4){0.f, 0.f, 0.f, 0.f};
    if (unit < nunits) { gdn_prep_issue(lds, A, unit, w, lane, zero_page); if (w == 0) smn = gdn_prep_scal(A, unit, lane); }
  for (; unit < nunits; unit += G) {
    const int h = (unit / NCH) % 8;
    unsigned char* blob = A.blob + (size_t)unit * BLOB;
    if (w == 0) {
        const float xf = smn.x + A.dtb_f[h], xb = smn.y + A.dtb_b[h];
        const float spf = xf > 20.f ? xf : log1pf(__expf(xf)), spb = xb > 20.f ? xb : log1pf(__expf(xb));
        const float gf = -__expf(A.a_log_f[h]) * spf, gb = -__expf(A.a_log_b[h]) * spb;
        float pf = gf, pb = gb;
#pragma unroll
        for (int o = 1; o < 64; o <<= 1) { const float yf = __shfl_up(pf, o), yb = __shfl_up(pb, o); if (lane >= o) { pf += yf; pb += yb; } }
        const float totb = __shfl(pb, 63);
        const float gcf = pf, gcb = totb - pb + gb;
        LAS float* sc = (LAS float*)(lds + L_SC);
        sc[lane] = gcf; sc[64 + lane] = gcb; sc[128 + lane] = sigmoidf_(smn.z); sc[192 + lane] = sigmoidf_(smn.w);
        float* gsc = (float*)(blob + B_SC); if (pflg & 8) gsc = (float*)(lds + L_LPF);
        const float glf = __shfl(pf, 63), glb = totb;
        gsc[lane] = gcf; gsc[64 + lane] = gcb; gsc[128 + lane] = __expf(gcf); gsc[192 + lane] = __expf(gcb); gsc[256 + lane] = __expf(glf - gcf); gsc[320 + lane] = __expf(glb - gcb);
        if (lane < 2) gsc[384 + lane] = __expf(lane ? glb : glf);
    }
    __syncthreads();
    if (!(pflg & 32)) {
        const int p0 = 8 * w;
#pragma unroll
        for (int m = 0; m < 3; ++m) {
            float wc[5][2];
#pragma unroll
            for (int tau = 0; tau < 5; ++tau) { const f32x2_t t2 = *(const f32x2_t*)(A.conv_w + tau * 3072 + m * 1024 + h * 128 + 2 * lane); wc[tau][0] = t2.x; wc[tau][1] = t2.y; }
            float in[12][2];
#pragma unroll
            for (int i = 0; i < 12; ++i) { const unsigned u = *(const LAS unsigned*)(lds + L_PRE + ((p0 + i) * 3 + m) * 256 + lane * 4); in[i][0] = bflo(u); in[i][1] = bfhi(u); }
            float y[8][2];
#pragma unroll
            for (int pp = 0; pp < 8; ++pp)
#pragma unroll
                for (int c = 0; c < 2; ++c) { float s = 0.f;
#pragma unroll
                    for (int tau = 0; tau < 5; ++tau) s += wc[tau][c] * in[pp + tau][c];
                    y[pp][c] = s * __builtin_amdgcn_rcpf(1.0f + __builtin_amdgcn_exp2f(-1.4426950408889634f * s)); }
            if (m < 2) {
#pragma unroll
                for (int pp = 0; pp < 8; ++pp) { float ss = row16_sum(y[pp][0] * y[pp][0] + y[pp][1] * y[pp][1]); ss += __shfl_xor(ss, 16); ss += __shfl_xor(ss, 32); const float rn = __builtin_amdgcn_rsqf(ss + EPS);
                    *(LAS unsigned*)(lds + (m == 0 ? L_QN : L_KN) + (p0 + pp) * QS_ + lane * 4) = pkbf(y[pp][0] * rn, y[pp][1] * rn); }
            } else {
#pragma unroll
                for (int c = 0; c < 2; ++c) { v4u o; o.x = pkbf(y[0][c], y[1][c]); o.y = pkbf(y[2][c], y[3][c]); o.z = pkbf(y[4][c], y[5][c]); o.w = pkbf(y[6][c], y[7][c]);
                    if (!(pflg & 8)) *(v4u*)(blob + B_VT + (2 * lane + c) * 128 + p0 * 2) = o; }
            }
        }
    }
    __syncthreads();
    { const int un = unit + G; if (un < nunits) { gdn_prep_issue(lds, A, un, w, lane, zero_page); if (w == 0) smn = gdn_prep_scal(A, un, lane); } }
    {
        const int which = w >> 2, rt = (w >> 1) & 1, ct = w & 1, r = lane & 31, hh = lane >> 5;
        const LAS unsigned char* ia = lds + (which ? L_QN : L_KN) + (32 * rt + r) * QS_ + 16 * hh;
        const LAS unsigned char* ib = lds + L_KN + (32 * ct + r) * QS_ + 16 * hh;
        f32x16 acc = zero16();
#pragma unroll
        for (int ks = 0; ks < 8; ++ks) acc = MFMA32(*(const LAS bf16x8*)(ia + 32 * ks), *(const LAS bf16x8*)(ib + 32 * ks), acc);
        const LAS float* sc = (const LAS float*)(lds + L_SC);
        const int j = 32 * ct + r; const float gfj = sc[j], gbj = sc[64 + j];
#pragma unroll
        for (int reg = 0; reg < 16; ++reg) {
            const int i = 32 * rt + (reg & 3) + 8 * (reg >> 2) + 4 * hh; const float val = acc[reg];
            const float ef = __expf(sc[i] - gfj), eb = __expf(sc[64 + i] - gbj);
            if (which == 0) {
                const float lf = (i > j) ? sc[128 + i] * val * ef : 0.f, lb = (i < j) ? sc[192 + i] * val * eb : 0.f;
                ((LAS float*)(lds + L_LPF))[i * 64 + (j & 3) * 16 + (j >> 2)] = lf;
                const int i2 = 63 - i, j2 = 63 - j;
                ((LAS float*)(lds + L_LPB))[i2 * 64 + (j2 & 3) * 16 + (j2 >> 2)] = lb;
            } else {
                const float af = (i >= j) ? QSCALE * val * ef : 0.f, ab = (i <= j) ? QSCALE * val * eb : 0.f;
                *(LAS unsigned short*)(lds + L_AF + i * AS_ + j * 2) = (unsigned short)(pkbf(af, 0.f) & 0xffffu);
                *(LAS unsigned short*)(lds + L_AB + i * AS_ + j * 2) = (unsigned short)(pkbf(ab, 0.f) & 0xffffu);
            }
        }
    }
    LBAR();
    if (!(pflg & 16)) {
        const int dir = w >> 2, li = (w & 3) * 64 + lane, j = li >> 2, q = li & 3;
        const LAS float* LP = (const LAS float*)(lds + (dir ? L_LPB : L_LPF)) + q * 16;
        float t[16];
#pragma unroll
        for (int a = 0; a < 16; ++a) t[a] = 0.f;
#pragma unroll
        for (int i = 0; i < 64; ++i) {
            float p = 0.f;
#pragma unroll
            for (int a4 = 0; a4 < (i + 15) / 16; ++a4) { const f32x4 lv = *(const LAS f32x4*)(LP + i * 64 + 4 * a4);
                p += lv.x * t[4 * a4] + lv.y * t[4 * a4 + 1] + lv.z * t[4 * a4 + 2] + lv.w * t[4 * a4 + 3]; }
            p = quad_sum(p);
            const float ti = (i == j ? 1.f : 0.f) - p;
            if (q == (i & 3)) t[i >> 2] = ti;
        }
        const LAS float* sc = (const LAS float*)(lds + L_SC);
        if (dir == 0) { const float bj = sc[128 + j];
#pragma unroll
            for (int a = 0; a < 16; ++a) *(LAS unsigned short*)(lds + L_TBF + (4 * a + q) * AS_ + j * 2) = (unsigned short)(pkbf(t[a] * bj, 0.f) & 0xffffu);
        } else { const int jo = 63 - j; const float bj = sc[192 + jo];
#pragma unroll
            for (int a = 0; a < 16; ++a) *(LAS unsigned short*)(lds + L_TBB + (63 - (4 * a + q)) * AS_ + jo * 2) = (unsigned short)(pkbf(t[a] * bj, 0.f) & 0xffffu);
        }
    }
    LBAR();
    if (!(pflg & 64)) for (int blk = w; blk < 80; blk += 8) {
        v4u f; int off;
        if (blk < 16)      { f = frag16_rm(lds + L_KN, QS_, blk >> 2, blk & 3, lane); off = B_KA + blk * 1024; }
        else if (blk < 32) { const int b = blk - 16; f = frag16_rm(lds + L_QN, QS_, b >> 2, b & 3, lane); off = B_QA + b * 1024; }
        else if (blk < 48) { const int b = blk - 32; f = frag16_tr(lds + L_KN, QS_, b >> 1, b & 1, lane); off = B_KT + b * 1024; }
        else { const int b = blk - 48, wh = b >> 3, bb = b & 7; const int lo = wh == 0 ? L_TBF : wh == 1 ? L_AF : wh == 2 ? L_TBB : L_AB;
               f = frag16_rm(lds + lo, AS_, bb >> 1, bb & 1, lane); off = B_TBF + b * 1024; }
        if (!(pflg & 8)) *(v4u*)(blob + off + lane * 16) = f; else asm volatile("" :: "v"(f));
    }
    LBAR();
  }
}
struct GdnChainArgs {
    const unsigned char* blob;
    unsigned char* stg;
    unsigned* flag;
    int nseq, flags;
};
namespace gdn { constexpr int C_Y = XBLK * 1024, C_BUF = C_Y + YBLK * 1024, C_END = 2 * C_BUF; }
#define CHAIN_SPIN_CAP (1u << 22)
#define MFMA16(a, b, c) __builtin_amdgcn_mfma_f32_16x16x32_bf16((a), (b), (c), 0, 0, 0)
__device__ __forceinline__ bf16x8 pack16(const f32x4& a, const f32x4& b) { v4u p; p.x = pkbf(a.x, a.y); p.y = pkbf(a.z, a.w); p.z = pkbf(b.x, b.y); p.w = pkbf(b.z, b.w); return __builtin_bit_cast(bf16x8, p); }

__device__ __forceinline__ void gdn_chain_unit(LAS unsigned char* lds, const GdnChainArgs& A, int item) {
    using namespace gdn;
    int tid_l = threadIdx.x; asm volatile("" : "+v"(tid_l));
    const int tid = tid_l, lane = tid & 63, w = __builtin_amdgcn_readfirstlane(tid >> 6);
    const int r = lane & 15, q = lane >> 4;
    const int c = item & 1, h = (item >> 1) & 7, sq = item >> 4; const int flags = A.flags;
    const size_t unit0 = (size_t)(sq * 8 + h) * NCH;
    const f32x4 z4 = (f32x4){0.f, 0.f, 0.f, 0.f};
    f32x4 S[8];
#pragma unroll
    for (int t = 0; t < 8; ++t) S[t] = z4;
    v2u vnext[4];
    unsigned long long pwn[4]; bool have = false; unsigned fnext = 0u;
#define GDN_ISSUE(s_, buf_) do { const int n_ = c ? NCH - 1 - (s_) : (s_); const unsigned char* bl_ = A.blob + (unit0 + n_) * BLOB; LAS unsigned char* d_ = lds + (buf_) * C_BUF; \
        { const unsigned char* vp_ = bl_ + B_VT + (16 * w + r) * 128 + 8 * q; _Pragma("unroll") for (int i = 0; i < 4; ++i) vnext[i] = *(const v2u*)(vp_ + 32 * i); } \
        if (!(flags & 4)) { glds_blocks(d_, bl_, XBLK, w, 8, lane); \
            if (c == 0) glds_blocks(d_ + C_Y, bl_ + B_KT, YBLK, w, 8, lane); \
            else { glds_blocks(d_ + C_Y, bl_ + B_KT, 16, w, 8, lane); glds_blocks(d_ + C_Y + 16384, bl_ + B_TBB, 16, w, 8, lane); } } } while (0)
    GDN_ISSUE(0, 0);
    __syncthreads();
    for (int s = 0; s < NCH; ++s) {
        const int n = c ? NCH - 1 - s : s;
        v2u vcur[4];
#pragma unroll
        for (int i = 0; i < 4; ++i) vcur[i] = vnext[i];
        unsigned long long* sp = (unsigned long long*)(A.stg + (unit0 + n) * 16384 + w * 2048) + lane;
        unsigned* fl = A.flag + (unit0 + n) * 8 + w;
        unsigned long long pw[4];
        if (s >= NCH / 2 && !(flags & 1)) {
            if (have) {
#pragma unroll
                for (int i = 0; i < 4; ++i) pw[i] = pwn[i];
            } else {
                for (unsigned sp_ = 0; __builtin_amdgcn_readfirstlane((int)__hip_atomic_load(fl, __ATOMIC_RELAXED, __HIP_MEMORY_SCOPE_AGENT)) == 0 && sp_ < CHAIN_SPIN_CAP; ++sp_) __builtin_amdgcn_s_sleep(2);
#pragma unroll
                for (int i = 0; i < 4; ++i) pw[i] = __hip_atomic_load(sp + i * 64, __ATOMIC_RELAXED, __HIP_MEMORY_SCOPE_AGENT);
            }
        }
        have = false;
        if (s + 1 >= NCH / 2 && s + 1 < NCH && !(flags & 1) && __builtin_amdgcn_readfirstlane((int)fnext) != 0) {
            const int n1 = c ? NCH - 2 - s : s + 1; const unsigned long long* sp1 = (const unsigned long long*)(A.stg + (unit0 + n1) * 16384 + w * 2048) + lane;
#pragma unroll
            for (int i = 0; i < 4; ++i) pwn[i] = __hip_atomic_load(sp1 + i * 64, __ATOMIC_RELAXED, __HIP_MEMORY_SCOPE_AGENT);
            have = true;
        }
        if (s + 2 >= NCH / 2 && s + 2 < NCH && !(flags & 1)) { const int n2 = c ? NCH - 3 - s : s + 2; fnext = __hip_atomic_load(A.flag + (unit0 + n2) * 8 + w, __ATOMIC_RELAXED, __HIP_MEMORY_SCOPE_AGENT); }
        if (s + 1 < NCH) GDN_ISSUE(s + 1, (s + 1) & 1);
        const LAS unsigned char* X = lds + (s & 1) * C_BUF; const LAS unsigned char* Y = X + C_Y; const LAS unsigned char* YT = Y + 16384;
        const LAS float* sc = (const LAS float*)(X + B_SC);
        bf16x8 sb[4];
#pragma unroll
        for (int k = 0; k < 4; ++k) sb[k] = pack16(S[2 * k], S[2 * k + 1]);
        f32x4 KS[4], QS[4];
#pragma unroll
        for (int rt = 0; rt < 4; ++rt) { KS[rt] = z4; QS[rt] = z4; }
        {
            constexpr int R = 8; bf16x8 ring[R];
#define G1_LD(i_) lds_frag(X + (((i_) & 1) ? B_QA : B_KA), ((i_) >> 3) * 4 + (((i_) >> 1) & 3), lane)
#pragma unroll
            for (int i = 0; i < R; ++i) ring[i] = G1_LD(i);
#pragma unroll
            for (int i = 0; i < 32; ++i) { const int rt = i >> 3, ks = (i >> 1) & 3;
                if (i & 1) QS[rt] = MFMA16(ring[i % R], sb[ks], QS[rt]); else KS[rt] = MFMA16(ring[i % R], sb[ks], KS[rt]);
                if (i + R < 32) ring[i % R] = G1_LD(i + R);
                __builtin_amdgcn_sched_barrier(0); }
#undef G1_LD
        }
#pragma unroll
        for (int rt = 0; rt < 4; ++rt) { const v2u vv = vcur[rt]; const f32x4 ev = *(const LAS f32x4*)(sc + 128 + c * 64 + 16 * rt + 4 * q);
            KS[rt].x = bflo(vv.x) - ev.x * KS[rt].x; KS[rt].y = bfhi(vv.x) - ev.y * KS[rt].y; KS[rt].z = bflo(vv.y) - ev.z * KS[rt].z; KS[rt].w = bfhi(vv.y) - ev.w * KS[rt].w; }
        bf16x8 rb[2] = {pack16(KS[0], KS[1]), pack16(KS[2], KS[3])};
        f32x4 vn[4];
#pragma unroll
        for (int rt = 0; rt < 4; ++rt) vn[rt] = z4;
        {   constexpr int R = 8; bf16x8 ring[R];
#pragma unroll
            for (int i = 0; i < R; ++i) ring[i] = lds_frag(YT, i, lane);
#pragma unroll
            for (int i = 0; i < 8; ++i) { vn[i >> 1] = MFMA16(ring[i], rb[i & 1], vn[i >> 1]); __builtin_amdgcn_sched_barrier(0); }
        }
        bf16x8 vb[2] = {pack16(vn[0], vn[1]), pack16(vn[2], vn[3])};
        f32x4 (&o)[4] = QS;
#pragma unroll
        for (int rt = 0; rt < 4; ++rt) { const f32x4 ev = *(const LAS f32x4*)(sc + 128 + c * 64 + 16 * rt + 4 * q);
            o[rt].x *= QSCALE * ev.x; o[rt].y *= QSCALE * ev.y; o[rt].z *= QSCALE * ev.z; o[rt].w *= QSCALE * ev.w; }
        {   constexpr int R = 8; bf16x8 ring[R];
#pragma unroll
            for (int i = 0; i < R; ++i) ring[i] = lds_frag(YT + 8192, i, lane);
#pragma unroll
            for (int i = 0; i < 8; ++i) { o[i >> 1] = MFMA16(ring[i], vb[i & 1], o[i >> 1]); __builtin_amdgcn_sched_barrier(0); }
        }
        if (!(flags & 1)) {
            if (s < NCH / 2) {
#pragma unroll
                for (int rt = 0; rt < 4; ++rt) __hip_atomic_store(sp + rt * 64, (unsigned long long)pkbf(o[rt].x, o[rt].y) | ((unsigned long long)pkbf(o[rt].z, o[rt].w) << 32), __ATOMIC_RELAXED, __HIP_MEMORY_SCOPE_AGENT);
            } else {
#pragma unroll
                for (int rt = 0; rt < 4; ++rt) { const unsigned plo = (unsigned)pw[rt], phi = (unsigned)(pw[rt] >> 32);
                    __hip_atomic_store(sp + rt * 64, (unsigned long long)pkbf(o[rt].x + bflo(plo), o[rt].y + bfhi(plo)) | ((unsigned long long)pkbf(o[rt].z + bflo(phi), o[rt].w + bfhi(phi)) << 32), __ATOMIC_RELAXED, __HIP_MEMORY_SCOPE_AGENT); }
            }
        }
#pragma unroll
        for (int rt = 0; rt < 4; ++rt) { const f32x4 ev = *(const LAS f32x4*)(sc + 256 + c * 64 + 16 * rt + 4 * q);
            vn[rt].x *= ev.x; vn[rt].y *= ev.y; vn[rt].z *= ev.z; vn[rt].w *= ev.w; }
        vb[0] = pack16(vn[0], vn[1]); vb[1] = pack16(vn[2], vn[3]);
        const float egl = sc[384 + c];
#pragma unroll
        for (int t = 0; t < 8; ++t) { S[t].x *= egl; S[t].y *= egl; S[t].z *= egl; S[t].w *= egl; }
        {   constexpr int R = 8; bf16x8 ring[R];
#pragma unroll
            for (int i = 0; i < R; ++i) ring[i] = lds_frag(Y, i, lane);
#pragma unroll
            for (int i = 0; i < 16; ++i) { S[i >> 1] = MFMA16(ring[i % R], vb[i & 1], S[i >> 1]); if (i + R < 16) ring[i % R] = lds_frag(Y, i + R, lane); __builtin_amdgcn_sched_barrier(0); }
        }
        if (!(flags & 1)) { asm volatile("s_waitcnt vmcnt(0)" ::: "memory"); if (lane == 0) __hip_atomic_store(fl, s < NCH / 2 ? 1u : 2u, __ATOMIC_RELAXED, __HIP_MEMORY_SCOPE_AGENT); }
        __syncthreads();
    }
#undef GDN_ISSUE
}
namespace gla {
constexpr int B_QGF = 0, B_QGB = 16384, B_SC = 32768, B_KDTF = 33792, B_KDTB = 50176, BLOBA = 66560;
constexpr int B_VB = 0, B_INTRA = 32768, BLOBB = 65536;
constexpr int L_R = 0, L_QGF = 8192, L_KGF = L_QGF + 17408, L_KDF = L_KGF + 17408, L_QGB = L_KDF + 17408, L_KGB = L_QGB + 17408, L_KDB = L_KGB + 17408, L_V = L_KDB + 17408, L_TOT = L_V + 33792, L_AS = L_TOT + 4096, L_END = L_AS + 9216;
static_assert(L_END <= 160 * 1024 - 256, "gla prep LDS");
constexpr int QS_ = 272, VS_ = 528, AS_ = 144;
constexpr int C_X = 0, C_Y = 17408, C_CHAIN = 66560, C_EG = 2 * C_CHAIN, C_END = C_EG + 1024;
__device__ __forceinline__ v4u frag_tr_nat(const LAS unsigned char* img, int st, int colbase, int ks, int lane) {
    const int r = lane & 31, hh = lane >> 5; const LAS unsigned char* p = img + (16 * ks + 8 * hh) * st + (colbase + r) * 2;
    unsigned short e[8];
#pragma unroll
    for (int j = 0; j < 8; ++j) e[j] = *(const LAS unsigned short*)(p + j * st);
    return (v4u){(unsigned)e[0] | ((unsigned)e[1] << 16), (unsigned)e[2] | ((unsigned)e[3] << 16), (unsigned)e[4] | ((unsigned)e[5] << 16), (unsigned)e[6] | ((unsigned)e[7] << 16)};
}
__device__ __forceinline__ float logsig2(float x) { const float xc = fminf(fmaxf(x, -60.f), 60.f); return -__builtin_amdgcn_logf(1.0f + __builtin_amdgcn_exp2f(-1.4426950408889634f * xc)); }
}

struct GlaPrepArgs {
    const bf16* qk;
    const bf16* vb;
    const float* small;
    const float *w2f, *b2f, *w2b, *b2b;
    unsigned char* blobA;
    unsigned char* blobB;
    int nseq, pad_;
};

__device__ __forceinline__ void gla_prep_phase(LAS unsigned char* lds, const GlaPrepArgs& A, int bid, int G) {
    using namespace gla;
    int tid_l = threadIdx.x; asm volatile("" : "+v"(tid_l));
    const int tid = tid_l, lane = tid & 63, w = __builtin_amdgcn_readfirstlane(tid >> 6);
    const int nunits = A.nseq * 4 * NCH;
    f32x4 pr; v4u pv[4], pq[2], pk[2];
#define GLA_PREFETCH(u_) do { const int n_ = (u_) % NCH, h_ = ((u_) / NCH) % 4, sq_ = (u_) / (NCH * 4); const size_t r_ = (size_t)sq_ * SEQ + n_ * CHUNK; \
        pr = *(const f32x4*)(A.small + (r_ + (tid >> 3)) * 64 + 32 + (tid & 7) * 4); \
        _Pragma("unroll") for (int i = 0; i < 4; ++i) { const int id = i * 512 + tid; pv[i] = *(const v4u*)(A.vb + (r_ + (id >> 5)) * 1024 + h_ * 256 + (id & 31) * 8); } \
        _Pragma("unroll") for (int i = 0; i < 2; ++i) { const int id = i * 512 + tid; const bf16* qp_ = A.qk + (r_ + (id >> 4)) * 1024 + h_ * 128 + (id & 15) * 8; pq[i] = *(const v4u*)qp_; pk[i] = *(const v4u*)(qp_ + 512); } } while (0)
    int unit = bid;
    if (unit < nunits) GLA_PREFETCH(unit);
  for (; unit < nunits; unit += G) {
    const int h = (unit / NCH) % 4;
    unsigned char* blob = A.blobA + (size_t)unit * BLOBA; unsigned char* blobB = A.blobB + (size_t)unit * BLOBB;
    *(LAS f32x4*)(lds + L_R + (tid >> 3) * 128 + (tid & 7) * 16) = pr;
#pragma unroll
    for (int i = 0; i < 4; ++i) { const int id = i * 512 + tid; *(LAS v4u*)(lds + L_V + (id >> 5) * VS_ + (id & 31) * 16) = pv[i]; }
#pragma unroll
    for (int i = 0; i < 2; ++i) { const int id = i * 512 + tid; *(LAS v4u*)(lds + L_QGF + (id >> 4) * QS_ + (id & 15) * 16) = pq[i]; *(LAS v4u*)(lds + L_KGF + (id >> 4) * QS_ + (id & 15) * 16) = pk[i]; }
    LBAR();
    {
        const int dd = tid & 127, pg = tid >> 7, d = h * 128 + dd;
        float wf[16], wb[16];
#pragma unroll
        for (int i = 0; i < 16; ++i) { wf[i] = A.w2f[i * 512 + d]; wb[i] = A.w2b[i * 512 + d]; }
        const float bf_ = A.b2f[d], bb_ = A.b2b[d];
        float lf[16], lb[16];
#pragma unroll
        for (int pp = 0; pp < 16; ++pp) {
            const LAS float* rr = (const LAS float*)(lds + L_R) + (pg * 16 + pp) * 32;
            float xf = bf_, xb = bb_;
#pragma unroll
            for (int i4 = 0; i4 < 4; ++i4) { const f32x4 a = *(const LAS f32x4*)(rr + 4 * i4), b = *(const LAS f32x4*)(rr + 16 + 4 * i4);
                xf += a.x * wf[4 * i4] + a.y * wf[4 * i4 + 1] + a.z * wf[4 * i4 + 2] + a.w * wf[4 * i4 + 3];
                xb += b.x * wb[4 * i4] + b.y * wb[4 * i4 + 1] + b.z * wb[4 * i4 + 2] + b.w * wb[4 * i4 + 3]; }
            lf[pp] = logsig2(xf) * (1.f / 16.f); lb[pp] = logsig2(xb) * (1.f / 16.f);
        }
#pragma unroll
        for (int pp = 1; pp < 16; ++pp) lf[pp] += lf[pp - 1];
#pragma unroll
        for (int pp = 14; pp >= 0; --pp) lb[pp] += lb[pp + 1];
        LAS float* tot = (LAS float*)(lds + L_TOT);
        tot[pg * 128 + dd] = lf[15]; tot[512 + pg * 128 + dd] = lb[0];
        LBAR();
        float offf = 0.f, offb = 0.f, glf = 0.f, glb = 0.f;
#pragma unroll
        for (int g = 0; g < 4; ++g) { const float tf = tot[g * 128 + dd], tb = tot[512 + g * 128 + dd]; glf += tf; glb += tb; if (g < pg) offf += tf; if (g > pg) offb += tb; }
        const float eglf = __builtin_amdgcn_exp2f(glf), eglb = __builtin_amdgcn_exp2f(glb);
        if (pg == 0) { float* sc = (float*)(blob + B_SC); sc[dd] = eglf; sc[128 + dd] = eglb; }
#pragma unroll
        for (int pp = 0; pp < 16; ++pp) {
            const int o = (pg * 16 + pp) * QS_ + dd * 2;
            const float qv = bf2f(*(const LAS unsigned short*)(lds + L_QGF + o)) * QSCALE, kv = bf2f(*(const LAS unsigned short*)(lds + L_KGF + o));
            const float ef = __builtin_amdgcn_exp2f(lf[pp] + offf), eb = __builtin_amdgcn_exp2f(lb[pp] + offb);
            const float rf = __builtin_amdgcn_rcpf(ef), rb = __builtin_amdgcn_rcpf(eb);
            *(LAS unsigned short*)(lds + L_QGF + o) = (unsigned short)(pkbf(qv * ef, 0.f) & 0xffffu);
            *(LAS unsigned short*)(lds + L_KGF + o) = (unsigned short)(pkbf(kv * rf, 0.f) & 0xffffu);
            *(LAS unsigned short*)(lds + L_KDF + o) = (unsigned short)(pkbf(kv * rf * eglf, 0.f) & 0xffffu);
            *(LAS unsigned short*)(lds + L_QGB + o) = (unsigned short)(pkbf(qv * eb, 0.f) & 0xffffu);
            *(LAS unsigned short*)(lds + L_KGB + o) = (unsigned short)(pkbf(kv * rb, 0.f) & 0xffffu);
            *(LAS unsigned short*)(lds + L_KDB + o) = (unsigned short)(pkbf(kv * rb * eglb, 0.f) & 0xffffu);
        }
    }
    LBAR();
    { const int un = unit + G; if (un < nunits) GLA_PREFETCH(un); }
    if (w < 4) {
        const int rt = w >> 1, ct = w & 1, r = lane & 31, hh = lane >> 5;
        f32x16 af = zero16(), ab = zero16();
        if (rt >= ct) { const LAS unsigned char* ia = lds + L_QGF + (32 * rt + r) * QS_ + 16 * hh; const LAS unsigned char* ib = lds + L_KGF + (32 * ct + r) * QS_ + 16 * hh;
#pragma unroll
            for (int ks = 0; ks < 8; ++ks) af = MFMA32(*(const LAS bf16x8*)(ia + 32 * ks), *(const LAS bf16x8*)(ib + 32 * ks), af); }
        if (rt <= ct) { const LAS unsigned char* ia = lds + L_QGB + (32 * rt + r) * QS_ + 16 * hh; const LAS unsigned char* ib = lds + L_KGB + (32 * ct + r) * QS_ + 16 * hh;
#pragma unroll
            for (int ks = 0; ks < 8; ++ks) ab = MFMA32(*(const LAS bf16x8*)(ia + 32 * ks), *(const LAS bf16x8*)(ib + 32 * ks), ab); }
        const int j = 32 * ct + r;
#pragma unroll
        for (int reg = 0; reg < 16; ++reg) { const int i = 32 * rt + (reg & 3) + 8 * (reg >> 2) + 4 * hh;
            const float val = (i >= j ? af[reg] : 0.f) + (i <= j ? ab[reg] : 0.f);
            *(LAS unsigned short*)(lds + L_AS + i * AS_ + j * 2) = (unsigned short)(pkbf(val, 0.f) & 0xffffu); }
    } else {
        for (int blk = w - 4; blk < 64; blk += 4) {
            const int wh = blk >> 4, b = blk & 15; v4u f; int off;
            if (wh == 0)      { f = gdn::frag_rm_perm(lds + L_QGF, QS_, b >> 3, b & 7, lane); off = B_QGF; }
            else if (wh == 1) { f = gdn::frag_rm_perm(lds + L_QGB, QS_, b >> 3, b & 7, lane); off = B_QGB; }
            else if (wh == 2) { f = frag_tr_nat(lds + L_KDF, QS_, 32 * (b >> 2), b & 3, lane); off = B_KDTF; }
            else              { f = frag_tr_nat(lds + L_KDB, QS_, 32 * (b >> 2), b & 3, lane); off = B_KDTB; }
            *(v4u*)(blob + off + b * 1024 + lane * 16) = f;
        }
    }
    LBAR();
    {
        const int ct = w, r = lane & 31, hh = lane >> 5;
        f32x16 o[2] = {zero16(), zero16()};
#pragma unroll
        for (int ks = 0; ks < 4; ++ks) {
            const v4u fb = frag_tr_nat(lds + L_V, VS_, 32 * ct, ks, lane);
            *(v4u*)(blobB + B_VB + (ct * 4 + ks) * 1024 + lane * 16) = fb;
            const bf16x8 bfr = __builtin_bit_cast(bf16x8, fb);
#pragma unroll
            for (int rt = 0; rt < 2; ++rt) o[rt] = MFMA32(*(const LAS bf16x8*)(lds + L_AS + (32 * rt + r) * AS_ + (16 * ks + 8 * hh) * 2), bfr, o[rt]);
        }
        unsigned long long* ip = (unsigned long long*)(blobB + B_INTRA) + (size_t)ct * 512 + lane;
#pragma unroll
        for (int rt = 0; rt < 2; ++rt)
#pragma unroll
            for (int g = 0; g < 4; ++g) ip[(rt * 4 + g) * 64] = (unsigned long long)pkbf(o[rt][4 * g], o[rt][4 * g + 1]) | ((unsigned long long)pkbf(o[rt][4 * g + 2], o[rt][4 * g + 3]) << 32);
    }
    LBAR();
  }
#undef GLA_PREFETCH
}

struct GlaChainArgs {
    const unsigned char* blobA;
    const unsigned char* blobB;
    unsigned char* stg;
    unsigned* flag;
    int nseq, flags;
};
namespace gla { constexpr int CB_Y = 17408, CB_BUF = 66560, CB_END = 2 * CB_BUF; }
__device__ __forceinline__ void gla_chain_unit(LAS unsigned char* lds, const GlaChainArgs& A, int item) {
    using namespace gla;
    int tid_l = threadIdx.x; asm volatile("" : "+v"(tid_l));
    const int tid = tid_l, lane = tid & 63, w = __builtin_amdgcn_readfirstlane(tid >> 6);
    const int hh = lane >> 5;
    const int c = item & 1, h = (item >> 1) & 3, sq = item >> 3; const int flags = A.flags;
    const size_t unit0 = (size_t)(sq * 4 + h) * NCH;
    f32x16 S[4];
#pragma unroll
    for (int t = 0; t < 4; ++t) S[t] = zero16();
    unsigned long long pwn[8]; bool have = false; unsigned fnext = 0u;
#define GLA_ISSUE(s_, buf_) do { if (!(flags & 4)) { const int n_ = c ? NCH - 1 - (s_) : (s_); const unsigned char* bl_ = A.blobA + (unit0 + n_) * BLOBA; const unsigned char* bb_ = A.blobB + (unit0 + n_) * BLOBB; \
        LAS unsigned char* d_ = lds + (buf_) * CB_BUF; glds_blocks(d_, bl_ + (c ? B_QGB : B_QGF), 16, w, 8, lane); if (w == 7) glds_blocks(d_ + 16384, bl_ + B_SC, 1, 0, 1, lane); \
        glds_blocks(d_ + CB_Y, bl_ + (c ? B_KDTB : B_KDTF), 16, w, 8, lane); glds_blocks(d_ + CB_Y + 16384, bb_ + B_VB, 32, w, 8, lane); } } while (0)
    GLA_ISSUE(0, 0);
    __syncthreads();
    for (int s = 0; s < NCH; ++s) {
        const int n = c ? NCH - 1 - s : s;
        unsigned long long* sp = (unsigned long long*)(A.stg + (unit0 + n) * 32768) + (size_t)w * 512 + lane;
        unsigned* fl = A.flag + (unit0 + n) * 8 + w;
        unsigned long long pw[8];
        if (s >= NCH / 2 && !(flags & 1)) {
            if (have) {
#pragma unroll
                for (int i = 0; i < 8; ++i) pw[i] = pwn[i];
            } else {
                for (unsigned sp_ = 0; __builtin_amdgcn_readfirstlane((int)__hip_atomic_load(fl, __ATOMIC_RELAXED, __HIP_MEMORY_SCOPE_AGENT)) == 0 && sp_ < CHAIN_SPIN_CAP; ++sp_) __builtin_amdgcn_s_sleep(2);
#pragma unroll
                for (int i = 0; i < 8; ++i) pw[i] = __hip_atomic_load(sp + i * 64, __ATOMIC_RELAXED, __HIP_MEMORY_SCOPE_AGENT);
            }
        }
        have = false;
        if (s + 1 >= NCH / 2 && s + 1 < NCH && !(flags & 1) && __builtin_amdgcn_readfirstlane((int)fnext) != 0) {
            const int n1 = c ? NCH - 2 - s : s + 1; const unsigned long long* sp1 = (const unsigned long long*)(A.stg + (unit0 + n1) * 32768) + (size_t)w * 512 + lane;
#pragma unroll
            for (int i = 0; i < 8; ++i) pwn[i] = __hip_atomic_load(sp1 + i * 64, __ATOMIC_RELAXED, __HIP_MEMORY_SCOPE_AGENT);
            have = true;
        }
        if (s + 2 >= NCH / 2 && s + 2 < NCH && !(flags & 1)) { const int n2 = c ? NCH - 3 - s : s + 2; fnext = __hip_atomic_load(A.flag + (unit0 + n2) * 8 + w, __ATOMIC_RELAXED, __HIP_MEMORY_SCOPE_AGENT); }
        if (s + 1 < NCH) GLA_ISSUE(s + 1, (s + 1) & 1);
        const LAS unsigned char* X = lds + (s & 1) * CB_BUF; const LAS unsigned char* Y = X + CB_Y;
        const LAS float* EG = (const LAS float*)(X + 16384) + c * 128;
        bf16x8 sb[8];
#pragma unroll
        for (int t = 0; t < 4; ++t) { sb[2 * t] = pack8(S[t], 0); sb[2 * t + 1] = pack8(S[t], 1); }
        f32x16 o[2] = {zero16(), zero16()};
        {   constexpr int R = 6; bf16x8 ring[R];
#pragma unroll
            for (int i = 0; i < R; ++i) ring[i] = lds_frag(X, i, lane);
#pragma unroll
            for (int i = 0; i < 16; ++i) { o[i >> 3] = MFMA32(ring[i % R], sb[i & 7], o[i >> 3]); if (i + R < 16) ring[i % R] = lds_frag(X, i + R, lane); __builtin_amdgcn_sched_barrier(0); }
        }
        if (!(flags & 1)) {
            if (s < NCH / 2) {
#pragma unroll
                for (int rt = 0; rt < 2; ++rt)
#pragma unroll
                    for (int g = 0; g < 4; ++g) __hip_atomic_store(sp + (rt * 4 + g) * 64, (unsigned long long)pkbf(o[rt][4 * g], o[rt][4 * g + 1]) | ((unsigned long long)pkbf(o[rt][4 * g + 2], o[rt][4 * g + 3]) << 32), __ATOMIC_RELAXED, __HIP_MEMORY_SCOPE_AGENT);
            } else {
#pragma unroll
                for (int rt = 0; rt < 2; ++rt)
#pragma unroll
                    for (int g = 0; g < 4; ++g) { const unsigned plo = (unsigned)pw[rt * 4 + g], phi = (unsigned)(pw[rt * 4 + g] >> 32);
                        __hip_atomic_store(sp + (rt * 4 + g) * 64, (unsigned long long)pkbf(o[rt][4 * g] + bflo(plo), o[rt][4 * g + 1] + bfhi(plo)) | ((unsigned long long)pkbf(o[rt][4 * g + 2] + bflo(phi), o[rt][4 * g + 3] + bfhi(phi)) << 32), __ATOMIC_RELAXED, __HIP_MEMORY_SCOPE_AGENT); }
            }
        }
        {
            bf16x8 bfr[4];
#pragma unroll
            for (int ks = 0; ks < 4; ++ks) bfr[ks] = lds_frag(Y + 16384, w * 4 + ks, lane);
#pragma unroll
            for (int t = 0; t < 4; ++t)
#pragma unroll
                for (int g = 0; g < 4; ++g) { const f32x4 ev = *(const LAS f32x4*)(EG + 32 * t + 8 * g + 4 * hh);
                    S[t][4 * g] *= ev.x; S[t][4 * g + 1] *= ev.y; S[t][4 * g + 2] *= ev.z; S[t][4 * g + 3] *= ev.w; }
            constexpr int R = 5; bf16x8 ring[R];
#pragma unroll
            for (int i = 0; i < R; ++i) ring[i] = lds_frag(Y, i, lane);
#pragma unroll
            for (int i = 0; i < 16; ++i) { S[i >> 2] = MFMA32(ring[i % R], bfr[i & 3], S[i >> 2]); if (i + R < 16) ring[i % R] = lds_frag(Y, i + R, lane); __builtin_amdgcn_sched_barrier(0); }
        }
        if (!(flags & 1)) { asm volatile("s_waitcnt vmcnt(0)" ::: "memory"); if (lane == 0) __hip_atomic_store(fl, s < NCH / 2 ? 1u : 2u, __ATOMIC_RELAXED, __HIP_MEMORY_SCOPE_AGENT); }
        __syncthreads();
    }
#undef GLA_ISSUE
}

template <int NC, bool S16>
__device__ __forceinline__ void p4_unit(LAS unsigned char* lds, const unsigned char* slot, const unsigned char* intra, const bf16* zg, const float* nw, bf16* out, const unsigned* done) {
    int tid_l = threadIdx.x; asm volatile("" : "+v"(tid_l));
    const int tid = tid_l, lane = tid & 63, w = __builtin_amdgcn_readfirstlane(tid >> 6), r = lane & 31, hh = lane >> 5;
    constexpr int ST = NC * 2 + 16, NB = (NC / 32) * 8, CPR = NC / 8;
    if (done) {
        for (unsigned sp_ = 0; sp_ < (1u << 22); ++sp_) { const unsigned f = lane < 8 ? __hip_atomic_load(done + lane, __ATOMIC_RELAXED, __HIP_MEMORY_SCOPE_AGENT) : 2u; if (__all(f == 2u)) break; __builtin_amdgcn_s_sleep(8); }
    }
    for (int b = w; b < NB; b += 8) {
        const unsigned long long v = __hip_atomic_load((const unsigned long long*)slot + b * 64 + lane, __ATOMIC_RELAXED, __HIP_MEMORY_SCOPE_AGENT);
        float x0 = bflo((unsigned)v), x1 = bfhi((unsigned)v), x2 = bflo((unsigned)(v >> 32)), x3 = bfhi((unsigned)(v >> 32));
        if (intra) { const unsigned long long iv = ((const unsigned long long*)intra)[b * 64 + lane];
            x0 += bflo((unsigned)iv); x1 += bfhi((unsigned)iv); x2 += bflo((unsigned)(iv >> 32)); x3 += bfhi((unsigned)(iv >> 32)); }
        int row, col;
        if (S16) { row = 16 * (b & 3) + 4 * (lane >> 4); col = 16 * (b >> 2) + (lane & 15); }
        else { row = 32 * ((b >> 2) & 1) + 8 * (b & 3) + 4 * hh; col = 32 * (b >> 3) + r; }
        LAS unsigned char* p = lds + row * ST + col * 2;
        const unsigned a = pkbf(x0, x1), bq = pkbf(x2, x3);
        *(LAS unsigned short*)p = (unsigned short)(a & 0xffffu); *(LAS unsigned short*)(p + ST) = (unsigned short)(a >> 16);
        *(LAS unsigned short*)(p + 2 * ST) = (unsigned short)(bq & 0xffffu); *(LAS unsigned short*)(p + 3 * ST) = (unsigned short)(bq >> 16);
    }
    __syncthreads();
#pragma unroll
    for (int it = 0; it < (64 * CPR) / 512; ++it) {
        const int idx = it * 512 + tid, row = idx / CPR, ch = idx % CPR;
        const v4u xw = *(const LAS v4u*)(lds + row * ST + ch * 16);
        float x[8] = {bflo(xw.x), bfhi(xw.x), bflo(xw.y), bfhi(xw.y), bflo(xw.z), bfhi(xw.z), bflo(xw.w), bfhi(xw.w)};
        float ss = 0.f;
#pragma unroll
        for (int i = 0; i < 8; ++i) ss += x[i] * x[i];
        ss = row16_sum(ss);
        if (NC == 256) ss += __shfl_xor(ss, 16);
        const float rstd = 1.0f / sqrtf(ss * (1.0f / NC) + EPS);
        f32x4 w0 = *(const f32x4*)(nw + ch * 8), w1 = *(const f32x4*)(nw + ch * 8 + 4);
        if (zg) { const v4u zw = *(const v4u*)(zg + (size_t)row * 1024 + ch * 8);
            const float z[8] = {bflo(zw.x), bfhi(zw.x), bflo(zw.y), bfhi(zw.y), bflo(zw.z), bfhi(zw.z), bflo(zw.w), bfhi(zw.w)};
            w0.x *= z[0] * __builtin_amdgcn_rcpf(1.0f + __expf(-z[0])); w0.y *= z[1] * __builtin_amdgcn_rcpf(1.0f + __expf(-z[1])); w0.z *= z[2] * __builtin_amdgcn_rcpf(1.0f + __expf(-z[2])); w0.w *= z[3] * __builtin_amdgcn_rcpf(1.0f + __expf(-z[3]));
            w1.x *= z[4] * __builtin_amdgcn_rcpf(1.0f + __expf(-z[4])); w1.y *= z[5] * __builtin_amdgcn_rcpf(1.0f + __expf(-z[5])); w1.z *= z[6] * __builtin_amdgcn_rcpf(1.0f + __expf(-z[6])); w1.w *= z[7] * __builtin_amdgcn_rcpf(1.0f + __expf(-z[7])); }
        v4u o; o.x = pkbf(x[0] * rstd * w0.x, x[1] * rstd * w0.y); o.y = pkbf(x[2] * rstd * w0.z, x[3] * rstd * w0.w); o.z = pkbf(x[4] * rstd * w1.x, x[5] * rstd * w1.y); o.w = pkbf(x[6] * rstd * w1.z, x[7] * rstd * w1.w);
        *(v4u*)(out + (size_t)row * 1024 + ch * 8) = o;
    }
    __syncthreads();
}
#define XB_TMO      128
#define XB_XCNT(j)  (256  + 64 * (j))
#define XB_XSUB(j)  (1280 + 64 * (j))
#define XB_XGEN(j)  (2304 + 64 * (j))
#define XB_TOP      3328
#define XB_TOPGEN   3392
#define XCD_BAR_WORDS 3456
#define XB_SPIN_CAP (1u << 18)

__device__ __forceinline__ unsigned xb_ld(unsigned* p)              { return __hip_atomic_load(p, __ATOMIC_RELAXED, __HIP_MEMORY_SCOPE_AGENT); }
__device__ __forceinline__ unsigned xb_add(unsigned* p, unsigned v) { return __hip_atomic_fetch_add(p, v, __ATOMIC_RELAXED, __HIP_MEMORY_SCOPE_AGENT); }
__device__ __forceinline__ unsigned xb_xcc_id() { return (unsigned)__builtin_amdgcn_s_getreg((3 << 11) | 20) & 0xFu; }
#define XB_SPIN(cond, bar) do { unsigned _sp = 0; while (cond) { __builtin_amdgcn_s_sleep(1); \
    if ((++_sp & 255u) == 0u) { if (xb_ld(&(bar)[XB_TMO])) break; if (_sp > XB_SPIN_CAP) { atomicAdd(&(bar)[XB_TMO], 1u); break; } } } } while (0)

struct XcdBarrier {
    unsigned* bar; unsigned x;
    volatile LAS unsigned* st;
};

__device__ __forceinline__ XcdBarrier xcd_barrier_post(unsigned* bar, volatile LAS unsigned* st) {
    XcdBarrier b; b.bar = bar; b.x = xb_xcc_id(); b.st = st;
    if (threadIdx.x == 0) (void)xb_add(&bar[XB_XCNT(b.x)], 1u);
    return b;
}
__device__ __forceinline__ void xcd_barrier_complete(unsigned* bar, unsigned x, unsigned& nloc, unsigned& nx) {
    const unsigned G = gridDim.x * gridDim.y * gridDim.z;
    unsigned sum, cnt, mine, sp = 0u;
    for (;;) {
        sum = 0u; cnt = 0u; mine = 0u;
#pragma unroll
        for (unsigned j = 0; j < 16; ++j) { const unsigned c = xb_ld(&bar[XB_XCNT(j)]); sum += c; cnt += (c > 0u) ? 1u : 0u; mine = (j == x) ? c : mine; }
        if (sum == G) break;
        __builtin_amdgcn_s_sleep(1);
        if ((++sp & 255u) == 0u) { if (xb_ld(&bar[XB_TMO])) break; if (sp > XB_SPIN_CAP) { atomicAdd(&bar[XB_TMO], 1u); break; } }
    }
    nloc = mine > 0u ? mine : 1u; nx = cnt > 0u ? cnt : 1u;
}

__device__ __forceinline__ void xcd_barrier(const XcdBarrier& b) {
    asm volatile("s_waitcnt vmcnt(0)" ::: "memory");
    __syncthreads();
    if (threadIdx.x == 0) {
        unsigned* bar = b.bar;
        __builtin_amdgcn_s_waitcnt(0);
        unsigned nloc = b.st[0], nx = b.st[1];
        if (nloc == 0u) { xcd_barrier_complete(bar, b.x, nloc, nx); b.st[0] = nloc; b.st[1] = nx; }
        const unsigned old = xb_add(&bar[XB_XSUB(b.x)], 1u);
        const unsigned gen = old / nloc;
        if (old + 1u == (gen + 1u) * nloc) {
            __builtin_amdgcn_fence(__ATOMIC_RELEASE, "agent");
            asm volatile("s_waitcnt vmcnt(0)" ::: "memory");
            const unsigned og = xb_add(&bar[XB_TOP], 1u);
            const unsigned tg = og / nx;
            if (og + 1u == (tg + 1u) * nx) xb_add(&bar[XB_TOPGEN], 1u);
            else XB_SPIN(xb_ld(&bar[XB_TOPGEN]) == tg, bar);
            __builtin_amdgcn_fence(__ATOMIC_ACQUIRE, "agent");
            xb_add(&bar[XB_XGEN(b.x)], 1u);
            asm volatile("s_waitcnt vmcnt(0)" ::: "memory");
        } else {
            XB_SPIN(xb_ld(&bar[XB_XGEN(b.x)]) == gen, bar);
            __builtin_amdgcn_fence(__ATOMIC_ACQUIRE, "agent");
            asm volatile("s_waitcnt vmcnt(0)" ::: "memory");
        }
    }
    __syncthreads();
}
__device__ __forceinline__ void transpose_item(const float* W, int ldw, int src_col0, int K, int ncols, bf16* WT, int dst_row0, LAS float* scr, int item, int lane) {
    asm volatile("" : "+v"(lane));
    const int nblk = ncols / 32, kb = item / nblk, nb = item % nblk, k0 = 64 * kb, n0 = 32 * nb;
#pragma unroll 8
    for (int i = 0; i < 32; ++i) { const int kk = 2 * i + (lane >> 5); scr[kk * 33 + (lane & 31)] = W[(size_t)(k0 + kk) * ldw + src_col0 + n0 + (lane & 31)]; }
    LDS_WAIT();
    const int c = lane & 7;
#pragma unroll
    for (int j = 0; j < 4; ++j) { const int n = (lane >> 3) + 8 * j; const LAS float* s = scr + (8 * c) * 33 + n;
        v4u o; o.x = pk2(s[0 * 33], s[1 * 33]); o.y = pk2(s[2 * 33], s[3 * 33]); o.z = pk2(s[4 * 33], s[5 * 33]); o.w = pk2(s[6 * 33], s[7 * 33]);
        *(v4u*)(WT + (size_t)(dst_row0 + n0 + n) * K + k0 + 8 * c) = o; }
    LDS_WAIT();
}

constexpr int WCV_MIX = 16 * ((1024 + 3072 + 1024 + 1024 + 32 + 32) / 32), WCV_ALL = WCV_MIX + 16 * ((1024 + 2048) / 32) + 3 * 512;
__device__ __forceinline__ void wconv_item(int it, const float* w_in, const float* wa, const float* wb, const float* wo, bf16* WT_IN, bf16* WT_A, bf16* WT_B, bf16* WT_O, LAS float* scr, int lane) {
    constexpr int c0 = 512, c1 = c0 + 1536, c2 = c1 + 512, c3 = c2 + 512, c4 = c3 + 16, c5 = c4 + 16, c6 = c5 + 512, c7 = c6 + 1024, c8 = c7 + 512, c9 = c8 + 512;
    static_assert(c5 == WCV_MIX && c9 + 512 == WCV_ALL, "weight conversion item list");
    if (it < c0) transpose_item(w_in, NIN, SRC_ZA, D, 1024, WT_IN, 0, scr, it, lane);
    else if (it < c1) transpose_item(w_in, NIN, SRC_QKVA, D, 3072, WT_IN, 1024, scr, it - c0, lane);
    else if (it < c2) transpose_item(w_in, NIN, SRC_QB, D, 1024, WT_IN, 4096, scr, it - c1, lane);
    else if (it < c3) transpose_item(w_in, NIN, SRC_VB, D, 1024, WT_IN, 5120, scr, it - c2, lane);
    else if (it < c4) transpose_item(w_in, NIN, SRC_AF, D, 32, WT_IN, 9216, scr, it - c3, lane);
    else if (it < c5) transpose_item(w_in, NIN, SRC_RF, D, 32, WT_IN, 9248, scr, it - c4, lane);
    else if (it < c6) transpose_item(w_in, NIN, SRC_GB, D, 1024, WT_IN, 6144, scr, it - c5, lane);
    else if (it < c7) transpose_item(w_in, NIN, SRC_GA, D, 2048, WT_IN, 7168, scr, it - c6, lane);
    else if (it < c8) transpose_item(wa, D, 0, D, D, WT_A, 0, scr, it - c7, lane);
    else if (it < c9) transpose_item(wb, D, 0, D, D, WT_B, 0, scr, it - c8, lane);
    else transpose_item(wo, D, 0, D, D, WT_O, 0, scr, it - c9, lane);
}
__device__ __forceinline__ void h_rows(const float* x, const float* w, bf16* h, int nrows, int gw, int ngw, int lane) {
    asm volatile("" : "+v"(lane));
    for (int m = gw; m < nrows; m += ngw) {
        const f32x4* xr = (const f32x4*)(x + (size_t)m * D) + lane; f32x4 v[4]; float s = 0.f;
#pragma unroll
        for (int j = 0; j < 4; ++j) { v[j] = xr[64 * j]; s += (v[j].x * v[j].x + v[j].y * v[j].y) + (v[j].z * v[j].z + v[j].w * v[j].w); }
        const float rstd = 1.0f / sqrtf(wave_sum(s) * (1.f / D) + EPS);
        unsigned long long* o8 = (unsigned long long*)(h + (size_t)m * D) + lane;
#pragma unroll
        for (int j = 0; j < 4; ++j) { const f32x4 ww = ((const f32x4*)w)[lane + 64 * j];
            o8[64 * j] = (unsigned long long)pkbf(v[j].x * rstd * ww.x, v[j].y * rstd * ww.y) | ((unsigned long long)pkbf(v[j].z * rstd * ww.z, v[j].w * rstd * ww.w) << 32); }
    }
}
__device__ __forceinline__ void h_rows_tiles(const float* x, const float* w, const pg8::Gemm& gt, int nrows, int gw, int ngw, int lane) {
    asm volatile("" : "+v"(lane));
    for (int m = gw; m < nrows; m += ngw) {
        const f32x4* xr = (const f32x4*)(x + (size_t)m * D) + lane; f32x4 v[4]; float s = 0.f;
#pragma unroll
        for (int j = 0; j < 4; ++j) { v[j] = xr[64 * j]; s += (v[j].x * v[j].x + v[j].y * v[j].y) + (v[j].z * v[j].z + v[j].w * v[j].w); }
        const float rstd = 1.0f / sqrtf(wave_sum(s) * (1.f / D) + EPS);
        unsigned long long* o8 = (unsigned long long*)(gt.atile(m >> 8, (size_t)256 * D * 2) + (size_t)(m & 255) * D * 2) + lane;
#pragma unroll
        for (int j = 0; j < 4; ++j) { const f32x4 ww = ((const f32x4*)w)[lane + 64 * j];
            o8[64 * j] = (unsigned long long)pkbf(v[j].x * rstd * ww.x, v[j].y * rstd * ww.y) | ((unsigned long long)pkbf(v[j].z * rstd * ww.z, v[j].w * rstd * ww.w) << 32); }
    }
}
__device__ __forceinline__ void final_rows(const float* x, const float* pre, const float* w, float* out, int nrows, int gw, int ngw, int lane) {
    asm volatile("" : "+v"(lane));
    for (int m = gw; m < nrows; m += ngw) {
        const f32x4* pr = (const f32x4*)(pre + (size_t)m * D) + lane; const f32x4* xr = (const f32x4*)(x + (size_t)m * D) + lane; f32x4 v[4]; float s = 0.f;
#pragma unroll
        for (int j = 0; j < 4; ++j) { v[j] = pr[64 * j]; s += (v[j].x * v[j].x + v[j].y * v[j].y) + (v[j].z * v[j].z + v[j].w * v[j].w); }
        const float rstd = 1.0f / sqrtf(wave_sum(s) * (1.f / D) + EPS);
        f32x4* orow = (f32x4*)(out + (size_t)m * D) + lane;
#pragma unroll
        for (int j = 0; j < 4; ++j) { const f32x4 ww = ((const f32x4*)w)[lane + 64 * j]; const f32x4 xv = xr[64 * j]; orow[64 * j] = xv + v[j] * rstd * ww; }
    }
}
__device__ __forceinline__ void small_unit(LAS unsigned char* lds, const bf16* h, const bf16* wsm, float* out, int unit) {
    int tid_l = threadIdx.x; asm volatile("" : "+v"(tid_l));
    const int tid = tid_l, lane = tid & 63, w = __builtin_amdgcn_readfirstlane(tid >> 6), r = lane & 31, hh = lane >> 5;
    const int ct = w & 1, kq = w >> 1;
    const bf16* ap = h + (size_t)(unit * 32 + r) * D + kq * 256 + 8 * hh;
    const bf16* bp = wsm + (size_t)(32 * ct + r) * D + kq * 256 + 8 * hh;
    f32x16 acc = zero16();
#pragma unroll 8
    for (int ks = 0; ks < 16; ++ks) acc = MFMA32(*(const bf16x8*)(ap + 16 * ks), *(const bf16x8*)(bp + 16 * ks), acc);
    LAS float* red = (LAS float*)lds + (size_t)w * 1024 + lane;
    if (kq != 0) {
#pragma unroll
        for (int i = 0; i < 16; ++i) red[i * 64] = acc[i]; }
    __syncthreads();
    if (kq == 0) {
        float* op = out + (size_t)(unit * 32 + 4 * hh) * 64 + 32 * ct + r;
#pragma unroll
        for (int i = 0; i < 16; ++i) op[((i & 3) + 8 * (i >> 2)) * 64] = ((acc[i] + red[2048 + i * 64]) + red[4096 + i * 64]) + red[6144 + i * 64]; }
    __syncthreads();
}

constexpr int NG = 2, MG = M / NG, NSEQG = BATCH / NG;
constexpr size_t KiB = 1024;
constexpr size_t WS_CTL = 0  , WS_WTIN = 320 * KiB, WS_WTA = WS_WTIN + 18560 * KiB, WS_WTB = WS_WTA + 2 * MiB, WS_WTO = WS_WTB + 2 * MiB, WS_SMALL = WS_WTO + 2 * MiB  ,
    WS_Z = WS_SMALL + 2 * MiB  , WS_PG = WS_Z + 16 * MiB  , WS_GBLOB = WS_PG + 80 * MiB  , WS_LBLOBB = WS_GBLOB + 98 * MiB  , WS_END = WS_LBLOBB + 32 * MiB;
static_assert(WS_END <= 256 * MiB, "workspace");
constexpr size_t WS_GATES = WS_GBLOB  , WS_M1 = WS_GATES + 64 * MiB  , WS_MERGED = WS_M1 + 32 * MiB  , WS_PRE = WS_MERGED + 32 * MiB  ;
static_assert(WS_PRE + 1 * MiB <= WS_END, "overlays");
constexpr size_t HT_TILE = 256 * 1024 * 2, WS_H0 = WS_WTIN, WS_H1 = WS_PG + (size_t)NSEQG * 4 * NCH * gla::BLOBA, WS_H2 = WS_SMALL, WS_H3 = WS_END;
constexpr int HT1 = 24, HT2 = 55, HT3 = 59;
static_assert(((size_t)NSEQG * 4 * NCH * gla::BLOBA) % HT_TILE == 0 && WS_H1 + (HT2 - HT1) * HT_TILE <= WS_PG + 3 * ((size_t)MG * 2048) && HT1 * HT_TILE <= (size_t)6144 * 2048 && (HT3 - HT2) * HT_TILE <= 2 * MiB && WS_H3 + (64 - HT3) * HT_TILE <= 256 * MiB, "h tiles");
constexpr size_t PGMAT = (size_t)MG * 1024 * 2;
static_assert((size_t)NSEQG * 4 * NCH * gla::BLOBA <= 3 * PGMAT && (size_t)NSEQG * 4 * NCH * 32768 <= PGMAT && (size_t)NSEQG * 8 * NCH * 16384 <= PGMAT, "overlays");
static_assert((size_t)NSEQG * 8 * NCH * gdn::BLOB <= 98 * MiB && (size_t)NSEQG * 4 * NCH * gla::BLOBB <= 32 * MiB, "blobs");
constexpr int LDS_BYTES = 160 * 1024, LDS_BAR = LDS_BYTES - 16;
static_assert(gla::L_END <= LDS_BAR && gdn::L_END <= LDS_BAR && gdn::C_END <= LDS_BAR && gla::CB_END <= LDS_BAR && pg8::STAGE_BYTES <= LDS_BAR, "LDS");
constexpr int N_PHASES = 12;

struct MegaArgs { const float* in[18]; float* out; unsigned char* ws; int ph_lo, ph_hi; };

__global__ void __launch_bounds__(512, 2) mega(MegaArgs a) {
    extern __shared__ __attribute__((aligned(16))) unsigned char lds_raw[];
    LAS unsigned char* lds = (LAS unsigned char*)lds_raw;
    const int tid = threadIdx.x, lane = tid & 63, wave = __builtin_amdgcn_readfirstlane(tid >> 6);
    const int G = gridDim.x, bid = blockIdx.x, gw = bid * 8 + wave, ngw = G * 8;
    unsigned char* ws = a.ws;
    const float* x = a.in[0]; const float* ln_pre_w = a.in[1]; const float* w_in = a.in[2]; const float* conv_w = a.in[3];
    if (tid < 4) ((LAS unsigned*)(lds + LDS_BAR))[tid] = 0u;
    __syncthreads();
    XcdBarrier bar = xcd_barrier_post((unsigned*)(ws + WS_CTL), (volatile LAS unsigned*)(lds + LDS_BAR));
    const int lo = a.ph_lo, hi = a.ph_hi;
#define IN(k) (lo <= (k) && (k) < hi)
#define SEAM(k) do { if (IN(k) && IN((k) + 1)) xcd_barrier(bar); } while (0)
#ifndef PROBE_REPEAT
#define PROBE_REPEAT 0
#endif
#ifndef PROBE_FLAGS
#define PROBE_FLAGS 0
#endif
#define PH(k) if (IN(k)) for (int rep_ = 0; rep_ <= ((PROBE_REPEAT >> (k)) & 1); ++rep_)
#define REPBAR() do { if (rep_) xcd_barrier(bar); } while (0)
    bf16* WT_IN = (bf16*)(ws + WS_WTIN); bf16* WT_A = (bf16*)(ws + WS_WTA); bf16* WT_B = (bf16*)(ws + WS_WTB); bf16* WT_O = (bf16*)(ws + WS_WTO);
    bf16* PG = (bf16*)(ws + WS_PG); float* SMALL = (float*)(ws + WS_SMALL);
    bf16* ORAWA = (bf16*)a.out; bf16* ORAWB = (bf16*)a.out + (size_t)M * 1024;
    pg8::Gemm gh{(const bf16*)(ws + WS_H0), WT_IN + (size_t)6144 * D, M, 3072, D, 0, (const bf16*)(ws + WS_H1), (const bf16*)(ws + WS_H2), (const bf16*)(ws + WS_H3), HT1, HT2, HT3};

    PH(0) { REPBAR();
        LAS float* scr = (LAS float*)lds + wave * (64 * 33);
        for (int it = gw; it < WCV_MIX; it += ngw) wconv_item(it, w_in, a.in[9], a.in[15], a.in[16], WT_IN, WT_A, WT_B, WT_O, scr, lane);
        h_rows(x, ln_pre_w, ORAWB + (size_t)MG * 1024, MG, gw, ngw, lane);
    }
    SEAM(0);
#ifdef PROBE_BARRIERS
    for (int i = 0; i < PROBE_BARRIERS; ++i) xcd_barrier(bar);
#endif
    for (int g = 0; g < NG; ++g) {
        const int pb = 1 + 4 * g;
        const size_t r0 = (size_t)g * MG;
        const bf16* hsrc = (g == 0 ? ORAWB : ORAWA) + (size_t)MG * 1024;
        PH(pb) { REPBAR();
            for (int u = bid; u < MG / 32; u += G) small_unit(lds, hsrc, WT_IN + (size_t)9216 * D, SMALL, u);
            pg8::Gemm gm{hsrc, WT_IN, MG, 6144, D, 0}; pg8::StaticOrder S; S.init(MG, 6144, G, bid);
            pg8::EpiBf16 E{(bf16*)(ws + WS_Z), 1024, 1024, (size_t)MG * 1024};
            pg8::gemm_phase<pg8::EpiBf16, pg8::StaticOrder, true, true>(lds, gm, S, E);
        }
        SEAM(pb);
        PH(pb + 1) { REPBAR();
            GdnPrepArgs pa{PG, PG + (size_t)MG * 1024, PG + (size_t)2 * MG * 1024, SMALL, conv_w, a.in[4], a.in[5], a.in[6], a.in[7], ws + WS_GBLOB, NSEQG, rep_ ? PROBE_FLAGS : 0};
            gdn_prep_phase(lds, pa, bid, G, ws + WS_CTL + 300 * KiB);
        }
        SEAM(pb + 1);
        PH(pb + 2) { REPBAR();
            GlaPrepArgs pa{PG + (size_t)3 * MG * 1024, PG + (size_t)4 * MG * 1024, SMALL, a.in[10], a.in[11], a.in[12], a.in[13], ws + WS_PG, ws + WS_LBLOBB, NSEQG, 0};
            gla_prep_phase(lds, pa, bid, G);
        }
        SEAM(pb + 2);
        PH(pb + 3) { REPBAR();
            constexpr int NGI = NSEQG * 8 * 2, NLI = NSEQG * 4 * 2;
            unsigned* gflag = (unsigned*)(ws + WS_CTL + 32 * KiB) + (size_t)g * (NSEQG * 8 * NCH * 8); unsigned* lflag = (unsigned*)(ws + WS_CTL + 96 * KiB) + (size_t)g * (NSEQG * 4 * NCH * 8);
            if (rep_) { gflag += 32 * 1024; lflag += 32 * 1024; }
            if (bid < NGI) { if (!(rep_ && (PROBE_FLAGS & 16))) { GdnChainArgs ca{ws + WS_GBLOB, ws + WS_PG + 4 * PGMAT, gflag, NSEQG, rep_ ? PROBE_FLAGS : 0}; gdn_chain_unit(lds, ca, bid); } }
            else if (bid < NGI + NLI) { if (!(rep_ && (PROBE_FLAGS & 32))) { GlaChainArgs ca{ws + WS_PG, ws + WS_LBLOBB, ws + WS_PG + 3 * PGMAT, lflag, NSEQG, rep_ ? PROBE_FLAGS : 0}; gla_chain_unit(lds, ca, bid - NGI); } }
            else if (!rep_) {
                const int wk = bid - NGI - NLI, nwk = G - NGI - NLI;
                if (g == 0) h_rows(x + (size_t)MG * D, ln_pre_w, ORAWA + (size_t)MG * 1024, MG, wk * 8 + wave, nwk * 8, lane);
                if (g == 0) { LAS float* scr = (LAS float*)lds + wave * (64 * 33);
                    for (int it = WCV_MIX + wk * 8 + wave; it < WCV_ALL; it += nwk * 8) wconv_item(it, w_in, a.in[9], a.in[15], a.in[16], WT_IN, WT_A, WT_B, WT_O, scr, lane);
                    __syncthreads(); }
                if (g == NG - 1) h_rows_tiles(x, ln_pre_w, gh, M, wk * 8 + wave, nwk * 8, lane);
            }
            if (!rep_) {
                constexpr int NPG = NSEQG * 8, NPL = NSEQG * 4;
                unsigned* qhead = (unsigned*)(ws + WS_CTL + 301 * KiB) + 64 * g;
                for (;;) {
                    if (tid == 0) ((LAS unsigned*)(lds + LDS_BAR))[3] = __hip_atomic_fetch_add(qhead, 1u, __ATOMIC_RELAXED, __HIP_MEMORY_SCOPE_AGENT);
                    __syncthreads();
                    const int j = (int)((LAS unsigned*)(lds + LDS_BAR))[3];
                    __syncthreads();
                    if (j >= NCH * (NPG + NPL)) break;
                    const int rk = j / (NPG + NPL), idx = j % (NPG + NPL), n = (rk & 1) ? (NCH / 2 - 1 - (rk >> 1)) : (NCH / 2 + (rk >> 1));
                    if (idx < NPG) { const int u = idx * NCH + n, hd = idx % 8, sq = idx / 8;
                        p4_unit<128, true>(lds, ws + WS_PG + 4 * PGMAT + (size_t)u * 16384, nullptr, (const bf16*)(ws + WS_Z) + ((size_t)sq * SEQ + n * CHUNK) * 1024 + hd * 128, a.in[8], ORAWA + (r0 + (size_t)sq * SEQ + n * CHUNK) * 1024 + hd * 128, gflag + (size_t)u * 8); }
                    else { const int pi = idx - NPG, u = pi * NCH + n, hd = pi % 4, sq = pi / 4;
                        p4_unit<256, false>(lds, ws + WS_PG + 3 * PGMAT + (size_t)u * 32768, ws + WS_LBLOBB + (size_t)u * gla::BLOBB + gla::B_INTRA, nullptr, a.in[14], ORAWB + (r0 + (size_t)sq * SEQ + n * CHUNK) * 1024 + hd * 256, lflag + (size_t)u * 8); }
                }
            }
        }
        SEAM(pb + 3);
    }
    PH(9) { REPBAR();
        const pg8::Gemm& gm = gh; pg8::StaticOrder S; S.init(M, 3072, G, bid);
        if (rep_ == 0) { pg8::EpiP1b E{ORAWB, (bf16*)(ws + WS_GATES), (size_t)M * 1024, ORAWB};
            pg8::gemm_phase<pg8::EpiP1b, pg8::StaticOrder, true, true>(lds, gm, S, E); }
        else { pg8::EpiP1b E{ORAWB, (bf16*)(ws + WS_GATES), (size_t)M * 1024, (bf16*)(ws + WS_MERGED)};
            pg8::gemm_phase<pg8::EpiP1b, pg8::StaticOrder, true, true>(lds, gm, S, E); }
    }
    SEAM(9);
    PH(10) { REPBAR();
        pg8::Gemm gm{ORAWA, WT_A, 2 * M, 2 * D, D, 0}; pg8::PairOrder S; S.init(M, D, G, bid);
        pg8::EpiMerge E{(bf16*)(ws + WS_M1), (bf16*)(ws + WS_MERGED), (const bf16*)(ws + WS_GATES), (size_t)M * 1024, M / 256, D / 256};
        pg8::gemm_phase<pg8::EpiMerge, pg8::PairOrder, true, true>(lds, gm, S, E);
    }
    SEAM(10);
    if (IN(11)) {
        pg8::Gemm gm{(const bf16*)(ws + WS_MERGED), WT_O, M, D, D, 0}; pg8::StaticOrder S; S.init(M, D, G, bid);
        pg8::EpiRmsRes E{x, a.in[17], a.out, (float*)(ws + WS_PRE), (unsigned*)(ws + WS_CTL + 304 * KiB)};
        pg8::gemm_phase<pg8::EpiRmsRes, pg8::StaticOrder, false, true>(lds, gm, S, E);
    }
#undef IN
#undef SEAM
}

#ifndef MK_N_LAUNCHES
#define MK_N_LAUNCHES 1
#endif
extern "C" void kernel_launch(void* const* d_in, const int* in_sizes, int n_in, void* d_out, int out_size, void* d_ws, size_t ws_size, hipStream_t stream) {
    static int ready = 0;
    if (!ready) {
        if (n_in != 18 || ws_size < 256 * MiB || out_size != M * D) { fprintf(stderr, "kernel_launch: unexpected problem shape / workspace (%d inputs, ws %zu)\n", n_in, ws_size); ready = -1; return; }
        if (hipFuncSetAttribute((const void*)mega, hipFuncAttributeMaxDynamicSharedMemorySize, LDS_BYTES) != hipSuccess) { fprintf(stderr, "kernel_launch: hipFuncSetAttribute failed\n"); ready = -1; return; }
        ready = 1;
    }
    if (ready < 0) return;
    (void)hipMemsetAsync((char*)d_ws + WS_CTL, 0, 320 * 1024, stream);
    MegaArgs a{};
    for (int i = 0; i < 18; ++i) a.in[i] = (const float*)d_in[i];
    a.out = (float*)d_out; a.ws = (unsigned char*)d_ws;
#if MK_N_LAUNCHES == 1
    a.ph_lo = 0; a.ph_hi = N_PHASES;
    hipLaunchKernelGGL(mega, dim3(256), dim3(512), LDS_BYTES, stream, a);
#else
    for (int p = 0; p < N_PHASES; ++p) { a.ph_lo = p; a.ph_hi = p + 1; hipLaunchKernelGGL(mega, dim3(256), dim3(512), LDS_BYTES, stream, a); }
#endif
}
```

```cpp
#include <hip/hip_runtime.h>
#include <cstdio>
#include <cstdint>

#define GAS __attribute__((address_space(1)))
#define LAS __attribute__((address_space(3)))
typedef unsigned short bf16;
typedef unsigned v4u __attribute__((ext_vector_type(4)));
typedef unsigned v2u __attribute__((ext_vector_type(2)));
typedef float f32x4 __attribute__((ext_vector_type(4)));
#define LDS_WAIT() asm volatile("s_waitcnt lgkmcnt(0)" ::: "memory")

constexpr int BATCH = 8, SEQ = 2048, D = 1024, M = BATCH * SEQ, NIN = 9280;
constexpr float EPS = 1e-6f;
constexpr size_t MiB = 1 << 20;
constexpr int SRC_QKVA = 0, SRC_ZA = 3072, SRC_AF = 4096, SRC_QB = 4128, SRC_KB = 4640, SRC_VB = 5152, SRC_GB = 6176, SRC_RF = 7200, SRC_GA = 7232, SRC_GBm = 8256;

__device__ __forceinline__ unsigned f2bf(float f) { unsigned u = __builtin_bit_cast(unsigned, f); return (u + 0x7fffu + ((u >> 16) & 1u)) >> 16; }
__device__ __forceinline__ unsigned pk2(float lo, float hi) { return f2bf(lo) | (f2bf(hi) << 16); }
__device__ __forceinline__ float bf2f(unsigned short b) { return __builtin_bit_cast(float, (unsigned)b << 16); }
__device__ __forceinline__ float bflo(unsigned w) { return __builtin_bit_cast(float, w << 16); }
__device__ __forceinline__ float bfhi(unsigned w) { return __builtin_bit_cast(float, w & 0xffff0000u); }
__device__ __forceinline__ float sigmoidf_(float x) { return 1.0f / (1.0f + __expf(-x)); }
__device__ __forceinline__ float siluf_(float x) { return x / (1.0f + __expf(-x)); }
__device__ __forceinline__ float wave_sum(float v) {
#pragma unroll
    for (int o = 1; o < 64; o <<= 1) v += __shfl_xor(v, o);
    return v;
}
namespace pg8 {
#define PG8_LAS __attribute__((address_space(3)))
typedef unsigned short bf16_t;
typedef short bf16x8 __attribute__((ext_vector_type(8)));
typedef float f32x4 __attribute__((ext_vector_type(4)));
typedef unsigned u32x4 __attribute__((ext_vector_type(4)));
constexpr int BM = 256, BK = 64, HALF = 128, HTB = HALF * BK * 2  , STAGE_BYTES = 8 * HTB, NXCD = 8, WGM = 8;

__host__ __device__ __forceinline__ int lds_byte(int r, int c) { const int st = (r >> 4) * 2 + (c >> 5), rr = r & 15, cc = c & 31, ob = rr * 64 + cc * 2; return st * 1024 + (ob ^ (((ob >> 9) & 1) << 5)); }
__host__ __device__ __forceinline__ void stage_rc(int b, int& R, int& C) { const int st = b / 1024, sb = b % 1024, swz = sb ^ (((sb >> 9) & 1) << 5); R = (st >> 1) * 16 + swz / 64; C = (st & 1) * 32 + (swz % 64) / 2; }
__host__ __device__ __forceinline__ int perm32(int rho) { const int n = rho >> 4, i = rho & 15; return 8 * (i >> 2) + 4 * n + (i & 3); }

struct Unit { int pm, pn; };
struct Gemm { const bf16_t* A; const bf16_t* Bt; int M, N, K, pad_;
    const bf16_t* A1 = nullptr; const bf16_t* A2 = nullptr; const bf16_t* A3 = nullptr; int t1 = 1 << 30, t2 = 1 << 30, t3 = 1 << 30;
    __host__ __device__ __forceinline__ const char* atile(int pm, size_t tstep) const {
        if (pm < t1) return (const char*)A + (size_t)pm * tstep;
        if (pm < t2) return (const char*)A1 + (size_t)(pm - t1) * tstep;
        if (pm < t3) return (const char*)A2 + (size_t)(pm - t2) * tstep;
        return (const char*)A3 + (size_t)(pm - t3) * tstep; }
};

struct StaticOrder {
    int nM, nN, nwg, G, c;
    __host__ __device__ void init(int M, int N, int G_, int c_) { nM = M / BM; nN = N / BM; nwg = nM * nN; G = G_; c = c_; }
    __host__ __device__ bool next(int i, Unit& u) const {
        const long L = (long)i * G + c; if (L >= nwg) return false;
        int wgid = (int)L; { const int q = nwg / NXCD, r = nwg % NXCD, xcd = wgid % NXCD, off = wgid / NXCD; wgid = (xcd < r ? xcd * (q + 1) : r * (q + 1) + (xcd - r) * q) + off; }
        const int nig = WGM * nN, gid = wgid / nig, fm = gid * WGM, gsz = (nM - fm) < WGM ? (nM - fm) : WGM;
        u.pm = fm + ((wgid % nig) % gsz); u.pn = (wgid % nig) / gsz; return true;
    }
    __device__ __forceinline__ void a_ready(const Unit&) const {}
    __device__ __forceinline__ void done(const Unit&) const {}
};

__device__ __forceinline__ unsigned cvt_pk_bf16(float lo, float hi) { unsigned r; asm volatile("v_cvt_pk_bf16_f32 %0, %1, %2" : "=v"(r) : "v"(lo), "v"(hi)); return r; }
struct EpiBf16 {
    static constexpr bool PERM = true, AFTER_DRAIN = false;
    bf16_t* O; int ldc; int split_cols; size_t split_stride;
    __device__ __forceinline__ void operator()(const f32x4 (&acc)[2][2][4][2], const Unit& u, int wr, int wc, int fr, int fq) const {
        const int row0 = u.pm * BM + wr * 64 + fr; int colt = u.pn * BM; bf16_t* base = O;
        if (split_cols) { const int t = colt / split_cols; base += (size_t)t * split_stride; colt -= t * split_cols; }
        const int col0 = colt + wc * 32 + 8 * fq;
#pragma unroll
        for (int ai = 0; ai < 2; ++ai)
#pragma unroll
            for (int m = 0; m < 4; ++m) { bf16_t* rowp = base + (size_t)(row0 + ai * HALF + m * 16) * ldc + col0;
#pragma unroll
                for (int bj = 0; bj < 2; ++bj) { const f32x4 v0 = acc[ai][bj][m][0], v1 = acc[ai][bj][m][1];
                    u32x4 w; w.x = cvt_pk_bf16(v0[0], v0[1]); w.y = cvt_pk_bf16(v0[2], v0[3]); w.z = cvt_pk_bf16(v1[0], v1[1]); w.w = cvt_pk_bf16(v1[2], v1[3]);
                    *(u32x4*)(rowp + bj * HALF) = w; } }
    }
};
template <int MODE> struct EpiGate {
    static constexpr bool PERM = true, AFTER_DRAIN = false;
    bf16_t* O; const bf16_t* G; const bf16_t* Add; int ldc, pad_;
    __device__ __forceinline__ void operator()(const f32x4 (&acc)[2][2][4][2], const Unit& u, int wr, int wc, int fr, int fq) const {
        const int row0 = u.pm * BM + wr * 64 + fr; const int col0 = u.pn * BM + wc * 32 + 8 * fq;
#pragma unroll
        for (int ai = 0; ai < 2; ++ai)
#pragma unroll
            for (int m = 0; m < 4; ++m) { const size_t ro = (size_t)(row0 + ai * HALF + m * 16) * ldc + col0;
#pragma unroll
                for (int bj = 0; bj < 2; ++bj) { const f32x4 v0 = acc[ai][bj][m][0], v1 = acc[ai][bj][m][1];
                    const u32x4 gw = *(const u32x4*)(G + ro + bj * HALF);
                    float r[8]; const float a[8] = {v0[0], v0[1], v0[2], v0[3], v1[0], v1[1], v1[2], v1[3]};
#pragma unroll
                    for (int i = 0; i < 4; ++i) { const unsigned w = gw[i]; const float g0 = __builtin_bit_cast(float, w << 16), g1 = __builtin_bit_cast(float, w & 0xffff0000u);
                        if (MODE == 0) { r[2 * i] = a[2 * i] * __builtin_amdgcn_rcpf(1.0f + __builtin_amdgcn_exp2f(-1.4426950408889634f * g0)); r[2 * i + 1] = a[2 * i + 1] * __builtin_amdgcn_rcpf(1.0f + __builtin_amdgcn_exp2f(-1.4426950408889634f * g1)); }
                        else { r[2 * i] = g0 * a[2 * i] * __builtin_amdgcn_rcpf(1.0f + __builtin_amdgcn_exp2f(-1.4426950408889634f * a[2 * i])); r[2 * i + 1] = g1 * a[2 * i + 1] * __builtin_amdgcn_rcpf(1.0f + __builtin_amdgcn_exp2f(-1.4426950408889634f * a[2 * i + 1])); } }
                    if (Add) { const u32x4 aw = *(const u32x4*)(Add + ro + bj * HALF);
#pragma unroll
                        for (int i = 0; i < 4; ++i) { const unsigned w = aw[i]; r[2 * i] += __builtin_bit_cast(float, w << 16); r[2 * i + 1] += __builtin_bit_cast(float, w & 0xffff0000u); } }
                    u32x4 w; w.x = cvt_pk_bf16(r[0], r[1]); w.y = cvt_pk_bf16(r[2], r[3]); w.z = cvt_pk_bf16(r[4], r[5]); w.w = cvt_pk_bf16(r[6], r[7]);
                    *(u32x4*)(O + ro + bj * HALF) = w; } }
    }
};
struct EpiF32 {
    static constexpr bool PERM = false, AFTER_DRAIN = false;
    float* O; int ldc, pad_;
    __device__ __forceinline__ void operator()(const f32x4 (&acc)[2][2][4][2], const Unit& u, int wr, int wc, int fr, int fq) const {
        const int row0 = u.pm * BM + wr * 64 + fr; const int col0 = u.pn * BM + wc * 32 + 4 * fq;
#pragma unroll
        for (int ai = 0; ai < 2; ++ai)
#pragma unroll
            for (int m = 0; m < 4; ++m) { float* rowp = O + (size_t)(row0 + ai * HALF + m * 16) * ldc + col0;
#pragma unroll
                for (int bj = 0; bj < 2; ++bj)
#pragma unroll
                    for (int n = 0; n < 2; ++n) *(f32x4*)(rowp + bj * HALF + n * 16) = acc[ai][bj][m][n]; }
    }
};
struct EpiP1b {
    static constexpr bool PERM = true, AFTER_DRAIN = false;
    const bf16_t* ob; bf16_t* gates; size_t gate_stride; bf16_t* ob_out;
    __device__ __forceinline__ void operator()(const f32x4 (&acc)[2][2][4][2], const Unit& u, int wr, int wc, int fr, int fq) const {
        if (u.pn < 4) { EpiGate<1> E{ob_out, ob, nullptr, 1024, 0}; E(acc, u, wr, wc, fr, fq); }
        else { Unit v = u; v.pn = (u.pn - 4) & 3; EpiBf16 E{gates + (size_t)((u.pn - 4) >> 2) * gate_stride, 1024, 0, 0}; E(acc, v, wr, wc, fr, fq); }
    }
};
struct EpiRmsRes {
    static constexpr bool PERM = false, AFTER_DRAIN = true;
    const float* xres; const float* w; float* out; float* xbuf; unsigned* cnt;
    __device__ __forceinline__ void fused(f32x4 (&acc)[2][2][4][2], const Unit& u, int wr, int wc, int fr, int fq, PG8_LAS unsigned char* lds, int wid, int lane) const {
        PG8_LAS float* P = (PG8_LAS float*)lds;
        PG8_LAS float* R = (PG8_LAS float*)(lds + 4096);
#pragma unroll
        for (int ai = 0; ai < 2; ++ai)
#pragma unroll
            for (int m = 0; m < 4; ++m) { float s = 0.f;
#pragma unroll
                for (int bj = 0; bj < 2; ++bj)
#pragma unroll
                    for (int n = 0; n < 2; ++n) { const f32x4 x = acc[ai][bj][m][n]; s += (x[0] * x[0] + x[1] * x[1]) + (x[2] * x[2] + x[3] * x[3]); }
                s += __shfl_xor(s, 16); s += __shfl_xor(s, 32);
                if (fq == 0) P[(ai * HALF + wr * 64 + m * 16 + fr) * 4 + wc] = s; }
        asm volatile("s_waitcnt lgkmcnt(0)" ::: "memory"); __builtin_amdgcn_s_barrier(); asm volatile("" ::: "memory");
        const int row = wid * 32 + (lane & 31);
        if (lane < 32) { const f32x4 p = *(const PG8_LAS f32x4*)(P + row * 4);
            __hip_atomic_store(xbuf + (size_t)(u.pm * BM + row) * 4 + u.pn, (p[0] + p[1]) + (p[2] + p[3]), __ATOMIC_RELAXED, __HIP_MEMORY_SCOPE_AGENT); }
        asm volatile("s_waitcnt vmcnt(0)" ::: "memory");
        if (lane == 0) __hip_atomic_fetch_add(cnt + 64 * u.pm, 1u, __ATOMIC_RELAXED, __HIP_MEMORY_SCOPE_AGENT);
        if (wid == 0) {
            for (unsigned sp = 0; (unsigned)__builtin_amdgcn_readfirstlane((int)__hip_atomic_load(cnt + 64 * u.pm, __ATOMIC_RELAXED, __HIP_MEMORY_SCOPE_AGENT)) < 32u && sp < (1u << 22); ++sp) __builtin_amdgcn_s_sleep(2);
        }
        asm volatile("s_waitcnt vmcnt(0) lgkmcnt(0)" ::: "memory"); __builtin_amdgcn_s_barrier(); asm volatile("" ::: "memory");
        if (lane < 32) { const float* sl = xbuf + (size_t)(u.pm * BM + row) * 4; float t = 0.f;
#pragma unroll
            for (int i = 0; i < 4; ++i) t += __hip_atomic_load(sl + i, __ATOMIC_RELAXED, __HIP_MEMORY_SCOPE_AGENT);
            R[row] = 1.0f / sqrtf(t * (1.0f / 1024.0f) + 1e-6f); }
        asm volatile("s_waitcnt vmcnt(0) lgkmcnt(0)" ::: "memory"); __builtin_amdgcn_s_barrier(); asm volatile("" ::: "memory");
        const int col0 = u.pn * BM + wc * 32 + 4 * fq;
#pragma unroll
        for (int ai = 0; ai < 2; ++ai)
#pragma unroll
            for (int m = 0; m < 4; ++m) { const int r = ai * HALF + wr * 64 + m * 16 + fr; const float rs = R[r]; const size_t off = (size_t)(u.pm * BM + r) * 1024 + col0;
#pragma unroll
                for (int bj = 0; bj < 2; ++bj)
#pragma unroll
                    for (int n = 0; n < 2; ++n) { const int c = bj * HALF + n * 16; const f32x4 xv = *(const f32x4*)(xres + off + c); const f32x4 wv = *(const f32x4*)(w + col0 + c);
                        *(f32x4*)(out + off + c) = xv + acc[ai][bj][m][n] * rs * wv; }
                if (m & 1) asm volatile("" ::: "memory"); }
    }
};
struct PairOrder {
    StaticOrder S; int nM, nN;
    __host__ __device__ void init(int M, int N, int G_, int c_) { S.init(M, N, G_, c_); nM = M / BM; nN = N / BM; }
    __host__ __device__ bool next(int i, Unit& u) const { if (i > 1) return false; Unit b; if (!S.next(0, b)) return false; u.pm = b.pm + i * nM; u.pn = b.pn + i * nN; return true; }
    __device__ __forceinline__ void a_ready(const Unit&) const {}
    __device__ __forceinline__ void done(const Unit&) const {}
};
struct EpiMerge {
    static constexpr bool PERM = true, AFTER_DRAIN = false;
    bf16_t* m1; bf16_t* merged; const bf16_t* gates; size_t gate_stride; int nM, nN;
    __device__ __forceinline__ void operator()(const f32x4 (&acc)[2][2][4][2], const Unit& u, int wr, int wc, int fr, int fq) const {
        if (u.pm < nM) { EpiGate<0> E{m1, gates, nullptr, 1024, 0}; E(acc, u, wr, wc, fr, fq); }
        else { Unit v; v.pm = u.pm - nM; v.pn = u.pn - nN; EpiGate<0> E{merged, gates + gate_stride, m1, 1024, 0}; E(acc, v, wr, wc, fr, fq); }
    }
};
template <class Epi, class Sched, bool ALIGN_EPI = false, bool SP2 = false>
__device__ __forceinline__ void gemm_phase(PG8_LAS unsigned char* lds, const Gemm g, const Sched& S, const Epi& E) {
    int tid_l = threadIdx.x; asm volatile("" : "+v"(tid_l));
    const int tid = tid_l, wid = __builtin_amdgcn_readfirstlane(tid >> 6), lane = tid & 63, wr = wid >> 2, wc = wid & 3, fr = lane & 15, fq = lane >> 4;
    const int K = g.K, nt = K / BK;
    unsigned voffA[2], voffB[2];
#pragma unroll
    for (int i = 0; i < 2; ++i) { int R, C; stage_rc(tid * 16 + i * 8192, R, C); const int Rb = Epi::PERM ? ((R & ~31) + perm32(R & 31)) : R;
        voffA[i] = (unsigned)(R * K + C) * 2u; voffB[i] = (unsigned)(Rb * K + C) * 2u; }
    const size_t kstep = (size_t)(BK * 2);
    const size_t hstep = (size_t)HALF * K * 2;
    const size_t tstep = 2 * hstep;
    const unsigned ldsw = (unsigned)wid * 1024u;
    const int aoff = lds_byte(wr * 64 + fr, fq * 8), boff = lds_byte(wc * 32 + fr, fq * 8);
#define PG8_SA(b, h) (((b) * 2 + (h)) * HTB)
#define PG8_SB(b, h) ((4 + (b) * 2 + (h)) * HTB)
#define PG8_STAGE(bufoff, gbase, voff) do { _Pragma("unroll") for (int _i = 0; _i < 2; ++_i) \
        __builtin_amdgcn_global_load_lds((const unsigned*)((const char*)(gbase) + (voff)[_i]), (PG8_LAS unsigned*)(lds + (bufoff) + ldsw + _i * 8192), 16, 0, 0); } while (0)
#define PG8_LDA(dst, b, h) do { _Pragma("unroll") for (int m = 0; m < 4; ++m) _Pragma("unroll") for (int k = 0; k < 2; ++k) dst[m][k] = *(const PG8_LAS bf16x8*)(lds + PG8_SA(b, h) + aoff + m * 2048 + k * 1024); } while (0)
#define PG8_LDB(dst, b, h) do { _Pragma("unroll") for (int n = 0; n < 2; ++n) _Pragma("unroll") for (int k = 0; k < 2; ++k) dst[n][k] = *(const PG8_LAS bf16x8*)(lds + PG8_SB(b, h) + boff + n * 2048 + k * 1024); } while (0)
#define PG8_MMA(ai, bj, At, Bt) do { __builtin_amdgcn_s_setprio(1); _Pragma("unroll") for (int m = 0; m < 4; ++m) _Pragma("unroll") for (int n = 0; n < 2; ++n) _Pragma("unroll") for (int k = 0; k < 2; ++k) \
        acc[ai][bj][m][n] = __builtin_amdgcn_mfma_f32_16x16x32_bf16(Bt[n][k], At[m][k], acc[ai][bj][m][n], 0, 0, 0); __builtin_amdgcn_s_setprio(0); } while (0)
#define PG8_WAIT_V(n) asm volatile("s_waitcnt vmcnt(" #n ")" ::: "memory")
#define PG8_WAIT_L(n) asm volatile("s_waitcnt lgkmcnt(" #n ")" ::: "memory")
#define PG8_BAR __builtin_amdgcn_s_barrier()
#define PG8_SCHED __builtin_amdgcn_sched_barrier(0)
    Unit cur, nxt; int ui = 0;
    if (!S.next(0, cur)) return;
    f32x4 acc[2][2][4][2];
#pragma unroll
    for (int a = 0; a < 2; ++a)
#pragma unroll
        for (int b = 0; b < 2; ++b)
#pragma unroll
            for (int m = 0; m < 4; ++m)
#pragma unroll
                for (int n = 0; n < 2; ++n) acc[a][b][m][n] = (f32x4){0.f, 0.f, 0.f, 0.f};
    bf16x8 At[4][2], B0[2][2], B1[2][2];
    const char* cA = g.atile(cur.pm, tstep); const char* cB = (const char*)g.Bt + (size_t)cur.pn * tstep;
    S.a_ready(cur);
    if constexpr (SP2) {
        PG8_STAGE(PG8_SB(0, 0), cB, voffB); PG8_STAGE(PG8_SB(0, 1), cB + hstep, voffB); PG8_STAGE(PG8_SA(0, 0), cA, voffA); PG8_STAGE(PG8_SA(0, 1), cA + hstep, voffA);
        if (wr == 1) PG8_BAR;
        PG8_WAIT_V(2); PG8_BAR;
        PG8_STAGE(PG8_SB(1, 0), cB + kstep, voffB); PG8_STAGE(PG8_SA(1, 0), cA + kstep, voffA); PG8_STAGE(PG8_SB(1, 1), cB + hstep + kstep, voffB);
        PG8_WAIT_V(6); PG8_BAR;
    } else {
        PG8_STAGE(PG8_SB(0, 0), cB, voffB); PG8_STAGE(PG8_SA(0, 0), cA, voffA); PG8_STAGE(PG8_SB(0, 1), cB + hstep, voffB); PG8_STAGE(PG8_SA(0, 1), cA + hstep, voffA);
        if (wr == 1) PG8_BAR;
        PG8_WAIT_V(4); PG8_BAR;
        PG8_STAGE(PG8_SB(1, 0), cB + kstep, voffB); PG8_STAGE(PG8_SA(1, 0), cA + kstep, voffA); PG8_STAGE(PG8_SB(1, 1), cB + hstep + kstep, voffB);
        PG8_WAIT_V(6); PG8_BAR;
    }
    for (;;) {
        const bool has_next = S.next(ui + 1, nxt);
        const char* nA = has_next ? g.atile(nxt.pm, tstep) : cA; const char* nB = has_next ? (const char*)g.Bt + (size_t)nxt.pn * tstep : cB;
        for (int t = 0; t < nt; t += 2) {
            const bool last = (t == nt - 2);
            const char* a1 = cA + (size_t)(t + 1) * kstep;
            const char* a2 = last ? nA : cA + (size_t)(t + 2) * kstep; const char* b2 = last ? nB : cB + (size_t)(t + 2) * kstep;
            const char* a3 = a2 + kstep; const char* b3 = b2 + kstep;
            if (last && has_next) S.a_ready(nxt);
            if constexpr (SP2) {
            PG8_LDB(B0, 0, 0); PG8_LDB(B1, 0, 1); PG8_SCHED; PG8_LDA(At, 0, 0); PG8_STAGE(PG8_SA(1, 1), a1 + hstep, voffA);
            PG8_WAIT_V(8); PG8_WAIT_L(0); PG8_BAR; PG8_MMA(0, 0, At, B0); PG8_MMA(0, 1, At, B1); PG8_BAR; PG8_SCHED;
            PG8_LDA(At, 0, 1); PG8_STAGE(PG8_SB(0, 0), b2, voffB); PG8_STAGE(PG8_SB(0, 1), b2 + hstep, voffB); PG8_STAGE(PG8_SA(0, 0), a2, voffA);
            PG8_WAIT_V(8); PG8_WAIT_L(0); PG8_BAR; PG8_MMA(1, 0, At, B0); PG8_MMA(1, 1, At, B1); PG8_BAR; PG8_SCHED;
            PG8_LDB(B0, 1, 0); PG8_LDB(B1, 1, 1); PG8_SCHED; PG8_LDA(At, 1, 0); PG8_STAGE(PG8_SA(0, 1), a2 + hstep, voffA);
            PG8_WAIT_V(8); PG8_WAIT_L(0); PG8_BAR; PG8_MMA(0, 0, At, B0); PG8_MMA(0, 1, At, B1); PG8_BAR; PG8_SCHED;
            PG8_LDA(At, 1, 1); PG8_STAGE(PG8_SB(1, 0), b3, voffB); PG8_STAGE(PG8_SB(1, 1), b3 + hstep, voffB); PG8_STAGE(PG8_SA(1, 0), a3, voffA);
            PG8_WAIT_V(8); PG8_WAIT_L(0); PG8_BAR; PG8_MMA(1, 0, At, B0); PG8_MMA(1, 1, At, B1); PG8_BAR; PG8_SCHED;
            } else {
            PG8_LDB(B0, 0, 0); PG8_SCHED; PG8_LDA(At, 0, 0); PG8_STAGE(PG8_SA(1, 1), a1 + hstep, voffA);
            PG8_WAIT_L(8); PG8_BAR; PG8_WAIT_L(0); PG8_MMA(0, 0, At, B0); PG8_BAR; PG8_SCHED;
            PG8_LDB(B1, 0, 1); PG8_STAGE(PG8_SB(0, 0), b2, voffB);
            PG8_BAR; PG8_WAIT_L(0); PG8_MMA(0, 1, At, B1); PG8_BAR;
            PG8_LDA(At, 0, 1); PG8_STAGE(PG8_SA(0, 0), a2, voffA);
            PG8_BAR; PG8_WAIT_L(0); PG8_MMA(1, 0, At, B0); PG8_BAR; PG8_SCHED;
            PG8_STAGE(PG8_SB(0, 1), b2 + hstep, voffB);
            PG8_WAIT_V(6); PG8_BAR; PG8_MMA(1, 1, At, B1); PG8_BAR;
            PG8_LDB(B0, 1, 0); PG8_SCHED; PG8_LDA(At, 1, 0); PG8_STAGE(PG8_SA(0, 1), a2 + hstep, voffA);
            PG8_WAIT_L(8); PG8_BAR; PG8_WAIT_L(0); PG8_MMA(0, 0, At, B0); PG8_BAR; PG8_SCHED;
            PG8_LDB(B1, 1, 1); PG8_STAGE(PG8_SB(1, 0), b3, voffB);
            PG8_BAR; PG8_WAIT_L(0); PG8_MMA(0, 1, At, B1); PG8_BAR;
            PG8_LDA(At, 1, 1); PG8_STAGE(PG8_SA(1, 0), a3, voffA);
            PG8_BAR; PG8_WAIT_L(0); PG8_MMA(1, 0, At, B0); PG8_BAR; PG8_SCHED;
            PG8_STAGE(PG8_SB(1, 1), b3 + hstep, voffB);
            PG8_WAIT_V(6); PG8_BAR; PG8_MMA(1, 1, At, B1); PG8_BAR;
            }
        }
        if constexpr (ALIGN_EPI) { if (wr == 0) PG8_BAR; }
        if constexpr (!Epi::AFTER_DRAIN) { E(acc, cur, wr, wc, fr, fq); S.done(cur); }
        if (!has_next) break;
#pragma unroll
        for (int a = 0; a < 2; ++a)
#pragma unroll
            for (int b = 0; b < 2; ++b)
#pragma unroll
                for (int m = 0; m < 4; ++m)
#pragma unroll
                    for (int n = 0; n < 2; ++n) acc[a][b][m][n] = (f32x4){0.f, 0.f, 0.f, 0.f};
        cur = nxt; cA = nA; cB = nB; ++ui;
        if constexpr (ALIGN_EPI) { if (wr == 1) PG8_BAR; }
    }
    PG8_WAIT_V(0);
    if constexpr (!ALIGN_EPI) { if (wr == 0) PG8_BAR; }
    PG8_BAR;
    if constexpr (Epi::AFTER_DRAIN) { E.fused(acc, cur, wr, wc, fr, fq, lds, wid, lane); S.done(cur); }
#undef PG8_SA
#undef PG8_SB
#undef PG8_STAGE
#undef PG8_LDA
#undef PG8_LDB
#undef PG8_MMA
#undef PG8_WAIT_V
#undef PG8_WAIT_L
#undef PG8_BAR
#undef PG8_SCHED
}
}
typedef __bf16 bf16x2_t __attribute__((ext_vector_type(2)));
typedef float f32x2_t __attribute__((ext_vector_type(2)));
typedef short bf16x8 __attribute__((ext_vector_type(8)));
typedef float f32x16 __attribute__((ext_vector_type(16)));
#define MFMA32(a, b, c) __builtin_amdgcn_mfma_f32_32x32x16_bf16((a), (b), (c), 0, 0, 0)
__device__ __forceinline__ unsigned pkbf(float a, float b) { bf16x2_t v = __builtin_convertvector((f32x2_t){a, b}, bf16x2_t); return __builtin_bit_cast(unsigned, v); }
__device__ __forceinline__ bf16x8 pack8(const f32x16& x, int s) { v4u p; p.x = pkbf(x[8 * s], x[8 * s + 1]); p.y = pkbf(x[8 * s + 2], x[8 * s + 3]); p.z = pkbf(x[8 * s + 4], x[8 * s + 5]); p.w = pkbf(x[8 * s + 6], x[8 * s + 7]); return __builtin_bit_cast(bf16x8, p); }
__device__ __forceinline__ f32x16 zero16() { f32x16 z;
#pragma unroll
    for (int i = 0; i < 16; ++i) z[i] = 0.f; return z; }
constexpr int CHUNK = 64, NCH = SEQ / CHUNK;
constexpr float QSCALE = 0.08838834764831845f;
__device__ __forceinline__ void glds_blocks(LAS unsigned char* dst, const unsigned char* src, int nblk, int wv, int nw, int lane) {
    for (int b = wv; b < nblk; b += nw)
        __builtin_amdgcn_global_load_lds((const unsigned*)(src + (size_t)b * 1024 + lane * 16), (LAS unsigned*)(dst + b * 1024), 16, 0, 0);
}
__device__ __forceinline__ bf16x8 lds_frag(const LAS unsigned char* base, int blk, int lane) { return *(const LAS bf16x8*)(base + blk * 1024 + lane * 16); }

namespace gdn {
constexpr int B_KA = 0, B_QA = 16384, B_SC = 32768, B_KT = 34816, B_TBF = 51200, B_AF = 59392, B_TBB = 67584, B_AB = 75776, B_VT = 83968, BLOB = 100352;
constexpr int XBLK = 34, YBLK = 32;
}

__device__ __forceinline__ float row16_sum(float v) {
    v += __builtin_bit_cast(float, __builtin_amdgcn_mov_dpp(__builtin_bit_cast(int, v), 0xB1, 0xF, 0xF, true));
    v += __builtin_bit_cast(float, __builtin_amdgcn_mov_dpp(__builtin_bit_cast(int, v), 0x4E, 0xF, 0xF, true));
    v += __builtin_bit_cast(float, __builtin_amdgcn_mov_dpp(__builtin_bit_cast(int, v), 0x141, 0xF, 0xF, true));
    v += __builtin_bit_cast(float, __builtin_amdgcn_mov_dpp(__builtin_bit_cast(int, v), 0x140, 0xF, 0xF, true));
    return v;
}
__device__ __forceinline__ float quad_sum(float v) {
    v += __builtin_bit_cast(float, __builtin_amdgcn_mov_dpp(__builtin_bit_cast(int, v), 0xB1, 0xF, 0xF, true));
    v += __builtin_bit_cast(float, __builtin_amdgcn_mov_dpp(__builtin_bit_cast(int, v), 0x4E, 0xF, 0xF, true));
    return v;
}
struct GdnPrepArgs {
    const bf16 *pq, *pk, *pv;
    const float* small;
    const float* conv_w;
    const float *a_log_f, *a_log_b, *dtb_f, *dtb_b;
    unsigned char* blob;
    int nseq, pad_;
};
namespace gdn {
constexpr int L_PRE = 0, L_QN = 52224, L_KN = L_QN + 17408, L_SC = L_KN + 17408, L_LPF = L_SC + 1024, L_LPB = L_LPF + 16384, L_AF = L_LPB + 16384, L_AB = L_AF + 9216, L_TBF = L_AB + 9216, L_TBB = L_TBF + 9216, L_END = L_TBB + 9216;
static_assert(L_END <= 160 * 1024 - 256, "gdn prep LDS");
constexpr int QS_ = 272, AS_ = 144;

__device__ __forceinline__ v4u frag_rm_perm(const LAS unsigned char* img, int st, int rt, int ks, int lane) {
    const int r = lane & 31, hh = lane >> 5; const LAS unsigned char* p = img + (32 * rt + r) * st + (16 * ks + 4 * hh) * 2;
    const v2u lo = *(const LAS v2u*)p, hi = *(const LAS v2u*)(p + 16);
    return (v4u){lo.x, lo.y, hi.x, hi.y};
}
__device__ __forceinline__ v4u frag_tr_perm(const LAS unsigned char* img, int st, int rt, int ks, int lane) {
    const int r = lane & 31, hh = lane >> 5; const LAS unsigned char* p = img + (16 * ks + 4 * hh) * st + (32 * rt + r) * 2;
    unsigned short e[8];
#pragma unroll
    for (int j = 0; j < 8; ++j) e[j] = *(const LAS unsigned short*)(p + (8 * (j >> 2) + (j & 3)) * st);
    return (v4u){(unsigned)e[0] | ((unsigned)e[1] << 16), (unsigned)e[2] | ((unsigned)e[3] << 16), (unsigned)e[4] | ((unsigned)e[5] << 16), (unsigned)e[6] | ((unsigned)e[7] << 16)};
}
__device__ __forceinline__ v4u frag16_rm(const LAS unsigned char* img, int st, int rt, int ks, int lane) {
    const int r = lane & 15, q = lane >> 4; const LAS unsigned char* p = img + (16 * rt + r) * st + (32 * ks + 4 * q) * 2;
    const v2u lo = *(const LAS v2u*)p, hi = *(const LAS v2u*)(p + 32);
    return (v4u){lo.x, lo.y, hi.x, hi.y};
}
__device__ __forceinline__ v4u frag16_tr(const LAS unsigned char* img, int st, int rt, int ks, int lane) {
    const int r = lane & 15, q = lane >> 4; const LAS unsigned char* p = img + (32 * ks + 4 * q) * st + (16 * rt + r) * 2;
    unsigned short e[8];
#pragma unroll
    for (int j = 0; j < 8; ++j) e[j] = *(const LAS unsigned short*)(p + (16 * (j >> 2) + (j & 3)) * st);
    return (v4u){(unsigned)e[0] | ((unsigned)e[1] << 16), (unsigned)e[2] | ((unsigned)e[3] << 16), (unsigned)e[4] | ((unsigned)e[5] << 16), (unsigned)e[6] | ((unsigned)e[7] << 16)};
}
}

#define LBAR() do { asm volatile("s_waitcnt lgkmcnt(0)" ::: "memory"); __builtin_amdgcn_s_barrier(); asm volatile("" ::: "memory"); } while (0)
__device__ __forceinline__ void gdn_prep_issue(LAS unsigned char* lds, const GdnPrepArgs& A, int unit, int w, int lane, const unsigned char* zero_page) {
    using namespace gdn;
    const int n = unit % NCH, h = (unit / NCH) % 8, sq = unit / (NCH * 8); const size_t row0 = (size_t)sq * SEQ; const int t0 = n * CHUNK;
    for (int q4 = w; q4 < 51; q4 += 8) {
        const int seg = q4 * 4 + (lane >> 4), r = seg / 3, m = seg % 3, tl = t0 - 2 + r;
        const bf16* pmat = A.pq + (size_t)m * (size_t)(A.pk - A.pq);
        const unsigned char* src = (tl >= 0 && tl < SEQ) ? (const unsigned char*)(pmat + (row0 + tl) * 1024 + h * 128) : zero_page;
        __builtin_amdgcn_global_load_lds((const unsigned*)(src + (lane & 15) * 16), (LAS unsigned*)(lds + L_PRE + q4 * 1024), 16, 0, 0);
    }
}
__device__ __forceinline__ f32x4 gdn_prep_scal(const GdnPrepArgs& A, int unit, int lane) {
    const int n = unit % NCH, h = (unit / NCH) % 8, sq = unit / (NCH * 8);
    const float* sm = A.small + ((size_t)sq * SEQ + n * CHUNK + lane) * 64;
    return (f32x4){sm[h], sm[8 + h], sm[16 + h], sm[24 + h]};
}
__device__ __forceinline__ void gdn_prep_phase(LAS unsigned char* lds, const GdnPrepArgs& A, int bid, int G, const unsigned char* zero_page) {
    using namespace gdn;
    int tid_l = threadIdx.x; asm volatile("" : "+v"(tid_l));
    const int tid = tid_l, lane = tid & 63, w = __builtin_amdgcn_readfirstlane(tid >> 6);
    const int nunits = A.nseq * 8 * NCH; const int pflg = A.pad_;
    int unit = bid;
    f32x4 smn = (f32x4){0.f, 0.f, 0.f, 0.f};
    if (unit < nunits) { gdn_prep_issue(lds, A, unit, w, lane, zero_page); if (w == 0) smn = gdn_prep_scal(A, unit, lane); }
  for (; unit < nunits; unit += G) {
    const int h = (unit / NCH) % 8;
    unsigned char* blob = A.blob + (size_t)unit * BLOB;
    if (w == 0) {
        const float xf = smn.x + A.dtb_f[h], xb = smn.y + A.dtb_b[h];
        const float spf = xf > 20.f ? xf : log1pf(__expf(xf)), spb = xb > 20.f ? xb : log1pf(__expf(xb));
        const float gf = -__expf(A.a_log_f[h]) * spf, gb = -__expf(A.a_log_b[h]) * spb;
        float pf = gf, pb = gb;
#pragma unroll
        for (int o = 1; o < 64; o <<= 1) { const float yf = __shfl_up(pf, o), yb = __shfl_up(pb, o); if (lane >= o) { pf += yf; pb += yb; } }
        const float totb = __shfl(pb, 63);
        const float gcf = pf, gcb = totb - pb + gb;
        LAS float* sc = (LAS float*)(lds + L_SC);
        sc[lane] = gcf; sc[64 + lane] = gcb; sc[128 + lane] = sigmoidf_(smn.z); sc[192 + lane] = sigmoidf_(smn.w);
        float* gsc = (float*)(blob + B_SC); if (pflg & 8) gsc = (float*)(lds + L_LPF);
        const float glf = __shfl(pf, 63), glb = totb;
        gsc[lane] = gcf; gsc[64 + lane] = gcb; gsc[128 + lane] = __expf(gcf); gsc[192 + lane] = __expf(gcb); gsc[256 + lane] = __expf(glf - gcf); gsc[320 + lane] = __expf(glb - gcb);
        if (lane < 2) gsc[384 + lane] = __expf(lane ? glb : glf);
    }
    __syncthreads();
    if (!(pflg & 32)) {
        const int p0 = 8 * w;
#pragma unroll
        for (int m = 0; m < 3; ++m) {
            float wc[5][2];
#pragma unroll
            for (int tau = 0; tau < 5; ++tau) { const f32x2_t t2 = *(const f32x2_t*)(A.conv_w + tau * 3072 + m * 1024 + h * 128 + 2 * lane); wc[tau][0] = t2.x; wc[tau][1] = t2.y; }
            float in[12][2];
#pragma unroll
            for (int i = 0; i < 12; ++i) { const unsigned u = *(const LAS unsigned*)(lds + L_PRE + ((p0 + i) * 3 + m) * 256 + lane * 4); in[i][0] = bflo(u); in[i][1] = bfhi(u); }
            float y[8][2];
#pragma unroll
            for (int pp = 0; pp < 8; ++pp)
#pragma unroll
                for (int c = 0; c < 2; ++c) { float s = 0.f;
#pragma unroll
                    for (int tau = 0; tau < 5; ++tau) s += wc[tau][c] * in[pp + tau][c];
                    y[pp][c] = s * __builtin_amdgcn_rcpf(1.0f + __builtin_amdgcn_exp2f(-1.4426950408889634f * s)); }
            if (m < 2) {
#pragma unroll
                for (int pp = 0; pp < 8; ++pp) { float ss = row16_sum(y[pp][0] * y[pp][0] + y[pp][1] * y[pp][1]); ss += __shfl_xor(ss, 16); ss += __shfl_xor(ss, 32); const float rn = __builtin_amdgcn_rsqf(ss + EPS);
                    *(LAS unsigned*)(lds + (m == 0 ? L_QN : L_KN) + (p0 + pp) * QS_ + lane * 4) = pkbf(y[pp][0] * rn, y[pp][1] * rn); }
            } else {
#pragma unroll
                for (int c = 0; c < 2; ++c) { v4u o; o.x = pkbf(y[0][c], y[1][c]); o.y = pkbf(y[2][c], y[3][c]); o.z = pkbf(y[4][c], y[5][c]); o.w = pkbf(y[6][c], y[7][c]);
                    if (!(pflg & 8)) *(v4u*)(blob + B_VT + (2 * lane + c) * 128 + p0 * 2) = o; }
            }
        }
    }
    __syncthreads();
    { const int un = unit + G; if (un < nunits) { gdn_prep_issue(lds, A, un, w, lane, zero_page); if (w == 0) smn = gdn_prep_scal(A, un, lane); } }
    {
        const int which = w >> 2, rt = (w >> 1) & 1, ct = w & 1, r = lane & 31, hh = lane >> 5;
        const LAS unsigned char* ia = lds + (which ? L_QN : L_KN) + (32 * rt + r) * QS_ + 16 * hh;
        const LAS unsigned char* ib = lds + L_KN + (32 * ct + r) * QS_ + 16 * hh;
        f32x16 acc = zero16();
#pragma unroll
        for (int ks = 0; ks < 8; ++ks) acc = MFMA32(*(const LAS bf16x8*)(ia + 32 * ks), *(const LAS bf16x8*)(ib + 32 * ks), acc);
        const LAS float* sc = (const LAS float*)(lds + L_SC);
        const int j = 32 * ct + r; const float gfj = sc[j], gbj = sc[64 + j];
#pragma unroll
        for (int reg = 0; reg < 16; ++reg) {
            const int i = 32 * rt + (reg & 3) + 8 * (reg >> 2) + 4 * hh; const float val = acc[reg];
            const float ef = __expf(sc[i] - gfj), eb = __expf(sc[64 + i] - gbj);
            if (which == 0) {
                const float lf = (i > j) ? sc[128 + i] * val * ef : 0.f, lb = (i < j) ? sc[192 + i] * val * eb : 0.f;
                ((LAS float*)(lds + L_LPF))[i * 64 + (j & 3) * 16 + (j >> 2)] = lf;
                const int i2 = 63 - i, j2 = 63 - j;
                ((LAS float*)(lds + L_LPB))[i2 * 64 + (j2 & 3) * 16 + (j2 >> 2)] = lb;
            } else {
                const float af = (i >= j) ? QSCALE * val * ef : 0.f, ab = (i <= j) ? QSCALE * val * eb : 0.f;
                *(LAS unsigned short*)(lds + L_AF + i * AS_ + j * 2) = (unsigned short)(pkbf(af, 0.f) & 0xffffu);
                *(LAS unsigned short*)(lds + L_AB + i * AS_ + j * 2) = (unsigned short)(pkbf(ab, 0.f) & 0xffffu);
            }
        }
    }
    LBAR();
    if (!(pflg & 16)) {
        const int dir = w >> 2, li = (w & 3) * 64 + lane, j = li >> 2, q = li & 3;
        const LAS float* LP = (const LAS float*)(lds + (dir ? L_LPB : L_LPF)) + q * 16;
        float t[16];
#pragma unroll
        for (int a = 0; a < 16; ++a) t[a] = 0.f;
#pragma unroll
        for (int i = 0; i < 64; ++i) {
            float p = 0.f;
#pragma unroll
            for (int a4 = 0; a4 < (i + 15) / 16; ++a4) { const f32x4 lv = *(const LAS f32x4*)(LP + i * 64 + 4 * a4);
                p += lv.x * t[4 * a4] + lv.y * t[4 * a4 + 1] + lv.z * t[4 * a4 + 2] + lv.w * t[4 * a4 + 3]; }
            p = quad_sum(p);
            const float ti = (i == j ? 1.f : 0.f) - p;
            if (q == (i & 3)) t[i >> 2] = ti;
        }
        const LAS float* sc = (const LAS float*)(lds + L_SC);
        if (dir == 0) { const float bj = sc[128 + j];
#pragma unroll
            for (int a = 0; a < 16; ++a) *(LAS unsigned short*)(lds + L_TBF + (4 * a + q) * AS_ + j * 2) = (unsigned short)(pkbf(t[a] * bj, 0.f) & 0xffffu);
        } else { const int jo = 63 - j; const float bj = sc[192 + jo];
#pragma unroll
            for (int a = 0; a < 16; ++a) *(LAS unsigned short*)(lds + L_TBB + (63 - (4 * a + q)) * AS_ + jo * 2) = (unsigned short)(pkbf(t[a] * bj, 0.f) & 0xffffu);
        }
    }
    LBAR();
    if (!(pflg & 64)) for (int blk = w; blk < 80; blk += 8) {
        v4u f; int off;
        if (blk < 16)      { f = frag16_rm(lds + L_KN, QS_, blk >> 2, blk & 3, lane); off = B_KA + blk * 1024; }
        else if (blk < 32) { const int b = blk - 16; f = frag16_rm(lds + L_QN, QS_, b >> 2, b & 3, lane); off = B_QA + b * 1024; }
        else if (blk < 48) { const int b = blk - 32; f = frag16_tr(lds + L_KN, QS_, b >> 1, b & 1, lane); off = B_KT + b * 1024; }
        else { const int b = blk - 48, wh = b >> 3, bb = b & 7; const int lo = wh == 0 ? L_TBF : wh == 1 ? L_AF : wh == 2 ? L_TBB : L_AB;
               f = frag16_rm(lds + lo, AS_, bb >> 1, bb & 1, lane); off = B_TBF + b * 1024; }
        if (!(pflg & 8)) *(v4u*)(blob + off + lane * 16) = f; else asm volatile("" :: "v"(f));
    }
    LBAR();
  }
}
struct GdnChainArgs {
    const unsigned char* blob;
    unsigned char* stg;
    unsigned* flag;
    int nseq, flags;
};
namespace gdn { constexpr int C_Y = XBLK * 1024, C_BUF = C_Y + YBLK * 1024, C_END = 2 * C_BUF; }
#define CHAIN_SPIN_CAP (1u << 22)
#define MFMA16(a, b, c) __builtin_amdgcn_mfma_f32_16x16x32_bf16((a), (b), (c), 0, 0, 0)
__device__ __forceinline__ bf16x8 pack16(const f32x4& a, const f32x4& b) { v4u p; p.x = pkbf(a.x, a.y); p.y = pkbf(a.z, a.w); p.z = pkbf(b.x, b.y); p.w = pkbf(b.z, b.w); return __builtin_bit_cast(bf16x8, p); }

__device__ __forceinline__ void gdn_chain_unit(LAS unsigned char* lds, const GdnChainArgs& A, int item) {
    using namespace gdn;
    int tid_l = threadIdx.x; asm volatile("" : "+v"(tid_l));
    const int tid = tid_l, lane = tid & 63, w = __builtin_amdgcn_readfirstlane(tid >> 6);
    const int r = lane & 15, q = lane >> 4;
    const int c = item & 1, h = (item >> 1) & 7, sq = item >> 4; const int flags = A.flags;
    const size_t unit0 = (size_t)(sq * 8 + h) * NCH;
    const f32x4 z4 = (f32x4){0.f, 0.f, 0.f, 0.f};
    f32x4 S[8];
#pragma unroll
    for (int t = 0; t < 8; ++t) S[t] = z4;
    v2u vnext[4];
    unsigned long long pwn[4]; bool have = false; unsigned fnext = 0u;
#define GDN_ISSUE(s_, buf_) do { const int n_ = c ? NCH - 1 - (s_) : (s_); const unsigned char* bl_ = A.blob + (unit0 + n_) * BLOB; LAS unsigned char* d_ = lds + (buf_) * C_BUF; \
        { const unsigned char* vp_ = bl_ + B_VT + (16 * w + r) * 128 + 8 * q; _Pragma("unroll") for (int i = 0; i < 4; ++i) vnext[i] = *(const v2u*)(vp_ + 32 * i); } \
        if (!(flags & 4)) { glds_blocks(d_, bl_, XBLK, w, 8, lane); \
            if (c == 0) glds_blocks(d_ + C_Y, bl_ + B_KT, YBLK, w, 8, lane); \
            else { glds_blocks(d_ + C_Y, bl_ + B_KT, 16, w, 8, lane); glds_blocks(d_ + C_Y + 16384, bl_ + B_TBB, 16, w, 8, lane); } } } while (0)
    GDN_ISSUE(0, 0);
    __syncthreads();
    for (int s = 0; s < NCH; ++s) {
        const int n = c ? NCH - 1 - s : s;
        v2u vcur[4];
#pragma unroll
        for (int i = 0; i < 4; ++i) vcur[i] = vnext[i];
        unsigned long long* sp = (unsigned long long*)(A.stg + (unit0 + n) * 16384 + w * 2048) + lane;
        unsigned* fl = A.flag + (unit0 + n) * 8 + w;
        unsigned long long pw[4];
        if (s >= NCH / 2 && !(flags & 1)) {
            if (have) {
#pragma unroll
                for (int i = 0; i < 4; ++i) pw[i] = pwn[i];
            } else {
                for (unsigned sp_ = 0; __builtin_amdgcn_readfirstlane((int)__hip_atomic_load(fl, __ATOMIC_RELAXED, __HIP_MEMORY_SCOPE_AGENT)) == 0 && sp_ < CHAIN_SPIN_CAP; ++sp_) __builtin_amdgcn_s_sleep(2);
#pragma unroll
                for (int i = 0; i < 4; ++i) pw[i] = __hip_atomic_load(sp + i * 64, __ATOMIC_RELAXED, __HIP_MEMORY_SCOPE_AGENT);
            }
        }
        have = false;
        if (s + 1 >= NCH / 2 && s + 1 < NCH && !(flags & 1) && __builtin_amdgcn_readfirstlane((int)fnext) != 0) {
            const int n1 = c ? NCH - 2 - s : s + 1; const unsigned long long* sp1 = (const unsigned long long*)(A.stg + (unit0 + n1) * 16384 + w * 2048) + lane;
#pragma unroll
            for (int i = 0; i < 4; ++i) pwn[i] = __hip_atomic_load(sp1 + i * 64, __ATOMIC_RELAXED, __HIP_MEMORY_SCOPE_AGENT);
            have = true;
        }
        if (s + 2 >= NCH / 2 && s + 2 < NCH && !(flags & 1)) { const int n2 = c ? NCH - 3 - s : s + 2; fnext = __hip_atomic_load(A.flag + (unit0 + n2) * 8 + w, __ATOMIC_RELAXED, __HIP_MEMORY_SCOPE_AGENT); }
        if (s + 1 < NCH) GDN_ISSUE(s + 1, (s + 1) & 1);
        const LAS unsigned char* X = lds + (s & 1) * C_BUF; const LAS unsigned char* Y = X + C_Y; const LAS unsigned char* YT = Y + 16384;
        const LAS float* sc = (const LAS float*)(X + B_SC);
        bf16x8 sb[4];
#pragma unroll
        for (int k = 0; k < 4; ++k) sb[k] = pack16(S[2 * k], S[2 * k + 1]);
        f32x4 KS[4], QS[4];
#pragma unroll
        for (int rt = 0; rt < 4; ++rt) { KS[rt] = z4; QS[rt] = z4; }
        {
            constexpr int R = 8; bf16x8 ring[R];
#define G1_LD(i_) lds_frag(X + (((i_) & 1) ? B_QA : B_KA), ((i_) >> 3) * 4 + (((i_) >> 1) & 3), lane)
#pragma unroll
            for (int i = 0; i < R; ++i) ring[i] = G1_LD(i);
#pragma unroll
            for (int i = 0; i < 32; ++i) { const int rt = i >> 3, ks = (i >> 1) & 3;
                if (i & 1) QS[rt] = MFMA16(ring[i % R], sb[ks], QS[rt]); else KS[rt] = MFMA16(ring[i % R], sb[ks], KS[rt]);
                if (i + R < 32) ring[i % R] = G1_LD(i + R);
                __builtin_amdgcn_sched_barrier(0); }
#undef G1_LD
        }
#pragma unroll
        for (int rt = 0; rt < 4; ++rt) { const v2u vv = vcur[rt]; const f32x4 ev = *(const LAS f32x4*)(sc + 128 + c * 64 + 16 * rt + 4 * q);
            KS[rt].x = bflo(vv.x) - ev.x * KS[rt].x; KS[rt].y = bfhi(vv.x) - ev.y * KS[rt].y; KS[rt].z = bflo(vv.y) - ev.z * KS[rt].z; KS[rt].w = bfhi(vv.y) - ev.w * KS[rt].w; }
        bf16x8 rb[2] = {pack16(KS[0], KS[1]), pack16(KS[2], KS[3])};
        f32x4 vn[4];
#pragma unroll
        for (int rt = 0; rt < 4; ++rt) vn[rt] = z4;
        {   constexpr int R = 8; bf16x8 ring[R];
#pragma unroll
            for (int i = 0; i < R; ++i) ring[i] = lds_frag(YT, i, lane);
#pragma unroll
            for (int i = 0; i < 8; ++i) { vn[i >> 1] = MFMA16(ring[i], rb[i & 1], vn[i >> 1]); __builtin_amdgcn_sched_barrier(0); }
        }
        bf16x8 vb[2] = {pack16(vn[0], vn[1]), pack16(vn[2], vn[3])};
        f32x4 (&o)[4] = QS;
#pragma unroll
        for (int rt = 0; rt < 4; ++rt) { const f32x4 ev = *(const LAS f32x4*)(sc + 128 + c * 64 + 16 * rt + 4 * q);
            o[rt].x *= QSCALE * ev.x; o[rt].y *= QSCALE * ev.y; o[rt].z *= QSCALE * ev.z; o[rt].w *= QSCALE * ev.w; }
        {   constexpr int R = 8; bf16x8 ring[R];
#pragma unroll
            for (int i = 0; i < R; ++i) ring[i] = lds_frag(YT + 8192, i, lane);
#pragma unroll
            for (int i = 0; i < 8; ++i) { o[i >> 1] = MFMA16(ring[i], vb[i & 1], o[i >> 1]); __builtin_amdgcn_sched_barrier(0); }
        }
        if (!(flags & 1)) {
            if (s < NCH / 2) {
#pragma unroll
                for (int rt = 0; rt < 4; ++rt) __hip_atomic_store(sp + rt * 64, (unsigned long long)pkbf(o[rt].x, o[rt].y) | ((unsigned long long)pkbf(o[rt].z, o[rt].w) << 32), __ATOMIC_RELAXED, __HIP_MEMORY_SCOPE_AGENT);
            } else {
#pragma unroll
                for (int rt = 0; rt < 4; ++rt) { const unsigned plo = (unsigned)pw[rt], phi = (unsigned)(pw[rt] >> 32);
                    __hip_atomic_store(sp + rt * 64, (unsigned long long)pkbf(o[rt].x + bflo(plo), o[rt].y + bfhi(plo)) | ((unsigned long long)pkbf(o[rt].z + bflo(phi), o[rt].w + bfhi(phi)) << 32), __ATOMIC_RELAXED, __HIP_MEMORY_SCOPE_AGENT); }
            }
        }
#pragma unroll
        for (int rt = 0; rt < 4; ++rt) { const f32x4 ev = *(const LAS f32x4*)(sc + 256 + c * 64 + 16 * rt + 4 * q);
            vn[rt].x *= ev.x; vn[rt].y *= ev.y; vn[rt].z *= ev.z; vn[rt].w *= ev.w; }
        vb[0] = pack16(vn[0], vn[1]); vb[1] = pack16(vn[2], vn[3]);
        const float egl = sc[384 + c];
#pragma unroll
        for (int t = 0; t < 8; ++t) { S[t].x *= egl; S[t].y *= egl; S[t].z *= egl; S[t].w *= egl; }
        {   constexpr int R = 8; bf16x8 ring[R];
#pragma unroll
            for (int i = 0; i < R; ++i) ring[i] = lds_frag(Y, i, lane);
#pragma unroll
            for (int i = 0; i < 16; ++i) { S[i >> 1] = MFMA16(ring[i % R], vb[i & 1], S[i >> 1]); if (i + R < 16) ring[i % R] = lds_frag(Y, i + R, lane); __builtin_amdgcn_sched_barrier(0); }
        }
        if (!(flags & 1)) { asm volatile("s_waitcnt vmcnt(0)" ::: "memory"); if (lane == 0) __hip_atomic_store(fl, s < NCH / 2 ? 1u : 2u, __ATOMIC_RELAXED, __HIP_MEMORY_SCOPE_AGENT); }
        __syncthreads();
    }
#undef GDN_ISSUE
}
namespace gla {
constexpr int B_QGF = 0, B_QGB = 16384, B_SC = 32768, B_KDTF = 33792, B_KDTB = 50176, BLOBA = 66560;
constexpr int B_VB = 0, B_INTRA = 32768, BLOBB = 65536;
constexpr int L_R = 0, L_QGF = 8192, L_KGF = L_QGF + 17408, L_KDF = L_KGF + 17408, L_QGB = L_KDF + 17408, L_KGB = L_QGB + 17408, L_KDB = L_KGB + 17408, L_V = L_KDB + 17408, L_TOT = L_V + 33792, L_AS = L_TOT + 4096, L_END = L_AS + 9216;
static_assert(L_END <= 160 * 1024 - 256, "gla prep LDS");
constexpr int QS_ = 272, VS_ = 528, AS_ = 144;
constexpr int C_X = 0, C_Y = 17408, C_CHAIN = 66560, C_EG = 2 * C_CHAIN, C_END = C_EG + 1024;
__device__ __forceinline__ v4u frag_tr_nat(const LAS unsigned char* img, int st, int colbase, int ks, int lane) {
    const int r = lane & 31, hh = lane >> 5; const LAS unsigned char* p = img + (16 * ks + 8 * hh) * st + (colbase + r) * 2;
    unsigned short e[8];
#pragma unroll
    for (int j = 0; j < 8; ++j) e[j] = *(const LAS unsigned short*)(p + j * st);
    return (v4u){(unsigned)e[0] | ((unsigned)e[1] << 16), (unsigned)e[2] | ((unsigned)e[3] << 16), (unsigned)e[4] | ((unsigned)e[5] << 16), (unsigned)e[6] | ((unsigned)e[7] << 16)};
}
__device__ __forceinline__ float logsig2(float x) { const float xc = fminf(fmaxf(x, -60.f), 60.f); return -__builtin_amdgcn_logf(1.0f + __builtin_amdgcn_exp2f(-1.4426950408889634f * xc)); }
}

struct GlaPrepArgs {
    const bf16* qk;
    const bf16* vb;
    const float* small;
    const float *w2f, *b2f, *w2b, *b2b;
    unsigned char* blobA;
    unsigned char* blobB;
    int nseq, pad_;
};

__device__ __forceinline__ void gla_prep_phase(LAS unsigned char* lds, const GlaPrepArgs& A, int bid, int G) {
    using namespace gla;
    int tid_l = threadIdx.x; asm volatile("" : "+v"(tid_l));
    const int tid = tid_l, lane = tid & 63, w = __builtin_amdgcn_readfirstlane(tid >> 6);
    const int nunits = A.nseq * 4 * NCH;
    f32x4 pr; v4u pv[4], pq[2], pk[2];
#define GLA_PREFETCH(u_) do { const int n_ = (u_) % NCH, h_ = ((u_) / NCH) % 4, sq_ = (u_) / (NCH * 4); const size_t r_ = (size_t)sq_ * SEQ + n_ * CHUNK; \
        pr = *(const f32x4*)(A.small + (r_ + (tid >> 3)) * 64 + 32 + (tid & 7) * 4); \
        _Pragma("unroll") for (int i = 0; i < 4; ++i) { const int id = i * 512 + tid; pv[i] = *(const v4u*)(A.vb + (r_ + (id >> 5)) * 1024 + h_ * 256 + (id & 31) * 8); } \
        _Pragma("unroll") for (int i = 0; i < 2; ++i) { const int id = i * 512 + tid; const bf16* qp_ = A.qk + (r_ + (id >> 4)) * 1024 + h_ * 128 + (id & 15) * 8; pq[i] = *(const v4u*)qp_; pk[i] = *(const v4u*)(qp_ + 512); } } while (0)
    int unit = bid;
    if (unit < nunits) GLA_PREFETCH(unit);
  for (; unit < nunits; unit += G) {
    const int h = (unit / NCH) % 4;
    unsigned char* blob = A.blobA + (size_t)unit * BLOBA; unsigned char* blobB = A.blobB + (size_t)unit * BLOBB;
    *(LAS f32x4*)(lds + L_R + (tid >> 3) * 128 + (tid & 7) * 16) = pr;
#pragma unroll
    for (int i = 0; i < 4; ++i) { const int id = i * 512 + tid; *(LAS v4u*)(lds + L_V + (id >> 5) * VS_ + (id & 31) * 16) = pv[i]; }
#pragma unroll
    for (int i = 0; i < 2; ++i) { const int id = i * 512 + tid; *(LAS v4u*)(lds + L_QGF + (id >> 4) * QS_ + (id & 15) * 16) = pq[i]; *(LAS v4u*)(lds + L_KGF + (id >> 4) * QS_ + (id & 15) * 16) = pk[i]; }
    LBAR();
    {
        const int dd = tid & 127, pg = tid >> 7, d = h * 128 + dd;
        float wf[16], wb[16];
#pragma unroll
        for (int i = 0; i < 16; ++i) { wf[i] = A.w2f[i * 512 + d]; wb[i] = A.w2b[i * 512 + d]; }
        const float bf_ = A.b2f[d], bb_ = A.b2b[d];
        float lf[16], lb[16];
#pragma unroll
        for (int pp = 0; pp < 16; ++pp) {
            const LAS float* rr = (const LAS float*)(lds + L_R) + (pg * 16 + pp) * 32;
            float xf = bf_, xb = bb_;
#pragma unroll
            for (int i4 = 0; i4 < 4; ++i4) { const f32x4 a = *(const LAS f32x4*)(rr + 4 * i4), b = *(const LAS f32x4*)(rr + 16 + 4 * i4);
                xf += a.x * wf[4 * i4] + a.y * wf[4 * i4 + 1] + a.z * wf[4 * i4 + 2] + a.w * wf[4 * i4 + 3];
                xb += b.x * wb[4 * i4] + b.y * wb[4 * i4 + 1] + b.z * wb[4 * i4 + 2] + b.w * wb[4 * i4 + 3]; }
            lf[pp] = logsig2(xf) * (1.f / 16.f); lb[pp] = logsig2(xb) * (1.f / 16.f);
        }
#pragma unroll
        for (int pp = 1; pp < 16; ++pp) lf[pp] += lf[pp - 1];
#pragma unroll
        for (int pp = 14; pp >= 0; --pp) lb[pp] += lb[pp + 1];
        LAS float* tot = (LAS float*)(lds + L_TOT);
        tot[pg * 128 + dd] = lf[15]; tot[512 + pg * 128 + dd] = lb[0];
        LBAR();
        float offf = 0.f, offb = 0.f, glf = 0.f, glb = 0.f;
#pragma unroll
        for (int g = 0; g < 4; ++g) { const float tf = tot[g * 128 + dd], tb = tot[512 + g * 128 + dd]; glf += tf; glb += tb; if (g < pg) offf += tf; if (g > pg) offb += tb; }
        const float eglf = __builtin_amdgcn_exp2f(glf), eglb = __builtin_amdgcn_exp2f(glb);
        if (pg == 0) { float* sc = (float*)(blob + B_SC); sc[dd] = eglf; sc[128 + dd] = eglb; }
#pragma unroll
        for (int pp = 0; pp < 16; ++pp) {
            const int o = (pg * 16 + pp) * QS_ + dd * 2;
            const float qv = bf2f(*(const LAS unsigned short*)(lds + L_QGF + o)) * QSCALE, kv = bf2f(*(const LAS unsigned short*)(lds + L_KGF + o));
            const float ef = __builtin_amdgcn_exp2f(lf[pp] + offf), eb = __builtin_amdgcn_exp2f(lb[pp] + offb);
            const float rf = __builtin_amdgcn_rcpf(ef), rb = __builtin_amdgcn_rcpf(eb);
            *(LAS unsigned short*)(lds + L_QGF + o) = (unsigned short)(pkbf(qv * ef, 0.f) & 0xffffu);
            *(LAS unsigned short*)(lds + L_KGF + o) = (unsigned short)(pkbf(kv * rf, 0.f) & 0xffffu);
            *(LAS unsigned short*)(lds + L_KDF + o) = (unsigned short)(pkbf(kv * rf * eglf, 0.f) & 0xffffu);
            *(LAS unsigned short*)(lds + L_QGB + o) = (unsigned short)(pkbf(qv * eb, 0.f) & 0xffffu);
            *(LAS unsigned short*)(lds + L_KGB + o) = (unsigned short)(pkbf(kv * rb, 0.f) & 0xffffu);
            *(LAS unsigned short*)(lds + L_KDB + o) = (unsigned short)(pkbf(kv * rb * eglb, 0.f) & 0xffffu);
        }
    }
    LBAR();
    { const int un = unit + G; if (un < nunits) GLA_PREFETCH(un); }
    if (w < 4) {
        const int rt = w >> 1, ct = w & 1, r = lane & 31, hh = lane >> 5;
        f32x16 af = zero16(), ab = zero16();
        if (rt >= ct) { const LAS unsigned char* ia = lds + L_QGF + (32 * rt + r) * QS_ + 16 * hh; const LAS unsigned char* ib = lds + L_KGF + (32 * ct + r) * QS_ + 16 * hh;
#pragma unroll
            for (int ks = 0; ks < 8; ++ks) af = MFMA32(*(const LAS bf16x8*)(ia + 32 * ks), *(const LAS bf16x8*)(ib + 32 * ks), af); }
        if (rt <= ct) { const LAS unsigned char* ia = lds + L_QGB + (32 * rt + r) * QS_ + 16 * hh; const LAS unsigned char* ib = lds + L_KGB + (32 * ct + r) * QS_ + 16 * hh;
#pragma unroll
            for (int ks = 0; ks < 8; ++ks) ab = MFMA32(*(const LAS bf16x8*)(ia + 32 * ks), *(const LAS bf16x8*)(ib + 32 * ks), ab); }
        const int j = 32 * ct + r;
#pragma unroll
        for (int reg = 0; reg < 16; ++reg) { const int i = 32 * rt + (reg & 3) + 8 * (reg >> 2) + 4 * hh;
            const float val = (i >= j ? af[reg] : 0.f) + (i <= j ? ab[reg] : 0.f);
            *(LAS unsigned short*)(lds + L_AS + i * AS_ + j * 2) = (unsigned short)(pkbf(val, 0.f) & 0xffffu); }
    } else {
        for (int blk = w - 4; blk < 64; blk += 4) {
            const int wh = blk >> 4, b = blk & 15; v4u f; int off;
            if (wh == 0)      { f = gdn::frag_rm_perm(lds + L_QGF, QS_, b >> 3, b & 7, lane); off = B_QGF; }
            else if (wh == 1) { f = gdn::frag_rm_perm(lds + L_QGB, QS_, b >> 3, b & 7, lane); off = B_QGB; }
            else if (wh == 2) { f = frag_tr_nat(lds + L_KDF, QS_, 32 * (b >> 2), b & 3, lane); off = B_KDTF; }
            else              { f = frag_tr_nat(lds + L_KDB, QS_, 32 * (b >> 2), b & 3, lane); off = B_KDTB; }
            *(v4u*)(blob + off + b * 1024 + lane * 16) = f;
        }
    }
    LBAR();
    {
        const int ct = w, r = lane & 31, hh = lane >> 5;
        f32x16 o[2] = {zero16(), zero16()};
#pragma unroll
        for (int ks = 0; ks < 4; ++ks) {
            const v4u fb = frag_tr_nat(lds + L_V, VS_, 32 * ct, ks, lane);
            *(v4u*)(blobB + B_VB + (ct * 4 + ks) * 1024 + lane * 16) = fb;
            const bf16x8 bfr = __builtin_bit_cast(bf16x8, fb);
#pragma unroll
            for (int rt = 0; rt < 2; ++rt) o[rt] = MFMA32(*(const LAS bf16x8*)(lds + L_AS + (32 * rt + r) * AS_ + (16 * ks + 8 * hh) * 2), bfr, o[rt]);
        }
        unsigned long long* ip = (unsigned long long*)(blobB + B_INTRA) + (size_t)ct * 512 + lane;
#pragma unroll
        for (int rt = 0; rt < 2; ++rt)
#pragma unroll
            for (int g = 0; g < 4; ++g) ip[(rt * 4 + g) * 64] = (unsigned long long)pkbf(o[rt][4 * g], o[rt][4 * g + 1]) | ((unsigned long long)pkbf(o[rt][4 * g + 2], o[rt][4 * g + 3]) << 32);
    }
    LBAR();
  }
#undef GLA_PREFETCH
}

struct GlaChainArgs {
    const unsigned char* blobA;
    const unsigned char* blobB;
    unsigned char* stg;
    unsigned* flag;
    int nseq, flags;
};
namespace gla { constexpr int CB_Y = 17408, CB_BUF = 66560, CB_END = 2 * CB_BUF; }
__device__ __forceinline__ void gla_chain_unit(LAS unsigned char* lds, const GlaChainArgs& A, int item) {
    using namespace gla;
    int tid_l = threadIdx.x; asm volatile("" : "+v"(tid_l));
    const int tid = tid_l, lane = tid & 63, w = __builtin_amdgcn_readfirstlane(tid >> 6);
    const int hh = lane >> 5;
    const int c = item & 1, h = (item >> 1) & 3, sq = item >> 3; const int flags = A.flags;
    const size_t unit0 = (size_t)(sq * 4 + h) * NCH;
    f32x16 S[4];
#pragma unroll
    for (int t = 0; t < 4; ++t) S[t] = zero16();
    unsigned long long pwn[8]; bool have = false; unsigned fnext = 0u;
#define GLA_ISSUE(s_, buf_) do { if (!(flags & 4)) { const int n_ = c ? NCH - 1 - (s_) : (s_); const unsigned char* bl_ = A.blobA + (unit0 + n_) * BLOBA; const unsigned char* bb_ = A.blobB + (unit0 + n_) * BLOBB; \
        LAS unsigned char* d_ = lds + (buf_) * CB_BUF; glds_blocks(d_, bl_ + (c ? B_QGB : B_QGF), 16, w, 8, lane); if (w == 7) glds_blocks(d_ + 16384, bl_ + B_SC, 1, 0, 1, lane); \
        glds_blocks(d_ + CB_Y, bl_ + (c ? B_KDTB : B_KDTF), 16, w, 8, lane); glds_blocks(d_ + CB_Y + 16384, bb_ + B_VB, 32, w, 8, lane); } } while (0)
    GLA_ISSUE(0, 0);
    __syncthreads();
    for (int s = 0; s < NCH; ++s) {
        const int n = c ? NCH - 1 - s : s;
        unsigned long long* sp = (unsigned long long*)(A.stg + (unit0 + n) * 32768) + (size_t)w * 512 + lane;
        unsigned* fl = A.flag + (unit0 + n) * 8 + w;
        unsigned long long pw[8];
        if (s >= NCH / 2 && !(flags & 1)) {
            if (have) {
#pragma unroll
                for (int i = 0; i < 8; ++i) pw[i] = pwn[i];
            } else {
                for (unsigned sp_ = 0; __builtin_amdgcn_readfirstlane((int)__hip_atomic_load(fl, __ATOMIC_RELAXED, __HIP_MEMORY_SCOPE_AGENT)) == 0 && sp_ < CHAIN_SPIN_CAP; ++sp_) __builtin_amdgcn_s_sleep(2);
#pragma unroll
                for (int i = 0; i < 8; ++i) pw[i] = __hip_atomic_load(sp + i * 64, __ATOMIC_RELAXED, __HIP_MEMORY_SCOPE_AGENT);
            }
        }
        have = false;
        if (s + 1 >= NCH / 2 && s + 1 < NCH && !(flags & 1) && __builtin_amdgcn_readfirstlane((int)fnext) != 0) {
            const int n1 = c ? NCH - 2 - s : s + 1; const unsigned long long* sp1 = (const unsigned long long*)(A.stg + (unit0 + n1) * 32768) + (size_t)w * 512 + lane;
#pragma unroll
            for (int i = 0; i < 8; ++i) pwn[i] = __hip_atomic_load(sp1 + i * 64, __ATOMIC_RELAXED, __HIP_MEMORY_SCOPE_AGENT);
            have = true;
        }
        if (s + 2 >= NCH / 2 && s + 2 < NCH && !(flags & 1)) { const int n2 = c ? NCH - 3 - s : s + 2; fnext = __hip_atomic_load(A.flag + (unit0 + n2) * 8 + w, __ATOMIC_RELAXED, __HIP_MEMORY_SCOPE_AGENT); }
        if (s + 1 < NCH) GLA_ISSUE(s + 1, (s + 1) & 1);
        const LAS unsigned char* X = lds + (s & 1) * CB_BUF; const LAS unsigned char* Y = X + CB_Y;
        const LAS float* EG = (const LAS float*)(X + 16384) + c * 128;
        bf16x8 sb[8];
#pragma unroll
        for (int t = 0; t < 4; ++t) { sb[2 * t] = pack8(S[t], 0); sb[2 * t + 1] = pack8(S[t], 1); }
        f32x16 o[2] = {zero16(), zero16()};
        {   constexpr int R = 6; bf16x8 ring[R];
#pragma unroll
            for (int i = 0; i < R; ++i) ring[i] = lds_frag(X, i, lane);
#pragma unroll
            for (int i = 0; i < 16; ++i) { o[i >> 3] = MFMA32(ring[i % R], sb[i & 7], o[i >> 3]); if (i + R < 16) ring[i % R] = lds_frag(X, i + R, lane); __builtin_amdgcn_sched_barrier(0); }
        }
        if (!(flags & 1)) {
            if (s < NCH / 2) {
#pragma unroll
                for (int rt = 0; rt < 2; ++rt)
#pragma unroll
                    for (int g = 0; g < 4; ++g) __hip_atomic_store(sp + (rt * 4 + g) * 64, (unsigned long long)pkbf(o[rt][4 * g], o[rt][4 * g + 1]) | ((unsigned long long)pkbf(o[rt][4 * g + 2], o[rt][4 * g + 3]) << 32), __ATOMIC_RELAXED, __HIP_MEMORY_SCOPE_AGENT);
            } else {
#pragma unroll
                for (int rt = 0; rt < 2; ++rt)
#pragma unroll
                    for (int g = 0; g < 4; ++g) { const unsigned plo = (unsigned)pw[rt * 4 + g], phi = (unsigned)(pw[rt * 4 + g] >> 32);
                        __hip_atomic_store(sp + (rt * 4 + g) * 64, (unsigned long long)pkbf(o[rt][4 * g] + bflo(plo), o[rt][4 * g + 1] + bfhi(plo)) | ((unsigned long long)pkbf(o[rt][4 * g + 2] + bflo(phi), o[rt][4 * g + 3] + bfhi(phi)) << 32), __ATOMIC_RELAXED, __HIP_MEMORY_SCOPE_AGENT); }
            }
        }
        {
            bf16x8 bfr[4];
#pragma unroll
            for (int ks = 0; ks < 4; ++ks) bfr[ks] = lds_frag(Y + 16384, w * 4 + ks, lane);
#pragma unroll
            for (int t = 0; t < 4; ++t)
#pragma unroll
                for (int g = 0; g < 4; ++g) { const f32x4 ev = *(const LAS f32x4*)(EG + 32 * t + 8 * g + 4 * hh);
                    S[t][4 * g] *= ev.x; S[t][4 * g + 1] *= ev.y; S[t][4 * g + 2] *= ev.z; S[t][4 * g + 3] *= ev.w; }
            constexpr int R = 5; bf16x8 ring[R];
#pragma unroll
            for (int i = 0; i < R; ++i) ring[i] = lds_frag(Y, i, lane);
#pragma unroll
            for (int i = 0; i < 16; ++i) { S[i >> 2] = MFMA32(ring[i % R], bfr[i & 3], S[i >> 2]); if (i + R < 16) ring[i % R] = lds_frag(Y, i + R, lane); __builtin_amdgcn_sched_barrier(0); }
        }
        if (!(flags & 1)) { asm volatile("s_waitcnt vmcnt(0)" ::: "memory"); if (lane == 0) __hip_atomic_store(fl, s < NCH / 2 ? 1u : 2u, __ATOMIC_RELAXED, __HIP_MEMORY_SCOPE_AGENT); }
        __syncthreads();
    }
#undef GLA_ISSUE
}

template <int NC, bool S16>
__device__ __forceinline__ void p4_unit(LAS unsigned char* lds, const unsigned char* slot, const unsigned char* intra, const bf16* zg, const float* nw, bf16* out, const unsigned* done) {
    int tid_l = threadIdx.x; asm volatile("" : "+v"(tid_l));
    const int tid = tid_l, lane = tid & 63, w = __builtin_amdgcn_readfirstlane(tid >> 6), r = lane & 31, hh = lane >> 5;
    constexpr int ST = NC * 2 + 16, NB = (NC / 32) * 8, CPR = NC / 8;
    if (done) {
        for (unsigned sp_ = 0; sp_ < (1u << 22); ++sp_) { const unsigned f = lane < 8 ? __hip_atomic_load(done + lane, __ATOMIC_RELAXED, __HIP_MEMORY_SCOPE_AGENT) : 2u; if (__all(f == 2u)) break; __builtin_amdgcn_s_sleep(8); }
    }
    for (int b = w; b < NB; b += 8) {
        const unsigned long long v = __hip_atomic_load((const unsigned long long*)slot + b * 64 + lane, __ATOMIC_RELAXED, __HIP_MEMORY_SCOPE_AGENT);
        float x0 = bflo((unsigned)v), x1 = bfhi((unsigned)v), x2 = bflo((unsigned)(v >> 32)), x3 = bfhi((unsigned)(v >> 32));
        if (intra) { const unsigned long long iv = ((const unsigned long long*)intra)[b * 64 + lane];
            x0 += bflo((unsigned)iv); x1 += bfhi((unsigned)iv); x2 += bflo((unsigned)(iv >> 32)); x3 += bfhi((unsigned)(iv >> 32)); }
        int row, col;
        if (S16) { row = 16 * (b & 3) + 4 * (lane >> 4); col = 16 * (b >> 2) + (lane & 15); }
        else { row = 32 * ((b >> 2) & 1) + 8 * (b & 3) + 4 * hh; col = 32 * (b >> 3) + r; }
        LAS unsigned char* p = lds + row * ST + col * 2;
        const unsigned a = pkbf(x0, x1), bq = pkbf(x2, x3);
        *(LAS unsigned short*)p = (unsigned short)(a & 0xffffu); *(LAS unsigned short*)(p + ST) = (unsigned short)(a >> 16);
        *(LAS unsigned short*)(p + 2 * ST) = (unsigned short)(bq & 0xffffu); *(LAS unsigned short*)(p + 3 * ST) = (unsigned short)(bq >> 16);
    }
    __syncthreads();
#pragma unroll
    for (int it = 0; it < (64 * CPR) / 512; ++it) {
        const int idx = it * 512 + tid, row = idx / CPR, ch = idx % CPR;
        const v4u xw = *(const LAS v4u*)(lds + row * ST + ch * 16);
        float x[8] = {bflo(xw.x), bfhi(xw.x), bflo(xw.y), bfhi(xw.y), bflo(xw.z), bfhi(xw.z), bflo(xw.w), bfhi(xw.w)};
        float ss = 0.f;
#pragma unroll
        for (int i = 0; i < 8; ++i) ss += x[i] * x[i];
        ss = row16_sum(ss);
        if (NC == 256) ss += __shfl_xor(ss, 16);
        const float rstd = 1.0f / sqrtf(ss * (1.0f / NC) + EPS);
        f32x4 w0 = *(const f32x4*)(nw + ch * 8), w1 = *(const f32x4*)(nw + ch * 8 + 4);
        if (zg) { const v4u zw = *(const v4u*)(zg + (size_t)row * 1024 + ch * 8);
            const float z[8] = {bflo(zw.x), bfhi(zw.x), bflo(zw.y), bfhi(zw.y), bflo(zw.z), bfhi(zw.z), bflo(zw.w), bfhi(zw.w)};
            w0.x *= z[0] * __builtin_amdgcn_rcpf(1.0f + __expf(-z[0])); w0.y *= z[1] * __builtin_amdgcn_rcpf(1.0f + __expf(-z[1])); w0.z *= z[2] * __builtin_amdgcn_rcpf(1.0f + __expf(-z[2])); w0.w *= z[3] * __builtin_amdgcn_rcpf(1.0f + __expf(-z[3]));
            w1.x *= z[4] * __builtin_amdgcn_rcpf(1.0f + __expf(-z[4])); w1.y *= z[5] * __builtin_amdgcn_rcpf(1.0f + __expf(-z[5])); w1.z *= z[6] * __builtin_amdgcn_rcpf(1.0f + __expf(-z[6])); w1.w *= z[7] * __builtin_amdgcn_rcpf(1.0f + __expf(-z[7])); }
        v4u o; o.x = pkbf(x[0] * rstd * w0.x, x[1] * rstd * w0.y); o.y = pkbf(x[2] * rstd * w0.z, x[3] * rstd * w0.w); o.z = pkbf(x[4] * rstd * w1.x, x[5] * rstd * w1.y); o.w = pkbf(x[6] * rstd * w1.z, x[7] * rstd * w1.w);
        *(v4u*)(out + (size_t)row * 1024 + ch * 8) = o;
    }
    __syncthreads();
}
#define XB_TMO      128
#define XB_XCNT(j)  (256  + 64 * (j))
#define XB_XSUB(j)  (1280 + 64 * (j))
#define XB_XGEN(j)  (2304 + 64 * (j))
#define XB_TOP      3328
#define XB_TOPGEN   3392
#define XCD_BAR_WORDS 3456
#define XB_SPIN_CAP (1u << 18)

__device__ __forceinline__ unsigned xb_ld(unsigned* p)              { return __hip_atomic_load(p, __ATOMIC_RELAXED, __HIP_MEMORY_SCOPE_AGENT); }
__device__ __forceinline__ unsigned xb_add(unsigned* p, unsigned v) { return __hip_atomic_fetch_add(p, v, __ATOMIC_RELAXED, __HIP_MEMORY_SCOPE_AGENT); }
__device__ __forceinline__ unsigned xb_xcc_id() { return (unsigned)__builtin_amdgcn_s_getreg((3 << 11) | 20) & 0xFu; }
#define XB_SPIN(cond, bar) do { unsigned _sp = 0; while (cond) { __builtin_amdgcn_s_sleep(1); \
    if ((++_sp & 255u) == 0u) { if (xb_ld(&(bar)[XB_TMO])) break; if (_sp > XB_SPIN_CAP) { atomicAdd(&(bar)[XB_TMO], 1u); break; } } } } while (0)

struct XcdBarrier {
    unsigned* bar; unsigned x;
    volatile LAS unsigned* st;
};

__device__ __forceinline__ XcdBarrier xcd_barrier_post(unsigned* bar, volatile LAS unsigned* st) {
    XcdBarrier b; b.bar = bar; b.x = xb_xcc_id(); b.st = st;
    if (threadIdx.x == 0) (void)xb_add(&bar[XB_XCNT(b.x)], 1u);
    return b;
}
__device__ __forceinline__ void xcd_barrier_complete(unsigned* bar, unsigned x, unsigned& nloc, unsigned& nx) {
    const unsigned G = gridDim.x * gridDim.y * gridDim.z;
    unsigned sum, cnt, mine, sp = 0u;
    for (;;) {
        sum = 0u; cnt = 0u; mine = 0u;
#pragma unroll
        for (unsigned j = 0; j < 16; ++j) { const unsigned c = xb_ld(&bar[XB_XCNT(j)]); sum += c; cnt += (c > 0u) ? 1u : 0u; mine = (j == x) ? c : mine; }
        if (sum == G) break;
        __builtin_amdgcn_s_sleep(1);
        if ((++sp & 255u) == 0u) { if (xb_ld(&bar[XB_TMO])) break; if (sp > XB_SPIN_CAP) { atomicAdd(&bar[XB_TMO], 1u); break; } }
    }
    nloc = mine > 0u ? mine : 1u; nx = cnt > 0u ? cnt : 1u;
}

__device__ __forceinline__ void xcd_barrier(const XcdBarrier& b) {
    asm volatile("s_waitcnt vmcnt(0)" ::: "memory");
    __syncthreads();
    if (threadIdx.x == 0) {
        unsigned* bar = b.bar;
        __builtin_amdgcn_s_waitcnt(0);
        unsigned nloc = b.st[0], nx = b.st[1];
        if (nloc == 0u) { xcd_barrier_complete(bar, b.x, nloc, nx); b.st[0] = nloc; b.st[1] = nx; }
        const unsigned old = xb_add(&bar[XB_XSUB(b.x)], 1u);
        const unsigned gen = old / nloc;
        if (old + 1u == (gen + 1u) * nloc) {
            __builtin_amdgcn_fence(__ATOMIC_RELEASE, "agent");
            asm volatile("s_waitcnt vmcnt(0)" ::: "memory");
            const unsigned og = xb_add(&bar[XB_TOP], 1u);
            const unsigned tg = og / nx;
            if (og + 1u == (tg + 1u) * nx) xb_add(&bar[XB_TOPGEN], 1u);
            else XB_SPIN(xb_ld(&bar[XB_TOPGEN]) == tg, bar);
            __builtin_amdgcn_fence(__ATOMIC_ACQUIRE, "agent");
            xb_add(&bar[XB_XGEN(b.x)], 1u);
            asm volatile("s_waitcnt vmcnt(0)" ::: "memory");
        } else {
            XB_SPIN(xb_ld(&bar[XB_XGEN(b.x)]) == gen, bar);
            __builtin_amdgcn_fence(__ATOMIC_ACQUIRE, "agent");
            asm volatile("s_waitcnt vmcnt(0)" ::: "memory");
        }
    }
    __syncthreads();
}
__device__ __forceinline__ void transpose_item(const float* W, int ldw, int src_col0, int K, int ncols, bf16* WT, int dst_row0, LAS float* scr, int item, int lane) {
    asm volatile("" : "+v"(lane));
    const int nblk = ncols / 32, kb = item / nblk, nb = item % nblk, k0 = 64 * kb, n0 = 32 * nb;
#pragma unroll 8
    for (int i = 0; i < 32; ++i) { const int kk = 2 * i + (lane >> 5); scr[kk * 33 + (lane & 31)] = W[(size_t)(k0 + kk) * ldw + src_col0 + n0 + (lane & 31)]; }
    LDS_WAIT();
    const int c = lane & 7;
#pragma unroll
    for (int j = 0; j < 4; ++j) { const int n = (lane >> 3) + 8 * j; const LAS float* s = scr + (8 * c) * 33 + n;
        v4u o; o.x = pk2(s[0 * 33], s[1 * 33]); o.y = pk2(s[2 * 33], s[3 * 33]); o.z = pk2(s[4 * 33], s[5 * 33]); o.w = pk2(s[6 * 33], s[7 * 33]);
        *(v4u*)(WT + (size_t)(dst_row0 + n0 + n) * K + k0 + 8 * c) = o; }
    LDS_WAIT();
}

constexpr int WCV_MIX = 16 * ((1024 + 3072 + 1024 + 1024 + 32 + 32) / 32), WCV_ALL = WCV_MIX + 16 * ((1024 + 2048) / 32) + 3 * 512;
__device__ __forceinline__ void wconv_item(int it, const float* w_in, const float* wa, const float* wb, const float* wo, bf16* WT_IN, bf16* WT_A, bf16* WT_B, bf16* WT_O, LAS float* scr, int lane) {
    constexpr int c0 = 512, c1 = c0 + 1536, c2 = c1 + 512, c3 = c2 + 512, c4 = c3 + 16, c5 = c4 + 16, c6 = c5 + 512, c7 = c6 + 1024, c8 = c7 + 512, c9 = c8 + 512;
    static_assert(c5 == WCV_MIX && c9 + 512 == WCV_ALL, "weight conversion item list");
    if (it < c0) transpose_item(w_in, NIN, SRC_ZA, D, 1024, WT_IN, 0, scr, it, lane);
    else if (it < c1) transpose_item(w_in, NIN, SRC_QKVA, D, 3072, WT_IN, 1024, scr, it - c0, lane);
    else if (it < c2) transpose_item(w_in, NIN, SRC_QB, D, 1024, WT_IN, 4096, scr, it - c1, lane);
    else if (it < c3) transpose_item(w_in, NIN, SRC_VB, D, 1024, WT_IN, 5120, scr, it - c2, lane);
    else if (it < c4) transpose_item(w_in, NIN, SRC_AF, D, 32, WT_IN, 9216, scr, it - c3, lane);
    else if (it < c5) transpose_item(w_in, NIN, SRC_RF, D, 32, WT_IN, 9248, scr, it - c4, lane);
    else if (it < c6) transpose_item(w_in, NIN, SRC_GB, D, 1024, WT_IN, 6144, scr, it - c5, lane);
    else if (it < c7) transpose_item(w_in, NIN, SRC_GA, D, 2048, WT_IN, 7168, scr, it - c6, lane);
    else if (it < c8) transpose_item(wa, D, 0, D, D, WT_A, 0, scr, it - c7, lane);
    else if (it < c9) transpose_item(wb, D, 0, D, D, WT_B, 0, scr, it - c8, lane);
    else transpose_item(wo, D, 0, D, D, WT_O, 0, scr, it - c9, lane);
}
__device__ __forceinline__ void h_rows(const float* x, const float* w, bf16* h, int nrows, int gw, int ngw, int lane) {
    asm volatile("" : "+v"(lane));
    for (int m = gw; m < nrows; m += ngw) {
        const f32x4* xr = (const f32x4*)(x + (size_t)m * D) + lane; f32x4 v[4]; float s = 0.f;
#pragma unroll
        for (int j = 0; j < 4; ++j) { v[j] = xr[64 * j]; s += (v[j].x * v[j].x + v[j].y * v[j].y) + (v[j].z * v[j].z + v[j].w * v[j].w); }
        const float rstd = 1.0f / sqrtf(wave_sum(s) * (1.f / D) + EPS);
        unsigned long long* o8 = (unsigned long long*)(h + (size_t)m * D) + lane;
#pragma unroll
        for (int j = 0; j < 4; ++j) { const f32x4 ww = ((const f32x4*)w)[lane + 64 * j];
            o8[64 * j] = (unsigned long long)pkbf(v[j].x * rstd * ww.x, v[j].y * rstd * ww.y) | ((unsigned long long)pkbf(v[j].z * rstd * ww.z, v[j].w * rstd * ww.w) << 32); }
    }
}
__device__ __forceinline__ void h_rows_tiles(const float* x, const float* w, const pg8::Gemm& gt, int nrows, int gw, int ngw, int lane) {
    asm volatile("" : "+v"(lane));
    for (int m = gw; m < nrows; m += ngw) {
        const f32x4* xr = (const f32x4*)(x + (size_t)m * D) + lane; f32x4 v[4]; float s = 0.f;
#pragma unroll
        for (int j = 0; j < 4; ++j) { v[j] = xr[64 * j]; s += (v[j].x * v[j].x + v[j].y * v[j].y) + (v[j].z * v[j].z + v[j].w * v[j].w); }
        const float rstd = 1.0f / sqrtf(wave_sum(s) * (1.f / D) + EPS);
        unsigned long long* o8 = (unsigned long long*)(gt.atile(m >> 8, (size_t)256 * D * 2) + (size_t)(m & 255) * D * 2) + lane;
#pragma unroll
        for (int j = 0; j < 4; ++j) { const f32x4 ww = ((const f32x4*)w)[lane + 64 * j];
            o8[64 * j] = (unsigned long long)pkbf(v[j].x * rstd * ww.x, v[j].y * rstd * ww.y) | ((unsigned long long)pkbf(v[j].z * rstd * ww.z, v[j].w * rstd * ww.w) << 32); }
    }
}
__device__ __forceinline__ void final_rows(const float* x, const float* pre, const float* w, float* out, int nrows, int gw, int ngw, int lane) {
    asm volatile("" : "+v"(lane));
    for (int m = gw; m < nrows; m += ngw) {
        const f32x4* pr = (const f32x4*)(pre + (size_t)m * D) + lane; const f32x4* xr = (const f32x4*)(x + (size_t)m * D) + lane; f32x4 v[4]; float s = 0.f;
#pragma unroll
        for (int j = 0; j < 4; ++j) { v[j] = pr[64 * j]; s += (v[j].x * v[j].x + v[j].y * v[j].y) + (v[j].z * v[j].z + v[j].w * v[j].w); }
        const float rstd = 1.0f / sqrtf(wave_sum(s) * (1.f / D) + EPS);
        f32x4* orow = (f32x4*)(out + (size_t)m * D) + lane;
#pragma unroll
        for (int j = 0; j < 4; ++j) { const f32x4 ww = ((const f32x4*)w)[lane + 64 * j]; const f32x4 xv = xr[64 * j]; orow[64 * j] = xv + v[j] * rstd * ww; }
    }
}
__device__ __forceinline__ void small_unit(LAS unsigned char* lds, const bf16* h, const bf16* wsm, float* out, int unit) {
    int tid_l = threadIdx.x; asm volatile("" : "+v"(tid_l));
    const int tid = tid_l, lane = tid & 63, w = __builtin_amdgcn_readfirstlane(tid >> 6), r = lane & 31, hh = lane >> 5;
    const int ct = w & 1, kq = w >> 1;
    const bf16* ap = h + (size_t)(unit * 32 + r) * D + kq * 256 + 8 * hh;
    const bf16* bp = wsm + (size_t)(32 * ct + r) * D + kq * 256 + 8 * hh;
    f32x16 acc = zero16();
#pragma unroll 8
    for (int ks = 0; ks < 16; ++ks) acc = MFMA32(*(const bf16x8*)(ap + 16 * ks), *(const bf16x8*)(bp + 16 * ks), acc);
    LAS float* red = (LAS float*)lds + (size_t)w * 1024 + lane;
    if (kq != 0) {
#pragma unroll
        for (int i = 0; i < 16; ++i) red[i * 64] = acc[i]; }
    __syncthreads();
    if (kq == 0) {
        float* op = out + (size_t)(unit * 32 + 4 * hh) * 64 + 32 * ct + r;
#pragma unroll
        for (int i = 0; i < 16; ++i) op[((i & 3) + 8 * (i >> 2)) * 64] = ((acc[i] + red[2048 + i * 64]) + red[4096 + i * 64]) + red[6144 + i * 64]; }
    __syncthreads();
}

constexpr int NG = 2, MG = M / NG, NSEQG = BATCH / NG;
constexpr size_t KiB = 1024;
constexpr size_t WS_CTL = 0  , WS_WTIN = 320 * KiB, WS_WTA = WS_WTIN + 18560 * KiB, WS_WTB = WS_WTA + 2 * MiB, WS_WTO = WS_WTB + 2 * MiB, WS_SMALL = WS_WTO + 2 * MiB  ,
    WS_Z = WS_SMALL + 2 * MiB  , WS_PG = WS_Z + 16 * MiB  , WS_GBLOB = WS_PG + 80 * MiB  , WS_LBLOBB = WS_GBLOB + 98 * MiB  , WS_END = WS_LBLOBB + 32 * MiB;
static_assert(WS_END <= 256 * MiB, "workspace");
constexpr size_t WS_GATES = WS_GBLOB  , WS_M1 = WS_GATES + 64 * MiB  , WS_MERGED = WS_M1 + 32 * MiB  , WS_PRE = WS_MERGED + 32 * MiB  ;
static_assert(WS_PRE + 1 * MiB <= WS_END, "overlays");
constexpr size_t HT_TILE = 256 * 1024 * 2, WS_H0 = WS_WTIN, WS_H1 = WS_PG + (size_t)NSEQG * 4 * NCH * gla::BLOBA, WS_H2 = WS_SMALL, WS_H3 = WS_END;
constexpr int HT1 = 24, HT2 = 55, HT3 = 59;
static_assert(((size_t)NSEQG * 4 * NCH * gla::BLOBA) % HT_TILE == 0 && WS_H1 + (HT2 - HT1) * HT_TILE <= WS_PG + 3 * ((size_t)MG * 2048) && HT1 * HT_TILE <= (size_t)6144 * 2048 && (HT3 - HT2) * HT_TILE <= 2 * MiB && WS_H3 + (64 - HT3) * HT_TILE <= 256 * MiB, "h tiles");
constexpr size_t PGMAT = (size_t)MG * 1024 * 2;
static_assert((size_t)NSEQG * 4 * NCH * gla::BLOBA <= 3 * PGMAT && (size_t)NSEQG * 4 * NCH * 32768 <= PGMAT && (size_t)NSEQG * 8 * NCH * 16384 <= PGMAT, "overlays");
static_assert((size_t)NSEQG * 8 * NCH * gdn::BLOB <= 98 * MiB && (size_t)NSEQG * 4 * NCH * gla::BLOBB <= 32 * MiB, "blobs");
constexpr int LDS_BYTES = 160 * 1024, LDS_BAR = LDS_BYTES - 16;
static_assert(gla::L_END <= LDS_BAR && gdn::L_END <= LDS_BAR && gdn::C_END <= LDS_BAR && gla::CB_END <= LDS_BAR && pg8::STAGE_BYTES <= LDS_BAR, "LDS");
constexpr int N_PHASES = 12;

struct MegaArgs { const float* in[18]; float* out; unsigned char* ws; int ph_lo, ph_hi; };

__global__ void __launch_bounds__(512, 2) mega(MegaArgs a) {
    extern __shared__ __attribute__((aligned(16))) unsigned char lds_raw[];
    LAS unsigned char* lds = (LAS unsigned char*)lds_raw;
    const int tid = threadIdx.x, lane = tid & 63, wave = __builtin_amdgcn_readfirstlane(tid >> 6);
    const int G = gridDim.x, bid = blockIdx.x, gw = bid * 8 + wave, ngw = G * 8;
    unsigned char* ws = a.ws;
    const float* x = a.in[0]; const float* ln_pre_w = a.in[1]; const float* w_in = a.in[2]; const float* conv_w = a.in[3];
    if (tid < 4) ((LAS unsigned*)(lds + LDS_BAR))[tid] = 0u;
    __syncthreads();
    XcdBarrier bar = xcd_barrier_post((unsigned*)(ws + WS_CTL), (volatile LAS unsigned*)(lds + LDS_BAR));
    const int lo = a.ph_lo, hi = a.ph_hi;
#define IN(k) (lo <= (k) && (k) < hi)
#define SEAM(k) do { if (IN(k) && IN((k) + 1)) xcd_barrier(bar); } while (0)
#ifndef PROBE_REPEAT
#define PROBE_REPEAT 0
#endif
#ifndef PROBE_FLAGS
#define PROBE_FLAGS 0
#endif
#define PH(k) if (IN(k)) for (int rep_ = 0; rep_ <= ((PROBE_REPEAT >> (k)) & 1); ++rep_)
#define REPBAR() do { if (rep_) xcd_barrier(bar); } while (0)
    bf16* WT_IN = (bf16*)(ws + WS_WTIN); bf16* WT_A = (bf16*)(ws + WS_WTA); bf16* WT_B = (bf16*)(ws + WS_WTB); bf16* WT_O = (bf16*)(ws + WS_WTO);
    bf16* PG = (bf16*)(ws + WS_PG); float* SMALL = (float*)(ws + WS_SMALL);
    bf16* ORAWA = (bf16*)a.out; bf16* ORAWB = (bf16*)a.out + (size_t)M * 1024;
    pg8::Gemm gh{(const bf16*)(ws + WS_H0), WT_IN + (size_t)6144 * D, M, 3072, D, 0, (const bf16*)(ws + WS_H1), (const bf16*)(ws + WS_H2), (const bf16*)(ws + WS_H3), HT1, HT2, HT3};

    PH(0) { REPBAR();
        LAS float* scr = (LAS float*)lds + wave * (64 * 33);
        for (int it = gw; it < WCV_MIX; it += ngw) wconv_item(it, w_in, a.in[9], a.in[15], a.in[16], WT_IN, WT_A, WT_B, WT_O, scr, lane);
        h_rows(x, ln_pre_w, ORAWB + (size_t)MG * 1024, MG, gw, ngw, lane);
    }
    SEAM(0);
#ifdef PROBE_BARRIERS
    for (int i = 0; i < PROBE_BARRIERS; ++i) xcd_barrier(bar);
#endif
    for (int g = 0; g < NG; ++g) {
        const int pb = 1 + 4 * g;
        const size_t r0 = (size_t)g * MG;
        const bf16* hsrc = (g == 0 ? ORAWB : ORAWA) + (size_t)MG * 1024;
        PH(pb) { REPBAR();
            for (int u = bid; u < MG / 32; u += G) small_unit(lds, hsrc, WT_IN + (size_t)9216 * D, SMALL, u);
            pg8::Gemm gm{hsrc, WT_IN, MG, 6144, D, 0}; pg8::StaticOrder S; S.init(MG, 6144, G, bid);
            pg8::EpiBf16 E{(bf16*)(ws + WS_Z), 1024, 1024, (size_t)MG * 1024};
            pg8::gemm_phase<pg8::EpiBf16, pg8::StaticOrder, true, true>(lds, gm, S, E);
        }
        SEAM(pb);
        PH(pb + 1) { REPBAR();
            GdnPrepArgs pa{PG, PG + (size_t)MG * 1024, PG + (size_t)2 * MG * 1024, SMALL, conv_w, a.in[4], a.in[5], a.in[6], a.in[7], ws + WS_GBLOB, NSEQG, rep_ ? PROBE_FLAGS : 0};
            gdn_prep_phase(lds, pa, bid, G, ws + WS_CTL + 300 * KiB);
        }
        SEAM(pb + 1);
        PH(pb + 2) { REPBAR();
            GlaPrepArgs pa{PG + (size_t)3 * MG * 1024, PG + (size_t)4 * MG * 1024, SMALL, a.in[10], a.in[11], a.in[12], a.in[13], ws + WS_PG, ws + WS_LBLOBB, NSEQG, 0};
            gla_prep_phase(lds, pa, bid, G);
        }
        SEAM(pb + 2);
        PH(pb + 3) { REPBAR();
            constexpr int NGI = NSEQG * 8 * 2, NLI = NSEQG * 4 * 2;
            unsigned* gflag = (unsigned*)(ws + WS_CTL + 32 * KiB) + (size_t)g * (NSEQG * 8 * NCH * 8); unsigned* lflag = (unsigned*)(ws + WS_CTL + 96 * KiB) + (size_t)g * (NSEQG * 4 * NCH * 8);
            if (rep_) { gflag += 32 * 1024; lflag += 32 * 1024; }
            if (bid < NGI) { if (!(rep_ && (PROBE_FLAGS & 16))) { GdnChainArgs ca{ws + WS_GBLOB, ws + WS_PG + 4 * PGMAT, gflag, NSEQG, rep_ ? PROBE_FLAGS : 0}; gdn_chain_unit(lds, ca, bid); } }
            else if (bid < NGI + NLI) { if (!(rep_ && (PROBE_FLAGS & 32))) { GlaChainArgs ca{ws + WS_PG, ws + WS_LBLOBB, ws + WS_PG + 3 * PGMAT, lflag, NSEQG, rep_ ? PROBE_FLAGS : 0}; gla_chain_unit(lds, ca, bid - NGI); } }
            else if (!rep_) {
                const int wk = bid - NGI - NLI, nwk = G - NGI - NLI;
                if (g == 0) h_rows(x + (size_t)MG * D, ln_pre_w, ORAWA + (size_t)MG * 1024, MG, wk * 8 + wave, nwk * 8, lane);
                if (g == 0) { LAS float* scr = (LAS float*)lds + wave * (64 * 33);
                    for (int it = WCV_MIX + wk * 8 + wave; it < WCV_ALL; it += nwk * 8) wconv_item(it, w_in, a.in[9], a.in[15], a.in[16], WT_IN, WT_A, WT_B, WT_O, scr, lane);
                    __syncthreads(); }
                if (g == NG - 1) h_rows_tiles(x, ln_pre_w, gh, M, wk * 8 + wave, nwk * 8, lane);
            }
            if (!rep_) {
                constexpr int NPG = NSEQG * 8, NPL = NSEQG * 4;
                unsigned* qhead = (unsigned*)(ws + WS_CTL + 301 * KiB) + 64 * g;
                for (;;) {
                    if (tid == 0) ((LAS unsigned*)(lds + LDS_BAR))[3] = __hip_atomic_fetch_add(qhead, 1u, __ATOMIC_RELAXED, __HIP_MEMORY_SCOPE_AGENT);
                    __syncthreads();
                    const int j = (int)((LAS unsigned*)(lds + LDS_BAR))[3];
                    __syncthreads();
                    if (j >= NCH * (NPG + NPL)) break;
                    const int rk = j / (NPG + NPL), idx = j % (NPG + NPL), n = (rk & 1) ? (NCH / 2 - 1 - (rk >> 1)) : (NCH / 2 + (rk >> 1));
                    if (idx < NPG) { const int u = idx * NCH + n, hd = idx % 8, sq = idx / 8;
                        p4_unit<128, true>(lds, ws + WS_PG + 4 * PGMAT + (size_t)u * 16384, nullptr, (const bf16*)(ws + WS_Z) + ((size_t)sq * SEQ + n * CHUNK) * 1024 + hd * 128, a.in[8], ORAWA + (r0 + (size_t)sq * SEQ + n * CHUNK) * 1024 + hd * 128, gflag + (size_t)u * 8); }
                    else { const int pi = idx - NPG, u = pi * NCH + n, hd = pi % 4, sq = pi / 4;
                        p4_unit<256, false>(lds, ws + WS_PG + 3 * PGMAT + (size_t)u * 32768, ws + WS_LBLOBB + (size_t)u * gla::BLOBB + gla::B_INTRA, nullptr, a.in[14], ORAWB + (r0 + (size_t)sq * SEQ + n * CHUNK) * 1024 + hd * 256, lflag + (size_t)u * 8); }
                }
            }
        }
        SEAM(pb + 3);
    }
    PH(9) { REPBAR();
        const pg8::Gemm& gm = gh; pg8::StaticOrder S; S.init(M, 3072, G, bid);
        if (rep_ == 0) { pg8::EpiP1b E{ORAWB, (bf16*)(ws + WS_GATES), (size_t)M * 1024, ORAWB};
            pg8::gemm_phase<pg8::EpiP1b, pg8::StaticOrder, true, true>(lds, gm, S, E); }
        else { pg8::EpiP1b E{ORAWB, (bf16*)(ws + WS_GATES), (size_t)M * 1024, (bf16*)(ws + WS_MERGED)};
            pg8::gemm_phase<pg8::EpiP1b, pg8::StaticOrder, true, true>(lds, gm, S, E); }
    }
    SEAM(9);
    PH(10) { REPBAR();
        pg8::Gemm gm{ORAWA, WT_A, 2 * M, 2 * D, D, 0}; pg8::PairOrder S; S.init(M, D, G, bid);
        pg8::EpiMerge E{(bf16*)(ws + WS_M1), (bf16*)(ws + WS_MERGED), (const bf16*)(ws + WS_GATES), (size_t)M * 1024, M / 256, D / 256};
        pg8::gemm_phase<pg8::EpiMerge, pg8::PairOrder, true, true>(lds, gm, S, E);
    }
    SEAM(10);
    if (IN(11)) {
        pg8::Gemm gm{(const bf16*)(ws + WS_MERGED), WT_O, M, D, D, 0}; pg8::StaticOrder S; S.init(M, D, G, bid);
        pg8::EpiRmsRes E{x, a.in[17], a.out, (float*)(ws + WS_PRE), (unsigned*)(ws + WS_CTL + 304 * KiB)};
        pg8::gemm_phase<pg8::EpiRmsRes, pg8::StaticOrder, false, true>(lds, gm, S, E);
    }
#undef IN
#undef SEAM
}

#ifndef MK_N_LAUNCHES
#define MK_N_LAUNCHES 1
#endif
extern "C" void kernel_launch(void* const* d_in, const int* in_sizes, int n_in, void* d_out, int out_size, void* d_ws, size_t ws_size, hipStream_t stream) {
    static int ready = 0;
    if (!ready) {
        if (n_in != 18 || ws_size < 256 * MiB || out_size != M * D) { fprintf(stderr, "kernel_launch: unexpected problem shape / workspace (%d inputs, ws %zu)\n", n_in, ws_size); ready = -1; return; }
        if (hipFuncSetAttribute((const void*)mega, hipFuncAttributeMaxDynamicSharedMemorySize, LDS_BYTES) != hipSuccess) { fprintf(stderr, "kernel_launch: hipFuncSetAttribute failed\n"); ready = -1; return; }
        ready = 1;
    }
    if (ready < 0) return;
    (void)hipMemsetAsync((char*)d_ws + WS_CTL, 0, 320 * 1024, stream);
    MegaArgs a{};
    for (int i = 0; i < 18; ++i) a.in[i] = (const float*)d_in[i];
    a.out = (float*)d_out; a.ws = (unsigned char*)d_ws;
#if MK_N_LAUNCHES == 1
    a.ph_lo = 0; a.ph_hi = N_PHASES;
    hipLaunchKernelGGL(mega, dim3(256), dim3(512), LDS_BYTES, stream, a);
#else
    for (int p = 0; p < N_PHASES; ++p) { a.ph_lo = p; a.ph_hi = p + 1; hipLaunchKernelGGL(mega, dim3(256), dim3(512), LDS_BYTES, stream, a); }
#endif
}
```

```cpp
#include <hip/hip_runtime.h>
#include <cstdio>
#include <cstdint>

#define GAS __attribute__((address_space(1)))
#define LAS __attribute__((address_space(3)))
typedef unsigned short bf16;
typedef unsigned v4u __attribute__((ext_vector_type(4)));
typedef unsigned v2u __attribute__((ext_vector_type(2)));
typedef float f32x4 __attribute__((ext_vector_type(4)));
#define LDS_WAIT() asm volatile("s_waitcnt lgkmcnt(0)" ::: "memory")

constexpr int BATCH = 8, SEQ = 2048, D = 1024, M = BATCH * SEQ, NIN = 9280;
constexpr float EPS = 1e-6f;
constexpr size_t MiB = 1 << 20;
constexpr int SRC_QKVA = 0, SRC_ZA = 3072, SRC_AF = 4096, SRC_QB = 4128, SRC_KB = 4640, SRC_VB = 5152, SRC_GB = 6176, SRC_RF = 7200, SRC_GA = 7232, SRC_GBm = 8256;

__device__ __forceinline__ unsigned f2bf(float f) { unsigned u = __builtin_bit_cast(unsigned, f); return (u + 0x7fffu + ((u >> 16) & 1u)) >> 16; }
__device__ __forceinline__ unsigned pk2(float lo, float hi) { return f2bf(lo) | (f2bf(hi) << 16); }
__device__ __forceinline__ float bf2f(unsigned short b) { return __builtin_bit_cast(float, (unsigned)b << 16); }
__device__ __forceinline__ float bflo(unsigned w) { return __builtin_bit_cast(float, w << 16); }
__device__ __forceinline__ float bfhi(unsigned w) { return __builtin_bit_cast(float, w & 0xffff0000u); }
__device__ __forceinline__ float sigmoidf_(float x) { return 1.0f / (1.0f + __expf(-x)); }
__device__ __forceinline__ float siluf_(float x) { return x / (1.0f + __expf(-x)); }
__device__ __forceinline__ float wave_sum(float v) {
#pragma unroll
    for (int o = 1; o < 64; o <<= 1) v += __shfl_xor(v, o);
    return v;
}
namespace pg8 {
#define PG8_LAS __attribute__((address_space(3)))
typedef unsigned short bf16_t;
typedef short bf16x8 __attribute__((ext_vector_type(8)));
typedef float f32x4 __attribute__((ext_vector_type(4)));
typedef unsigned u32x4 __attribute__((ext_vector_type(4)));
constexpr int BM = 256, BK = 64, HALF = 128, HTB = HALF * BK * 2  , STAGE_BYTES = 8 * HTB, NXCD = 8, WGM = 8;

__host__ __device__ __forceinline__ int lds_byte(int r, int c) { const int st = (r >> 4) * 2 + (c >> 5), rr = r & 15, cc = c & 31, ob = rr * 64 + cc * 2; return st * 1024 + (ob ^ (((ob >> 9) & 1) << 5)); }
__host__ __device__ __forceinline__ void stage_rc(int b, int& R, int& C) { const int st = b / 1024, sb = b % 1024, swz = sb ^ (((sb >> 9) & 1) << 5); R = (st >> 1) * 16 + swz / 64; C = (st & 1) * 32 + (swz % 64) / 2; }
__host__ __device__ __forceinline__ int perm32(int rho) { const int n = rho >> 4, i = rho & 15; return 8 * (i >> 2) + 4 * n + (i & 3); }

struct Unit { int pm, pn; };
struct Gemm { const bf16_t* A; const bf16_t* Bt; int M, N, K, pad_;
    const bf16_t* A1 = nullptr; const bf16_t* A2 = nullptr; const bf16_t* A3 = nullptr; int t1 = 1 << 30, t2 = 1 << 30, t3 = 1 << 30;
    __host__ __device__ __forceinline__ const char* atile(int pm, size_t tstep) const {
        if (pm < t1) return (const char*)A + (size_t)pm * tstep;
        if (pm < t2) return (const char*)A1 + (size_t)(pm - t1) * tstep;
        if (pm < t3) return (const char*)A2 + (size_t)(pm - t2) * tstep;
        return (const char*)A3 + (size_t)(pm - t3) * tstep; }
};

struct StaticOrder {
    int nM, nN, nwg, G, c;
    __host__ __device__ void init(int M, int N, int G_, int c_) { nM = M / BM; nN = N / BM; nwg = nM * nN; G = G_; c = c_; }
    __host__ __device__ bool next(int i, Unit& u) const {
        const long L = (long)i * G + c; if (L >= nwg) return false;
        int wgid = (int)L; { const int q = nwg / NXCD, r = nwg % NXCD, xcd = wgid % NXCD, off = wgid / NXCD; wgid = (xcd < r ? xcd * (q + 1) : r * (q + 1) + (xcd - r) * q) + off; }
        const int nig = WGM * nN, gid = wgid / nig, fm = gid * WGM, gsz = (nM - fm) < WGM ? (nM - fm) : WGM;
        u.pm = fm + ((wgid % nig) % gsz); u.pn = (wgid % nig) / gsz; return true;
    }
    __device__ __forceinline__ void a_ready(const Unit&) const {}
    __device__ __forceinline__ void done(const Unit&) const {}
};

__device__ __forceinline__ unsigned cvt_pk_bf16(float lo, float hi) { unsigned r; asm volatile("v_cvt_pk_bf16_f32 %0, %1, %2" : "=v"(r) : "v"(lo), "v"(hi)); return r; }
struct EpiBf16 {
    static constexpr bool PERM = true, AFTER_DRAIN = false;
    bf16_t* O; int ldc; int split_cols; size_t split_stride;
    __device__ __forceinline__ void operator()(const f32x4 (&acc)[2][2][4][2], const Unit& u, int wr, int wc, int fr, int fq) const {
        const int row0 = u.pm * BM + wr * 64 + fr; int colt = u.pn * BM; bf16_t* base = O;
        if (split_cols) { const int t = colt / split_cols; base += (size_t)t * split_stride; colt -= t * split_cols; }
        const int col0 = colt + wc * 32 + 8 * fq;
#pragma unroll
        for (int ai = 0; ai < 2; ++ai)
#pragma unroll
            for (int m = 0; m < 4; ++m) { bf16_t* rowp = base + (size_t)(row0 + ai * HALF + m * 16) * ldc + col0;
#pragma unroll
                for (int bj = 0; bj < 2; ++bj) { const f32x4 v0 = acc[ai][bj][m][0], v1 = acc[ai][bj][m][1];
                    u32x4 w; w.x = cvt_pk_bf16(v0[0], v0[1]); w.y = cvt_pk_bf16(v0[2], v0[3]); w.z = cvt_pk_bf16(v1[0], v1[1]); w.w = cvt_pk_bf16(v1[2], v1[3]);
                    *(u32x4*)(rowp + bj * HALF) = w; } }
    }
};
template <int MODE> struct EpiGate {
    static constexpr bool PERM = true, AFTER_DRAIN = false;
    bf16_t* O; const bf16_t* G; const bf16_t* Add; int ldc, pad_;
    __device__ __forceinline__ void operator()(const f32x4 (&acc)[2][2][4][2], const Unit& u, int wr, int wc, int fr, int fq) const {
        const int row0 = u.pm * BM + wr * 64 + fr; const int col0 = u.pn * BM + wc * 32 + 8 * fq;
#pragma unroll
        for (int ai = 0; ai < 2; ++ai)
#pragma unroll
            for (int m = 0; m < 4; ++m) { const size_t ro = (size_t)(row0 + ai * HALF + m * 16) * ldc + col0;
#pragma unroll
                for (int bj = 0; bj < 2; ++bj) { const f32x4 v0 = acc[ai][bj][m][0], v1 = acc[ai][bj][m][1];
                    const u32x4 gw = *(const u32x4*)(G + ro + bj * HALF);
                    float r[8]; const float a[8] = {v0[0], v0[1], v0[2], v0[3], v1[0], v1[1], v1[2], v1[3]};
#pragma unroll
                    for (int i = 0; i < 4; ++i) { const unsigned w = gw[i]; const float g0 = __builtin_bit_cast(float, w << 16), g1 = __builtin_bit_cast(float, w & 0xffff0000u);
                        if (MODE == 0) { r[2 * i] = a[2 * i] * __builtin_amdgcn_rcpf(1.0f + __builtin_amdgcn_exp2f(-1.4426950408889634f * g0)); r[2 * i + 1] = a[2 * i + 1] * __builtin_amdgcn_rcpf(1.0f + __builtin_amdgcn_exp2f(-1.4426950408889634f * g1)); }
                        else { r[2 * i] = g0 * a[2 * i] * __builtin_amdgcn_rcpf(1.0f + __builtin_amdgcn_exp2f(-1.4426950408889634f * a[2 * i])); r[2 * i + 1] = g1 * a[2 * i + 1] * __builtin_amdgcn_rcpf(1.0f + __builtin_amdgcn_exp2f(-1.4426950408889634f * a[2 * i + 1])); } }
                    if (Add) { const u32x4 aw = *(const u32x4*)(Add + ro + bj * HALF);
#pragma unroll
                        for (int i = 0; i < 4; ++i) { const unsigned w = aw[i]; r[2 * i] += __builtin_bit_cast(float, w << 16); r[2 * i + 1] += __builtin_bit_cast(float, w & 0xffff0000u); } }
                    u32x4 w; w.x = cvt_pk_bf16(r[0], r[1]); w.y = cvt_pk_bf16(r[2], r[3]); w.z = cvt_pk_bf16(r[4], r[5]); w.w = cvt_pk_bf16(r[6], r[7]);
                    *(u32x4*)(O + ro + bj * HALF) = w; } }
    }
};
struct EpiF32 {
    static constexpr bool PERM = false, AFTER_DRAIN = false;
    float* O; int ldc, pad_;
    __device__ __forceinline__ void operator()(const f32x4 (&acc)[2][2][4][2], const Unit& u, int wr, int wc, int fr, int fq) const {
        const int row0 = u.pm * BM + wr * 64 + fr; const int col0 = u.pn * BM + wc * 32 + 4 * fq;
#pragma unroll
        for (int ai = 0; ai < 2; ++ai)
#pragma unroll
            for (int m = 0; m < 4; ++m) { float* rowp = O + (size_t)(row0 + ai * HALF + m * 16) * ldc + col0;
#pragma unroll
                for (int bj = 0; bj < 2; ++bj)
#pragma unroll
                    for (int n = 0; n < 2; ++n) *(f32x4*)(rowp + bj * HALF + n * 16) = acc[ai][bj][m][n]; }
    }
};
struct EpiP1b {
    static constexpr bool PERM = true, AFTER_DRAIN = false;
    const bf16_t* ob; bf16_t* gates; size_t gate_stride; bf16_t* ob_out;
    __device__ __forceinline__ void operator()(const f32x4 (&acc)[2][2][4][2], const Unit& u, int wr, int wc, int fr, int fq) const {
        if (u.pn < 4) { EpiGate<1> E{ob_out, ob, nullptr, 1024, 0}; E(acc, u, wr, wc, fr, fq); }
        else { Unit v = u; v.pn = (u.pn - 4) & 3; EpiBf16 E{gates + (size_t)((u.pn - 4) >> 2) * gate_stride, 1024, 0, 0}; E(acc, v, wr, wc, fr, fq); }
    }
};
struct EpiRmsRes {
    static constexpr bool PERM = false, AFTER_DRAIN = true;
    const float* xres; const float* w; float* out; float* xbuf; unsigned* cnt;
    __device__ __forceinline__ void fused(f32x4 (&acc)[2][2][4][2], const Unit& u, int wr, int wc, int fr, int fq, PG8_LAS unsigned char* lds, int wid, int lane) const {
        PG8_LAS float* P = (PG8_LAS float*)lds;
        PG8_LAS float* R = (PG8_LAS float*)(lds + 4096);
#pragma unroll
        for (int ai = 0; ai < 2; ++ai)
#pragma unroll
            for (int m = 0; m < 4; ++m) { float s = 0.f;
#pragma unroll
                for (int bj = 0; bj < 2; ++bj)
#pragma unroll
                    for (int n = 0; n < 2; ++n) { const f32x4 x = acc[ai][bj][m][n]; s += (x[0] * x[0] + x[1] * x[1]) + (x[2] * x[2] + x[3] * x[3]); }
                s += __shfl_xor(s, 16); s += __shfl_xor(s, 32);
                if (fq == 0) P[(ai * HALF + wr * 64 + m * 16 + fr) * 4 + wc] = s; }
        asm volatile("s_waitcnt lgkmcnt(0)" ::: "memory"); __builtin_amdgcn_s_barrier(); asm volatile("" ::: "memory");
        const int row = wid * 32 + (lane & 31);
        if (lane < 32) { const f32x4 p = *(const PG8_LAS f32x4*)(P + row * 4);
            __hip_atomic_store(xbuf + (size_t)(u.pm * BM + row) * 4 + u.pn, (p[0] + p[1]) + (p[2] + p[3]), __ATOMIC_RELAXED, __HIP_MEMORY_SCOPE_AGENT); }
        asm volatile("s_waitcnt vmcnt(0)" ::: "memory");
        if (lane == 0) __hip_atomic_fetch_add(cnt + 64 * u.pm, 1u, __ATOMIC_RELAXED, __HIP_MEMORY_SCOPE_AGENT);
        if (wid == 0) {
            for (unsigned sp = 0; (unsigned)__builtin_amdgcn_readfirstlane((int)__hip_atomic_load(cnt + 64 * u.pm, __ATOMIC_RELAXED, __HIP_MEMORY_SCOPE_AGENT)) < 32u && sp < (1u << 22); ++sp) __builtin_amdgcn_s_sleep(2);
        }
        asm volatile("s_waitcnt vmcnt(0) lgkmcnt(0)" ::: "memory"); __builtin_amdgcn_s_barrier(); asm volatile("" ::: "memory");
        if (lane < 32) { const float* sl = xbuf + (size_t)(u.pm * BM + row) * 4; float t = 0.f;
#pragma unroll
            for (int i = 0; i < 4; ++i) t += __hip_atomic_load(sl + i, __ATOMIC_RELAXED, __HIP_MEMORY_SCOPE_AGENT);
            R[row] = 1.0f / sqrtf(t * (1.0f / 1024.0f) + 1e-6f); }
        asm volatile("s_waitcnt vmcnt(0) lgkmcnt(0)" ::: "memory"); __builtin_amdgcn_s_barrier(); asm volatile("" ::: "memory");
        const int col0 = u.pn * BM + wc * 32 + 4 * fq;
#pragma unroll
        for (int ai = 0; ai < 2; ++ai)
#pragma unroll
            for (int m = 0; m < 4; ++m) { const int r = ai * HALF + wr * 64 + m * 16 + fr; const float rs = R[r]; const size_t off = (size_t)(u.pm * BM + r) * 1024 + col0;
#pragma unroll
                for (int bj = 0; bj < 2; ++bj)
#pragma unroll
                    for (int n = 0; n < 2; ++n) { const int c = bj * HALF + n * 16; const f32x4 xv = *(const f32x4*)(xres + off + c); const f32x4 wv = *(const f32x4*)(w + col0 + c);
                        *(f32x4*)(out + off + c) = xv + acc[ai][bj][m][n] * rs * wv; }
                if (m & 1) asm volatile("" ::: "memory"); }
    }
};
struct PairOrder {
    StaticOrder S; int nM, nN;
    __host__ __device__ void init(int M, int N, int G_, int c_) { S.init(M, N, G_, c_); nM = M / BM; nN = N / BM; }
    __host__ __device__ bool next(int i, Unit& u) const { if (i > 1) return false; Unit b; if (!S.next(0, b)) return false; u.pm = b.pm + i * nM; u.pn = b.pn + i * nN; return true; }
    __device__ __forceinline__ void a_ready(const Unit&) const {}
    __device__ __forceinline__ void done(const Unit&) const {}
};
struct EpiMerge {
    static constexpr bool PERM = true, AFTER_DRAIN = false;
    bf16_t* m1; bf16_t* merged; const bf16_t* gates; size_t gate_stride; int nM, nN;
    __device__ __forceinline__ void operator()(const f32x4 (&acc)[2][2][4][2], const Unit& u, int wr, int wc, int fr, int fq) const {
        if (u.pm < nM) { EpiGate<0> E{m1, gates, nullptr, 1024, 0}; E(acc, u, wr, wc, fr, fq); }
        else { Unit v; v.pm = u.pm - nM; v.pn = u.pn - nN; EpiGate<0> E{merged, gates + gate_stride, m1, 1024, 0}; E(acc, v, wr, wc, fr, fq); }
    }
};
template <class Epi, class Sched, bool ALIGN_EPI = false, bool SP2 = false>
__device__ __forceinline__ void gemm_phase(PG8_LAS unsigned char* lds, const Gemm g, const Sched& S, const Epi& E) {
    int tid_l = threadIdx.x; asm volatile("" : "+v"(tid_l));
    const int tid = tid_l, wid = __builtin_amdgcn_readfirstlane(tid >> 6), lane = tid & 63, wr = wid >> 2, wc = wid & 3, fr = lane & 15, fq = lane >> 4;
    const int K = g.K, nt = K / BK;
    unsigned voffA[2], voffB[2];
#pragma unroll
    for (int i = 0; i < 2; ++i) { int R, C; stage_rc(tid * 16 + i * 8192, R, C); const int Rb = Epi::PERM ? ((R & ~31) + perm32(R & 31)) : R;
        voffA[i] = (unsigned)(R * K + C) * 2u; voffB[i] = (unsigned)(Rb * K + C) * 2u; }
    const size_t kstep = (size_t)(BK * 2);
    const size_t hstep = (size_t)HALF * K * 2;
    const size_t tstep = 2 * hstep;
    const unsigned ldsw = (unsigned)wid * 1024u;
    const int aoff = lds_byte(wr * 64 + fr, fq * 8), boff = lds_byte(wc * 32 + fr, fq * 8);
#define PG8_SA(b, h) (((b) * 2 + (h)) * HTB)
#define PG8_SB(b, h) ((4 + (b) * 2 + (h)) * HTB)
#define PG8_STAGE(bufoff, gbase, voff) do { _Pragma("unroll") for (int _i = 0; _i < 2; ++_i) \
        __builtin_amdgcn_global_load_lds((const unsigned*)((const char*)(gbase) + (voff)[_i]), (PG8_LAS unsigned*)(lds + (bufoff) + ldsw + _i * 8192), 16, 0, 0); } while (0)
#define PG8_LDA(dst, b, h) do { _Pragma("unroll") for (int m = 0; m < 4; ++m) _Pragma("unroll") for (int k = 0; k < 2; ++k) dst[m][k] = *(const PG8_LAS bf16x8*)(lds + PG8_SA(b, h) + aoff + m * 2048 + k * 1024); } while (0)
#define PG8_LDB(dst, b, h) do { _Pragma("unroll") for (int n = 0; n < 2; ++n) _Pragma("unroll") for (int k = 0; k < 2; ++k) dst[n][k] = *(const PG8_LAS bf16x8*)(lds + PG8_SB(b, h) + boff + n * 2048 + k * 1024); } while (0)
#define PG8_MMA(ai, bj, At, Bt) do { __builtin_amdgcn_s_setprio(1); _Pragma("unroll") for (int m = 0; m < 4; ++m) _Pragma("unroll") for (int n = 0; n < 2; ++n) _Pragma("unroll") for (int k = 0; k < 2; ++k) \
        acc[ai][bj][m][n] = __builtin_amdgcn_mfma_f32_16x16x32_bf16(Bt[n][k], At[m][k], acc[ai][bj][m][n], 0, 0, 0); __builtin_amdgcn_s_setprio(0); } while (0)
#define PG8_WAIT_V(n) asm volatile("s_waitcnt vmcnt(" #n ")" ::: "memory")
#define PG8_WAIT_L(n) asm volatile("s_waitcnt lgkmcnt(" #n ")" ::: "memory")
#define PG8_BAR __builtin_amdgcn_s_barrier()
#define PG8_SCHED __builtin_amdgcn_sched_barrier(0)
    Unit cur, nxt; int ui = 0;
    if (!S.next(0, cur)) return;
    f32x4 acc[2][2][4][2];
#pragma unroll
    for (int a = 0; a < 2; ++a)
#pragma unroll
        for (int b = 0; b < 2; ++b)
#pragma unroll
            for (int m = 0; m < 4; ++m)
#pragma unroll
                for (int n = 0; n < 2; ++n) acc[a][b][m][n] = (f32x4){0.f, 0.f, 0.f, 0.f};
    bf16x8 At[4][2], B0[2][2], B1[2][2];
    const char* cA = g.atile(cur.pm, tstep); const char* cB = (const char*)g.Bt + (size_t)cur.pn * tstep;
    S.a_ready(cur);
    if constexpr (SP2) {
        PG8_STAGE(PG8_SB(0, 0), cB, voffB); PG8_STAGE(PG8_SB(0, 1), cB + hstep, voffB); PG8_STAGE(PG8_SA(0, 0), cA, voffA); PG8_STAGE(PG8_SA(0, 1), cA + hstep, voffA);
        if (wr == 1) PG8_BAR;
        PG8_WAIT_V(2); PG8_BAR;
        PG8_STAGE(PG8_SB(1, 0), cB + kstep, voffB); PG8_STAGE(PG8_SA(1, 0), cA + kstep, voffA); PG8_STAGE(PG8_SB(1, 1), cB + hstep + kstep, voffB);
        PG8_WAIT_V(6); PG8_BAR;
    } else {
        PG8_STAGE(PG8_SB(0, 0), cB, voffB); PG8_STAGE(PG8_SA(0, 0), cA, voffA); PG8_STAGE(PG8_SB(0, 1), cB + hstep, voffB); PG8_STAGE(PG8_SA(0, 1), cA + hstep, voffA);
        if (wr == 1) PG8_BAR;
        PG8_WAIT_V(4); PG8_BAR;
        PG8_STAGE(PG8_SB(1, 0), cB + kstep, voffB); PG8_STAGE(PG8_SA(1, 0), cA + kstep, voffA); PG8_STAGE(PG8_SB(1, 1), cB + hstep + kstep, voffB);
        PG8_WAIT_V(6); PG8_BAR;
    }
    for (;;) {
        const bool has_next = S.next(ui + 1, nxt);
        const char* nA = has_next ? g.atile(nxt.pm, tstep) : cA; const char* nB = has_next ? (const char*)g.Bt + (size_t)nxt.pn * tstep : cB;
        for (int t = 0; t < nt; t += 2) {
            const bool last = (t == nt - 2);
            const char* a1 = cA + (size_t)(t + 1) * kstep;
            const char* a2 = last ? nA : cA + (size_t)(t + 2) * kstep; const char* b2 = last ? nB : cB + (size_t)(t + 2) * kstep;
            const char* a3 = a2 + kstep; const char* b3 = b2 + kstep;
            if (last && has_next) S.a_ready(nxt);
            if constexpr (SP2) {
            PG8_LDB(B0, 0, 0); PG8_LDB(B1, 0, 1); PG8_SCHED; PG8_LDA(At, 0, 0); PG8_STAGE(PG8_SA(1, 1), a1 + hstep, voffA);
            PG8_WAIT_V(8); PG8_WAIT_L(0); PG8_BAR; PG8_MMA(0, 0, At, B0); PG8_MMA(0, 1, At, B1); PG8_BAR; PG8_SCHED;
            PG8_LDA(At, 0, 1); PG8_STAGE(PG8_SB(0, 0), b2, voffB); PG8_STAGE(PG8_SB(0, 1), b2 + hstep, voffB); PG8_STAGE(PG8_SA(0, 0), a2, voffA);
            PG8_WAIT_V(8); PG8_WAIT_L(0); PG8_BAR; PG8_MMA(1, 0, At, B0); PG8_MMA(1, 1, At, B1); PG8_BAR; PG8_SCHED;
            PG8_LDB(B0, 1, 0); PG8_LDB(B1, 1, 1); PG8_SCHED; PG8_LDA(At, 1, 0); PG8_STAGE(PG8_SA(0, 1), a2 + hstep, voffA);
            PG8_WAIT_V(8); PG8_WAIT_L(0); PG8_BAR; PG8_MMA(0, 0, At, B0); PG8_MMA(0, 1, At, B1); PG8_BAR; PG8_SCHED;
            PG8_LDA(At, 1, 1); PG8_STAGE(PG8_SB(1, 0), b3, voffB); PG8_STAGE(PG8_SB(1, 1), b3 + hstep, voffB); PG8_STAGE(PG8_SA(1, 0), a3, voffA);
            PG8_WAIT_V(8); PG8_WAIT_L(0); PG8_BAR; PG8_MMA(1, 0, At, B0); PG8_MMA(1, 1, At, B1); PG8_BAR; PG8_SCHED;
            } else {
            PG8_LDB(B0, 0, 0); PG8_SCHED; PG8_LDA(At, 0, 0); PG8_STAGE(PG8_SA(1, 1), a1 + hstep, voffA);
            PG8_WAIT_L(8); PG8_BAR; PG8_WAIT_L(0); PG8_MMA(0, 0, At, B0); PG8_BAR; PG8_SCHED;
            PG8_LDB(B1, 0, 1); PG8_STAGE(PG8_SB(0, 0), b2, voffB);
            PG8_BAR; PG8_WAIT_L(0); PG8_MMA(0, 1, At, B1); PG8_BAR;
            PG8_LDA(At, 0, 1); PG8_STAGE(PG8_SA(0, 0), a2, voffA);
            PG8_BAR; PG8_WAIT_L(0); PG8_MMA(1, 0, At, B0); PG8_BAR; PG8_SCHED;
            PG8_STAGE(PG8_SB(0, 1), b2 + hstep, voffB);
            PG8_WAIT_V(6); PG8_BAR; PG8_MMA(1, 1, At, B1); PG8_BAR;
            PG8_LDB(B0, 1, 0); PG8_SCHED; PG8_LDA(At, 1, 0); PG8_STAGE(PG8_SA(0, 1), a2 + hstep, voffA);
            PG8_WAIT_L(8); PG8_BAR; PG8_WAIT_L(0); PG8_MMA(0, 0, At, B0); PG8_BAR; PG8_SCHED;
            PG8_LDB(B1, 1, 1); PG8_STAGE(PG8_SB(1, 0), b3, voffB);
            PG8_BAR; PG8_WAIT_L(0); PG8_MMA(0, 1, At, B1); PG8_BAR;
            PG8_LDA(At, 1, 1); PG8_STAGE(PG8_SA(1, 0), a3, voffA);
            PG8_BAR; PG8_WAIT_L(0); PG8_MMA(1, 0, At, B0); PG8_BAR; PG8_SCHED;
            PG8_STAGE(PG8_SB(1, 1), b3 + hstep, voffB);
            PG8_WAIT_V(6); PG8_BAR; PG8_MMA(1, 1, At, B1); PG8_BAR;
            }
        }
        if constexpr (ALIGN_EPI) { if (wr == 0) PG8_BAR; }
        if constexpr (!Epi::AFTER_DRAIN) { E(acc, cur, wr, wc, fr, fq); S.done(cur); }
        if (!has_next) break;
#pragma unroll
        for (int a = 0; a < 2; ++a)
#pragma unroll
            for (int b = 0; b < 2; ++b)
#pragma unroll
                for (int m = 0; m < 4; ++m)
#pragma unroll
                    for (int n = 0; n < 2; ++n) acc[a][b][m][n] = (f32x4){0.f, 0.f, 0.f, 0.f};
        cur = nxt; cA = nA; cB = nB; ++ui;
        if constexpr (ALIGN_EPI) { if (wr == 1) PG8_BAR; }
    }
    PG8_WAIT_V(0);
    if constexpr (!ALIGN_EPI) { if (wr == 0) PG8_BAR; }
    PG8_BAR;
    if constexpr (Epi::AFTER_DRAIN) { E.fused(acc, cur, wr, wc, fr, fq, lds, wid, lane); S.done(cur); }
#undef PG8_SA
#undef PG8_SB
#undef PG8_STAGE
#undef PG8_LDA
#undef PG8_LDB
#undef PG8_MMA
#undef PG8_WAIT_V
#undef PG8_WAIT_L
#undef PG8_BAR
#undef PG8_SCHED
}
}
typedef __bf16 bf16x2_t __attribute__((ext_vector_type(2)));
typedef float f32x2_t __attribute__((ext_vector_type(2)));
typedef short bf16x8 __attribute__((ext_vector_type(8)));
typedef float f32x16 __attribute__((ext_vector_type(16)));
#define MFMA32(a, b, c) __builtin_amdgcn_mfma_f32_32x32x16_bf16((a), (b), (c), 0, 0, 0)
__device__ __forceinline__ unsigned pkbf(float a, float b) { bf16x2_t v = __builtin_convertvector((f32x2_t){a, b}, bf16x2_t); return __builtin_bit_cast(unsigned, v); }
__device__ __forceinline__ bf16x8 pack8(const f32x16& x, int s) { v4u p; p.x = pkbf(x[8 * s], x[8 * s + 1]); p.y = pkbf(x[8 * s + 2], x[8 * s + 3]); p.z = pkbf(x[8 * s + 4], x[8 * s + 5]); p.w = pkbf(x[8 * s + 6], x[8 * s + 7]); return __builtin_bit_cast(bf16x8, p); }
__device__ __forceinline__ f32x16 zero16() { f32x16 z;
#pragma unroll
    for (int i = 0; i < 16; ++i) z[i] = 0.f; return z; }
constexpr int CHUNK = 64, NCH = SEQ / CHUNK;
constexpr float QSCALE = 0.08838834764831845f;
__device__ __forceinline__ void glds_blocks(LAS unsigned char* dst, const unsigned char* src, int nblk, int wv, int nw, int lane) {
    for (int b = wv; b < nblk; b += nw)
        __builtin_amdgcn_global_load_lds((const unsigned*)(src + (size_t)b * 1024 + lane * 16), (LAS unsigned*)(dst + b * 1024), 16, 0, 0);
}
__device__ __forceinline__ bf16x8 lds_frag(const LAS unsigned char* base, int blk, int lane) { return *(const LAS bf16x8*)(base + blk * 1024 + lane * 16); }

namespace gdn {
constexpr int B_KA = 0, B_QA = 16384, B_SC = 32768, B_KT = 34816, B_TBF = 51200, B_AF = 59392, B_TBB = 67584, B_AB = 75776, B_VT = 83968, BLOB = 100352;
constexpr int XBLK = 34, YBLK = 32;
}

__device__ __forceinline__ float row16_sum(float v) {
    v += __builtin_bit_cast(float, __builtin_amdgcn_mov_dpp(__builtin_bit_cast(int, v), 0xB1, 0xF, 0xF, true));
    v += __builtin_bit_cast(float, __builtin_amdgcn_mov_dpp(__builtin_bit_cast(int, v), 0x4E, 0xF, 0xF, true));
    v += __builtin_bit_cast(float, __builtin_amdgcn_mov_dpp(__builtin_bit_cast(int, v), 0x141, 0xF, 0xF, true));
    v += __builtin_bit_cast(float, __builtin_amdgcn_mov_dpp(__builtin_bit_cast(int, v), 0x140, 0xF, 0xF, true));
    return v;
}
__device__ __forceinline__ float quad_sum(float v) {
    v += __builtin_bit_cast(float, __builtin_amdgcn_mov_dpp(__builtin_bit_cast(int, v), 0xB1, 0xF, 0xF, true));
    v += __builtin_bit_cast(float, __builtin_amdgcn_mov_dpp(__builtin_bit_cast(int, v), 0x4E, 0xF, 0xF, true));
    return v;
}
struct GdnPrepArgs {
    const bf16 *pq, *pk, *pv;
    const float* small;
    const float* conv_w;
    const float *a_log_f, *a_log_b, *dtb_f, *dtb_b;
    unsigned char* blob;
    int nseq, pad_;
};
namespace gdn {
constexpr int L_PRE = 0, L_QN = 52224, L_KN = L_QN + 17408, L_SC = L_KN + 17408, L_LPF = L_SC + 1024, L_LPB = L_LPF + 16384, L_AF = L_LPB + 16384, L_AB = L_AF + 9216, L_TBF = L_AB + 9216, L_TBB = L_TBF + 9216, L_END = L_TBB + 9216;
static_assert(L_END <= 160 * 1024 - 256, "gdn prep LDS");
constexpr int QS_ = 272, AS_ = 144;

__device__ __forceinline__ v4u frag_rm_perm(const LAS unsigned char* img, int st, int rt, int ks, int lane) {
    const int r = lane & 31, hh = lane >> 5; const LAS unsigned char* p = img + (32 * rt + r) * st + (16 * ks + 4 * hh) * 2;
    const v2u lo = *(const LAS v2u*)p, hi = *(const LAS v2u*)(p + 16);
    return (v4u){lo.x, lo.y, hi.x, hi.y};
}
__device__ __forceinline__ v4u frag_tr_perm(const LAS unsigned char* img, int st, int rt, int ks, int lane) {
    const int r = lane & 31, hh = lane >> 5; const LAS unsigned char* p = img + (16 * ks + 4 * hh) * st + (32 * rt + r) * 2;
    unsigned short e[8];
#pragma unroll
    for (int j = 0; j < 8; ++j) e[j] = *(const LAS unsigned short*)(p + (8 * (j >> 2) + (j & 3)) * st);
    return (v4u){(unsigned)e[0] | ((unsigned)e[1] << 16), (unsigned)e[2] | ((unsigned)e[3] << 16), (unsigned)e[4] | ((unsigned)e[5] << 16), (unsigned)e[6] | ((unsigned)e[7] << 16)};
}
__device__ __forceinline__ v4u frag16_rm(const LAS unsigned char* img, int st, int rt, int ks, int lane) {
    const int r = lane & 15, q = lane >> 4; const LAS unsigned char* p = img + (16 * rt + r) * st + (32 * ks + 4 * q) * 2;
    const v2u lo = *(const LAS v2u*)p, hi = *(const LAS v2u*)(p + 32);
    return (v4u){lo.x, lo.y, hi.x, hi.y};
}
__device__ __forceinline__ v4u frag16_tr(const LAS unsigned char* img, int st, int rt, int ks, int lane) {
    const int r = lane & 15, q = lane >> 4; const LAS unsigned char* p = img + (32 * ks + 4 * q) * st + (16 * rt + r) * 2;
    unsigned short e[8];
#pragma unroll
    for (int j = 0; j < 8; ++j) e[j] = *(const LAS unsigned short*)(p + (16 * (j >> 2) + (j & 3)) * st);
    return (v4u){(unsigned)e[0] | ((unsigned)e[1] << 16), (unsigned)e[2] | ((unsigned)e[3] << 16), (unsigned)e[4] | ((unsigned)e[5] << 16), (unsigned)e[6] | ((unsigned)e[7] << 16)};
}
}

#define LBAR() do { asm volatile("s_waitcnt lgkmcnt(0)" ::: "memory"); __builtin_amdgcn_s_barrier(); asm volatile("" ::: "memory"); } while (0)
__device__ __forceinline__ void gdn_prep_issue(LAS unsigned char* lds, const GdnPrepArgs& A, int unit, int w, int lane, const unsigned char* zero_page) {
    using namespace gdn;
    const int n = unit % NCH, h = (unit / NCH) % 8, sq = unit / (NCH * 8); const size_t row0 = (size_t)sq * SEQ; const int t0 = n * CHUNK;
    for (int q4 = w; q4 < 51; q4 += 8) {
        const int seg = q4 * 4 + (lane >> 4), r = seg / 3, m = seg % 3, tl = t0 - 2 + r;
        const bf16* pmat = A.pq + (size_t)m * (size_t)(A.pk - A.pq);
        const unsigned char* src = (tl >= 0 && tl < SEQ) ? (const unsigned char*)(pmat + (row0 + tl) * 1024 + h * 128) : zero_page;
        __builtin_amdgcn_global_load_lds((const unsigned*)(src + (lane & 15) * 16), (LAS unsigned*)(lds + L_PRE + q4 * 1024), 16, 0, 0);
    }
}
__device__ __forceinline__ f32x4 gdn_prep_scal(const GdnPrepArgs& A, int unit, int lane) {
    const int n = unit % NCH, h = (unit / NCH) % 8, sq = unit / (NCH * 8);
    const float* sm = A.small + ((size_t)sq * SEQ + n * CHUNK + lane) * 64;
    return (f32x4){sm[h], sm[8 + h], sm[16 + h], sm[24 + h]};
}
__device__ __forceinline__ void gdn_prep_phase(LAS unsigned char* lds, const GdnPrepArgs& A, int bid, int G, const unsigned char* zero_page) {
    using namespace gdn;
    int tid_l = threadIdx.x; asm volatile("" : "+v"(tid_l));
    const int tid = tid_l, lane = tid & 63, w = __builtin_amdgcn_readfirstlane(tid >> 6);
    const int nunits = A.nseq * 8 * NCH; const int pflg = A.pad_;
    int unit = bid;
    f32x4 smn = (f32x4){0.f, 0.f, 0.f, 0.f};
    if (unit < nunits) { gdn_prep_issue(lds, A, unit, w, lane, zero_page); if (w == 0) smn = gdn_prep_scal(A, unit, lane); }
  for (; unit < nunits; unit += G) {
    const int h = (unit / NCH) % 8;
    unsigned char* blob = A.blob + (size_t)unit * BLOB;
    if (w == 0) {
        const float xf = smn.x + A.dtb_f[h], xb = smn.y + A.dtb_b[h];
        const float spf = xf > 20.f ? xf : log1pf(__expf(xf)), spb = xb > 20.f ? xb : log1pf(__expf(xb));
        const float gf = -__expf(A.a_log_f[h]) * spf, gb = -__expf(A.a_log_b[h]) * spb;
        float pf = gf, pb = gb;
#pragma unroll
        for (int o = 1; o < 64; o <<= 1) { const float yf = __shfl_up(pf, o), yb = __shfl_up(pb, o); if (lane >= o) { pf += yf; pb += yb; } }
        const float totb = __shfl(pb, 63);
        const float gcf = pf, gcb = totb - pb + gb;
        LAS float* sc = (LAS float*)(lds + L_SC);
        sc[lane] = gcf; sc[64 + lane] = gcb; sc[128 + lane] = sigmoidf_(smn.z); sc[192 + lane] = sigmoidf_(smn.w);
        float* gsc = (float*)(blob + B_SC); if (pflg & 8) gsc = (float*)(lds + L_LPF);
        const float glf = __shfl(pf, 63), glb = totb;
        gsc[lane] = gcf; gsc[64 + lane] = gcb; gsc[128 + lane] = __expf(gcf); gsc[192 + lane] = __expf(gcb); gsc[256 + lane] = __expf(glf - gcf); gsc[320 + lane] = __expf(glb - gcb);
        if (lane < 2) gsc[384 + lane] = __expf(lane ? glb : glf);
    }
    __syncthreads();
    if (!(pflg & 32)) {
        const int p0 = 8 * w;
#pragma unroll
        for (int m = 0; m < 3; ++m) {
            float wc[5][2];
#pragma unroll
            for (int tau = 0; tau < 5; ++tau) { const f32x2_t t2 = *(const f32x2_t*)(A.conv_w + tau * 3072 + m * 1024 + h * 128 + 2 * lane); wc[tau][0] = t2.x; wc[tau][1] = t2.y; }
            float in[12][2];
#pragma unroll
            for (int i = 0; i < 12; ++i) { const unsigned u = *(const LAS unsigned*)(lds + L_PRE + ((p0 + i) * 3 + m) * 256 + lane * 4); in[i][0] = bflo(u); in[i][1] = bfhi(u); }
            float y[8][2];
#pragma unroll
            for (int pp = 0; pp < 8; ++pp)
#pragma unroll
                for (int c = 0; c < 2; ++c) { float s = 0.f;
#pragma unroll
                    for (int tau = 0; tau < 5; ++tau) s += wc[tau][c] * in[pp + tau][c];
                    y[pp][c] = s * __builtin_amdgcn_rcpf(1.0f + __builtin_amdgcn_exp2f(-1.4426950408889634f * s)); }
            if (m < 2) {
#pragma unroll
                for (int pp = 0; pp < 8; ++pp) { float ss = row16_sum(y[pp][0] * y[pp][0] + y[pp][1] * y[pp][1]); ss += __shfl_xor(ss, 16); ss += __shfl_xor(ss, 32); const float rn = __builtin_amdgcn_rsqf(ss + EPS);
                    *(LAS unsigned*)(lds + (m == 0 ? L_QN : L_KN) + (p0 + pp) * QS_ + lane * 4) = pkbf(y[pp][0] * rn, y[pp][1] * rn); }
            } else {
#pragma unroll
                for (int c = 0; c < 2; ++c) { v4u o; o.x = pkbf(y[0][c], y[1][c]); o.y = pkbf(y[2][c], y[3][c]); o.z = pkbf(y[4][c], y[5][c]); o.w = pkbf(y[6][c], y[7][c]);
                    if (!(pflg & 8)) *(v4u*)(blob + B_VT + (2 * lane + c) * 128 + p0 * 2) = o; }
            }
        }
    }
    __syncthreads();
    { const int un = unit + G; if (un < nunits) { gdn_prep_issue(lds, A, un, w, lane, zero_page); if (w == 0) smn = gdn_prep_scal(A, un, lane); } }
    {
        const int which = w >> 2, rt = (w >> 1) & 1, ct = w & 1, r = lane & 31, hh = lane >> 5;
        const LAS unsigned char* ia = lds + (which ? L_QN : L_KN) + (32 * rt + r) * QS_ + 16 * hh;
        const LAS unsigned char* ib = lds + L_KN + (32 * ct + r) * QS_ + 16 * hh;
        f32x16 acc = zero16();
#pragma unroll
        for (int ks = 0; ks < 8; ++ks) acc = MFMA32(*(const LAS bf16x8*)(ia + 32 * ks), *(const LAS bf16x8*)(ib + 32 * ks), acc);
        const LAS float* sc = (const LAS float*)(lds + L_SC);
        const int j = 32 * ct + r; const float gfj = sc[j], gbj = sc[64 + j];
#pragma unroll
        for (int reg = 0; reg < 16; ++reg) {
            const int i = 32 * rt + (reg & 3) + 8 * (reg >> 2) + 4 * hh; const float val = acc[reg];
            const float ef = __expf(sc[i] - gfj), eb = __expf(sc[64 + i] - gbj);
            if (which == 0) {
                const float lf = (i > j) ? sc[128 + i] * val * ef : 0.f, lb = (i < j) ? sc[192 + i] * val * eb : 0.f;
                ((LAS float*)(lds + L_LPF))[i * 64 + (j & 3) * 16 + (j >> 2)] = lf;
                const int i2 = 63 - i, j2 = 63 - j;
                ((LAS float*)(lds + L_LPB))[i2 * 64 + (j2 & 3) * 16 + (j2 >> 2)] = lb;
            } else {
                const float af = (i >= j) ? QSCALE * val * ef : 0.f, ab = (i <= j) ? QSCALE * val * eb : 0.f;
                *(LAS unsigned short*)(lds + L_AF + i * AS_ + j * 2) = (unsigned short)(pkbf(af, 0.f) & 0xffffu);
                *(LAS unsigned short*)(lds + L_AB + i * AS_ + j * 2) = (unsigned short)(pkbf(ab, 0.f) & 0xffffu);
            }
        }
    }
    LBAR();
    if (!(pflg & 16)) {
        const int dir = w >> 2, li = (w & 3) * 64 + lane, j = li >> 2, q = li & 3;
        const LAS float* LP = (const LAS float*)(lds + (dir ? L_LPB : L_LPF)) + q * 16;
        float t[16];
#pragma unroll
        for (int a = 0; a < 16; ++a) t[a] = 0.f;
        constexpr int PD = 1;
        f32x4 lq[PD + 1][4];
#define SOLVE_LD(i_) do { _Pragma("unroll") for (int a4 = 0; a4 < ((i_) + 15) / 16; ++a4) lq[(i_) % (PD + 1)][a4] = *(const LAS f32x4*)(LP + (i_) * 64 + 4 * a4); } while (0)
#pragma unroll
        for (int i = 0; i < PD; ++i) SOLVE_LD(i);
#pragma unroll
        for (int i = 0; i < 64; ++i) {
            if (i + PD < 64) SOLVE_LD(i + PD);
            float p0 = 0.f, p1 = 0.f;
#pragma unroll
            for (int a4 = 0; a4 < (i + 15) / 16; ++a4) { const f32x4 lv = lq[i % (PD + 1)][a4];
                p0 = __builtin_fmaf(lv.x, t[4 * a4], p0); p1 = __builtin_fmaf(lv.y, t[4 * a4 + 1], p1); p0 = __builtin_fmaf(lv.z, t[4 * a4 + 2], p0); p1 = __builtin_fmaf(lv.w, t[4 * a4 + 3], p1); }
            float p = quad_sum(p0 + p1);
            const float ti = (i == j ? 1.f : 0.f) - p;
            if (q == (i & 3)) t[i >> 2] = ti;
            __builtin_amdgcn_sched_barrier(0);
        }
#undef SOLVE_LD
        const LAS float* sc = (const LAS float*)(lds + L_SC);
        if (dir == 0) { const float bj = sc[128 + j];
#pragma unroll
            for (int a = 0; a < 16; ++a) *(LAS unsigned short*)(lds + L_TBF + (4 * a + q) * AS_ + j * 2) = (unsigned short)(pkbf(t[a] * bj, 0.f) & 0xffffu);
        } else { const int jo = 63 - j; const float bj = sc[192 + jo];
#pragma unroll
            for (int a = 0; a < 16; ++a) *(LAS unsigned short*)(lds + L_TBB + (63 - (4 * a + q)) * AS_ + jo * 2) = (unsigned short)(pkbf(t[a] * bj, 0.f) & 0xffffu);
        }
    }
    LBAR();
    if (!(pflg & 64)) for (int blk = w; blk < 80; blk += 8) {
        v4u f; int off;
        if (blk < 16)      { f = frag16_rm(lds + L_KN, QS_, blk >> 2, blk & 3, lane); off = B_KA + blk * 1024; }
        else if (blk < 32) { const int b = blk - 16; f = frag16_rm(lds + L_QN, QS_, b >> 2, b & 3, lane); off = B_QA + b * 1024; }
        else if (blk < 48) { const int b = blk - 32; f = frag16_tr(lds + L_KN, QS_, b >> 1, b & 1, lane); off = B_KT + b * 1024; }
        else { const int b = blk - 48, wh = b >> 3, bb = b & 7; const int lo = wh == 0 ? L_TBF : wh == 1 ? L_AF : wh == 2 ? L_TBB : L_AB;
               f = frag16_rm(lds + lo, AS_, bb >> 1, bb & 1, lane); off = B_TBF + b * 1024; }
        if (!(pflg & 8)) *(v4u*)(blob + off + lane * 16) = f; else asm volatile("" :: "v"(f));
    }
    LBAR();
  }
}
struct GdnChainArgs {
    const unsigned char* blob;
    unsigned char* stg;
    unsigned* flag;
    int nseq, flags;
};
namespace gdn { constexpr int C_Y = XBLK * 1024, C_BUF = C_Y + YBLK * 1024, C_END = 2 * C_BUF; }
#define CHAIN_SPIN_CAP (1u << 22)
#define MFMA16(a, b, c) __builtin_amdgcn_mfma_f32_16x16x32_bf16((a), (b), (c), 0, 0, 0)
__device__ __forceinline__ bf16x8 pack16(const f32x4& a, const f32x4& b) { v4u p; p.x = pkbf(a.x, a.y); p.y = pkbf(a.z, a.w); p.z = pkbf(b.x, b.y); p.w = pkbf(b.z, b.w); return __builtin_bit_cast(bf16x8, p); }

__device__ __forceinline__ void gdn_chain_unit(LAS unsigned char* lds, const GdnChainArgs& A, int item) {
    using namespace gdn;
    int tid_l = threadIdx.x; asm volatile("" : "+v"(tid_l));
    const int tid = tid_l, lane = tid & 63, w = __builtin_amdgcn_readfirstlane(tid >> 6);
    const int r = lane & 15, q = lane >> 4;
    const int c = item & 1, h = (item >> 1) & 7, sq = item >> 4; const int flags = A.flags;
    const size_t unit0 = (size_t)(sq * 8 + h) * NCH;
    const f32x4 z4 = (f32x4){0.f, 0.f, 0.f, 0.f};
    f32x4 S[8];
#pragma unroll
    for (int t = 0; t < 8; ++t) S[t] = z4;
    v2u vnext[4];
    unsigned long long pwn[4]; bool have = false; unsigned fnext = 0u;
#define GDN_ISSUE(s_, buf_) do { const int n_ = c ? NCH - 1 - (s_) : (s_); const unsigned char* bl_ = A.blob + (unit0 + n_) * BLOB; LAS unsigned char* d_ = lds + (buf_) * C_BUF; \
        { const unsigned char* vp_ = bl_ + B_VT + (16 * w + r) * 128 + 8 * q; _Pragma("unroll") for (int i = 0; i < 4; ++i) vnext[i] = *(const v2u*)(vp_ + 32 * i); } \
        if (!(flags & 4)) { glds_blocks(d_, bl_, XBLK, w, 8, lane); \
            if (c == 0) glds_blocks(d_ + C_Y, bl_ + B_KT, YBLK, w, 8, lane); \
            else { glds_blocks(d_ + C_Y, bl_ + B_KT, 16, w, 8, lane); glds_blocks(d_ + C_Y + 16384, bl_ + B_TBB, 16, w, 8, lane); } } } while (0)
    GDN_ISSUE(0, 0);
    __syncthreads();
    for (int s = 0; s < NCH; ++s) {
        const int n = c ? NCH - 1 - s : s;
        v2u vcur[4];
#pragma unroll
        for (int i = 0; i < 4; ++i) vcur[i] = vnext[i];
        unsigned long long* sp = (unsigned long long*)(A.stg + (unit0 + n) * 16384 + w * 2048) + lane;
        unsigned* fl = A.flag + (unit0 + n) * 8 + w;
        unsigned long long pw[4];
        if (s >= NCH / 2 && !(flags & 1)) {
            if (have) {
#pragma unroll
                for (int i = 0; i < 4; ++i) pw[i] = pwn[i];
            } else {
                for (unsigned sp_ = 0; __builtin_amdgcn_readfirstlane((int)__hip_atomic_load(fl, __ATOMIC_RELAXED, __HIP_MEMORY_SCOPE_AGENT)) == 0 && sp_ < CHAIN_SPIN_CAP; ++sp_) __builtin_amdgcn_s_sleep(2);
#pragma unroll
                for (int i = 0; i < 4; ++i) pw[i] = __hip_atomic_load(sp + i * 64, __ATOMIC_RELAXED, __HIP_MEMORY_SCOPE_AGENT);
            }
        }
        have = false;
        if (s + 1 >= NCH / 2 && s + 1 < NCH && !(flags & 1) && __builtin_amdgcn_readfirstlane((int)fnext) != 0) {
            const int n1 = c ? NCH - 2 - s : s + 1; const unsigned long long* sp1 = (const unsigned long long*)(A.stg + (unit0 + n1) * 16384 + w * 2048) + lane;
#pragma unroll
            for (int i = 0; i < 4; ++i) pwn[i] = __hip_atomic_load(sp1 + i * 64, __ATOMIC_RELAXED, __HIP_MEMORY_SCOPE_AGENT);
            have = true;
        }
        if (s + 2 >= NCH / 2 && s + 2 < NCH && !(flags & 1)) { const int n2 = c ? NCH - 3 - s : s + 2; fnext = __hip_atomic_load(A.flag + (unit0 + n2) * 8 + w, __ATOMIC_RELAXED, __HIP_MEMORY_SCOPE_AGENT); }
        if (s + 1 < NCH) GDN_ISSUE(s + 1, (s + 1) & 1);
        const LAS unsigned char* X = lds + (s & 1) * C_BUF; const LAS unsigned char* Y = X + C_Y; const LAS unsigned char* YT = Y + 16384;
        const LAS float* sc = (const LAS float*)(X + B_SC);
        bf16x8 sb[4];
#pragma unroll
        for (int k = 0; k < 4; ++k) sb[k] = pack16(S[2 * k], S[2 * k + 1]);
        f32x4 KS[4], QS[4];
#pragma unroll
        for (int rt = 0; rt < 4; ++rt) { KS[rt] = z4; QS[rt] = z4; }
        {
            constexpr int R = 8; bf16x8 ring[R];
#define G1_LD(i_) lds_frag(X + (((i_) & 1) ? B_QA : B_KA), ((i_) >> 3) * 4 + (((i_) >> 1) & 3), lane)
#pragma unroll
            for (int i = 0; i < R; ++i) ring[i] = G1_LD(i);
#pragma unroll
            for (int i = 0; i < 32; ++i) { const int rt = i >> 3, ks = (i >> 1) & 3;
                if (i & 1) QS[rt] = MFMA16(ring[i % R], sb[ks], QS[rt]); else KS[rt] = MFMA16(ring[i % R], sb[ks], KS[rt]);
                if (i + R < 32) ring[i % R] = G1_LD(i + R);
                __builtin_amdgcn_sched_barrier(0); }
#undef G1_LD
        }
#pragma unroll
        for (int rt = 0; rt < 4; ++rt) { const v2u vv = vcur[rt]; const f32x4 ev = *(const LAS f32x4*)(sc + 128 + c * 64 + 16 * rt + 4 * q);
            KS[rt].x = bflo(vv.x) - ev.x * KS[rt].x; KS[rt].y = bfhi(vv.x) - ev.y * KS[rt].y; KS[rt].z = bflo(vv.y) - ev.z * KS[rt].z; KS[rt].w = bfhi(vv.y) - ev.w * KS[rt].w; }
        bf16x8 rb[2] = {pack16(KS[0], KS[1]), pack16(KS[2], KS[3])};
        f32x4 vn[4];
#pragma unroll
        for (int rt = 0; rt < 4; ++rt) vn[rt] = z4;
        {   constexpr int R = 8; bf16x8 ring[R];
#pragma unroll
            for (int i = 0; i < R; ++i) ring[i] = lds_frag(YT, i, lane);
#pragma unroll
            for (int i = 0; i < 8; ++i) { vn[i >> 1] = MFMA16(ring[i], rb[i & 1], vn[i >> 1]); __builtin_amdgcn_sched_barrier(0); }
        }
        bf16x8 vb[2] = {pack16(vn[0], vn[1]), pack16(vn[2], vn[3])};
        f32x4 (&o)[4] = QS;
#pragma unroll
        for (int rt = 0; rt < 4; ++rt) { const f32x4 ev = *(const LAS f32x4*)(sc + 128 + c * 64 + 16 * rt + 4 * q);
            o[rt].x *= QSCALE * ev.x; o[rt].y *= QSCALE * ev.y; o[rt].z *= QSCALE * ev.z; o[rt].w *= QSCALE * ev.w; }
        {   constexpr int R = 8; bf16x8 ring[R];
#pragma unroll
            for (int i = 0; i < R; ++i) ring[i] = lds_frag(YT + 8192, i, lane);
#pragma unroll
            for (int i = 0; i < 8; ++i) { o[i >> 1] = MFMA16(ring[i], vb[i & 1], o[i >> 1]); __builtin_amdgcn_sched_barrier(0); }
        }
        if (!(flags & 1)) {
            if (s < NCH / 2) {
#pragma unroll
                for (int rt = 0; rt < 4; ++rt) __hip_atomic_store(sp + rt * 64, (unsigned long long)pkbf(o[rt].x, o[rt].y) | ((unsigned long long)pkbf(o[rt].z, o[rt].w) << 32), __ATOMIC_RELAXED, __HIP_MEMORY_SCOPE_AGENT);
            } else {
#pragma unroll
                for (int rt = 0; rt < 4; ++rt) { const unsigned plo = (unsigned)pw[rt], phi = (unsigned)(pw[rt] >> 32);
                    __hip_atomic_store(sp + rt * 64, (unsigned long long)pkbf(o[rt].x + bflo(plo), o[rt].y + bfhi(plo)) | ((unsigned long long)pkbf(o[rt].z + bflo(phi), o[rt].w + bfhi(phi)) << 32), __ATOMIC_RELAXED, __HIP_MEMORY_SCOPE_AGENT); }
            }
        }
#pragma unroll
        for (int rt = 0; rt < 4; ++rt) { const f32x4 ev = *(const LAS f32x4*)(sc + 256 + c * 64 + 16 * rt + 4 * q);
            vn[rt].x *= ev.x; vn[rt].y *= ev.y; vn[rt].z *= ev.z; vn[rt].w *= ev.w; }
        vb[0] = pack16(vn[0], vn[1]); vb[1] = pack16(vn[2], vn[3]);
        const float egl = sc[384 + c];
#pragma unroll
        for (int t = 0; t < 8; ++t) { S[t].x *= egl; S[t].y *= egl; S[t].z *= egl; S[t].w *= egl; }
        {   constexpr int R = 8; bf16x8 ring[R];
#pragma unroll
            for (int i = 0; i < R; ++i) ring[i] = lds_frag(Y, i, lane);
#pragma unroll
            for (int i = 0; i < 16; ++i) { S[i >> 1] = MFMA16(ring[i % R], vb[i & 1], S[i >> 1]); if (i + R < 16) ring[i % R] = lds_frag(Y, i + R, lane); __builtin_amdgcn_sched_barrier(0); }
        }
        if (!(flags & 1)) { asm volatile("s_waitcnt vmcnt(0)" ::: "memory"); if (lane == 0) __hip_atomic_store(fl, s < NCH / 2 ? 1u : 2u, __ATOMIC_RELAXED, __HIP_MEMORY_SCOPE_AGENT); }
        __syncthreads();
    }
#undef GDN_ISSUE
}
namespace gla {
constexpr int B_QGF = 0, B_QGB = 16384, B_SC = 32768, B_KDTF = 33792, B_KDTB = 50176, BLOBA = 66560;
constexpr int B_VB = 0, B_INTRA = 32768, BLOBB = 65536;
constexpr int L_R = 0, L_QGF = 8192, L_KGF = L_QGF + 17408, L_KDF = L_KGF + 17408, L_QGB = L_KDF + 17408, L_KGB = L_QGB + 17408, L_KDB = L_KGB + 17408, L_V = L_KDB + 17408, L_TOT = L_V + 33792, L_AS = L_TOT + 4096, L_END = L_AS + 9216;
static_assert(L_END <= 160 * 1024 - 256, "gla prep LDS");
constexpr int QS_ = 272, VS_ = 528, AS_ = 144;
constexpr int C_X = 0, C_Y = 17408, C_CHAIN = 66560, C_EG = 2 * C_CHAIN, C_END = C_EG + 1024;
__device__ __forceinline__ v4u frag_tr_nat(const LAS unsigned char* img, int st, int colbase, int ks, int lane) {
    const int r = lane & 31, hh = lane >> 5; const LAS unsigned char* p = img + (16 * ks + 8 * hh) * st + (colbase + r) * 2;
    unsigned short e[8];
#pragma unroll
    for (int j = 0; j < 8; ++j) e[j] = *(const LAS unsigned short*)(p + j * st);
    return (v4u){(unsigned)e[0] | ((unsigned)e[1] << 16), (unsigned)e[2] | ((unsigned)e[3] << 16), (unsigned)e[4] | ((unsigned)e[5] << 16), (unsigned)e[6] | ((unsigned)e[7] << 16)};
}
__device__ __forceinline__ float logsig2(float x) { const float xc = fminf(fmaxf(x, -60.f), 60.f); return -__builtin_amdgcn_logf(1.0f + __builtin_amdgcn_exp2f(-1.4426950408889634f * xc)); }
}

struct GlaPrepArgs {
    const bf16* qk;
    const bf16* vb;
    const float* small;
    const float *w2f, *b2f, *w2b, *b2b;
    unsigned char* blobA;
    unsigned char* blobB;
    int nseq, pad_;
};

__device__ __forceinline__ void gla_prep_phase(LAS unsigned char* lds, const GlaPrepArgs& A, int bid, int G) {
    using namespace gla;
    int tid_l = threadIdx.x; asm volatile("" : "+v"(tid_l));
    const int tid = tid_l, lane = tid & 63, w = __builtin_amdgcn_readfirstlane(tid >> 6);
    const int nunits = A.nseq * 4 * NCH;
    f32x4 pr; v4u pv[4], pq[2], pk[2];
#define GLA_PREFETCH(u_) do { const int n_ = (u_) % NCH, h_ = ((u_) / NCH) % 4, sq_ = (u_) / (NCH * 4); const size_t r_ = (size_t)sq_ * SEQ + n_ * CHUNK; \
        pr = *(const f32x4*)(A.small + (r_ + (tid >> 3)) * 64 + 32 + (tid & 7) * 4); \
        _Pragma("unroll") for (int i = 0; i < 4; ++i) { const int id = i * 512 + tid; pv[i] = *(const v4u*)(A.vb + (r_ + (id >> 5)) * 1024 + h_ * 256 + (id & 31) * 8); } \
        _Pragma("unroll") for (int i = 0; i < 2; ++i) { const int id = i * 512 + tid; const bf16* qp_ = A.qk + (r_ + (id >> 4)) * 1024 + h_ * 128 + (id & 15) * 8; pq[i] = *(const v4u*)qp_; pk[i] = *(const v4u*)(qp_ + 512); } } while (0)
    int unit = bid;
    if (unit < nunits) GLA_PREFETCH(unit);
  for (; unit < nunits; unit += G) {
    const int h = (unit / NCH) % 4;
    unsigned char* blob = A.blobA + (size_t)unit * BLOBA; unsigned char* blobB = A.blobB + (size_t)unit * BLOBB;
    *(LAS f32x4*)(lds + L_R + (tid >> 3) * 128 + (tid & 7) * 16) = pr;
#pragma unroll
    for (int i = 0; i < 4; ++i) { const int id = i * 512 + tid; *(LAS v4u*)(lds + L_V + (id >> 5) * VS_ + (id & 31) * 16) = pv[i]; }
#pragma unroll
    for (int i = 0; i < 2; ++i) { const int id = i * 512 + tid; *(LAS v4u*)(lds + L_QGF + (id >> 4) * QS_ + (id & 15) * 16) = pq[i]; *(LAS v4u*)(lds + L_KGF + (id >> 4) * QS_ + (id & 15) * 16) = pk[i]; }
    LBAR();
    {
        const int dd = tid & 127, pg = tid >> 7, d = h * 128 + dd;
        float wf[16], wb[16];
#pragma unroll
        for (int i = 0; i < 16; ++i) { wf[i] = A.w2f[i * 512 + d]; wb[i] = A.w2b[i * 512 + d]; }
        const float bf_ = A.b2f[d], bb_ = A.b2b[d];
        float lf[16], lb[16];
#pragma unroll
        for (int pp = 0; pp < 16; ++pp) {
            const LAS float* rr = (const LAS float*)(lds + L_R) + (pg * 16 + pp) * 32;
            float xf = bf_, xb = bb_;
#pragma unroll
            for (int i4 = 0; i4 < 4; ++i4) { const f32x4 a = *(const LAS f32x4*)(rr + 4 * i4), b = *(const LAS f32x4*)(rr + 16 + 4 * i4);
                xf += a.x * wf[4 * i4] + a.y * wf[4 * i4 + 1] + a.z * wf[4 * i4 + 2] + a.w * wf[4 * i4 + 3];
                xb += b.x * wb[4 * i4] + b.y * wb[4 * i4 + 1] + b.z * wb[4 * i4 + 2] + b.w * wb[4 * i4 + 3]; }
            lf[pp] = logsig2(xf) * (1.f / 16.f); lb[pp] = logsig2(xb) * (1.f / 16.f);
        }
#pragma unroll
        for (int pp = 1; pp < 16; ++pp) lf[pp] += lf[pp - 1];
#pragma unroll
        for (int pp = 14; pp >= 0; --pp) lb[pp] += lb[pp + 1];
        LAS float* tot = (LAS float*)(lds + L_TOT);
        tot[pg * 128 + dd] = lf[15]; tot[512 + pg * 128 + dd] = lb[0];
        LBAR();
        float offf = 0.f, offb = 0.f, glf = 0.f, glb = 0.f;
#pragma unroll
        for (int g = 0; g < 4; ++g) { const float tf = tot[g * 128 + dd], tb = tot[512 + g * 128 + dd]; glf += tf; glb += tb; if (g < pg) offf += tf; if (g > pg) offb += tb; }
        const float eglf = __builtin_amdgcn_exp2f(glf), eglb = __builtin_amdgcn_exp2f(glb);
        if (pg == 0) { float* sc = (float*)(blob + B_SC); sc[dd] = eglf; sc[128 + dd] = eglb; }
#pragma unroll
        for (int pp = 0; pp < 16; ++pp) {
            const int o = (pg * 16 + pp) * QS_ + dd * 2;
            const float qv = bf2f(*(const LAS unsigned short*)(lds + L_QGF + o)) * QSCALE, kv = bf2f(*(const LAS unsigned short*)(lds + L_KGF + o));
            const float ef = __builtin_amdgcn_exp2f(lf[pp] + offf), eb = __builtin_amdgcn_exp2f(lb[pp] + offb);
            const float rf = __builtin_amdgcn_rcpf(ef), rb = __builtin_amdgcn_rcpf(eb);
            *(LAS unsigned short*)(lds + L_QGF + o) = (unsigned short)(pkbf(qv * ef, 0.f) & 0xffffu);
            *(LAS unsigned short*)(lds + L_KGF + o) = (unsigned short)(pkbf(kv * rf, 0.f) & 0xffffu);
            *(LAS unsigned short*)(lds + L_KDF + o) = (unsigned short)(pkbf(kv * rf * eglf, 0.f) & 0xffffu);
            *(LAS unsigned short*)(lds + L_QGB + o) = (unsigned short)(pkbf(qv * eb, 0.f) & 0xffffu);
            *(LAS unsigned short*)(lds + L_KGB + o) = (unsigned short)(pkbf(kv * rb, 0.f) & 0xffffu);
            *(LAS unsigned short*)(lds + L_KDB + o) = (unsigned short)(pkbf(kv * rb * eglb, 0.f) & 0xffffu);
        }
    }
    LBAR();
    { const int un = unit + G; if (un < nunits) GLA_PREFETCH(un); }
    if (w < 4) {
        const int rt = w >> 1, ct = w & 1, r = lane & 31, hh = lane >> 5;
        f32x16 af = zero16(), ab = zero16();
        if (rt >= ct) { const LAS unsigned char* ia = lds + L_QGF + (32 * rt + r) * QS_ + 16 * hh; const LAS unsigned char* ib = lds + L_KGF + (32 * ct + r) * QS_ + 16 * hh;
#pragma unroll
            for (int ks = 0; ks < 8; ++ks) af = MFMA32(*(const LAS bf16x8*)(ia + 32 * ks), *(const LAS bf16x8*)(ib + 32 * ks), af); }
        if (rt <= ct) { const LAS unsigned char* ia = lds + L_QGB + (32 * rt + r) * QS_ + 16 * hh; const LAS unsigned char* ib = lds + L_KGB + (32 * ct + r) * QS_ + 16 * hh;
#pragma unroll
            for (int ks = 0; ks < 8; ++ks) ab = MFMA32(*(const LAS bf16x8*)(ia + 32 * ks), *(const LAS bf16x8*)(ib + 32 * ks), ab); }
        const int j = 32 * ct + r;
#pragma unroll
        for (int reg = 0; reg < 16; ++reg) { const int i = 32 * rt + (reg & 3) + 8 * (reg >> 2) + 4 * hh;
            const float val = (i >= j ? af[reg] : 0.f) + (i <= j ? ab[reg] : 0.f);
            *(LAS unsigned short*)(lds + L_AS + i * AS_ + j * 2) = (unsigned short)(pkbf(val, 0.f) & 0xffffu); }
    } else {
        for (int blk = w - 4; blk < 64; blk += 4) {
            const int wh = blk >> 4, b = blk & 15; v4u f; int off;
            if (wh == 0)      { f = gdn::frag_rm_perm(lds + L_QGF, QS_, b >> 3, b & 7, lane); off = B_QGF; }
            else if (wh == 1) { f = gdn::frag_rm_perm(lds + L_QGB, QS_, b >> 3, b & 7, lane); off = B_QGB; }
            else if (wh == 2) { f = frag_tr_nat(lds + L_KDF, QS_, 32 * (b >> 2), b & 3, lane); off = B_KDTF; }
            else              { f = frag_tr_nat(lds + L_KDB, QS_, 32 * (b >> 2), b & 3, lane); off = B_KDTB; }
            *(v4u*)(blob + off + b * 1024 + lane * 16) = f;
        }
    }
    LBAR();
    {
        const int ct = w, r = lane & 31, hh = lane >> 5;
        f32x16 o[2] = {zero16(), zero16()};
#pragma unroll
        for (int ks = 0; ks < 4; ++ks) {
            const v4u fb = frag_tr_nat(lds + L_V, VS_, 32 * ct, ks, lane);
            *(v4u*)(blobB + B_VB + (ct * 4 + ks) * 1024 + lane * 16) = fb;
            const bf16x8 bfr = __builtin_bit_cast(bf16x8, fb);
#pragma unroll
            for (int rt = 0; rt < 2; ++rt) o[rt] = MFMA32(*(const LAS bf16x8*)(lds + L_AS + (32 * rt + r) * AS_ + (16 * ks + 8 * hh) * 2), bfr, o[rt]);
        }
        unsigned long long* ip = (unsigned long long*)(blobB + B_INTRA) + (size_t)ct * 512 + lane;
#pragma unroll
        for (int rt = 0; rt < 2; ++rt)
#pragma unroll
            for (int g = 0; g < 4; ++g) ip[(rt * 4 + g) * 64] = (unsigned long long)pkbf(o[rt][4 * g], o[rt][4 * g + 1]) | ((unsigned long long)pkbf(o[rt][4 * g + 2], o[rt][4 * g + 3]) << 32);
    }
    LBAR();
  }
#undef GLA_PREFETCH
}

struct GlaChainArgs {
    const unsigned char* blobA;
    const unsigned char* blobB;
    unsigned char* stg;
    unsigned* flag;
    int nseq, flags;
};
namespace gla { constexpr int CB_Y = 17408, CB_BUF = 66560, CB_END = 2 * CB_BUF; }
__device__ __forceinline__ void gla_chain_unit(LAS unsigned char* lds, const GlaChainArgs& A, int item) {
    using namespace gla;
    int tid_l = threadIdx.x; asm volatile("" : "+v"(tid_l));
    const int tid = tid_l, lane = tid & 63, w = __builtin_amdgcn_readfirstlane(tid >> 6);
    const int hh = lane >> 5;
    const int c = item & 1, h = (item >> 1) & 3, sq = item >> 3; const int flags = A.flags;
    const size_t unit0 = (size_t)(sq * 4 + h) * NCH;
    f32x16 S[4];
#pragma unroll
    for (int t = 0; t < 4; ++t) S[t] = zero16();
    unsigned long long pwn[8]; bool have = false; unsigned fnext = 0u;
#define GLA_ISSUE(s_, buf_) do { if (!(flags & 4)) { const int n_ = c ? NCH - 1 - (s_) : (s_); const unsigned char* bl_ = A.blobA + (unit0 + n_) * BLOBA; const unsigned char* bb_ = A.blobB + (unit0 + n_) * BLOBB; \
        LAS unsigned char* d_ = lds + (buf_) * CB_BUF; glds_blocks(d_, bl_ + (c ? B_QGB : B_QGF), 16, w, 8, lane); if (w == 7) glds_blocks(d_ + 16384, bl_ + B_SC, 1, 0, 1, lane); \
        glds_blocks(d_ + CB_Y, bl_ + (c ? B_KDTB : B_KDTF), 16, w, 8, lane); glds_blocks(d_ + CB_Y + 16384, bb_ + B_VB, 32, w, 8, lane); } } while (0)
    GLA_ISSUE(0, 0);
    __syncthreads();
    for (int s = 0; s < NCH; ++s) {
        const int n = c ? NCH - 1 - s : s;
        unsigned long long* sp = (unsigned long long*)(A.stg + (unit0 + n) * 32768) + (size_t)w * 512 + lane;
        unsigned* fl = A.flag + (unit0 + n) * 8 + w;
        unsigned long long pw[8];
        if (s >= NCH / 2 && !(flags & 1)) {
            if (have) {
#pragma unroll
                for (int i = 0; i < 8; ++i) pw[i] = pwn[i];
            } else {
                for (unsigned sp_ = 0; __builtin_amdgcn_readfirstlane((int)__hip_atomic_load(fl, __ATOMIC_RELAXED, __HIP_MEMORY_SCOPE_AGENT)) == 0 && sp_ < CHAIN_SPIN_CAP; ++sp_) __builtin_amdgcn_s_sleep(2);
#pragma unroll
                for (int i = 0; i < 8; ++i) pw[i] = __hip_atomic_load(sp + i * 64, __ATOMIC_RELAXED, __HIP_MEMORY_SCOPE_AGENT);
            }
        }
        have = false;
        if (s + 1 >= NCH / 2 && s + 1 < NCH && !(flags & 1) && __builtin_amdgcn_readfirstlane((int)fnext) != 0) {
            const int n1 = c ? NCH - 2 - s : s + 1; const unsigned long long* sp1 = (const unsigned long long*)(A.stg + (unit0 + n1) * 32768) + (size_t)w * 512 + lane;
#pragma unroll
            for (int i = 0; i < 8; ++i) pwn[i] = __hip_atomic_load(sp1 + i * 64, __ATOMIC_RELAXED, __HIP_MEMORY_SCOPE_AGENT);
            have = true;
        }
        if (s + 2 >= NCH / 2 && s + 2 < NCH && !(flags & 1)) { const int n2 = c ? NCH - 3 - s : s + 2; fnext = __hip_atomic_load(A.flag + (unit0 + n2) * 8 + w, __ATOMIC_RELAXED, __HIP_MEMORY_SCOPE_AGENT); }
        if (s + 1 < NCH) GLA_ISSUE(s + 1, (s + 1) & 1);
        const LAS unsigned char* X = lds + (s & 1) * CB_BUF; const LAS unsigned char* Y = X + CB_Y;
        const LAS float* EG = (const LAS float*)(X + 16384) + c * 128;
        bf16x8 sb[8];
#pragma unroll
        for (int t = 0; t < 4; ++t) { sb[2 * t] = pack8(S[t], 0); sb[2 * t + 1] = pack8(S[t], 1); }
        f32x16 o[2] = {zero16(), zero16()};
        {   constexpr int R = 6; bf16x8 ring[R];
#pragma unroll
            for (int i = 0; i < R; ++i) ring[i] = lds_frag(X, i, lane);
#pragma unroll
            for (int i = 0; i < 16; ++i) { o[i >> 3] = MFMA32(ring[i % R], sb[i & 7], o[i >> 3]); if (i + R < 16) ring[i % R] = lds_frag(X, i + R, lane); __builtin_amdgcn_sched_barrier(0); }
        }
        if (!(flags & 1)) {
            if (s < NCH / 2) {
#pragma unroll
                for (int rt = 0; rt < 2; ++rt)
#pragma unroll
                    for (int g = 0; g < 4; ++g) __hip_atomic_store(sp + (rt * 4 + g) * 64, (unsigned long long)pkbf(o[rt][4 * g], o[rt][4 * g + 1]) | ((unsigned long long)pkbf(o[rt][4 * g + 2], o[rt][4 * g + 3]) << 32), __ATOMIC_RELAXED, __HIP_MEMORY_SCOPE_AGENT);
            } else {
#pragma unroll
                for (int rt = 0; rt < 2; ++rt)
#pragma unroll
                    for (int g = 0; g < 4; ++g) { const unsigned plo = (unsigned)pw[rt * 4 + g], phi = (unsigned)(pw[rt * 4 + g] >> 32);
                        __hip_atomic_store(sp + (rt * 4 + g) * 64, (unsigned long long)pkbf(o[rt][4 * g] + bflo(plo), o[rt][4 * g + 1] + bfhi(plo)) | ((unsigned long long)pkbf(o[rt][4 * g + 2] + bflo(phi), o[rt][4 * g + 3] + bfhi(phi)) << 32), __ATOMIC_RELAXED, __HIP_MEMORY_SCOPE_AGENT); }
            }
        }
        {
            bf16x8 bfr[4];
#pragma unroll
            for (int ks = 0; ks < 4; ++ks) bfr[ks] = lds_frag(Y + 16384, w * 4 + ks, lane);
#pragma unroll
            for (int t = 0; t < 4; ++t)
#pragma unroll
                for (int g = 0; g < 4; ++g) { const f32x4 ev = *(const LAS f32x4*)(EG + 32 * t + 8 * g + 4 * hh);
                    S[t][4 * g] *= ev.x; S[t][4 * g + 1] *= ev.y; S[t][4 * g + 2] *= ev.z; S[t][4 * g + 3] *= ev.w; }
            constexpr int R = 5; bf16x8 ring[R];
#pragma unroll
            for (int i = 0; i < R; ++i) ring[i] = lds_frag(Y, i, lane);
#pragma unroll
            for (int i = 0; i < 16; ++i) { S[i >> 2] = MFMA32(ring[i % R], bfr[i & 3], S[i >> 2]); if (i + R < 16) ring[i % R] = lds_frag(Y, i + R, lane); __builtin_amdgcn_sched_barrier(0); }
        }
        if (!(flags & 1)) { asm volatile("s_waitcnt vmcnt(0)" ::: "memory"); if (lane == 0) __hip_atomic_store(fl, s < NCH / 2 ? 1u : 2u, __ATOMIC_RELAXED, __HIP_MEMORY_SCOPE_AGENT); }
        __syncthreads();
    }
#undef GLA_ISSUE
}

template <int NC, bool S16>
__device__ __forceinline__ void p4_unit(LAS unsigned char* lds, const unsigned char* slot, const unsigned char* intra, const bf16* zg, const float* nw, bf16* out, const unsigned* done) {
    int tid_l = threadIdx.x; asm volatile("" : "+v"(tid_l));
    const int tid = tid_l, lane = tid & 63, w = __builtin_amdgcn_readfirstlane(tid >> 6), r = lane & 31, hh = lane >> 5;
    constexpr int ST = NC * 2 + 16, NB = (NC / 32) * 8, CPR = NC / 8;
    if (done) {
        for (unsigned sp_ = 0; sp_ < (1u << 22); ++sp_) { const unsigned f = lane < 8 ? __hip_atomic_load(done + lane, __ATOMIC_RELAXED, __HIP_MEMORY_SCOPE_AGENT) : 2u; if (__all(f == 2u)) break; __builtin_amdgcn_s_sleep(8); }
    }
    for (int b = w; b < NB; b += 8) {
        const unsigned long long v = __hip_atomic_load((const unsigned long long*)slot + b * 64 + lane, __ATOMIC_RELAXED, __HIP_MEMORY_SCOPE_AGENT);
        float x0 = bflo((unsigned)v), x1 = bfhi((unsigned)v), x2 = bflo((unsigned)(v >> 32)), x3 = bfhi((unsigned)(v >> 32));
        if (intra) { const unsigned long long iv = ((const unsigned long long*)intra)[b * 64 + lane];
            x0 += bflo((unsigned)iv); x1 += bfhi((unsigned)iv); x2 += bflo((unsigned)(iv >> 32)); x3 += bfhi((unsigned)(iv >> 32)); }
        int row, col;
        if (S16) { row = 16 * (b & 3) + 4 * (lane >> 4); col = 16 * (b >> 2) + (lane & 15); }
        else { row = 32 * ((b >> 2) & 1) + 8 * (b & 3) + 4 * hh; col = 32 * (b >> 3) + r; }
        LAS unsigned char* p = lds + row * ST + col * 2;
        const unsigned a = pkbf(x0, x1), bq = pkbf(x2, x3);
        *(LAS unsigned short*)p = (unsigned short)(a & 0xffffu); *(LAS unsigned short*)(p + ST) = (unsigned short)(a >> 16);
        *(LAS unsigned short*)(p + 2 * ST) = (unsigned short)(bq & 0xffffu); *(LAS unsigned short*)(p + 3 * ST) = (unsigned short)(bq >> 16);
    }
    __syncthreads();
#pragma unroll
    for (int it = 0; it < (64 * CPR) / 512; ++it) {
        const int idx = it * 512 + tid, row = idx / CPR, ch = idx % CPR;
        const v4u xw = *(const LAS v4u*)(lds + row * ST + ch * 16);
        float x[8] = {bflo(xw.x), bfhi(xw.x), bflo(xw.y), bfhi(xw.y), bflo(xw.z), bfhi(xw.z), bflo(xw.w), bfhi(xw.w)};
        float ss = 0.f;
#pragma unroll
        for (int i = 0; i < 8; ++i) ss += x[i] * x[i];
        ss = row16_sum(ss);
        if (NC == 256) ss += __shfl_xor(ss, 16);
        const float rstd = 1.0f / sqrtf(ss * (1.0f / NC) + EPS);
        f32x4 w0 = *(const f32x4*)(nw + ch * 8), w1 = *(const f32x4*)(nw + ch * 8 + 4);
        if (zg) { const v4u zw = *(const v4u*)(zg + (size_t)row * 1024 + ch * 8);
            const float z[8] = {bflo(zw.x), bfhi(zw.x), bflo(zw.y), bfhi(zw.y), bflo(zw.z), bfhi(zw.z), bflo(zw.w), bfhi(zw.w)};
            w0.x *= z[0] * __builtin_amdgcn_rcpf(1.0f + __expf(-z[0])); w0.y *= z[1] * __builtin_amdgcn_rcpf(1.0f + __expf(-z[1])); w0.z *= z[2] * __builtin_amdgcn_rcpf(1.0f + __expf(-z[2])); w0.w *= z[3] * __builtin_amdgcn_rcpf(1.0f + __expf(-z[3]));
            w1.x *= z[4] * __builtin_amdgcn_rcpf(1.0f + __expf(-z[4])); w1.y *= z[5] * __builtin_amdgcn_rcpf(1.0f + __expf(-z[5])); w1.z *= z[6] * __builtin_amdgcn_rcpf(1.0f + __expf(-z[6])); w1.w *= z[7] * __builtin_amdgcn_rcpf(1.0f + __expf(-z[7])); }
        v4u o; o.x = pkbf(x[0] * rstd * w0.x, x[1] * rstd * w0.y); o.y = pkbf(x[2] * rstd * w0.z, x[3] * rstd * w0.w); o.z = pkbf(x[4] * rstd * w1.x, x[5] * rstd * w1.y); o.w = pkbf(x[6] * rstd * w1.z, x[7] * rstd * w1.w);
        *(v4u*)(out + (size_t)row * 1024 + ch * 8) = o;
    }
    __syncthreads();
}
#define XB_TMO      128
#define XB_XCNT(j)  (256  + 64 * (j))
#define XB_XSUB(j)  (1280 + 64 * (j))
#define XB_XGEN(j)  (2304 + 64 * (j))
#define XB_TOP      3328
#define XB_TOPGEN   3392
#define XCD_BAR_WORDS 3456
#define XB_SPIN_CAP (1u << 18)

__device__ __forceinline__ unsigned xb_ld(unsigned* p)              { return __hip_atomic_load(p, __ATOMIC_RELAXED, __HIP_MEMORY_SCOPE_AGENT); }
__device__ __forceinline__ unsigned xb_add(unsigned* p, unsigned v) { return __hip_atomic_fetch_add(p, v, __ATOMIC_RELAXED, __HIP_MEMORY_SCOPE_AGENT); }
__device__ __forceinline__ unsigned xb_xcc_id() { return (unsigned)__builtin_amdgcn_s_getreg((3 << 11) | 20) & 0xFu; }
#define XB_SPIN(cond, bar) do { unsigned _sp = 0; while (cond) { __builtin_amdgcn_s_sleep(1); \
    if ((++_sp & 255u) == 0u) { if (xb_ld(&(bar)[XB_TMO])) break; if (_sp > XB_SPIN_CAP) { atomicAdd(&(bar)[XB_TMO], 1u); break; } } } } while (0)

struct XcdBarrier {
    unsigned* bar; unsigned x;
    volatile LAS unsigned* st;
};

__device__ __forceinline__ XcdBarrier xcd_barrier_post(unsigned* bar, volatile LAS unsigned* st) {
    XcdBarrier b; b.bar = bar; b.x = xb_xcc_id(); b.st = st;
    if (threadIdx.x == 0) (void)xb_add(&bar[XB_XCNT(b.x)], 1u);
    return b;
}
__device__ __forceinline__ void xcd_barrier_complete(unsigned* bar, unsigned x, unsigned& nloc, unsigned& nx) {
    const unsigned G = gridDim.x * gridDim.y * gridDim.z;
    unsigned sum, cnt, mine, sp = 0u;
    for (;;) {
        sum = 0u; cnt = 0u; mine = 0u;
#pragma unroll
        for (unsigned j = 0; j < 16; ++j) { const unsigned c = xb_ld(&bar[XB_XCNT(j)]); sum += c; cnt += (c > 0u) ? 1u : 0u; mine = (j == x) ? c : mine; }
        if (sum == G) break;
        __builtin_amdgcn_s_sleep(1);
        if ((++sp & 255u) == 0u) { if (xb_ld(&bar[XB_TMO])) break; if (sp > XB_SPIN_CAP) { atomicAdd(&bar[XB_TMO], 1u); break; } }
    }
    nloc = mine > 0u ? mine : 1u; nx = cnt > 0u ? cnt : 1u;
}

__device__ __forceinline__ void xcd_barrier(const XcdBarrier& b) {
    asm volatile("s_waitcnt vmcnt(0)" ::: "memory");
    __syncthreads();
    if (threadIdx.x == 0) {
        unsigned* bar = b.bar;
        __builtin_amdgcn_s_waitcnt(0);
        unsigned nloc = b.st[0], nx = b.st[1];
        if (nloc == 0u) { xcd_barrier_complete(bar, b.x, nloc, nx); b.st[0] = nloc; b.st[1] = nx; }
        const unsigned old = xb_add(&bar[XB_XSUB(b.x)], 1u);
        const unsigned gen = old / nloc;
        if (old + 1u == (gen + 1u) * nloc) {
            __builtin_amdgcn_fence(__ATOMIC_RELEASE, "agent");
            asm volatile("s_waitcnt vmcnt(0)" ::: "memory");
            const unsigned og = xb_add(&bar[XB_TOP], 1u);
            const unsigned tg = og / nx;
            if (og + 1u == (tg + 1u) * nx) xb_add(&bar[XB_TOPGEN], 1u);
            else XB_SPIN(xb_ld(&bar[XB_TOPGEN]) == tg, bar);
            __builtin_amdgcn_fence(__ATOMIC_ACQUIRE, "agent");
            xb_add(&bar[XB_XGEN(b.x)], 1u);
            asm volatile("s_waitcnt vmcnt(0)" ::: "memory");
        } else {
            XB_SPIN(xb_ld(&bar[XB_XGEN(b.x)]) == gen, bar);
            __builtin_amdgcn_fence(__ATOMIC_ACQUIRE, "agent");
            asm volatile("s_waitcnt vmcnt(0)" ::: "memory");
        }
    }
    __syncthreads();
}
__device__ __forceinline__ void transpose_item(const float* W, int ldw, int src_col0, int K, int ncols, bf16* WT, int dst_row0, LAS float* scr, int item, int lane) {
    asm volatile("" : "+v"(lane));
    const int nblk = ncols / 32, kb = item / nblk, nb = item % nblk, k0 = 64 * kb, n0 = 32 * nb;
#pragma unroll 8
    for (int i = 0; i < 32; ++i) { const int kk = 2 * i + (lane >> 5); scr[kk * 33 + (lane & 31)] = W[(size_t)(k0 + kk) * ldw + src_col0 + n0 + (lane & 31)]; }
    LDS_WAIT();
    const int c = lane & 7;
#pragma unroll
    for (int j = 0; j < 4; ++j) { const int n = (lane >> 3) + 8 * j; const LAS float* s = scr + (8 * c) * 33 + n;
        v4u o; o.x = pk2(s[0 * 33], s[1 * 33]); o.y = pk2(s[2 * 33], s[3 * 33]); o.z = pk2(s[4 * 33], s[5 * 33]); o.w = pk2(s[6 * 33], s[7 * 33]);
        *(v4u*)(WT + (size_t)(dst_row0 + n0 + n) * K + k0 + 8 * c) = o; }
    LDS_WAIT();
}

constexpr int WCV_MIX = 16 * ((1024 + 3072 + 1024 + 1024 + 32 + 32) / 32), WCV_ALL = WCV_MIX + 16 * ((1024 + 2048) / 32) + 3 * 512;
__device__ __forceinline__ void wconv_item(int it, const float* w_in, const float* wa, const float* wb, const float* wo, bf16* WT_IN, bf16* WT_A, bf16* WT_B, bf16* WT_O, LAS float* scr, int lane) {
    constexpr int c0 = 512, c1 = c0 + 1536, c2 = c1 + 512, c3 = c2 + 512, c4 = c3 + 16, c5 = c4 + 16, c6 = c5 + 512, c7 = c6 + 1024, c8 = c7 + 512, c9 = c8 + 512;
    static_assert(c5 == WCV_MIX && c9 + 512 == WCV_ALL, "weight conversion item list");
    if (it < c0) transpose_item(w_in, NIN, SRC_ZA, D, 1024, WT_IN, 0, scr, it, lane);
    else if (it < c1) transpose_item(w_in, NIN, SRC_QKVA, D, 3072, WT_IN, 1024, scr, it - c0, lane);
    else if (it < c2) transpose_item(w_in, NIN, SRC_QB, D, 1024, WT_IN, 4096, scr, it - c1, lane);
    else if (it < c3) transpose_item(w_in, NIN, SRC_VB, D, 1024, WT_IN, 5120, scr, it - c2, lane);
    else if (it < c4) transpose_item(w_in, NIN, SRC_AF, D, 32, WT_IN, 9216, scr, it - c3, lane);
    else if (it < c5) transpose_item(w_in, NIN, SRC_RF, D, 32, WT_IN, 9248, scr, it - c4, lane);
    else if (it < c6) transpose_item(w_in, NIN, SRC_GB, D, 1024, WT_IN, 6144, scr, it - c5, lane);
    else if (it < c7) transpose_item(w_in, NIN, SRC_GA, D, 2048, WT_IN, 7168, scr, it - c6, lane);
    else if (it < c8) transpose_item(wa, D, 0, D, D, WT_A, 0, scr, it - c7, lane);
    else if (it < c9) transpose_item(wb, D, 0, D, D, WT_B, 0, scr, it - c8, lane);
    else transpose_item(wo, D, 0, D, D, WT_O, 0, scr, it - c9, lane);
}
__device__ __forceinline__ void h_rows(const float* x, const float* w, bf16* h, int nrows, int gw, int ngw, int lane) {
    asm volatile("" : "+v"(lane));
    for (int m = gw; m < nrows; m += ngw) {
        const f32x4* xr = (const f32x4*)(x + (size_t)m * D) + lane; f32x4 v[4]; float s = 0.f;
#pragma unroll
        for (int j = 0; j < 4; ++j) { v[j] = xr[64 * j]; s += (v[j].x * v[j].x + v[j].y * v[j].y) + (v[j].z * v[j].z + v[j].w * v[j].w); }
        const float rstd = 1.0f / sqrtf(wave_sum(s) * (1.f / D) + EPS);
        unsigned long long* o8 = (unsigned long long*)(h + (size_t)m * D) + lane;
#pragma unroll
        for (int j = 0; j < 4; ++j) { const f32x4 ww = ((const f32x4*)w)[lane + 64 * j];
            o8[64 * j] = (unsigned long long)pkbf(v[j].x * rstd * ww.x, v[j].y * rstd * ww.y) | ((unsigned long long)pkbf(v[j].z * rstd * ww.z, v[j].w * rstd * ww.w) << 32); }
    }
}
__device__ __forceinline__ void h_rows_tiles(const float* x, const float* w, const pg8::Gemm& gt, int nrows, int gw, int ngw, int lane) {
    asm volatile("" : "+v"(lane));
    for (int m = gw; m < nrows; m += ngw) {
        const f32x4* xr = (const f32x4*)(x + (size_t)m * D) + lane; f32x4 v[4]; float s = 0.f;
#pragma unroll
        for (int j = 0; j < 4; ++j) { v[j] = xr[64 * j]; s += (v[j].x * v[j].x + v[j].y * v[j].y) + (v[j].z * v[j].z + v[j].w * v[j].w); }
        const float rstd = 1.0f / sqrtf(wave_sum(s) * (1.f / D) + EPS);
        unsigned long long* o8 = (unsigned long long*)(gt.atile(m >> 8, (size_t)256 * D * 2) + (size_t)(m & 255) * D * 2) + lane;
#pragma unroll
        for (int j = 0; j < 4; ++j) { const f32x4 ww = ((const f32x4*)w)[lane + 64 * j];
            o8[64 * j] = (unsigned long long)pkbf(v[j].x * rstd * ww.x, v[j].y * rstd * ww.y) | ((unsigned long long)pkbf(v[j].z * rstd * ww.z, v[j].w * rstd * ww.w) << 32); }
    }
}
__device__ __forceinline__ void final_rows(const float* x, const float* pre, const float* w, float* out, int nrows, int gw, int ngw, int lane) {
    asm volatile("" : "+v"(lane));
    for (int m = gw; m < nrows; m += ngw) {
        const f32x4* pr = (const f32x4*)(pre + (size_t)m * D) + lane; const f32x4* xr = (const f32x4*)(x + (size_t)m * D) + lane; f32x4 v[4]; float s = 0.f;
#pragma unroll
        for (int j = 0; j < 4; ++j) { v[j] = pr[64 * j]; s += (v[j].x * v[j].x + v[j].y * v[j].y) + (v[j].z * v[j].z + v[j].w * v[j].w); }
        const float rstd = 1.0f / sqrtf(wave_sum(s) * (1.f / D) + EPS);
        f32x4* orow = (f32x4*)(out + (size_t)m * D) + lane;
#pragma unroll
        for (int j = 0; j < 4; ++j) { const f32x4 ww = ((const f32x4*)w)[lane + 64 * j]; const f32x4 xv = xr[64 * j]; orow[64 * j] = xv + v[j] * rstd * ww; }
    }
}
__device__ __forceinline__ void small_unit(LAS unsigned char* lds, const bf16* h, const bf16* wsm, float* out, int unit) {
    int tid_l = threadIdx.x; asm volatile("" : "+v"(tid_l));
    const int tid = tid_l, lane = tid & 63, w = __builtin_amdgcn_readfirstlane(tid >> 6), r = lane & 31, hh = lane >> 5;
    const int ct = w & 1, kq = w >> 1;
    const bf16* ap = h + (size_t)(unit * 32 + r) * D + kq * 256 + 8 * hh;
    const bf16* bp = wsm + (size_t)(32 * ct + r) * D + kq * 256 + 8 * hh;
    f32x16 acc = zero16();
#pragma unroll 8
    for (int ks = 0; ks < 16; ++ks) acc = MFMA32(*(const bf16x8*)(ap + 16 * ks), *(const bf16x8*)(bp + 16 * ks), acc);
    LAS float* red = (LAS float*)lds + (size_t)w * 1024 + lane;
    if (kq != 0) {
#pragma unroll
        for (int i = 0; i < 16; ++i) red[i * 64] = acc[i]; }
    __syncthreads();
    if (kq == 0) {
        float* op = out + (size_t)(unit * 32 + 4 * hh) * 64 + 32 * ct + r;
#pragma unroll
        for (int i = 0; i < 16; ++i) op[((i & 3) + 8 * (i >> 2)) * 64] = ((acc[i] + red[2048 + i * 64]) + red[4096 + i * 64]) + red[6144 + i * 64]; }
    __syncthreads();
}

constexpr int NG = 2, MG = M / NG, NSEQG = BATCH / NG;
constexpr size_t KiB = 1024;
constexpr size_t WS_CTL = 0  , WS_WTIN = 320 * KiB, WS_WTA = WS_WTIN + 18560 * KiB, WS_WTB = WS_WTA + 2 * MiB, WS_WTO = WS_WTB + 2 * MiB, WS_SMALL = WS_WTO + 2 * MiB  ,
    WS_Z = WS_SMALL + 2 * MiB  , WS_PG = WS_Z + 16 * MiB  , WS_GBLOB = WS_PG + 80 * MiB  , WS_LBLOBB = WS_GBLOB + 98 * MiB  , WS_END = WS_LBLOBB + 32 * MiB;
static_assert(WS_END <= 256 * MiB, "workspace");
constexpr size_t WS_GATES = WS_GBLOB  , WS_M1 = WS_GATES + 64 * MiB  , WS_MERGED = WS_M1 + 32 * MiB  , WS_PRE = WS_MERGED + 32 * MiB  ;
static_assert(WS_PRE + 1 * MiB <= WS_END, "overlays");
constexpr size_t HT_TILE = 256 * 1024 * 2, WS_H0 = WS_WTIN, WS_H1 = WS_PG + (size_t)NSEQG * 4 * NCH * gla::BLOBA, WS_H2 = WS_SMALL, WS_H3 = WS_END;
constexpr int HT1 = 24, HT2 = 55, HT3 = 59;
static_assert(((size_t)NSEQG * 4 * NCH * gla::BLOBA) % HT_TILE == 0 && WS_H1 + (HT2 - HT1) * HT_TILE <= WS_PG + 3 * ((size_t)MG * 2048) && HT1 * HT_TILE <= (size_t)6144 * 2048 && (HT3 - HT2) * HT_TILE <= 2 * MiB && WS_H3 + (64 - HT3) * HT_TILE <= 256 * MiB, "h tiles");
constexpr size_t PGMAT = (size_t)MG * 1024 * 2;
static_assert((size_t)NSEQG * 4 * NCH * gla::BLOBA <= 3 * PGMAT && (size_t)NSEQG * 4 * NCH * 32768 <= PGMAT && (size_t)NSEQG * 8 * NCH * 16384 <= PGMAT, "overlays");
static_assert((size_t)NSEQG * 8 * NCH * gdn::BLOB <= 98 * MiB && (size_t)NSEQG * 4 * NCH * gla::BLOBB <= 32 * MiB, "blobs");
constexpr int LDS_BYTES = 160 * 1024, LDS_BAR = LDS_BYTES - 16;
static_assert(gla::L_END <= LDS_BAR && gdn::L_END <= LDS_BAR && gdn::C_END <= LDS_BAR && gla::CB_END <= LDS_BAR && pg8::STAGE_BYTES <= LDS_BAR, "LDS");
constexpr int N_PHASES = 12;

struct MegaArgs { const float* in[18]; float* out; unsigned char* ws; int ph_lo, ph_hi; };

__global__ void __launch_bounds__(512, 2) mega(MegaArgs a) {
    extern __shared__ __attribute__((aligned(16))) unsigned char lds_raw[];
    LAS unsigned char* lds = (LAS unsigned char*)lds_raw;
    const int tid = threadIdx.x, lane = tid & 63, wave = __builtin_amdgcn_readfirstlane(tid >> 6);
    const int G = gridDim.x, bid = blockIdx.x, gw = bid * 8 + wave, ngw = G * 8;
    unsigned char* ws = a.ws;
    const float* x = a.in[0]; const float* ln_pre_w = a.in[1]; const float* w_in = a.in[2]; const float* conv_w = a.in[3];
    if (tid < 4) ((LAS unsigned*)(lds + LDS_BAR))[tid] = 0u;
    __syncthreads();
    XcdBarrier bar = xcd_barrier_post((unsigned*)(ws + WS_CTL), (volatile LAS unsigned*)(lds + LDS_BAR));
    const int lo = a.ph_lo, hi = a.ph_hi;
#define IN(k) (lo <= (k) && (k) < hi)
#define SEAM(k) do { if (IN(k) && IN((k) + 1)) xcd_barrier(bar); } while (0)
#ifndef PROBE_REPEAT
#define PROBE_REPEAT 0
#endif
#ifndef PROBE_FLAGS
#define PROBE_FLAGS 0
#endif
#define PH(k) if (IN(k)) for (int rep_ = 0; rep_ <= ((PROBE_REPEAT >> (k)) & 1); ++rep_)
#define REPBAR() do { if (rep_) xcd_barrier(bar); } while (0)
    bf16* WT_IN = (bf16*)(ws + WS_WTIN); bf16* WT_A = (bf16*)(ws + WS_WTA); bf16* WT_B = (bf16*)(ws + WS_WTB); bf16* WT_O = (bf16*)(ws + WS_WTO);
    bf16* PG = (bf16*)(ws + WS_PG); float* SMALL = (float*)(ws + WS_SMALL);
    bf16* ORAWA = (bf16*)a.out; bf16* ORAWB = (bf16*)a.out + (size_t)M * 1024;
    pg8::Gemm gh{(const bf16*)(ws + WS_H0), WT_IN + (size_t)6144 * D, M, 3072, D, 0, (const bf16*)(ws + WS_H1), (const bf16*)(ws + WS_H2), (const bf16*)(ws + WS_H3), HT1, HT2, HT3};

    PH(0) { REPBAR();
        LAS float* scr = (LAS float*)lds + wave * (64 * 33);
        for (int it = gw; it < WCV_MIX; it += ngw) wconv_item(it, w_in, a.in[9], a.in[15], a.in[16], WT_IN, WT_A, WT_B, WT_O, scr, lane);
        h_rows(x, ln_pre_w, ORAWB + (size_t)MG * 1024, MG, gw, ngw, lane);
    }
    SEAM(0);
#ifdef PROBE_BARRIERS
    for (int i = 0; i < PROBE_BARRIERS; ++i) xcd_barrier(bar);
#endif
    for (int g = 0; g < NG; ++g) {
        const int pb = 1 + 4 * g;
        const size_t r0 = (size_t)g * MG;
        const bf16* hsrc = (g == 0 ? ORAWB : ORAWA) + (size_t)MG * 1024;
        PH(pb) { REPBAR();
            for (int u = bid; u < MG / 32; u += G) small_unit(lds, hsrc, WT_IN + (size_t)9216 * D, SMALL, u);
            pg8::Gemm gm{hsrc, WT_IN, MG, 6144, D, 0}; pg8::StaticOrder S; S.init(MG, 6144, G, bid);
            pg8::EpiBf16 E{(bf16*)(ws + WS_Z), 1024, 1024, (size_t)MG * 1024};
            pg8::gemm_phase<pg8::EpiBf16, pg8::StaticOrder, true, true>(lds, gm, S, E);
        }
        SEAM(pb);
        PH(pb + 1) { REPBAR();
            GdnPrepArgs pa{PG, PG + (size_t)MG * 1024, PG + (size_t)2 * MG * 1024, SMALL, conv_w, a.in[4], a.in[5], a.in[6], a.in[7], ws + WS_GBLOB, NSEQG, rep_ ? PROBE_FLAGS : 0};
            gdn_prep_phase(lds, pa, bid, G, ws + WS_CTL + 300 * KiB);
        }
        SEAM(pb + 1);
        PH(pb + 2) { REPBAR();
            GlaPrepArgs pa{PG + (size_t)3 * MG * 1024, PG + (size_t)4 * MG * 1024, SMALL, a.in[10], a.in[11], a.in[12], a.in[13], ws + WS_PG, ws + WS_LBLOBB, NSEQG, 0};
            gla_prep_phase(lds, pa, bid, G);
        }
        SEAM(pb + 2);
        PH(pb + 3) { REPBAR();
            constexpr int NGI = NSEQG * 8 * 2, NLI = NSEQG * 4 * 2;
            unsigned* gflag = (unsigned*)(ws + WS_CTL + 32 * KiB) + (size_t)g * (NSEQG * 8 * NCH * 8); unsigned* lflag = (unsigned*)(ws + WS_CTL + 96 * KiB) + (size_t)g * (NSEQG * 4 * NCH * 8);
            if (rep_) { gflag += 32 * 1024; lflag += 32 * 1024; }
            if (bid < NGI) { if (!(rep_ && (PROBE_FLAGS & 16))) { GdnChainArgs ca{ws + WS_GBLOB, ws + WS_PG + 4 * PGMAT, gflag, NSEQG, rep_ ? PROBE_FLAGS : 0}; gdn_chain_unit(lds, ca, bid); } }
            else if (bid < NGI + NLI) { if (!(rep_ && (PROBE_FLAGS & 32))) { GlaChainArgs ca{ws + WS_PG, ws + WS_LBLOBB, ws + WS_PG + 3 * PGMAT, lflag, NSEQG, rep_ ? PROBE_FLAGS : 0}; gla_chain_unit(lds, ca, bid - NGI); } }
            else if (!rep_) {
                const int wk = bid - NGI - NLI, nwk = G - NGI - NLI;
                if (g == 0) h_rows(x + (size_t)MG * D, ln_pre_w, ORAWA + (size_t)MG * 1024, MG, wk * 8 + wave, nwk * 8, lane);
                if (g == 0) { LAS float* scr = (LAS float*)lds + wave * (64 * 33);
                    for (int it = WCV_MIX + wk * 8 + wave; it < WCV_ALL; it += nwk * 8) wconv_item(it, w_in, a.in[9], a.in[15], a.in[16], WT_IN, WT_A, WT_B, WT_O, scr, lane);
                    __syncthreads(); }
                if (g == NG - 1) h_rows_tiles(x, ln_pre_w, gh, M, wk * 8 + wave, nwk * 8, lane);
            }
            if (!rep_) {
                constexpr int NPG = NSEQG * 8, NPL = NSEQG * 4;
                unsigned* qhead = (unsigned*)(ws + WS_CTL + 301 * KiB) + 64 * g;
                for (;;) {
                    if (tid == 0) ((LAS unsigned*)(lds + LDS_BAR))[3] = __hip_atomic_fetch_add(qhead, 1u, __ATOMIC_RELAXED, __HIP_MEMORY_SCOPE_AGENT);
                    __syncthreads();
                    const int j = (int)((LAS unsigned*)(lds + LDS_BAR))[3];
                    __syncthreads();
                    if (j >= NCH * (NPG + NPL)) break;
                    const int rk = j / (NPG + NPL), idx = j % (NPG + NPL), n = (rk & 1) ? (NCH / 2 - 1 - (rk >> 1)) : (NCH / 2 + (rk >> 1));
                    if (idx < NPG) { const int u = idx * NCH + n, hd = idx % 8, sq = idx / 8;
                        p4_unit<128, true>(lds, ws + WS_PG + 4 * PGMAT + (size_t)u * 16384, nullptr, (const bf16*)(ws + WS_Z) + ((size_t)sq * SEQ + n * CHUNK) * 1024 + hd * 128, a.in[8], ORAWA + (r0 + (size_t)sq * SEQ + n * CHUNK) * 1024 + hd * 128, gflag + (size_t)u * 8); }
                    else { const int pi = idx - NPG, u = pi * NCH + n, hd = pi % 4, sq = pi / 4;
                        p4_unit<256, false>(lds, ws + WS_PG + 3 * PGMAT + (size_t)u * 32768, ws + WS_LBLOBB + (size_t)u * gla::BLOBB + gla::B_INTRA, nullptr, a.in[14], ORAWB + (r0 + (size_t)sq * SEQ + n * CHUNK) * 1024 + hd * 256, lflag + (size_t)u * 8); }
                }
            }
        }
        SEAM(pb + 3);
    }
    PH(9) { REPBAR();
        const pg8::Gemm& gm = gh; pg8::StaticOrder S; S.init(M, 3072, G, bid);
        if (rep_ == 0) { pg8::EpiP1b E{ORAWB, (bf16*)(ws + WS_GATES), (size_t)M * 1024, ORAWB};
            pg8::gemm_phase<pg8::EpiP1b, pg8::StaticOrder, true, true>(lds, gm, S, E); }
        else { pg8::EpiP1b E{ORAWB, (bf16*)(ws + WS_GATES), (size_t)M * 1024, (bf16*)(ws + WS_MERGED)};
            pg8::gemm_phase<pg8::EpiP1b, pg8::StaticOrder, true, true>(lds, gm, S, E); }
    }
    SEAM(9);
    PH(10) { REPBAR();
        pg8::Gemm gm{ORAWA, WT_A, 2 * M, 2 * D, D, 0}; pg8::PairOrder S; S.init(M, D, G, bid);
        pg8::EpiMerge E{(bf16*)(ws + WS_M1), (bf16*)(ws + WS_MERGED), (const bf16*)(ws + WS_GATES), (size_t)M * 1024, M / 256, D / 256};
        pg8::gemm_phase<pg8::EpiMerge, pg8::PairOrder, true, true>(lds, gm, S, E);
    }
    SEAM(10);
    if (IN(11)) {
        pg8::Gemm gm{(const bf16*)(ws + WS_MERGED), WT_O, M, D, D, 0}; pg8::StaticOrder S; S.init(M, D, G, bid);
        pg8::EpiRmsRes E{x, a.in[17], a.out, (float*)(ws + WS_PRE), (unsigned*)(ws + WS_CTL + 304 * KiB)};
        pg8::gemm_phase<pg8::EpiRmsRes, pg8::StaticOrder, false, true>(lds, gm, S, E);
    }
#undef IN
#undef SEAM
}

#ifndef MK_N_LAUNCHES
#define MK_N_LAUNCHES 1
#endif
extern "C" void kernel_launch(void* const* d_in, const int* in_sizes, int n_in, void* d_out, int out_size, void* d_ws, size_t ws_size, hipStream_t stream) {
    static int ready = 0;
    if (!ready) {
        if (n_in != 18 || ws_size < 256 * MiB || out_size != M * D) { fprintf(stderr, "kernel_launch: unexpected problem shape / workspace (%d inputs, ws %zu)\n", n_in, ws_size); ready = -1; return; }
        if (hipFuncSetAttribute((const void*)mega, hipFuncAttributeMaxDynamicSharedMemorySize, LDS_BYTES) != hipSuccess) { fprintf(stderr, "kernel_launch: hipFuncSetAttribute failed\n"); ready = -1; return; }
        ready = 1;
    }
    if (ready < 0) return;
    (void)hipMemsetAsync((char*)d_ws + WS_CTL, 0, 320 * 1024, stream);
    MegaArgs a{};
    for (int i = 0; i < 18; ++i) a.in[i] = (const float*)d_in[i];
    a.out = (float*)d_out; a.ws = (unsigned char*)d_ws;
#if MK_N_LAUNCHES == 1
    a.ph_lo = 0; a.ph_hi = N_PHASES;
    hipLaunchKernelGGL(mega, dim3(256), dim3(512), LDS_BYTES, stream, a);
#else
    for (int p = 0; p < N_PHASES; ++p) { a.ph_lo = p; a.ph_hi = p + 1; hipLaunchKernelGGL(mega, dim3(256), dim3(512), LDS_BYTES, stream, a); }
#endif
}
```

```cpp
#include <hip/hip_runtime.h>
#include <cstdio>
#include <cstdint>

#define GAS __attribute__((address_space(1)))
#define LAS __attribute__((address_space(3)))
typedef unsigned short bf16;
typedef unsigned v4u __attribute__((ext_vector_type(4)));
typedef unsigned v2u __attribute__((ext_vector_type(2)));
typedef float f32x4 __attribute__((ext_vector_type(4)));
#define LDS_WAIT() asm volatile("s_waitcnt lgkmcnt(0)" ::: "memory")

constexpr int BATCH = 8, SEQ = 2048, D = 1024, M = BATCH * SEQ, NIN = 9280;
constexpr float EPS = 1e-6f;
constexpr size_t MiB = 1 << 20;
constexpr int SRC_QKVA = 0, SRC_ZA = 3072, SRC_AF = 4096, SRC_QB = 4128, SRC_KB = 4640, SRC_VB = 5152, SRC_GB = 6176, SRC_RF = 7200, SRC_GA = 7232, SRC_GBm = 8256;

__device__ __forceinline__ unsigned f2bf(float f) { unsigned u = __builtin_bit_cast(unsigned, f); return (u + 0x7fffu + ((u >> 16) & 1u)) >> 16; }
__device__ __forceinline__ unsigned pk2(float lo, float hi) { return f2bf(lo) | (f2bf(hi) << 16); }
__device__ __forceinline__ float bf2f(unsigned short b) { return __builtin_bit_cast(float, (unsigned)b << 16); }
__device__ __forceinline__ float bflo(unsigned w) { return __builtin_bit_cast(float, w << 16); }
__device__ __forceinline__ float bfhi(unsigned w) { return __builtin_bit_cast(float, w & 0xffff0000u); }
__device__ __forceinline__ float sigmoidf_(float x) { return 1.0f / (1.0f + __expf(-x)); }
__device__ __forceinline__ float siluf_(float x) { return x / (1.0f + __expf(-x)); }
__device__ __forceinline__ float wave_sum(float v) {
#pragma unroll
    for (int o = 1; o < 64; o <<= 1) v += __shfl_xor(v, o);
    return v;
}
namespace pg8 {
#define PG8_LAS __attribute__((address_space(3)))
typedef unsigned short bf16_t;
typedef short bf16x8 __attribute__((ext_vector_type(8)));
typedef float f32x4 __attribute__((ext_vector_type(4)));
typedef unsigned u32x4 __attribute__((ext_vector_type(4)));
constexpr int BM = 256, BK = 64, HALF = 128, HTB = HALF * BK * 2  , STAGE_BYTES = 8 * HTB, NXCD = 8, WGM = 8;

__host__ __device__ __forceinline__ int lds_byte(int r, int c) { const int st = (r >> 4) * 2 + (c >> 5), rr = r & 15, cc = c & 31, ob = rr * 64 + cc * 2; return st * 1024 + (ob ^ (((ob >> 9) & 1) << 5)); }
__host__ __device__ __forceinline__ void stage_rc(int b, int& R, int& C) { const int st = b / 1024, sb = b % 1024, swz = sb ^ (((sb >> 9) & 1) << 5); R = (st >> 1) * 16 + swz / 64; C = (st & 1) * 32 + (swz % 64) / 2; }
__host__ __device__ __forceinline__ int perm32(int rho) { const int n = rho >> 4, i = rho & 15; return 8 * (i >> 2) + 4 * n + (i & 3); }

struct Unit { int pm, pn; };
struct Gemm { const bf16_t* A; const bf16_t* Bt; int M, N, K, pad_;
    const bf16_t* A1 = nullptr; const bf16_t* A2 = nullptr; const bf16_t* A3 = nullptr; int t1 = 1 << 30, t2 = 1 << 30, t3 = 1 << 30;
    __host__ __device__ __forceinline__ const char* atile(int pm, size_t tstep) const {
        if (pm < t1) return (const char*)A + (size_t)pm * tstep;
        if (pm < t2) return (const char*)A1 + (size_t)(pm - t1) * tstep;
        if (pm < t3) return (const char*)A2 + (size_t)(pm - t2) * tstep;
        return (const char*)A3 + (size_t)(pm - t3) * tstep; }
};

struct StaticOrder {
    int nM, nN, nwg, G, c;
    __host__ __device__ void init(int M, int N, int G_, int c_) { nM = M / BM; nN = N / BM; nwg = nM * nN; G = G_; c = c_; }
    __host__ __device__ bool next(int i, Unit& u) const {
        const long L = (long)i * G + c; if (L >= nwg) return false;
        int wgid = (int)L; { const int q = nwg / NXCD, r = nwg % NXCD, xcd = wgid % NXCD, off = wgid / NXCD; wgid = (xcd < r ? xcd * (q + 1) : r * (q + 1) + (xcd - r) * q) + off; }
        const int nig = WGM * nN, gid = wgid / nig, fm = gid * WGM, gsz = (nM - fm) < WGM ? (nM - fm) : WGM;
        u.pm = fm + ((wgid % nig) % gsz); u.pn = (wgid % nig) / gsz; return true;
    }
    __device__ __forceinline__ void a_ready(const Unit&) const {}
    __device__ __forceinline__ void done(const Unit&) const {}
};

__device__ __forceinline__ unsigned cvt_pk_bf16(float lo, float hi) { unsigned r; asm volatile("v_cvt_pk_bf16_f32 %0, %1, %2" : "=v"(r) : "v"(lo), "v"(hi)); return r; }
struct EpiBf16 {
    static constexpr bool PERM = true, AFTER_DRAIN = false;
    bf16_t* O; int ldc; int split_cols; size_t split_stride;
    __device__ __forceinline__ void operator()(const f32x4 (&acc)[2][2][4][2], const Unit& u, int wr, int wc, int fr, int fq) const {
        const int row0 = u.pm * BM + wr * 64 + fr; int colt = u.pn * BM; bf16_t* base = O;
        if (split_cols) { const int t = colt / split_cols; base += (size_t)t * split_stride; colt -= t * split_cols; }
        const int col0 = colt + wc * 32 + 8 * fq;
#pragma unroll
        for (int ai = 0; ai < 2; ++ai)
#pragma unroll
            for (int m = 0; m < 4; ++m) { bf16_t* rowp = base + (size_t)(row0 + ai * HALF + m * 16) * ldc + col0;
#pragma unroll
                for (int bj = 0; bj < 2; ++bj) { const f32x4 v0 = acc[ai][bj][m][0], v1 = acc[ai][bj][m][1];
                    u32x4 w; w.x = cvt_pk_bf16(v0[0], v0[1]); w.y = cvt_pk_bf16(v0[2], v0[3]); w.z = cvt_pk_bf16(v1[0], v1[1]); w.w = cvt_pk_bf16(v1[2], v1[3]);
                    *(u32x4*)(rowp + bj * HALF) = w; } }
    }
};
template <int MODE> struct EpiGate {
    static constexpr bool PERM = true, AFTER_DRAIN = false;
    bf16_t* O; const bf16_t* G; const bf16_t* Add; int ldc, pad_;
    __device__ __forceinline__ void operator()(const f32x4 (&acc)[2][2][4][2], const Unit& u, int wr, int wc, int fr, int fq) const {
        const int row0 = u.pm * BM + wr * 64 + fr; const int col0 = u.pn * BM + wc * 32 + 8 * fq;
#pragma unroll
        for (int ai = 0; ai < 2; ++ai)
#pragma unroll
            for (int m = 0; m < 4; ++m) { const size_t ro = (size_t)(row0 + ai * HALF + m * 16) * ldc + col0;
#pragma unroll
                for (int bj = 0; bj < 2; ++bj) { const f32x4 v0 = acc[ai][bj][m][0], v1 = acc[ai][bj][m][1];
                    const u32x4 gw = *(const u32x4*)(G + ro + bj * HALF);
                    float r[8]; const float a[8] = {v0[0], v0[1], v0[2], v0[3], v1[0], v1[1], v1[2], v1[3]};
#pragma unroll
                    for (int i = 0; i < 4; ++i) { const unsigned w = gw[i]; const float g0 = __builtin_bit_cast(float, w << 16), g1 = __builtin_bit_cast(float, w & 0xffff0000u);
                        if (MODE == 0) { r[2 * i] = a[2 * i] * __builtin_amdgcn_rcpf(1.0f + __builtin_amdgcn_exp2f(-1.4426950408889634f * g0)); r[2 * i + 1] = a[2 * i + 1] * __builtin_amdgcn_rcpf(1.0f + __builtin_amdgcn_exp2f(-1.4426950408889634f * g1)); }
                        else { r[2 * i] = g0 * a[2 * i] * __builtin_amdgcn_rcpf(1.0f + __builtin_amdgcn_exp2f(-1.4426950408889634f * a[2 * i])); r[2 * i + 1] = g1 * a[2 * i + 1] * __builtin_amdgcn_rcpf(1.0f + __builtin_amdgcn_exp2f(-1.4426950408889634f * a[2 * i + 1])); } }
                    if (Add) { const u32x4 aw = *(const u32x4*)(Add + ro + bj * HALF);
#pragma unroll
                        for (int i = 0; i < 4; ++i) { const unsigned w = aw[i]; r[2 * i] += __builtin_bit_cast(float, w << 16); r[2 * i + 1] += __builtin_bit_cast(float, w & 0xffff0000u); } }
                    u32x4 w; w.x = cvt_pk_bf16(r[0], r[1]); w.y = cvt_pk_bf16(r[2], r[3]); w.z = cvt_pk_bf16(r[4], r[5]); w.w = cvt_pk_bf16(r[6], r[7]);
                    *(u32x4*)(O + ro + bj * HALF) = w; } }
    }
};
struct EpiF32 {
    static constexpr bool PERM = false, AFTER_DRAIN = false;
    float* O; int ldc, pad_;
    __device__ __forceinline__ void operator()(const f32x4 (&acc)[2][2][4][2], const Unit& u, int wr, int wc, int fr, int fq) const {
        const int row0 = u.pm * BM + wr * 64 + fr; const int col0 = u.pn * BM + wc * 32 + 4 * fq;
#pragma unroll
        for (int ai = 0; ai < 2; ++ai)
#pragma unroll
            for (int m = 0; m < 4; ++m) { float* rowp = O + (size_t)(row0 + ai * HALF + m * 16) * ldc + col0;
#pragma unroll
                for (int bj = 0; bj < 2; ++bj)
#pragma unroll
                    for (int n = 0; n < 2; ++n) *(f32x4*)(rowp + bj * HALF + n * 16) = acc[ai][bj][m][n]; }
    }
};
struct EpiP1b {
    static constexpr bool PERM = true, AFTER_DRAIN = false;
    const bf16_t* ob; bf16_t* gates; size_t gate_stride; bf16_t* ob_out;
    __device__ __forceinline__ void operator()(const f32x4 (&acc)[2][2][4][2], const Unit& u, int wr, int wc, int fr, int fq) const {
        if (u.pn < 4) { EpiGate<1> E{ob_out, ob, nullptr, 1024, 0}; E(acc, u, wr, wc, fr, fq); }
        else { Unit v = u; v.pn = (u.pn - 4) & 3; EpiBf16 E{gates + (size_t)((u.pn - 4) >> 2) * gate_stride, 1024, 0, 0}; E(acc, v, wr, wc, fr, fq); }
    }
};
struct EpiRmsRes {
    static constexpr bool PERM = false, AFTER_DRAIN = true;
    const float* xres; const float* w; float* out; float* xbuf; unsigned* cnt;
    __device__ __forceinline__ void fused(f32x4 (&acc)[2][2][4][2], const Unit& u, int wr, int wc, int fr, int fq, PG8_LAS unsigned char* lds, int wid, int lane) const {
        PG8_LAS float* P = (PG8_LAS float*)lds;
        PG8_LAS float* R = (PG8_LAS float*)(lds + 4096);
#pragma unroll
        for (int ai = 0; ai < 2; ++ai)
#pragma unroll
            for (int m = 0; m < 4; ++m) { float s = 0.f;
#pragma unroll
                for (int bj = 0; bj < 2; ++bj)
#pragma unroll
                    for (int n = 0; n < 2; ++n) { const f32x4 x = acc[ai][bj][m][n]; s += (x[0] * x[0] + x[1] * x[1]) + (x[2] * x[2] + x[3] * x[3]); }
                s += __shfl_xor(s, 16); s += __shfl_xor(s, 32);
                if (fq == 0) P[(ai * HALF + wr * 64 + m * 16 + fr) * 4 + wc] = s; }
        asm volatile("s_waitcnt lgkmcnt(0)" ::: "memory"); __builtin_amdgcn_s_barrier(); asm volatile("" ::: "memory");
        const int row = wid * 32 + (lane & 31);
        if (lane < 32) { const f32x4 p = *(const PG8_LAS f32x4*)(P + row * 4);
            __hip_atomic_store(xbuf + (size_t)(u.pm * BM + row) * 4 + u.pn, (p[0] + p[1]) + (p[2] + p[3]), __ATOMIC_RELAXED, __HIP_MEMORY_SCOPE_AGENT); }
        asm volatile("s_waitcnt vmcnt(0)" ::: "memory");
        if (lane == 0) __hip_atomic_fetch_add(cnt + 64 * u.pm, 1u, __ATOMIC_RELAXED, __HIP_MEMORY_SCOPE_AGENT);
        if (wid == 0) {
            for (unsigned sp = 0; (unsigned)__builtin_amdgcn_readfirstlane((int)__hip_atomic_load(cnt + 64 * u.pm, __ATOMIC_RELAXED, __HIP_MEMORY_SCOPE_AGENT)) < 32u && sp < (1u << 22); ++sp) __builtin_amdgcn_s_sleep(2);
        }
        asm volatile("s_waitcnt vmcnt(0) lgkmcnt(0)" ::: "memory"); __builtin_amdgcn_s_barrier(); asm volatile("" ::: "memory");
        if (lane < 32) { const float* sl = xbuf + (size_t)(u.pm * BM + row) * 4; float t = 0.f;
#pragma unroll
            for (int i = 0; i < 4; ++i) t += __hip_atomic_load(sl + i, __ATOMIC_RELAXED, __HIP_MEMORY_SCOPE_AGENT);
            R[row] = 1.0f / sqrtf(t * (1.0f / 1024.0f) + 1e-6f); }
        asm volatile("s_waitcnt vmcnt(0) lgkmcnt(0)" ::: "memory"); __builtin_amdgcn_s_barrier(); asm volatile("" ::: "memory");
        const int col0 = u.pn * BM + wc * 32 + 4 * fq;
#pragma unroll
        for (int ai = 0; ai < 2; ++ai)
#pragma unroll
            for (int m = 0; m < 4; ++m) { const int r = ai * HALF + wr * 64 + m * 16 + fr; const float rs = R[r]; const size_t off = (size_t)(u.pm * BM + r) * 1024 + col0;
#pragma unroll
                for (int bj = 0; bj < 2; ++bj)
#pragma unroll
                    for (int n = 0; n < 2; ++n) { const int c = bj * HALF + n * 16; const f32x4 xv = *(const f32x4*)(xres + off + c); const f32x4 wv = *(const f32x4*)(w + col0 + c);
                        *(f32x4*)(out + off + c) = xv + acc[ai][bj][m][n] * rs * wv; }
                if (m & 1) asm volatile("" ::: "memory"); }
    }
};
struct PairOrder {
    StaticOrder S; int nM, nN;
    __host__ __device__ void init(int M, int N, int G_, int c_) { S.init(M, N, G_, c_); nM = M / BM; nN = N / BM; }
    __host__ __device__ bool next(int i, Unit& u) const { if (i > 1) return false; Unit b; if (!S.next(0, b)) return false; u.pm = b.pm + i * nM; u.pn = b.pn + i * nN; return true; }
    __device__ __forceinline__ void a_ready(const Unit&) const {}
    __device__ __forceinline__ void done(const Unit&) const {}
};
struct EpiMerge {
    static constexpr bool PERM = true, AFTER_DRAIN = false;
    bf16_t* m1; bf16_t* merged; const bf16_t* gates; size_t gate_stride; int nM, nN;
    __device__ __forceinline__ void operator()(const f32x4 (&acc)[2][2][4][2], const Unit& u, int wr, int wc, int fr, int fq) const {
        if (u.pm < nM) { EpiGate<0> E{m1, gates, nullptr, 1024, 0}; E(acc, u, wr, wc, fr, fq); }
        else { Unit v; v.pm = u.pm - nM; v.pn = u.pn - nN; EpiGate<0> E{merged, gates + gate_stride, m1, 1024, 0}; E(acc, v, wr, wc, fr, fq); }
    }
};
template <class Epi, class Sched, bool ALIGN_EPI = false, bool SP2 = false>
__device__ __forceinline__ void gemm_phase(PG8_LAS unsigned char* lds, const Gemm g, const Sched& S, const Epi& E) {
    int tid_l = threadIdx.x; asm volatile("" : "+v"(tid_l));
    const int tid = tid_l, wid = __builtin_amdgcn_readfirstlane(tid >> 6), lane = tid & 63, wr = wid >> 2, wc = wid & 3, fr = lane & 15, fq = lane >> 4;
    const int K = g.K, nt = K / BK;
    unsigned voffA[2], voffB[2];
#pragma unroll
    for (int i = 0; i < 2; ++i) { int R, C; stage_rc(tid * 16 + i * 8192, R, C); const int Rb = Epi::PERM ? ((R & ~31) + perm32(R & 31)) : R;
        voffA[i] = (unsigned)(R * K + C) * 2u; voffB[i] = (unsigned)(Rb * K + C) * 2u; }
    const size_t kstep = (size_t)(BK * 2);
    const size_t hstep = (size_t)HALF * K * 2;
    const size_t tstep = 2 * hstep;
    const unsigned ldsw = (unsigned)wid * 1024u;
    const int aoff = lds_byte(wr * 64 + fr, fq * 8), boff = lds_byte(wc * 32 + fr, fq * 8);
#define PG8_SA(b, h) (((b) * 2 + (h)) * HTB)
#define PG8_SB(b, h) ((4 + (b) * 2 + (h)) * HTB)
#define PG8_STAGE(bufoff, gbase, voff) do { _Pragma("unroll") for (int _i = 0; _i < 2; ++_i) \
        __builtin_amdgcn_global_load_lds((const unsigned*)((const char*)(gbase) + (voff)[_i]), (PG8_LAS unsigned*)(lds + (bufoff) + ldsw + _i * 8192), 16, 0, 0); } while (0)
#define PG8_LDA(dst, b, h) do { _Pragma("unroll") for (int m = 0; m < 4; ++m) _Pragma("unroll") for (int k = 0; k < 2; ++k) dst[m][k] = *(const PG8_LAS bf16x8*)(lds + PG8_SA(b, h) + aoff + m * 2048 + k * 1024); } while (0)
#define PG8_LDB(dst, b, h) do { _Pragma("unroll") for (int n = 0; n < 2; ++n) _Pragma("unroll") for (int k = 0; k < 2; ++k) dst[n][k] = *(const PG8_LAS bf16x8*)(lds + PG8_SB(b, h) + boff + n * 2048 + k * 1024); } while (0)
#define PG8_MMA(ai, bj, At, Bt) do { __builtin_amdgcn_s_setprio(1); _Pragma("unroll") for (int m = 0; m < 4; ++m) _Pragma("unroll") for (int n = 0; n < 2; ++n) _Pragma("unroll") for (int k = 0; k < 2; ++k) \
        acc[ai][bj][m][n] = __builtin_amdgcn_mfma_f32_16x16x32_bf16(Bt[n][k], At[m][k], acc[ai][bj][m][n], 0, 0, 0); __builtin_amdgcn_s_setprio(0); } while (0)
#define PG8_WAIT_V(n) asm volatile("s_waitcnt vmcnt(" #n ")" ::: "memory")
#define PG8_WAIT_L(n) asm volatile("s_waitcnt lgkmcnt(" #n ")" ::: "memory")
#define PG8_BAR __builtin_amdgcn_s_barrier()
#define PG8_SCHED __builtin_amdgcn_sched_barrier(0)
    Unit cur, nxt; int ui = 0;
    if (!S.next(0, cur)) return;
    f32x4 acc[2][2][4][2];
#pragma unroll
    for (int a = 0; a < 2; ++a)
#pragma unroll
        for (int b = 0; b < 2; ++b)
#pragma unroll
            for (int m = 0; m < 4; ++m)
#pragma unroll
                for (int n = 0; n < 2; ++n) acc[a][b][m][n] = (f32x4){0.f, 0.f, 0.f, 0.f};
    bf16x8 At[4][2], B0[2][2], B1[2][2];
    const char* cA = g.atile(cur.pm, tstep); const char* cB = (const char*)g.Bt + (size_t)cur.pn * tstep;
    S.a_ready(cur);
    if constexpr (SP2) {
        PG8_STAGE(PG8_SB(0, 0), cB, voffB); PG8_STAGE(PG8_SB(0, 1), cB + hstep, voffB); PG8_STAGE(PG8_SA(0, 0), cA, voffA); PG8_STAGE(PG8_SA(0, 1), cA + hstep, voffA);
        if (wr == 1) PG8_BAR;
        PG8_WAIT_V(2); PG8_BAR;
        PG8_STAGE(PG8_SB(1, 0), cB + kstep, voffB); PG8_STAGE(PG8_SA(1, 0), cA + kstep, voffA); PG8_STAGE(PG8_SB(1, 1), cB + hstep + kstep, voffB);
        PG8_WAIT_V(6); PG8_BAR;
    } else {
        PG8_STAGE(PG8_SB(0, 0), cB, voffB); PG8_STAGE(PG8_SA(0, 0), cA, voffA); PG8_STAGE(PG8_SB(0, 1), cB + hstep, voffB); PG8_STAGE(PG8_SA(0, 1), cA + hstep, voffA);
        if (wr == 1) PG8_BAR;
        PG8_WAIT_V(4); PG8_BAR;
        PG8_STAGE(PG8_SB(1, 0), cB + kstep, voffB); PG8_STAGE(PG8_SA(1, 0), cA + kstep, voffA); PG8_STAGE(PG8_SB(1, 1), cB + hstep + kstep, voffB);
        PG8_WAIT_V(6); PG8_BAR;
    }
    for (;;) {
        const bool has_next = S.next(ui + 1, nxt);
        const char* nA = has_next ? g.atile(nxt.pm, tstep) : cA; const char* nB = has_next ? (const char*)g.Bt + (size_t)nxt.pn * tstep : cB;
        for (int t = 0; t < nt; t += 2) {
            const bool last = (t == nt - 2);
            const char* a1 = cA + (size_t)(t + 1) * kstep;
            const char* a2 = last ? nA : cA + (size_t)(t + 2) * kstep; const char* b2 = last ? nB : cB + (size_t)(t + 2) * kstep;
            const char* a3 = a2 + kstep; const char* b3 = b2 + kstep;
            if (last && has_next) S.a_ready(nxt);
            if constexpr (SP2) {
            PG8_LDB(B0, 0, 0); PG8_LDB(B1, 0, 1); PG8_SCHED; PG8_LDA(At, 0, 0); PG8_STAGE(PG8_SA(1, 1), a1 + hstep, voffA);
            PG8_WAIT_V(8); PG8_WAIT_L(0); PG8_BAR; PG8_MMA(0, 0, At, B0); PG8_MMA(0, 1, At, B1); PG8_BAR; PG8_SCHED;
            PG8_LDA(At, 0, 1); PG8_STAGE(PG8_SB(0, 0), b2, voffB); PG8_STAGE(PG8_SB(0, 1), b2 + hstep, voffB); PG8_STAGE(PG8_SA(0, 0), a2, voffA);
            PG8_WAIT_V(8); PG8_WAIT_L(0); PG8_BAR; PG8_MMA(1, 0, At, B0); PG8_MMA(1, 1, At, B1); PG8_BAR; PG8_SCHED;
            PG8_LDB(B0, 1, 0); PG8_LDB(B1, 1, 1); PG8_SCHED; PG8_LDA(At, 1, 0); PG8_STAGE(PG8_SA(0, 1), a2 + hstep, voffA);
            PG8_WAIT_V(8); PG8_WAIT_L(0); PG8_BAR; PG8_MMA(0, 0, At, B0); PG8_MMA(0, 1, At, B1); PG8_BAR; PG8_SCHED;
            PG8_LDA(At, 1, 1); PG8_STAGE(PG8_SB(1, 0), b3, voffB); PG8_STAGE(PG8_SB(1, 1), b3 + hstep, voffB); PG8_STAGE(PG8_SA(1, 0), a3, voffA);
            PG8_WAIT_V(8); PG8_WAIT_L(0); PG8_BAR; PG8_MMA(1, 0, At, B0); PG8_MMA(1, 1, At, B1); PG8_BAR; PG8_SCHED;
            } else {
            PG8_LDB(B0, 0, 0); PG8_SCHED; PG8_LDA(At, 0, 0); PG8_STAGE(PG8_SA(1, 1), a1 + hstep, voffA);
            PG8_WAIT_L(8); PG8_BAR; PG8_WAIT_L(0); PG8_MMA(0, 0, At, B0); PG8_BAR; PG8_SCHED;
            PG8_LDB(B1, 0, 1); PG8_STAGE(PG8_SB(0, 0), b2, voffB);
            PG8_BAR; PG8_WAIT_L(0); PG8_MMA(0, 1, At, B1); PG8_BAR;
            PG8_LDA(At, 0, 1); PG8_STAGE(PG8_SA(0, 0), a2, voffA);
            PG8_BAR; PG8_WAIT_L(0); PG8_MMA(1, 0, At, B0); PG8_BAR; PG8_SCHED;
            PG8_STAGE(PG8_SB(0, 1), b2 + hstep, voffB);
            PG8_WAIT_V(6); PG8_BAR; PG8_MMA(1, 1, At, B1); PG8_BAR;
            PG8_LDB(B0, 1, 0); PG8_SCHED; PG8_LDA(At, 1, 0); PG8_STAGE(PG8_SA(0, 1), a2 + hstep, voffA);
            PG8_WAIT_L(8); PG8_BAR; PG8_WAIT_L(0); PG8_MMA(0, 0, At, B0); PG8_BAR; PG8_SCHED;
            PG8_LDB(B1, 1, 1); PG8_STAGE(PG8_SB(1, 0), b3, voffB);
            PG8_BAR; PG8_WAIT_L(0); PG8_MMA(0, 1, At, B1); PG8_BAR;
            PG8_LDA(At, 1, 1); PG8_STAGE(PG8_SA(1, 0), a3, voffA);
            PG8_BAR; PG8_WAIT_L(0); PG8_MMA(1, 0, At, B0); PG8_BAR; PG8_SCHED;
            PG8_STAGE(PG8_SB(1, 1), b3 + hstep, voffB);
            PG8_WAIT_V(6); PG8_BAR; PG8_MMA(1, 1, At, B1); PG8_BAR;
            }
        }
        if constexpr (ALIGN_EPI) { if (wr == 0) PG8_BAR; }
        if constexpr (!Epi::AFTER_DRAIN) { E(acc, cur, wr, wc, fr, fq); S.done(cur); }
        if (!has_next) break;
#pragma unroll
        for (int a = 0; a < 2; ++a)
#pragma unroll
            for (int b = 0; b < 2; ++b)
#pragma unroll
                for (int m = 0; m < 4; ++m)
#pragma unroll
                    for (int n = 0; n < 2; ++n) acc[a][b][m][n] = (f32x4){0.f, 0.f, 0.f, 0.f};
        cur = nxt; cA = nA; cB = nB; ++ui;
        if constexpr (ALIGN_EPI) { if (wr == 1) PG8_BAR; }
    }
    PG8_WAIT_V(0);
    if constexpr (!ALIGN_EPI) { if (wr == 0) PG8_BAR; }
    PG8_BAR;
    if constexpr (Epi::AFTER_DRAIN) { E.fused(acc, cur, wr, wc, fr, fq, lds, wid, lane); S.done(cur); }
#undef PG8_SA
#undef PG8_SB
#undef PG8_STAGE
#undef PG8_LDA
#undef PG8_LDB
#undef PG8_MMA
#undef PG8_WAIT_V
#undef PG8_WAIT_L
#undef PG8_BAR
#undef PG8_SCHED
}
}
typedef __bf16 bf16x2_t __attribute__((ext_vector_type(2)));
typedef float f32x2_t __attribute__((ext_vector_type(2)));
typedef short bf16x8 __attribute__((ext_vector_type(8)));
typedef float f32x16 __attribute__((ext_vector_type(16)));
#define MFMA32(a, b, c) __builtin_amdgcn_mfma_f32_32x32x16_bf16((a), (b), (c), 0, 0, 0)
__device__ __forceinline__ unsigned pkbf(float a, float b) { bf16x2_t v = __builtin_convertvector((f32x2_t){a, b}, bf16x2_t); return __builtin_bit_cast(unsigned, v); }
__device__ __forceinline__ bf16x8 pack8(const f32x16& x, int s) { v4u p; p.x = pkbf(x[8 * s], x[8 * s + 1]); p.y = pkbf(x[8 * s + 2], x[8 * s + 3]); p.z = pkbf(x[8 * s + 4], x[8 * s + 5]); p.w = pkbf(x[8 * s + 6], x[8 * s + 7]); return __builtin_bit_cast(bf16x8, p); }
__device__ __forceinline__ f32x16 zero16() { f32x16 z;
#pragma unroll
    for (int i = 0; i < 16; ++i) z[i] = 0.f; return z; }
constexpr int CHUNK = 64, NCH = SEQ / CHUNK;
constexpr float QSCALE = 0.08838834764831845f;
__device__ __forceinline__ void glds_blocks(LAS unsigned char* dst, const unsigned char* src, int nblk, int wv, int nw, int lane) {
    for (int b = wv; b < nblk; b += nw)
        __builtin_amdgcn_global_load_lds((const unsigned*)(src + (size_t)b * 1024 + lane * 16), (LAS unsigned*)(dst + b * 1024), 16, 0, 0);
}
__device__ __forceinline__ bf16x8 lds_frag(const LAS unsigned char* base, int blk, int lane) { return *(const LAS bf16x8*)(base + blk * 1024 + lane * 16); }

namespace gdn {
constexpr int B_KA = 0, B_QA = 16384, B_SC = 32768, B_KT = 34816, B_TBF = 51200, B_AF = 59392, B_TBB = 67584, B_AB = 75776, B_VT = 83968, BLOB = 100352;
constexpr int XBLK = 34, YBLK = 32;
}

__device__ __forceinline__ float row16_sum(float v) {
    v += __builtin_bit_cast(float, __builtin_amdgcn_mov_dpp(__builtin_bit_cast(int, v), 0xB1, 0xF, 0xF, true));
    v += __builtin_bit_cast(float, __builtin_amdgcn_mov_dpp(__builtin_bit_cast(int, v), 0x4E, 0xF, 0xF, true));
    v += __builtin_bit_cast(float, __builtin_amdgcn_mov_dpp(__builtin_bit_cast(int, v), 0x141, 0xF, 0xF, true));
    v += __builtin_bit_cast(float, __builtin_amdgcn_mov_dpp(__builtin_bit_cast(int, v), 0x140, 0xF, 0xF, true));
    return v;
}
__device__ __forceinline__ float quad_sum(float v) {
    v += __builtin_bit_cast(float, __builtin_amdgcn_mov_dpp(__builtin_bit_cast(int, v), 0xB1, 0xF, 0xF, true));
    v += __builtin_bit_cast(float, __builtin_amdgcn_mov_dpp(__builtin_bit_cast(int, v), 0x4E, 0xF, 0xF, true));
    return v;
}
struct GdnPrepArgs {
    const bf16 *pq, *pk, *pv;
    const float* small;
    const float* conv_w;
    const float *a_log_f, *a_log_b, *dtb_f, *dtb_b;
    unsigned char* blob;
    int nseq, pad_;
};
namespace gdn {
constexpr int L_PRE = 0, L_QN = 52224, L_KN = L_QN + 17408, L_SC = L_KN + 17408, L_LPF = L_SC + 1024, L_LPB = L_LPF + 16384, L_AF = L_LPB + 16384, L_AB = L_AF + 9216, L_TBF = L_AB + 9216, L_TBB = L_TBF + 9216, L_END = L_TBB + 9216;
static_assert(L_END <= 160 * 1024 - 256, "gdn prep LDS");
constexpr int QS_ = 272, AS_ = 144;

__device__ __forceinline__ v4u frag_rm_perm(const LAS unsigned char* img, int st, int rt, int ks, int lane) {
    const int r = lane & 31, hh = lane >> 5; const LAS unsigned char* p = img + (32 * rt + r) * st + (16 * ks + 4 * hh) * 2;
    const v2u lo = *(const LAS v2u*)p, hi = *(const LAS v2u*)(p + 16);
    return (v4u){lo.x, lo.y, hi.x, hi.y};
}
__device__ __forceinline__ v4u frag_tr_perm(const LAS unsigned char* img, int st, int rt, int ks, int lane) {
    const int r = lane & 31, hh = lane >> 5; const LAS unsigned char* p = img + (16 * ks + 4 * hh) * st + (32 * rt + r) * 2;
    unsigned short e[8];
#pragma unroll
    for (int j = 0; j < 8; ++j) e[j] = *(const LAS unsigned short*)(p + (8 * (j >> 2) + (j & 3)) * st);
    return (v4u){(unsigned)e[0] | ((unsigned)e[1] << 16), (unsigned)e[2] | ((unsigned)e[3] << 16), (unsigned)e[4] | ((unsigned)e[5] << 16), (unsigned)e[6] | ((unsigned)e[7] << 16)};
}
__device__ __forceinline__ v4u frag16_rm(const LAS unsigned char* img, int st, int rt, int ks, int lane) {
    const int r = lane & 15, q = lane >> 4; const LAS unsigned char* p = img + (16 * rt + r) * st + (32 * ks + 4 * q) * 2;
    const v2u lo = *(const LAS v2u*)p, hi = *(const LAS v2u*)(p + 32);
    return (v4u){lo.x, lo.y, hi.x, hi.y};
}
__device__ __forceinline__ v4u frag16_tr(const LAS unsigned char* img, int st, int rt, int ks, int lane) {
    const int r = lane & 15, q = lane >> 4; const LAS unsigned char* p = img + (32 * ks + 4 * q) * st + (16 * rt + r) * 2;
    unsigned short e[8];
#pragma unroll
    for (int j = 0; j < 8; ++j) e[j] = *(const LAS unsigned short*)(p + (16 * (j >> 2) + (j & 3)) * st);
    return (v4u){(unsigned)e[0] | ((unsigned)e[1] << 16), (unsigned)e[2] | ((unsigned)e[3] << 16), (unsigned)e[4] | ((unsigned)e[5] << 16), (unsigned)e[6] | ((unsigned)e[7] << 16)};
}
}

#define LBAR() do { asm volatile("s_waitcnt lgkmcnt(0)" ::: "memory"); __builtin_amdgcn_s_barrier(); asm volatile("" ::: "memory"); } while (0)
__device__ __forceinline__ void gdn_prep_issue(LAS unsigned char* lds, const GdnPrepArgs& A, int unit, int w, int lane, const unsigned char* zero_page) {
    using namespace gdn;
    const int n = unit % NCH, h = (unit / NCH) % 8, sq = unit / (NCH * 8); const size_t row0 = (size_t)sq * SEQ; const int t0 = n * CHUNK;
    for (int q4 = w; q4 < 51; q4 += 8) {
        const int seg = q4 * 4 + (lane >> 4), r = seg / 3, m = seg % 3, tl = t0 - 2 + r;
        const bf16* pmat = A.pq + (size_t)m * (size_t)(A.pk - A.pq);
        const unsigned char* src = (tl >= 0 && tl < SEQ) ? (const unsigned char*)(pmat + (row0 + tl) * 1024 + h * 128) : zero_page;
        __builtin_amdgcn_global_load_lds((const unsigned*)(src + (lane & 15) * 16), (LAS unsigned*)(lds + L_PRE + q4 * 1024), 16, 0, 0);
    }
}
__device__ __forceinline__ f32x4 gdn_prep_scal(const GdnPrepArgs& A, int unit, int lane) {
    const int n = unit % NCH, h = (unit / NCH) % 8, sq = unit / (NCH * 8);
    const float* sm = A.small + ((size_t)sq * SEQ + n * CHUNK + lane) * 64;
    return (f32x4){sm[h], sm[8 + h], sm[16 + h], sm[24 + h]};
}
__device__ __forceinline__ void gdn_prep_phase(LAS unsigned char* lds, const GdnPrepArgs& A, int bid, int G, const unsigned char* zero_page) {
    using namespace gdn;
    int tid_l = threadIdx.x; asm volatile("" : "+v"(tid_l));
    const int tid = tid_l, lane = tid & 63, w = __builtin_amdgcn_readfirstlane(tid >> 6);
    const int nunits = A.nseq * 8 * NCH; const int pflg = A.pad_;
    int unit = bid;
    f32x4 smn = (f32x4){0.f, 0.f, 0.f, 0.f};
    if (unit < nunits) { gdn_prep_issue(lds, A, unit, w, lane, zero_page); if (w == 0) smn = gdn_prep_scal(A, unit, lane); }
  for (; unit < nunits; unit += G) {
    const int h = (unit / NCH) % 8;
    unsigned char* blob = A.blob + (size_t)unit * BLOB;
    if (w == 0) {
        const float xf = smn.x + A.dtb_f[h], xb = smn.y + A.dtb_b[h];
        const float spf = xf > 20.f ? xf : log1pf(__expf(xf)), spb = xb > 20.f ? xb : log1pf(__expf(xb));
        const float gf = -__expf(A.a_log_f[h]) * spf, gb = -__expf(A.a_log_b[h]) * spb;
        float pf = gf, pb = gb;
#pragma unroll
        for (int o = 1; o < 64; o <<= 1) { const float yf = __shfl_up(pf, o), yb = __shfl_up(pb, o); if (lane >= o) { pf += yf; pb += yb; } }
        const float totb = __shfl(pb, 63);
        const float gcf = pf, gcb = totb - pb + gb;
        LAS float* sc = (LAS float*)(lds + L_SC);
        sc[lane] = gcf; sc[64 + lane] = gcb; sc[128 + lane] = sigmoidf_(smn.z); sc[192 + lane] = sigmoidf_(smn.w);
        float* gsc = (float*)(blob + B_SC); if (pflg & 8) gsc = (float*)(lds + L_LPF);
        const float glf = __shfl(pf, 63), glb = totb;
        gsc[lane] = gcf; gsc[64 + lane] = gcb; gsc[128 + lane] = __expf(gcf); gsc[192 + lane] = __expf(gcb); gsc[256 + lane] = __expf(glf - gcf); gsc[320 + lane] = __expf(glb - gcb);
        if (lane < 2) gsc[384 + lane] = __expf(lane ? glb : glf);
    }
    __syncthreads();
    if (!(pflg & 32)) {
        const int p0 = 8 * w;
#pragma unroll
        for (int m = 0; m < 3; ++m) {
            float wc[5][2];
#pragma unroll
            for (int tau = 0; tau < 5; ++tau) { const f32x2_t t2 = *(const f32x2_t*)(A.conv_w + tau * 3072 + m * 1024 + h * 128 + 2 * lane); wc[tau][0] = t2.x; wc[tau][1] = t2.y; }
            float in[12][2];
#pragma unroll
            for (int i = 0; i < 12; ++i) { const unsigned u = *(const LAS unsigned*)(lds + L_PRE + ((p0 + i) * 3 + m) * 256 + lane * 4); in[i][0] = bflo(u); in[i][1] = bfhi(u); }
            float y[8][2];
#pragma unroll
            for (int pp = 0; pp < 8; ++pp)
#pragma unroll
                for (int c = 0; c < 2; ++c) { float s = 0.f;
#pragma unroll
                    for (int tau = 0; tau < 5; ++tau) s += wc[tau][c] * in[pp + tau][c];
                    y[pp][c] = s * __builtin_amdgcn_rcpf(1.0f + __builtin_amdgcn_exp2f(-1.4426950408889634f * s)); }
            if (m < 2) {
#pragma unroll
                for (int pp = 0; pp < 8; ++pp) { float ss = row16_sum(y[pp][0] * y[pp][0] + y[pp][1] * y[pp][1]); ss += __shfl_xor(ss, 16); ss += __shfl_xor(ss, 32); const float rn = __builtin_amdgcn_rsqf(ss + EPS);
                    *(LAS unsigned*)(lds + (m == 0 ? L_QN : L_KN) + (p0 + pp) * QS_ + lane * 4) = pkbf(y[pp][0] * rn, y[pp][1] * rn); }
            } else {
#pragma unroll
                for (int c = 0; c < 2; ++c) { v4u o; o.x = pkbf(y[0][c], y[1][c]); o.y = pkbf(y[2][c], y[3][c]); o.z = pkbf(y[4][c], y[5][c]); o.w = pkbf(y[6][c], y[7][c]);
                    if (!(pflg & 8)) *(v4u*)(blob + B_VT + (2 * lane + c) * 128 + p0 * 2) = o; }
            }
        }
    }
    __syncthreads();
    { const int un = unit + G; if (un < nunits) { gdn_prep_issue(lds, A, un, w, lane, zero_page); if (w == 0) smn = gdn_prep_scal(A, un, lane); } }
    {
        const int which = w >> 2, rt = (w >> 1) & 1, ct = w & 1, r = lane & 31, hh = lane >> 5;
        const LAS unsigned char* ia = lds + (which ? L_QN : L_KN) + (32 * rt + r) * QS_ + 16 * hh;
        const LAS unsigned char* ib = lds + L_KN + (32 * ct + r) * QS_ + 16 * hh;
        f32x16 acc = zero16();
#pragma unroll
        for (int ks = 0; ks < 8; ++ks) acc = MFMA32(*(const LAS bf16x8*)(ia + 32 * ks), *(const LAS bf16x8*)(ib + 32 * ks), acc);
        const LAS float* sc = (const LAS float*)(lds + L_SC);
        const int j = 32 * ct + r; const float gfj = sc[j], gbj = sc[64 + j];
#pragma unroll
        for (int reg = 0; reg < 16; ++reg) {
            const int i = 32 * rt + (reg & 3) + 8 * (reg >> 2) + 4 * hh; const float val = acc[reg];
            const float ef = __expf(sc[i] - gfj), eb = __expf(sc[64 + i] - gbj);
            if (which == 0) {
                const float lf = (i > j) ? sc[128 + i] * val * ef : 0.f, lb = (i < j) ? sc[192 + i] * val * eb : 0.f;
                ((LAS float*)(lds + L_LPF))[i * 64 + (j & 3) * 16 + (j >> 2)] = lf;
                const int i2 = 63 - i, j2 = 63 - j;
                ((LAS float*)(lds + L_LPB))[i2 * 64 + (j2 & 3) * 16 + (j2 >> 2)] = lb;
            } else {
                const float af = (i >= j) ? QSCALE * val * ef : 0.f, ab = (i <= j) ? QSCALE * val * eb : 0.f;
                *(LAS unsigned short*)(lds + L_AF + i * AS_ + j * 2) = (unsigned short)(pkbf(af, 0.f) & 0xffffu);
                *(LAS unsigned short*)(lds + L_AB + i * AS_ + j * 2) = (unsigned short)(pkbf(ab, 0.f) & 0xffffu);
            }
        }
    }
    LBAR();
    if (!(pflg & 16)) {
        const int dir = w >> 2, li = (w & 3) * 64 + lane, j = li >> 2, q = li & 3;
        const LAS float* LP = (const LAS float*)(lds + (dir ? L_LPB : L_LPF)) + q * 16;
        float t[16];
#pragma unroll
        for (int a = 0; a < 16; ++a) t[a] = 0.f;
        f32x4 lq[3][4];
#define SOLVE_LD(i_) do { _Pragma("unroll") for (int a4 = 0; a4 < ((i_) + 15) / 16; ++a4) lq[(i_) % 3][a4] = *(const LAS f32x4*)(LP + (i_) * 64 + 4 * a4); } while (0)
        SOLVE_LD(0); SOLVE_LD(1);
#pragma unroll
        for (int i = 0; i < 64; ++i) {
            if (i + 2 < 48) SOLVE_LD(i + 2);
            else if (i + 1 >= 48 && i + 1 < 64) SOLVE_LD(i + 1);
            float p0 = 0.f, p1 = 0.f;
#pragma unroll
            for (int a4 = 0; a4 < (i + 15) / 16; ++a4) { const f32x4 lv = lq[i % 3][a4];
                p0 = __builtin_fmaf(lv.x, t[4 * a4], p0); p1 = __builtin_fmaf(lv.y, t[4 * a4 + 1], p1); p0 = __builtin_fmaf(lv.z, t[4 * a4 + 2], p0); p1 = __builtin_fmaf(lv.w, t[4 * a4 + 3], p1); }
            float p = quad_sum(p0 + p1);
            const float ti = (i == j ? 1.f : 0.f) - p;
            if (q == (i & 3)) t[i >> 2] = ti;
            __builtin_amdgcn_sched_barrier(0);
        }
#undef SOLVE_LD
        const LAS float* sc = (const LAS float*)(lds + L_SC);
        if (dir == 0) { const float bj = sc[128 + j];
#pragma unroll
            for (int a = 0; a < 16; ++a) *(LAS unsigned short*)(lds + L_TBF + (4 * a + q) * AS_ + j * 2) = (unsigned short)(pkbf(t[a] * bj, 0.f) & 0xffffu);
        } else { const int jo = 63 - j; const float bj = sc[192 + jo];
#pragma unroll
            for (int a = 0; a < 16; ++a) *(LAS unsigned short*)(lds + L_TBB + (63 - (4 * a + q)) * AS_ + jo * 2) = (unsigned short)(pkbf(t[a] * bj, 0.f) & 0xffffu);
        }
    }
    LBAR();
    if (!(pflg & 64)) for (int blk = w; blk < 80; blk += 8) {
        v4u f; int off;
        if (blk < 16)      { f = frag16_rm(lds + L_KN, QS_, blk >> 2, blk & 3, lane); off = B_KA + blk * 1024; }
        else if (blk < 32) { const int b = blk - 16; f = frag16_rm(lds + L_QN, QS_, b >> 2, b & 3, lane); off = B_QA + b * 1024; }
        else if (blk < 48) { const int b = blk - 32; f = frag16_tr(lds + L_KN, QS_, b >> 1, b & 1, lane); off = B_KT + b * 1024; }
        else { const int b = blk - 48, wh = b >> 3, bb = b & 7; const int lo = wh == 0 ? L_TBF : wh == 1 ? L_AF : wh == 2 ? L_TBB : L_AB;
               f = frag16_rm(lds + lo, AS_, bb >> 1, bb & 1, lane); off = B_TBF + b * 1024; }
        if (!(pflg & 8)) *(v4u*)(blob + off + lane * 16) = f; else asm volatile("" :: "v"(f));
    }
    LBAR();
  }
}
struct GdnChainArgs {
    const unsigned char* blob;
    unsigned char* stg;
    unsigned* flag;
    int nseq, flags;
};
namespace gdn { constexpr int C_Y = XBLK * 1024, C_BUF = C_Y + YBLK * 1024, C_END = 2 * C_BUF; }
#define CHAIN_SPIN_CAP (1u << 22)
#define MFMA16(a, b, c) __builtin_amdgcn_mfma_f32_16x16x32_bf16((a), (b), (c), 0, 0, 0)
__device__ __forceinline__ bf16x8 pack16(const f32x4& a, const f32x4& b) { v4u p; p.x = pkbf(a.x, a.y); p.y = pkbf(a.z, a.w); p.z = pkbf(b.x, b.y); p.w = pkbf(b.z, b.w); return __builtin_bit_cast(bf16x8, p); }

__device__ __forceinline__ void gdn_chain_unit(LAS unsigned char* lds, const GdnChainArgs& A, int item) {
    using namespace gdn;
    int tid_l = threadIdx.x; asm volatile("" : "+v"(tid_l));
    const int tid = tid_l, lane = tid & 63, w = __builtin_amdgcn_readfirstlane(tid >> 6);
    const int r = lane & 15, q = lane >> 4;
    const int c = item & 1, h = (item >> 1) & 7, sq = item >> 4; const int flags = A.flags;
    const size_t unit0 = (size_t)(sq * 8 + h) * NCH;
    const f32x4 z4 = (f32x4){0.f, 0.f, 0.f, 0.f};
    f32x4 S[8];
#pragma unroll
    for (int t = 0; t < 8; ++t) S[t] = z4;
    v2u vnext[4];
    unsigned long long pwn[4]; bool have = false; unsigned fnext = 0u;
#define GDN_ISSUE(s_, buf_) do { const int n_ = c ? NCH - 1 - (s_) : (s_); const unsigned char* bl_ = A.blob + (unit0 + n_) * BLOB; LAS unsigned char* d_ = lds + (buf_) * C_BUF; \
        { const unsigned char* vp_ = bl_ + B_VT + (16 * w + r) * 128 + 8 * q; _Pragma("unroll") for (int i = 0; i < 4; ++i) vnext[i] = *(const v2u*)(vp_ + 32 * i); } \
        if (!(flags & 4)) { glds_blocks(d_, bl_, XBLK, w, 8, lane); \
            if (c == 0) glds_blocks(d_ + C_Y, bl_ + B_KT, YBLK, w, 8, lane); \
            else { glds_blocks(d_ + C_Y, bl_ + B_KT, 16, w, 8, lane); glds_blocks(d_ + C_Y + 16384, bl_ + B_TBB, 16, w, 8, lane); } } } while (0)
    GDN_ISSUE(0, 0);
    __syncthreads();
    for (int s = 0; s < NCH; ++s) {
        const int n = c ? NCH - 1 - s : s;
        v2u vcur[4];
#pragma unroll
        for (int i = 0; i < 4; ++i) vcur[i] = vnext[i];
        unsigned long long* sp = (unsigned long long*)(A.stg + (unit0 + n) * 16384 + w * 2048) + lane;
        unsigned* fl = A.flag + (unit0 + n) * 8 + w;
        unsigned long long pw[4];
        if (s >= NCH / 2 && !(flags & 1)) {
            if (have) {
#pragma unroll
                for (int i = 0; i < 4; ++i) pw[i] = pwn[i];
            } else {
                for (unsigned sp_ = 0; __builtin_amdgcn_readfirstlane((int)__hip_atomic_load(fl, __ATOMIC_RELAXED, __HIP_MEMORY_SCOPE_AGENT)) == 0 && sp_ < CHAIN_SPIN_CAP; ++sp_) __builtin_amdgcn_s_sleep(2);
#pragma unroll
                for (int i = 0; i < 4; ++i) pw[i] = __hip_atomic_load(sp + i * 64, __ATOMIC_RELAXED, __HIP_MEMORY_SCOPE_AGENT);
            }
        }
        have = false;
        if (s + 1 >= NCH / 2 && s + 1 < NCH && !(flags & 1) && __builtin_amdgcn_readfirstlane((int)fnext) != 0) {
            const int n1 = c ? NCH - 2 - s : s + 1; const unsigned long long* sp1 = (const unsigned long long*)(A.stg + (unit0 + n1) * 16384 + w * 2048) + lane;
#pragma unroll
            for (int i = 0; i < 4; ++i) pwn[i] = __hip_atomic_load(sp1 + i * 64, __ATOMIC_RELAXED, __HIP_MEMORY_SCOPE_AGENT);
            have = true;
        }
        if (s + 2 >= NCH / 2 && s + 2 < NCH && !(flags & 1)) { const int n2 = c ? NCH - 3 - s : s + 2; fnext = __hip_atomic_load(A.flag + (unit0 + n2) * 8 + w, __ATOMIC_RELAXED, __HIP_MEMORY_SCOPE_AGENT); }
        if (s + 1 < NCH) GDN_ISSUE(s + 1, (s + 1) & 1);
        const LAS unsigned char* X = lds + (s & 1) * C_BUF; const LAS unsigned char* Y = X + C_Y; const LAS unsigned char* YT = Y + 16384;
        const LAS float* sc = (const LAS float*)(X + B_SC);
        bf16x8 sb[4];
#pragma unroll
        for (int k = 0; k < 4; ++k) sb[k] = pack16(S[2 * k], S[2 * k + 1]);
        f32x4 KS[4], QS[4];
#pragma unroll
        for (int rt = 0; rt < 4; ++rt) { KS[rt] = z4; QS[rt] = z4; }
        {
            constexpr int R = 8; bf16x8 ring[R];
#define G1_LD(i_) lds_frag(X + (((i_) & 1) ? B_QA : B_KA), ((i_) >> 3) * 4 + (((i_) >> 1) & 3), lane)
#pragma unroll
            for (int i = 0; i < R; ++i) ring[i] = G1_LD(i);
#pragma unroll
            for (int i = 0; i < 32; ++i) { const int rt = i >> 3, ks = (i >> 1) & 3;
                if (i & 1) QS[rt] = MFMA16(ring[i % R], sb[ks], QS[rt]); else KS[rt] = MFMA16(ring[i % R], sb[ks], KS[rt]);
                if (i + R < 32) ring[i % R] = G1_LD(i + R);
                __builtin_amdgcn_sched_barrier(0); }
#undef G1_LD
        }
#pragma unroll
        for (int rt = 0; rt < 4; ++rt) { const v2u vv = vcur[rt]; const f32x4 ev = *(const LAS f32x4*)(sc + 128 + c * 64 + 16 * rt + 4 * q);
            KS[rt].x = bflo(vv.x) - ev.x * KS[rt].x; KS[rt].y = bfhi(vv.x) - ev.y * KS[rt].y; KS[rt].z = bflo(vv.y) - ev.z * KS[rt].z; KS[rt].w = bfhi(vv.y) - ev.w * KS[rt].w; }
        bf16x8 rb[2] = {pack16(KS[0], KS[1]), pack16(KS[2], KS[3])};
        f32x4 vn[4];
#pragma unroll
        for (int rt = 0; rt < 4; ++rt) vn[rt] = z4;
        {   constexpr int R = 8; bf16x8 ring[R];
#pragma unroll
            for (int i = 0; i < R; ++i) ring[i] = lds_frag(YT, i, lane);
#pragma unroll
            for (int i = 0; i < 8; ++i) { vn[i >> 1] = MFMA16(ring[i], rb[i & 1], vn[i >> 1]); __builtin_amdgcn_sched_barrier(0); }
        }
        bf16x8 vb[2] = {pack16(vn[0], vn[1]), pack16(vn[2], vn[3])};
        f32x4 (&o)[4] = QS;
#pragma unroll
        for (int rt = 0; rt < 4; ++rt) { const f32x4 ev = *(const LAS f32x4*)(sc + 128 + c * 64 + 16 * rt + 4 * q);
            o[rt].x *= QSCALE * ev.x; o[rt].y *= QSCALE * ev.y; o[rt].z *= QSCALE * ev.z; o[rt].w *= QSCALE * ev.w; }
        {   constexpr int R = 8; bf16x8 ring[R];
#pragma unroll
            for (int i = 0; i < R; ++i) ring[i] = lds_frag(YT + 8192, i, lane);
#pragma unroll
            for (int i = 0; i < 8; ++i) { o[i >> 1] = MFMA16(ring[i], vb[i & 1], o[i >> 1]); __builtin_amdgcn_sched_barrier(0); }
        }
        if (!(flags & 1)) {
            if (s < NCH / 2) {
#pragma unroll
                for (int rt = 0; rt < 4; ++rt) __hip_atomic_store(sp + rt * 64, (unsigned long long)pkbf(o[rt].x, o[rt].y) | ((unsigned long long)pkbf(o[rt].z, o[rt].w) << 32), __ATOMIC_RELAXED, __HIP_MEMORY_SCOPE_AGENT);
            } else {
#pragma unroll
                for (int rt = 0; rt < 4; ++rt) { const unsigned plo = (unsigned)pw[rt], phi = (unsigned)(pw[rt] >> 32);
                    __hip_atomic_store(sp + rt * 64, (unsigned long long)pkbf(o[rt].x + bflo(plo), o[rt].y + bfhi(plo)) | ((unsigned long long)pkbf(o[rt].z + bflo(phi), o[rt].w + bfhi(phi)) << 32), __ATOMIC_RELAXED, __HIP_MEMORY_SCOPE_AGENT); }
            }
        }
#pragma unroll
        for (int rt = 0; rt < 4; ++rt) { const f32x4 ev = *(const LAS f32x4*)(sc + 256 + c * 64 + 16 * rt + 4 * q);
            vn[rt].x *= ev.x; vn[rt].y *= ev.y; vn[rt].z *= ev.z; vn[rt].w *= ev.w; }
        vb[0] = pack16(vn[0], vn[1]); vb[1] = pack16(vn[2], vn[3]);
        const float egl = sc[384 + c];
#pragma unroll
        for (int t = 0; t < 8; ++t) { S[t].x *= egl; S[t].y *= egl; S[t].z *= egl; S[t].w *= egl; }
        {   constexpr int R = 8; bf16x8 ring[R];
#pragma unroll
            for (int i = 0; i < R; ++i) ring[i] = lds_frag(Y, i, lane);
#pragma unroll
            for (int i = 0; i < 16; ++i) { S[i >> 1] = MFMA16(ring[i % R], vb[i & 1], S[i >> 1]); if (i + R < 16) ring[i % R] = lds_frag(Y, i + R, lane); __builtin_amdgcn_sched_barrier(0); }
        }
        if (!(flags & 1)) { asm volatile("s_waitcnt vmcnt(0)" ::: "memory"); if (lane == 0) __hip_atomic_store(fl, s < NCH / 2 ? 1u : 2u, __ATOMIC_RELAXED, __HIP_MEMORY_SCOPE_AGENT); }
        __syncthreads();
    }
#undef GDN_ISSUE
}
namespace gla {
constexpr int B_QGF = 0, B_QGB = 16384, B_SC = 32768, B_KDTF = 33792, B_KDTB = 50176, BLOBA = 66560;
constexpr int B_VB = 0, B_INTRA = 32768, BLOBB = 65536;
constexpr int L_R = 0, L_QGF = 8192, L_KGF = L_QGF + 17408, L_KDF = L_KGF + 17408, L_QGB = L_KDF + 17408, L_KGB = L_QGB + 17408, L_KDB = L_KGB + 17408, L_V = L_KDB + 17408, L_TOT = L_V + 33792, L_AS = L_TOT + 4096, L_END = L_AS + 9216;
static_assert(L_END <= 160 * 1024 - 256, "gla prep LDS");
constexpr int QS_ = 272, VS_ = 528, AS_ = 144;
constexpr int C_X = 0, C_Y = 17408, C_CHAIN = 66560, C_EG = 2 * C_CHAIN, C_END = C_EG + 1024;
__device__ __forceinline__ v4u frag_tr_nat(const LAS unsigned char* img, int st, int colbase, int ks, int lane) {
    const int r = lane & 31, hh = lane >> 5; const LAS unsigned char* p = img + (16 * ks + 8 * hh) * st + (colbase + r) * 2;
    unsigned short e[8];
#pragma unroll
    for (int j = 0; j < 8; ++j) e[j] = *(const LAS unsigned short*)(p + j * st);
    return (v4u){(unsigned)e[0] | ((unsigned)e[1] << 16), (unsigned)e[2] | ((unsigned)e[3] << 16), (unsigned)e[4] | ((unsigned)e[5] << 16), (unsigned)e[6] | ((unsigned)e[7] << 16)};
}
__device__ __forceinline__ float logsig2(float x) { const float xc = fminf(fmaxf(x, -60.f), 60.f); return -__builtin_amdgcn_logf(1.0f + __builtin_amdgcn_exp2f(-1.4426950408889634f * xc)); }
}

struct GlaPrepArgs {
    const bf16* qk;
    const bf16* vb;
    const float* small;
    const float *w2f, *b2f, *w2b, *b2b;
    unsigned char* blobA;
    unsigned char* blobB;
    int nseq, pad_;
};

__device__ __forceinline__ void gla_prep_phase(LAS unsigned char* lds, const GlaPrepArgs& A, int bid, int G) {
    using namespace gla;
    int tid_l = threadIdx.x; asm volatile("" : "+v"(tid_l));
    const int tid = tid_l, lane = tid & 63, w = __builtin_amdgcn_readfirstlane(tid >> 6);
    const int nunits = A.nseq * 4 * NCH;
    f32x4 pr; v4u pv[4], pq[2], pk[2];
#define GLA_PREFETCH(u_) do { const int n_ = (u_) % NCH, h_ = ((u_) / NCH) % 4, sq_ = (u_) / (NCH * 4); const size_t r_ = (size_t)sq_ * SEQ + n_ * CHUNK; \
        pr = *(const f32x4*)(A.small + (r_ + (tid >> 3)) * 64 + 32 + (tid & 7) * 4); \
        _Pragma("unroll") for (int i = 0; i < 4; ++i) { const int id = i * 512 + tid; pv[i] = *(const v4u*)(A.vb + (r_ + (id >> 5)) * 1024 + h_ * 256 + (id & 31) * 8); } \
        _Pragma("unroll") for (int i = 0; i < 2; ++i) { const int id = i * 512 + tid; const bf16* qp_ = A.qk + (r_ + (id >> 4)) * 1024 + h_ * 128 + (id & 15) * 8; pq[i] = *(const v4u*)qp_; pk[i] = *(const v4u*)(qp_ + 512); } } while (0)
    int unit = bid;
    if (unit < nunits) GLA_PREFETCH(unit);
  for (; unit < nunits; unit += G) {
    const int h = (unit / NCH) % 4;
    unsigned char* blob = A.blobA + (size_t)unit * BLOBA; unsigned char* blobB = A.blobB + (size_t)unit * BLOBB;
    *(LAS f32x4*)(lds + L_R + (tid >> 3) * 128 + (tid & 7) * 16) = pr;
#pragma unroll
    for (int i = 0; i < 4; ++i) { const int id = i * 512 + tid; *(LAS v4u*)(lds + L_V + (id >> 5) * VS_ + (id & 31) * 16) = pv[i]; }
#pragma unroll
    for (int i = 0; i < 2; ++i) { const int id = i * 512 + tid; *(LAS v4u*)(lds + L_QGF + (id >> 4) * QS_ + (id & 15) * 16) = pq[i]; *(LAS v4u*)(lds + L_KGF + (id >> 4) * QS_ + (id & 15) * 16) = pk[i]; }
    LBAR();
    {
        const int dd = tid & 127, pg = tid >> 7, d = h * 128 + dd;
        float wf[16], wb[16];
#pragma unroll
        for (int i = 0; i < 16; ++i) { wf[i] = A.w2f[i * 512 + d]; wb[i] = A.w2b[i * 512 + d]; }
        const float bf_ = A.b2f[d], bb_ = A.b2b[d];
        float lf[16], lb[16];
#pragma unroll
        for (int pp = 0; pp < 16; ++pp) {
            const LAS float* rr = (const LAS float*)(lds + L_R) + (pg * 16 + pp) * 32;
            float xf = bf_, xb = bb_;
#pragma unroll
            for (int i4 = 0; i4 < 4; ++i4) { const f32x4 a = *(const LAS f32x4*)(rr + 4 * i4), b = *(const LAS f32x4*)(rr + 16 + 4 * i4);
                xf += a.x * wf[4 * i4] + a.y * wf[4 * i4 + 1] + a.z * wf[4 * i4 + 2] + a.w * wf[4 * i4 + 3];
                xb += b.x * wb[4 * i4] + b.y * wb[4 * i4 + 1] + b.z * wb[4 * i4 + 2] + b.w * wb[4 * i4 + 3]; }
            lf[pp] = logsig2(xf) * (1.f / 16.f); lb[pp] = logsig2(xb) * (1.f / 16.f);
        }
#pragma unroll
        for (int pp = 1; pp < 16; ++pp) lf[pp] += lf[pp - 1];
#pragma unroll
        for (int pp = 14; pp >= 0; --pp) lb[pp] += lb[pp + 1];
        LAS float* tot = (LAS float*)(lds + L_TOT);
        tot[pg * 128 + dd] = lf[15]; tot[512 + pg * 128 + dd] = lb[0];
        LBAR();
        float offf = 0.f, offb = 0.f, glf = 0.f, glb = 0.f;
#pragma unroll
        for (int g = 0; g < 4; ++g) { const float tf = tot[g * 128 + dd], tb = tot[512 + g * 128 + dd]; glf += tf; glb += tb; if (g < pg) offf += tf; if (g > pg) offb += tb; }
        const float eglf = __builtin_amdgcn_exp2f(glf), eglb = __builtin_amdgcn_exp2f(glb);
        if (pg == 0) { float* sc = (float*)(blob + B_SC); sc[dd] = eglf; sc[128 + dd] = eglb; }
#pragma unroll
        for (int pp = 0; pp < 16; ++pp) {
            const int o = (pg * 16 + pp) * QS_ + dd * 2;
            const float qv = bf2f(*(const LAS unsigned short*)(lds + L_QGF + o)) * QSCALE, kv = bf2f(*(const LAS unsigned short*)(lds + L_KGF + o));
            const float ef = __builtin_amdgcn_exp2f(lf[pp] + offf), eb = __builtin_amdgcn_exp2f(lb[pp] + offb);
            const float rf = __builtin_amdgcn_rcpf(ef), rb = __builtin_amdgcn_rcpf(eb);
            *(LAS unsigned short*)(lds + L_QGF + o) = (unsigned short)(pkbf(qv * ef, 0.f) & 0xffffu);
            *(LAS unsigned short*)(lds + L_KGF + o) = (unsigned short)(pkbf(kv * rf, 0.f) & 0xffffu);
            *(LAS unsigned short*)(lds + L_KDF + o) = (unsigned short)(pkbf(kv * rf * eglf, 0.f) & 0xffffu);
            *(LAS unsigned short*)(lds + L_QGB + o) = (unsigned short)(pkbf(qv * eb, 0.f) & 0xffffu);
            *(LAS unsigned short*)(lds + L_KGB + o) = (unsigned short)(pkbf(kv * rb, 0.f) & 0xffffu);
            *(LAS unsigned short*)(lds + L_KDB + o) = (unsigned short)(pkbf(kv * rb * eglb, 0.f) & 0xffffu);
        }
    }
    LBAR();
    { const int un = unit + G; if (un < nunits) GLA_PREFETCH(un); }
    if (w < 4) {
        const int rt = w >> 1, ct = w & 1, r = lane & 31, hh = lane >> 5;
        f32x16 af = zero16(), ab = zero16();
        if (rt >= ct) { const LAS unsigned char* ia = lds + L_QGF + (32 * rt + r) * QS_ + 16 * hh; const LAS unsigned char* ib = lds + L_KGF + (32 * ct + r) * QS_ + 16 * hh;
#pragma unroll
            for (int ks = 0; ks < 8; ++ks) af = MFMA32(*(const LAS bf16x8*)(ia + 32 * ks), *(const LAS bf16x8*)(ib + 32 * ks), af); }
        if (rt <= ct) { const LAS unsigned char* ia = lds + L_QGB + (32 * rt + r) * QS_ + 16 * hh; const LAS unsigned char* ib = lds + L_KGB + (32 * ct + r) * QS_ + 16 * hh;
#pragma unroll
            for (int ks = 0; ks < 8; ++ks) ab = MFMA32(*(const LAS bf16x8*)(ia + 32 * ks), *(const LAS bf16x8*)(ib + 32 * ks), ab); }
        const int j = 32 * ct + r;
#pragma unroll
        for (int reg = 0; reg < 16; ++reg) { const int i = 32 * rt + (reg & 3) + 8 * (reg >> 2) + 4 * hh;
            const float val = (i >= j ? af[reg] : 0.f) + (i <= j ? ab[reg] : 0.f);
            *(LAS unsigned short*)(lds + L_AS + i * AS_ + j * 2) = (unsigned short)(pkbf(val, 0.f) & 0xffffu); }
    } else {
        for (int blk = w - 4; blk < 64; blk += 4) {
            const int wh = blk >> 4, b = blk & 15; v4u f; int off;
            if (wh == 0)      { f = gdn::frag_rm_perm(lds + L_QGF, QS_, b >> 3, b & 7, lane); off = B_QGF; }
            else if (wh == 1) { f = gdn::frag_rm_perm(lds + L_QGB, QS_, b >> 3, b & 7, lane); off = B_QGB; }
            else if (wh == 2) { f = frag_tr_nat(lds + L_KDF, QS_, 32 * (b >> 2), b & 3, lane); off = B_KDTF; }
            else              { f = frag_tr_nat(lds + L_KDB, QS_, 32 * (b >> 2), b & 3, lane); off = B_KDTB; }
            *(v4u*)(blob + off + b * 1024 + lane * 16) = f;
        }
    }
    LBAR();
    {
        const int ct = w, r = lane & 31, hh = lane >> 5;
        f32x16 o[2] = {zero16(), zero16()};
#pragma unroll
        for (int ks = 0; ks < 4; ++ks) {
            const v4u fb = frag_tr_nat(lds + L_V, VS_, 32 * ct, ks, lane);
            *(v4u*)(blobB + B_VB + (ct * 4 + ks) * 1024 + lane * 16) = fb;
            const bf16x8 bfr = __builtin_bit_cast(bf16x8, fb);
#pragma unroll
            for (int rt = 0; rt < 2; ++rt) o[rt] = MFMA32(*(const LAS bf16x8*)(lds + L_AS + (32 * rt + r) * AS_ + (16 * ks + 8 * hh) * 2), bfr, o[rt]);
        }
        unsigned long long* ip = (unsigned long long*)(blobB + B_INTRA) + (size_t)ct * 512 + lane;
#pragma unroll
        for (int rt = 0; rt < 2; ++rt)
#pragma unroll
            for (int g = 0; g < 4; ++g) ip[(rt * 4 + g) * 64] = (unsigned long long)pkbf(o[rt][4 * g], o[rt][4 * g + 1]) | ((unsigned long long)pkbf(o[rt][4 * g + 2], o[rt][4 * g + 3]) << 32);
    }
    LBAR();
  }
#undef GLA_PREFETCH
}

struct GlaChainArgs {
    const unsigned char* blobA;
    const unsigned char* blobB;
    unsigned char* stg;
    unsigned* flag;
    int nseq, flags;
};
namespace gla { constexpr int CB_Y = 17408, CB_BUF = 66560, CB_END = 2 * CB_BUF; }
__device__ __forceinline__ void gla_chain_unit(LAS unsigned char* lds, const GlaChainArgs& A, int item) {
    using namespace gla;
    int tid_l = threadIdx.x; asm volatile("" : "+v"(tid_l));
    const int tid = tid_l, lane = tid & 63, w = __builtin_amdgcn_readfirstlane(tid >> 6);
    const int hh = lane >> 5;
    const int c = item & 1, h = (item >> 1) & 3, sq = item >> 3; const int flags = A.flags;
    const size_t unit0 = (size_t)(sq * 4 + h) * NCH;
    f32x16 S[4];
#pragma unroll
    for (int t = 0; t < 4; ++t) S[t] = zero16();
    unsigned long long pwn[8]; bool have = false; unsigned fnext = 0u;
#define GLA_ISSUE(s_, buf_) do { if (!(flags & 4)) { const int n_ = c ? NCH - 1 - (s_) : (s_); const unsigned char* bl_ = A.blobA + (unit0 + n_) * BLOBA; const unsigned char* bb_ = A.blobB + (unit0 + n_) * BLOBB; \
        LAS unsigned char* d_ = lds + (buf_) * CB_BUF; glds_blocks(d_, bl_ + (c ? B_QGB : B_QGF), 16, w, 8, lane); if (w == 7) glds_blocks(d_ + 16384, bl_ + B_SC, 1, 0, 1, lane); \
        glds_blocks(d_ + CB_Y, bl_ + (c ? B_KDTB : B_KDTF), 16, w, 8, lane); glds_blocks(d_ + CB_Y + 16384, bb_ + B_VB, 32, w, 8, lane); } } while (0)
    GLA_ISSUE(0, 0);
    __syncthreads();
    for (int s = 0; s < NCH; ++s) {
        const int n = c ? NCH - 1 - s : s;
        unsigned long long* sp = (unsigned long long*)(A.stg + (unit0 + n) * 32768) + (size_t)w * 512 + lane;
        unsigned* fl = A.flag + (unit0 + n) * 8 + w;
        unsigned long long pw[8];
        if (s >= NCH / 2 && !(flags & 1)) {
            if (have) {
#pragma unroll
                for (int i = 0; i < 8; ++i) pw[i] = pwn[i];
            } else {
                for (unsigned sp_ = 0; __builtin_amdgcn_readfirstlane((int)__hip_atomic_load(fl, __ATOMIC_RELAXED, __HIP_MEMORY_SCOPE_AGENT)) == 0 && sp_ < CHAIN_SPIN_CAP; ++sp_) __builtin_amdgcn_s_sleep(2);
#pragma unroll
                for (int i = 0; i < 8; ++i) pw[i] = __hip_atomic_load(sp + i * 64, __ATOMIC_RELAXED, __HIP_MEMORY_SCOPE_AGENT);
            }
        }
        have = false;
        if (s + 1 >= NCH / 2 && s + 1 < NCH && !(flags & 1) && __builtin_amdgcn_readfirstlane((int)fnext) != 0) {
            const int n1 = c ? NCH - 2 - s : s + 1; const unsigned long long* sp1 = (const unsigned long long*)(A.stg + (unit0 + n1) * 32768) + (size_t)w * 512 + lane;
#pragma unroll
            for (int i = 0; i < 8; ++i) pwn[i] = __hip_atomic_load(sp1 + i * 64, __ATOMIC_RELAXED, __HIP_MEMORY_SCOPE_AGENT);
            have = true;
        }
        if (s + 2 >= NCH / 2 && s + 2 < NCH && !(flags & 1)) { const int n2 = c ? NCH - 3 - s : s + 2; fnext = __hip_atomic_load(A.flag + (unit0 + n2) * 8 + w, __ATOMIC_RELAXED, __HIP_MEMORY_SCOPE_AGENT); }
        if (s + 1 < NCH) GLA_ISSUE(s + 1, (s + 1) & 1);
        const LAS unsigned char* X = lds + (s & 1) * CB_BUF; const LAS unsigned char* Y = X + CB_Y;
        const LAS float* EG = (const LAS float*)(X + 16384) + c * 128;
        bf16x8 sb[8];
#pragma unroll
        for (int t = 0; t < 4; ++t) { sb[2 * t] = pack8(S[t], 0); sb[2 * t + 1] = pack8(S[t], 1); }
        f32x16 o[2] = {zero16(), zero16()};
        {   constexpr int R = 6; bf16x8 ring[R];
#pragma unroll
            for (int i = 0; i < R; ++i) ring[i] = lds_frag(X, i, lane);
#pragma unroll
            for (int i = 0; i < 16; ++i) { o[i >> 3] = MFMA32(ring[i % R], sb[i & 7], o[i >> 3]); if (i + R < 16) ring[i % R] = lds_frag(X, i + R, lane); __builtin_amdgcn_sched_barrier(0); }
        }
        if (!(flags & 1)) {
            if (s < NCH / 2) {
#pragma unroll
                for (int rt = 0; rt < 2; ++rt)
#pragma unroll
                    for (int g = 0; g < 4; ++g) __hip_atomic_store(sp + (rt * 4 + g) * 64, (unsigned long long)pkbf(o[rt][4 * g], o[rt][4 * g + 1]) | ((unsigned long long)pkbf(o[rt][4 * g + 2], o[rt][4 * g + 3]) << 32), __ATOMIC_RELAXED, __HIP_MEMORY_SCOPE_AGENT);
            } else {
#pragma unroll
                for (int rt = 0; rt < 2; ++rt)
#pragma unroll
                    for (int g = 0; g < 4; ++g) { const unsigned plo = (unsigned)pw[rt * 4 + g], phi = (unsigned)(pw[rt * 4 + g] >> 32);
                        __hip_atomic_store(sp + (rt * 4 + g) * 64, (unsigned long long)pkbf(o[rt][4 * g] + bflo(plo), o[rt][4 * g + 1] + bfhi(plo)) | ((unsigned long long)pkbf(o[rt][4 * g + 2] + bflo(phi), o[rt][4 * g + 3] + bfhi(phi)) << 32), __ATOMIC_RELAXED, __HIP_MEMORY_SCOPE_AGENT); }
            }
        }
        {
            bf16x8 bfr[4];
#pragma unroll
            for (int ks = 0; ks < 4; ++ks) bfr[ks] = lds_frag(Y + 16384, w * 4 + ks, lane);
#pragma unroll
            for (int t = 0; t < 4; ++t)
#pragma unroll
                for (int g = 0; g < 4; ++g) { const f32x4 ev = *(const LAS f32x4*)(EG + 32 * t + 8 * g + 4 * hh);
                    S[t][4 * g] *= ev.x; S[t][4 * g + 1] *= ev.y; S[t][4 * g + 2] *= ev.z; S[t][4 * g + 3] *= ev.w; }
            constexpr int R = 5; bf16x8 ring[R];
#pragma unroll
            for (int i = 0; i < R; ++i) ring[i] = lds_frag(Y, i, lane);
#pragma unroll
            for (int i = 0; i < 16; ++i) { S[i >> 2] = MFMA32(ring[i % R], bfr[i & 3], S[i >> 2]); if (i + R < 16) ring[i % R] = lds_frag(Y, i + R, lane); __builtin_amdgcn_sched_barrier(0); }
        }
        if (!(flags & 1)) { asm volatile("s_waitcnt vmcnt(0)" ::: "memory"); if (lane == 0) __hip_atomic_store(fl, s < NCH / 2 ? 1u : 2u, __ATOMIC_RELAXED, __HIP_MEMORY_SCOPE_AGENT); }
        __syncthreads();
    }
#undef GLA_ISSUE
}

template <int NC, bool S16>
__device__ __forceinline__ void p4_unit(LAS unsigned char* lds, const unsigned char* slot, const unsigned char* intra, const bf16* zg, const float* nw, bf16* out, const unsigned* done) {
    int tid_l = threadIdx.x; asm volatile("" : "+v"(tid_l));
    const int tid = tid_l, lane = tid & 63, w = __builtin_amdgcn_readfirstlane(tid >> 6), r = lane & 31, hh = lane >> 5;
    constexpr int ST = NC * 2 + 16, NB = (NC / 32) * 8, CPR = NC / 8;
    if (done) {
        for (unsigned sp_ = 0; sp_ < (1u << 22); ++sp_) { const unsigned f = lane < 8 ? __hip_atomic_load(done + lane, __ATOMIC_RELAXED, __HIP_MEMORY_SCOPE_AGENT) : 2u; if (__all(f == 2u)) break; __builtin_amdgcn_s_sleep(8); }
    }
    for (int b = w; b < NB; b += 8) {
        const unsigned long long v = __hip_atomic_load((const unsigned long long*)slot + b * 64 + lane, __ATOMIC_RELAXED, __HIP_MEMORY_SCOPE_AGENT);
        float x0 = bflo((unsigned)v), x1 = bfhi((unsigned)v), x2 = bflo((unsigned)(v >> 32)), x3 = bfhi((unsigned)(v >> 32));
        if (intra) { const unsigned long long iv = ((const unsigned long long*)intra)[b * 64 + lane];
            x0 += bflo((unsigned)iv); x1 += bfhi((unsigned)iv); x2 += bflo((unsigned)(iv >> 32)); x3 += bfhi((unsigned)(iv >> 32)); }
        int row, col;
        if (S16) { row = 16 * (b & 3) + 4 * (lane >> 4); col = 16 * (b >> 2) + (lane & 15); }
        else { row = 32 * ((b >> 2) & 1) + 8 * (b & 3) + 4 * hh; col = 32 * (b >> 3) + r; }
        LAS unsigned char* p = lds + row * ST + col * 2;
        const unsigned a = pkbf(x0, x1), bq = pkbf(x2, x3);
        *(LAS unsigned short*)p = (unsigned short)(a & 0xffffu); *(LAS unsigned short*)(p + ST) = (unsigned short)(a >> 16);
        *(LAS unsigned short*)(p + 2 * ST) = (unsigned short)(bq & 0xffffu); *(LAS unsigned short*)(p + 3 * ST) = (unsigned short)(bq >> 16);
    }
    __syncthreads();
#pragma unroll
    for (int it = 0; it < (64 * CPR) / 512; ++it) {
        const int idx = it * 512 + tid, row = idx / CPR, ch = idx % CPR;
        const v4u xw = *(const LAS v4u*)(lds + row * ST + ch * 16);
        float x[8] = {bflo(xw.x), bfhi(xw.x), bflo(xw.y), bfhi(xw.y), bflo(xw.z), bfhi(xw.z), bflo(xw.w), bfhi(xw.w)};
        float ss = 0.f;
#pragma unroll
        for (int i = 0; i < 8; ++i) ss += x[i] * x[i];
        ss = row16_sum(ss);
        if (NC == 256) ss += __shfl_xor(ss, 16);
        const float rstd = 1.0f / sqrtf(ss * (1.0f / NC) + EPS);
        f32x4 w0 = *(const f32x4*)(nw + ch * 8), w1 = *(const f32x4*)(nw + ch * 8 + 4);
        if (zg) { const v4u zw = *(const v4u*)(zg + (size_t)row * 1024 + ch * 8);
            const float z[8] = {bflo(zw.x), bfhi(zw.x), bflo(zw.y), bfhi(zw.y), bflo(zw.z), bfhi(zw.z), bflo(zw.w), bfhi(zw.w)};
            w0.x *= z[0] * __builtin_amdgcn_rcpf(1.0f + __expf(-z[0])); w0.y *= z[1] * __builtin_amdgcn_rcpf(1.0f + __expf(-z[1])); w0.z *= z[2] * __builtin_amdgcn_rcpf(1.0f + __expf(-z[2])); w0.w *= z[3] * __builtin_amdgcn_rcpf(1.0f + __expf(-z[3]));
            w1.x *= z[4] * __builtin_amdgcn_rcpf(1.0f + __expf(-z[4])); w1.y *= z[5] * __builtin_amdgcn_rcpf(1.0f + __expf(-z[5])); w1.z *= z[6] * __builtin_amdgcn_rcpf(1.0f + __expf(-z[6])); w1.w *= z[7] * __builtin_amdgcn_rcpf(1.0f + __expf(-z[7])); }
        v4u o; o.x = pkbf(x[0] * rstd * w0.x, x[1] * rstd * w0.y); o.y = pkbf(x[2] * rstd * w0.z, x[3] * rstd * w0.w); o.z = pkbf(x[4] * rstd * w1.x, x[5] * rstd * w1.y); o.w = pkbf(x[6] * rstd * w1.z, x[7] * rstd * w1.w);
        *(v4u*)(out + (size_t)row * 1024 + ch * 8) = o;
    }
    __syncthreads();
}
#define XB_TMO      128
#define XB_XCNT(j)  (256  + 64 * (j))
#define XB_XSUB(j)  (1280 + 64 * (j))
#define XB_XGEN(j)  (2304 + 64 * (j))
#define XB_TOP      3328
#define XB_TOPGEN   3392
#define XCD_BAR_WORDS 3456
#define XB_SPIN_CAP (1u << 18)

__device__ __forceinline__ unsigned xb_ld(unsigned* p)              { return __hip_atomic_load(p, __ATOMIC_RELAXED, __HIP_MEMORY_SCOPE_AGENT); }
__device__ __forceinline__ unsigned xb_add(unsigned* p, unsigned v) { return __hip_atomic_fetch_add(p, v, __ATOMIC_RELAXED, __HIP_MEMORY_SCOPE_AGENT); }
__device__ __forceinline__ unsigned xb_xcc_id() { return (unsigned)__builtin_amdgcn_s_getreg((3 << 11) | 20) & 0xFu; }
#define XB_SPIN(cond, bar) do { unsigned _sp = 0; while (cond) { __builtin_amdgcn_s_sleep(1); \
    if ((++_sp & 255u) == 0u) { if (xb_ld(&(bar)[XB_TMO])) break; if (_sp > XB_SPIN_CAP) { atomicAdd(&(bar)[XB_TMO], 1u); break; } } } } while (0)

struct XcdBarrier {
    unsigned* bar; unsigned x;
    volatile LAS unsigned* st;
};

__device__ __forceinline__ XcdBarrier xcd_barrier_post(unsigned* bar, volatile LAS unsigned* st) {
    XcdBarrier b; b.bar = bar; b.x = xb_xcc_id(); b.st = st;
    if (threadIdx.x == 0) (void)xb_add(&bar[XB_XCNT(b.x)], 1u);
    return b;
}
__device__ __forceinline__ void xcd_barrier_complete(unsigned* bar, unsigned x, unsigned& nloc, unsigned& nx) {
    const unsigned G = gridDim.x * gridDim.y * gridDim.z;
    unsigned sum, cnt, mine, sp = 0u;
    for (;;) {
        sum = 0u; cnt = 0u; mine = 0u;
#pragma unroll
        for (unsigned j = 0; j < 16; ++j) { const unsigned c = xb_ld(&bar[XB_XCNT(j)]); sum += c; cnt += (c > 0u) ? 1u : 0u; mine = (j == x) ? c : mine; }
        if (sum == G) break;
        __builtin_amdgcn_s_sleep(1);
        if ((++sp & 255u) == 0u) { if (xb_ld(&bar[XB_TMO])) break; if (sp > XB_SPIN_CAP) { atomicAdd(&bar[XB_TMO], 1u); break; } }
    }
    nloc = mine > 0u ? mine : 1u; nx = cnt > 0u ? cnt : 1u;
}

__device__ __forceinline__ void xcd_barrier(const XcdBarrier& b) {
    asm volatile("s_waitcnt vmcnt(0)" ::: "memory");
    __syncthreads();
    if (threadIdx.x == 0) {
        unsigned* bar = b.bar;
        __builtin_amdgcn_s_waitcnt(0);
        unsigned nloc = b.st[0], nx = b.st[1];
        if (nloc == 0u) { xcd_barrier_complete(bar, b.x, nloc, nx); b.st[0] = nloc; b.st[1] = nx; }
        const unsigned old = xb_add(&bar[XB_XSUB(b.x)], 1u);
        const unsigned gen = old / nloc;
        if (old + 1u == (gen + 1u) * nloc) {
            __builtin_amdgcn_fence(__ATOMIC_RELEASE, "agent");
            asm volatile("s_waitcnt vmcnt(0)" ::: "memory");
            const unsigned og = xb_add(&bar[XB_TOP], 1u);
            const unsigned tg = og / nx;
            if (og + 1u == (tg + 1u) * nx) xb_add(&bar[XB_TOPGEN], 1u);
            else XB_SPIN(xb_ld(&bar[XB_TOPGEN]) == tg, bar);
            __builtin_amdgcn_fence(__ATOMIC_ACQUIRE, "agent");
            xb_add(&bar[XB_XGEN(b.x)], 1u);
            asm volatile("s_waitcnt vmcnt(0)" ::: "memory");
        } else {
            XB_SPIN(xb_ld(&bar[XB_XGEN(b.x)]) == gen, bar);
            __builtin_amdgcn_fence(__ATOMIC_ACQUIRE, "agent");
            asm volatile("s_waitcnt vmcnt(0)" ::: "memory");
        }
    }
    __syncthreads();
}
__device__ __forceinline__ void transpose_item(const float* W, int ldw, int src_col0, int K, int ncols, bf16* WT, int dst_row0, LAS float* scr, int item, int lane) {
    asm volatile("" : "+v"(lane));
    const int nblk = ncols / 32, kb = item / nblk, nb = item % nblk, k0 = 64 * kb, n0 = 32 * nb;
#pragma unroll 8
    for (int i = 0; i < 32; ++i) { const int kk = 2 * i + (lane >> 5); scr[kk * 33 + (lane & 31)] = W[(size_t)(k0 + kk) * ldw + src_col0 + n0 + (lane & 31)]; }
    LDS_WAIT();
    const int c = lane & 7;
#pragma unroll
    for (int j = 0; j < 4; ++j) { const int n = (lane >> 3) + 8 * j; const LAS float* s = scr + (8 * c) * 33 + n;
        v4u o; o.x = pk2(s[0 * 33], s[1 * 33]); o.y = pk2(s[2 * 33], s[3 * 33]); o.z = pk2(s[4 * 33], s[5 * 33]); o.w = pk2(s[6 * 33], s[7 * 33]);
        *(v4u*)(WT + (size_t)(dst_row0 + n0 + n) * K + k0 + 8 * c) = o; }
    LDS_WAIT();
}

constexpr int WCV_MIX = 16 * ((1024 + 3072 + 1024 + 1024 + 32 + 32) / 32), WCV_ALL = WCV_MIX + 16 * ((1024 + 2048) / 32) + 3 * 512;
__device__ __forceinline__ void wconv_item(int it, const float* w_in, const float* wa, const float* wb, const float* wo, bf16* WT_IN, bf16* WT_A, bf16* WT_B, bf16* WT_O, LAS float* scr, int lane) {
    constexpr int c0 = 512, c1 = c0 + 1536, c2 = c1 + 512, c3 = c2 + 512, c4 = c3 + 16, c5 = c4 + 16, c6 = c5 + 512, c7 = c6 + 1024, c8 = c7 + 512, c9 = c8 + 512;
    static_assert(c5 == WCV_MIX && c9 + 512 == WCV_ALL, "weight conversion item list");
    if (it < c0) transpose_item(w_in, NIN, SRC_ZA, D, 1024, WT_IN, 0, scr, it, lane);
    else if (it < c1) transpose_item(w_in, NIN, SRC_QKVA, D, 3072, WT_IN, 1024, scr, it - c0, lane);
    else if (it < c2) transpose_item(w_in, NIN, SRC_QB, D, 1024, WT_IN, 4096, scr, it - c1, lane);
    else if (it < c3) transpose_item(w_in, NIN, SRC_VB, D, 1024, WT_IN, 5120, scr, it - c2, lane);
    else if (it < c4) transpose_item(w_in, NIN, SRC_AF, D, 32, WT_IN, 9216, scr, it - c3, lane);
    else if (it < c5) transpose_item(w_in, NIN, SRC_RF, D, 32, WT_IN, 9248, scr, it - c4, lane);
    else if (it < c6) transpose_item(w_in, NIN, SRC_GB, D, 1024, WT_IN, 6144, scr, it - c5, lane);
    else if (it < c7) transpose_item(w_in, NIN, SRC_GA, D, 2048, WT_IN, 7168, scr, it - c6, lane);
    else if (it < c8) transpose_item(wa, D, 0, D, D, WT_A, 0, scr, it - c7, lane);
    else if (it < c9) transpose_item(wb, D, 0, D, D, WT_B, 0, scr, it - c8, lane);
    else transpose_item(wo, D, 0, D, D, WT_O, 0, scr, it - c9, lane);
}
__device__ __forceinline__ void h_rows(const float* x, const float* w, bf16* h, int nrows, int gw, int ngw, int lane) {
    asm volatile("" : "+v"(lane));
    for (int m = gw; m < nrows; m += ngw) {
        const f32x4* xr = (const f32x4*)(x + (size_t)m * D) + lane; f32x4 v[4]; float s = 0.f;
#pragma unroll
        for (int j = 0; j < 4; ++j) { v[j] = xr[64 * j]; s += (v[j].x * v[j].x + v[j].y * v[j].y) + (v[j].z * v[j].z + v[j].w * v[j].w); }
        const float rstd = 1.0f / sqrtf(wave_sum(s) * (1.f / D) + EPS);
        unsigned long long* o8 = (unsigned long long*)(h + (size_t)m * D) + lane;
#pragma unroll
        for (int j = 0; j < 4; ++j) { const f32x4 ww = ((const f32x4*)w)[lane + 64 * j];
            o8[64 * j] = (unsigned long long)pkbf(v[j].x * rstd * ww.x, v[j].y * rstd * ww.y) | ((unsigned long long)pkbf(v[j].z * rstd * ww.z, v[j].w * rstd * ww.w) << 32); }
    }
}
__device__ __forceinline__ void h_rows_tiles(const float* x, const float* w, const pg8::Gemm& gt, int nrows, int gw, int ngw, int lane) {
    asm volatile("" : "+v"(lane));
    for (int m = gw; m < nrows; m += ngw) {
        const f32x4* xr = (const f32x4*)(x + (size_t)m * D) + lane; f32x4 v[4]; float s = 0.f;
#pragma unroll
        for (int j = 0; j < 4; ++j) { v[j] = xr[64 * j]; s += (v[j].x * v[j].x + v[j].y * v[j].y) + (v[j].z * v[j].z + v[j].w * v[j].w); }
        const float rstd = 1.0f / sqrtf(wave_sum(s) * (1.f / D) + EPS);
        unsigned long long* o8 = (unsigned long long*)(gt.atile(m >> 8, (size_t)256 * D * 2) + (size_t)(m & 255) * D * 2) + lane;
#pragma unroll
        for (int j = 0; j < 4; ++j) { const f32x4 ww = ((const f32x4*)w)[lane + 64 * j];
            o8[64 * j] = (unsigned long long)pkbf(v[j].x * rstd * ww.x, v[j].y * rstd * ww.y) | ((unsigned long long)pkbf(v[j].z * rstd * ww.z, v[j].w * rstd * ww.w) << 32); }
    }
}
__device__ __forceinline__ void final_rows(const float* x, const float* pre, const float* w, float* out, int nrows, int gw, int ngw, int lane) {
    asm volatile("" : "+v"(lane));
    for (int m = gw; m < nrows; m += ngw) {
        const f32x4* pr = (const f32x4*)(pre + (size_t)m * D) + lane; const f32x4* xr = (const f32x4*)(x + (size_t)m * D) + lane; f32x4 v[4]; float s = 0.f;
#pragma unroll
        for (int j = 0; j < 4; ++j) { v[j] = pr[64 * j]; s += (v[j].x * v[j].x + v[j].y * v[j].y) + (v[j].z * v[j].z + v[j].w * v[j].w); }
        const float rstd = 1.0f / sqrtf(wave_sum(s) * (1.f / D) + EPS);
        f32x4* orow = (f32x4*)(out + (size_t)m * D) + lane;
#pragma unroll
        for (int j = 0; j < 4; ++j) { const f32x4 ww = ((const f32x4*)w)[lane + 64 * j]; const f32x4 xv = xr[64 * j]; orow[64 * j] = xv + v[j] * rstd * ww; }
    }
}
__device__ __forceinline__ void small_unit(LAS unsigned char* lds, const bf16* h, const bf16* wsm, float* out, int unit) {
    int tid_l = threadIdx.x; asm volatile("" : "+v"(tid_l));
    const int tid = tid_l, lane = tid & 63, w = __builtin_amdgcn_readfirstlane(tid >> 6), r = lane & 31, hh = lane >> 5;
    const int ct = w & 1, kq = w >> 1;
    const bf16* ap = h + (size_t)(unit * 32 + r) * D + kq * 256 + 8 * hh;
    const bf16* bp = wsm + (size_t)(32 * ct + r) * D + kq * 256 + 8 * hh;
    f32x16 acc = zero16();
#pragma unroll 8
    for (int ks = 0; ks < 16; ++ks) acc = MFMA32(*(const bf16x8*)(ap + 16 * ks), *(const bf16x8*)(bp + 16 * ks), acc);
    LAS float* red = (LAS float*)lds + (size_t)w * 1024 + lane;
    if (kq != 0) {
#pragma unroll
        for (int i = 0; i < 16; ++i) red[i * 64] = acc[i]; }
    __syncthreads();
    if (kq == 0) {
        float* op = out + (size_t)(unit * 32 + 4 * hh) * 64 + 32 * ct + r;
#pragma unroll
        for (int i = 0; i < 16; ++i) op[((i & 3) + 8 * (i >> 2)) * 64] = ((acc[i] + red[2048 + i * 64]) + red[4096 + i * 64]) + red[6144 + i * 64]; }
    __syncthreads();
}

constexpr int NG = 2, MG = M / NG, NSEQG = BATCH / NG;
constexpr size_t KiB = 1024;
constexpr size_t WS_CTL = 0  , WS_WTIN = 320 * KiB, WS_WTA = WS_WTIN + 18560 * KiB, WS_WTB = WS_WTA + 2 * MiB, WS_WTO = WS_WTB + 2 * MiB, WS_SMALL = WS_WTO + 2 * MiB  ,
    WS_Z = WS_SMALL + 2 * MiB  , WS_PG = WS_Z + 16 * MiB  , WS_GBLOB = WS_PG + 80 * MiB  , WS_LBLOBB = WS_GBLOB + 98 * MiB  , WS_END = WS_LBLOBB + 32 * MiB;
static_assert(WS_END <= 256 * MiB, "workspace");
constexpr size_t WS_GATES = WS_GBLOB  , WS_M1 = WS_GATES + 64 * MiB  , WS_MERGED = WS_M1 + 32 * MiB  , WS_PRE = WS_MERGED + 32 * MiB  ;
static_assert(WS_PRE + 1 * MiB <= WS_END, "overlays");
constexpr size_t HT_TILE = 256 * 1024 * 2, WS_H0 = WS_WTIN, WS_H1 = WS_PG + (size_t)NSEQG * 4 * NCH * gla::BLOBA, WS_H2 = WS_SMALL, WS_H3 = WS_END;
constexpr int HT1 = 24, HT2 = 55, HT3 = 59;
static_assert(((size_t)NSEQG * 4 * NCH * gla::BLOBA) % HT_TILE == 0 && WS_H1 + (HT2 - HT1) * HT_TILE <= WS_PG + 3 * ((size_t)MG * 2048) && HT1 * HT_TILE <= (size_t)6144 * 2048 && (HT3 - HT2) * HT_TILE <= 2 * MiB && WS_H3 + (64 - HT3) * HT_TILE <= 256 * MiB, "h tiles");
constexpr size_t PGMAT = (size_t)MG * 1024 * 2;
static_assert((size_t)NSEQG * 4 * NCH * gla::BLOBA <= 3 * PGMAT && (size_t)NSEQG * 4 * NCH * 32768 <= PGMAT && (size_t)NSEQG * 8 * NCH * 16384 <= PGMAT, "overlays");
static_assert((size_t)NSEQG * 8 * NCH * gdn::BLOB <= 98 * MiB && (size_t)NSEQG * 4 * NCH * gla::BLOBB <= 32 * MiB, "blobs");
constexpr int LDS_BYTES = 160 * 1024, LDS_BAR = LDS_BYTES - 16;
static_assert(gla::L_END <= LDS_BAR && gdn::L_END <= LDS_BAR && gdn::C_END <= LDS_BAR && gla::CB_END <= LDS_BAR && pg8::STAGE_BYTES <= LDS_BAR, "LDS");
constexpr int N_PHASES = 12;

struct MegaArgs { const float* in[18]; float* out; unsigned char* ws; int ph_lo, ph_hi; };

__global__ void __launch_bounds__(512, 2) mega(MegaArgs a) {
    extern __shared__ __attribute__((aligned(16))) unsigned char lds_raw[];
    LAS unsigned char* lds = (LAS unsigned char*)lds_raw;
    const int tid = threadIdx.x, lane = tid & 63, wave = __builtin_amdgcn_readfirstlane(tid >> 6);
    const int G = gridDim.x, bid = blockIdx.x, gw = bid * 8 + wave, ngw = G * 8;
    unsigned char* ws = a.ws;
    const float* x = a.in[0]; const float* ln_pre_w = a.in[1]; const float* w_in = a.in[2]; const float* conv_w = a.in[3];
    if (tid < 4) ((LAS unsigned*)(lds + LDS_BAR))[tid] = 0u;
    __syncthreads();
    XcdBarrier bar = xcd_barrier_post((unsigned*)(ws + WS_CTL), (volatile LAS unsigned*)(lds + LDS_BAR));
    const int lo = a.ph_lo, hi = a.ph_hi;
#define IN(k) (lo <= (k) && (k) < hi)
#define SEAM(k) do { if (IN(k) && IN((k) + 1)) xcd_barrier(bar); } while (0)
#ifndef PROBE_REPEAT
#define PROBE_REPEAT 0
#endif
#ifndef PROBE_FLAGS
#define PROBE_FLAGS 0
#endif
#define PH(k) if (IN(k)) for (int rep_ = 0; rep_ <= ((PROBE_REPEAT >> (k)) & 1); ++rep_)
#define REPBAR() do { if (rep_) xcd_barrier(bar); } while (0)
    bf16* WT_IN = (bf16*)(ws + WS_WTIN); bf16* WT_A = (bf16*)(ws + WS_WTA); bf16* WT_B = (bf16*)(ws + WS_WTB); bf16* WT_O = (bf16*)(ws + WS_WTO);
    bf16* PG = (bf16*)(ws + WS_PG); float* SMALL = (float*)(ws + WS_SMALL);
    bf16* ORAWA = (bf16*)a.out; bf16* ORAWB = (bf16*)a.out + (size_t)M * 1024;
    pg8::Gemm gh{(const bf16*)(ws + WS_H0), WT_IN + (size_t)6144 * D, M, 3072, D, 0, (const bf16*)(ws + WS_H1), (const bf16*)(ws + WS_H2), (const bf16*)(ws + WS_H3), HT1, HT2, HT3};

    PH(0) { REPBAR();
        LAS float* scr = (LAS float*)lds + wave * (64 * 33);
        for (int it = gw; it < WCV_MIX; it += ngw) wconv_item(it, w_in, a.in[9], a.in[15], a.in[16], WT_IN, WT_A, WT_B, WT_O, scr, lane);
        h_rows(x, ln_pre_w, ORAWB + (size_t)MG * 1024, MG, gw, ngw, lane);
    }
    SEAM(0);
#ifdef PROBE_BARRIERS
    for (int i = 0; i < PROBE_BARRIERS; ++i) xcd_barrier(bar);
#endif
    for (int g = 0; g < NG; ++g) {
        const int pb = 1 + 4 * g;
        const size_t r0 = (size_t)g * MG;
        const bf16* hsrc = (g == 0 ? ORAWB : ORAWA) + (size_t)MG * 1024;
        PH(pb) { REPBAR();
            for (int u = bid; u < MG / 32; u += G) small_unit(lds, hsrc, WT_IN + (size_t)9216 * D, SMALL, u);
            pg8::Gemm gm{hsrc, WT_IN, MG, 6144, D, 0}; pg8::StaticOrder S; S.init(MG, 6144, G, bid);
            pg8::EpiBf16 E{(bf16*)(ws + WS_Z), 1024, 1024, (size_t)MG * 1024};
            pg8::gemm_phase<pg8::EpiBf16, pg8::StaticOrder, true, true>(lds, gm, S, E);
        }
        SEAM(pb);
        PH(pb + 1) { REPBAR();
            GdnPrepArgs pa{PG, PG + (size_t)MG * 1024, PG + (size_t)2 * MG * 1024, SMALL, conv_w, a.in[4], a.in[5], a.in[6], a.in[7], ws + WS_GBLOB, NSEQG, rep_ ? PROBE_FLAGS : 0};
            gdn_prep_phase(lds, pa, bid, G, ws + WS_CTL + 300 * KiB);
        }
        SEAM(pb + 1);
        PH(pb + 2) { REPBAR();
            GlaPrepArgs pa{PG + (size_t)3 * MG * 1024, PG + (size_t)4 * MG * 1024, SMALL, a.in[10], a.in[11], a.in[12], a.in[13], ws + WS_PG, ws + WS_LBLOBB, NSEQG, 0};
            gla_prep_phase(lds, pa, bid, G);
        }
        SEAM(pb + 2);
        PH(pb + 3) { REPBAR();
            constexpr int NGI = NSEQG * 8 * 2, NLI = NSEQG * 4 * 2;
            unsigned* gflag = (unsigned*)(ws + WS_CTL + 32 * KiB) + (size_t)g * (NSEQG * 8 * NCH * 8); unsigned* lflag = (unsigned*)(ws + WS_CTL + 96 * KiB) + (size_t)g * (NSEQG * 4 * NCH * 8);
            if (rep_) { gflag += 32 * 1024; lflag += 32 * 1024; }
            if (bid < NGI) { if (!(rep_ && (PROBE_FLAGS & 16))) { GdnChainArgs ca{ws + WS_GBLOB, ws + WS_PG + 4 * PGMAT, gflag, NSEQG, rep_ ? PROBE_FLAGS : 0}; gdn_chain_unit(lds, ca, bid); } }
            else if (bid < NGI + NLI) { if (!(rep_ && (PROBE_FLAGS & 32))) { GlaChainArgs ca{ws + WS_PG, ws + WS_LBLOBB, ws + WS_PG + 3 * PGMAT, lflag, NSEQG, rep_ ? PROBE_FLAGS : 0}; gla_chain_unit(lds, ca, bid - NGI); } }
            else if (!rep_) {
                const int wk = bid - NGI - NLI, nwk = G - NGI - NLI;
                if (g == 0) h_rows(x + (size_t)MG * D, ln_pre_w, ORAWA + (size_t)MG * 1024, MG, wk * 8 + wave, nwk * 8, lane);
                if (g == 0) { LAS float* scr = (LAS float*)lds + wave * (64 * 33);
                    for (int it = WCV_MIX + wk * 8 + wave; it < WCV_ALL; it += nwk * 8) wconv_item(it, w_in, a.in[9], a.in[15], a.in[16], WT_IN, WT_A, WT_B, WT_O, scr, lane);
                    __syncthreads(); }
                if (g == NG - 1) h_rows_tiles(x, ln_pre_w, gh, M, wk * 8 + wave, nwk * 8, lane);
            }
            if (!rep_) {
                constexpr int NPG = NSEQG * 8, NPL = NSEQG * 4;
                unsigned* qhead = (unsigned*)(ws + WS_CTL + 301 * KiB) + 64 * g;
                for (;;) {
                    if (tid == 0) ((LAS unsigned*)(lds + LDS_BAR))[3] = __hip_atomic_fetch_add(qhead, 1u, __ATOMIC_RELAXED, __HIP_MEMORY_SCOPE_AGENT);
                    __syncthreads();
                    const int j = (int)((LAS unsigned*)(lds + LDS_BAR))[3];
                    __syncthreads();
                    if (j >= NCH * (NPG + NPL)) break;
                    const int rk = j / (NPG + NPL), idx = j % (NPG + NPL), n = (rk & 1) ? (NCH / 2 - 1 - (rk >> 1)) : (NCH / 2 + (rk >> 1));
                    if (idx < NPG) { const int u = idx * NCH + n, hd = idx % 8, sq = idx / 8;
                        p4_unit<128, true>(lds, ws + WS_PG + 4 * PGMAT + (size_t)u * 16384, nullptr, (const bf16*)(ws + WS_Z) + ((size_t)sq * SEQ + n * CHUNK) * 1024 + hd * 128, a.in[8], ORAWA + (r0 + (size_t)sq * SEQ + n * CHUNK) * 1024 + hd * 128, gflag + (size_t)u * 8); }
                    else { const int pi = idx - NPG, u = pi * NCH + n, hd = pi % 4, sq = pi / 4;
                        p4_unit<256, false>(lds, ws + WS_PG + 3 * PGMAT + (size_t)u * 32768, ws + WS_LBLOBB + (size_t)u * gla::BLOBB + gla::B_INTRA, nullptr, a.in[14], ORAWB + (r0 + (size_t)sq * SEQ + n * CHUNK) * 1024 + hd * 256, lflag + (size_t)u * 8); }
                }
            }
        }
        SEAM(pb + 3);
    }
    PH(9) { REPBAR();
        const pg8::Gemm& gm = gh; pg8::StaticOrder S; S.init(M, 3072, G, bid);
        if (rep_ == 0) { pg8::EpiP1b E{ORAWB, (bf16*)(ws + WS_GATES), (size_t)M * 1024, ORAWB};
            pg8::gemm_phase<pg8::EpiP1b, pg8::StaticOrder, true, true>(lds, gm, S, E); }
        else { pg8::EpiP1b E{ORAWB, (bf16*)(ws + WS_GATES), (size_t)M * 1024, (bf16*)(ws + WS_MERGED)};
            pg8::gemm_phase<pg8::EpiP1b, pg8::StaticOrder, true, true>(lds, gm, S, E); }
    }
    SEAM(9);
    PH(10) { REPBAR();
        pg8::Gemm gm{ORAWA, WT_A, 2 * M, 2 * D, D, 0}; pg8::PairOrder S; S.init(M, D, G, bid);
        pg8::EpiMerge E{(bf16*)(ws + WS_M1), (bf16*)(ws + WS_MERGED), (const bf16*)(ws + WS_GATES), (size_t)M * 1024, M / 256, D / 256};
        pg8::gemm_phase<pg8::EpiMerge, pg8::PairOrder, true, true>(lds, gm, S, E);
    }
    SEAM(10);
    if (IN(11)) {
        pg8::Gemm gm{(const bf16*)(ws + WS_MERGED), WT_O, M, D, D, 0}; pg8::StaticOrder S; S.init(M, D, G, bid);
        pg8::EpiRmsRes E{x, a.in[17], a.out, (float*)(ws + WS_PRE), (unsigned*)(ws + WS_CTL + 304 * KiB)};
        pg8::gemm_phase<pg8::EpiRmsRes, pg8::StaticOrder, false, true>(lds, gm, S, E);
    }
#undef IN
#undef SEAM
}

#ifndef MK_N_LAUNCHES
#define MK_N_LAUNCHES 1
#endif
extern "C" void kernel_launch(void* const* d_in, const int* in_sizes, int n_in, void* d_out, int out_size, void* d_ws, size_t ws_size, hipStream_t stream) {
    static int ready = 0;
    if (!ready) {
        if (n_in != 18 || ws_size < 256 * MiB || out_size != M * D) { fprintf(stderr, "kernel_launch: unexpected problem shape / workspace (%d inputs, ws %zu)\n", n_in, ws_size); ready = -1; return; }
        if (hipFuncSetAttribute((const void*)mega, hipFuncAttributeMaxDynamicSharedMemorySize, LDS_BYTES) != hipSuccess) { fprintf(stderr, "kernel_launch: hipFuncSetAttribute failed\n"); ready = -1; return; }
        ready = 1;
    }
    if (ready < 0) return;
    (void)hipMemsetAsync((char*)d_ws + WS_CTL, 0, 320 * 1024, stream);
    MegaArgs a{};
    for (int i = 0; i < 18; ++i) a.in[i] = (const float*)d_in[i];
    a.out = (float*)d_out; a.ws = (unsigned char*)d_ws;
#if MK_N_LAUNCHES == 1
    a.ph_lo = 0; a.ph_hi = N_PHASES;
    hipLaunchKernelGGL(mega, dim3(256), dim3(512), LDS_BYTES, stream, a);
#else
    for (int p = 0; p < N_PHASES; ++p) { a.ph_lo = p; a.ph_hi = p + 1; hipLaunchKernelGGL(mega, dim3(256), dim3(512), LDS_BYTES, stream, a); }
#endif
}
```

```cpp
#include <hip/hip_runtime.h>
#include <cstdio>
#include <cstdint>

#define GAS __attribute__((address_space(1)))
#define LAS __attribute__((address_space(3)))
typedef unsigned short bf16;
typedef unsigned v4u __attribute__((ext_vector_type(4)));
typedef unsigned v2u __attribute__((ext_vector_type(2)));
typedef float f32x4 __attribute__((ext_vector_type(4)));
#define LDS_WAIT() asm volatile("s_waitcnt lgkmcnt(0)" ::: "memory")

constexpr int BATCH = 8, SEQ = 2048, D = 1024, M = BATCH * SEQ, NIN = 9280;
constexpr float EPS = 1e-6f;
constexpr size_t MiB = 1 << 20;
constexpr int SRC_QKVA = 0, SRC_ZA = 3072, SRC_AF = 4096, SRC_QB = 4128, SRC_KB = 4640, SRC_VB = 5152, SRC_GB = 6176, SRC_RF = 7200, SRC_GA = 7232, SRC_GBm = 8256;

__device__ __forceinline__ unsigned f2bf(float f) { unsigned u = __builtin_bit_cast(unsigned, f); return (u + 0x7fffu + ((u >> 16) & 1u)) >> 16; }
__device__ __forceinline__ unsigned pk2(float lo, float hi) { return f2bf(lo) | (f2bf(hi) << 16); }
__device__ __forceinline__ float bf2f(unsigned short b) { return __builtin_bit_cast(float, (unsigned)b << 16); }
__device__ __forceinline__ float bflo(unsigned w) { return __builtin_bit_cast(float, w << 16); }
__device__ __forceinline__ float bfhi(unsigned w) { return __builtin_bit_cast(float, w & 0xffff0000u); }
__device__ __forceinline__ float sigmoidf_(float x) { return 1.0f / (1.0f + __expf(-x)); }
__device__ __forceinline__ float siluf_(float x) { return x / (1.0f + __expf(-x)); }
__device__ __forceinline__ float wave_sum(float v) {
#pragma unroll
    for (int o = 1; o < 64; o <<= 1) v += __shfl_xor(v, o);
    return v;
}
namespace pg8 {
#define PG8_LAS __attribute__((address_space(3)))
typedef unsigned short bf16_t;
typedef short bf16x8 __attribute__((ext_vector_type(8)));
typedef float f32x4 __attribute__((ext_vector_type(4)));
typedef unsigned u32x4 __attribute__((ext_vector_type(4)));
constexpr int BM = 256, BK = 64, HALF = 128, HTB = HALF * BK * 2  , STAGE_BYTES = 8 * HTB, NXCD = 8, WGM = 8;

__host__ __device__ __forceinline__ int lds_byte(int r, int c) { const int st = (r >> 4) * 2 + (c >> 5), rr = r & 15, cc = c & 31, ob = rr * 64 + cc * 2; return st * 1024 + (ob ^ (((ob >> 9) & 1) << 5)); }
__host__ __device__ __forceinline__ void stage_rc(int b, int& R, int& C) { const int st = b / 1024, sb = b % 1024, swz = sb ^ (((sb >> 9) & 1) << 5); R = (st >> 1) * 16 + swz / 64; C = (st & 1) * 32 + (swz % 64) / 2; }
__host__ __device__ __forceinline__ int perm32(int rho) { const int n = rho >> 4, i = rho & 15; return 8 * (i >> 2) + 4 * n + (i & 3); }

struct Unit { int pm, pn; };
struct Gemm { const bf16_t* A; const bf16_t* Bt; int M, N, K, pad_;
    const bf16_t* A1 = nullptr; const bf16_t* A2 = nullptr; const bf16_t* A3 = nullptr; int t1 = 1 << 30, t2 = 1 << 30, t3 = 1 << 30;
    __host__ __device__ __forceinline__ const char* atile(int pm, size_t tstep) const {
        if (pm < t1) return (const char*)A + (size_t)pm * tstep;
        if (pm < t2) return (const char*)A1 + (size_t)(pm - t1) * tstep;
        if (pm < t3) return (const char*)A2 + (size_t)(pm - t2) * tstep;
        return (const char*)A3 + (size_t)(pm - t3) * tstep; }
};

struct StaticOrder {
    int nM, nN, nwg, G, c;
    __host__ __device__ void init(int M, int N, int G_, int c_) { nM = M / BM; nN = N / BM; nwg = nM * nN; G = G_; c = c_; }
    __host__ __device__ bool next(int i, Unit& u) const {
        const long L = (long)i * G + c; if (L >= nwg) return false;
        int wgid = (int)L; { const int q = nwg / NXCD, r = nwg % NXCD, xcd = wgid % NXCD, off = wgid / NXCD; wgid = (xcd < r ? xcd * (q + 1) : r * (q + 1) + (xcd - r) * q) + off; }
        const int nig = WGM * nN, gid = wgid / nig, fm = gid * WGM, gsz = (nM - fm) < WGM ? (nM - fm) : WGM;
        u.pm = fm + ((wgid % nig) % gsz); u.pn = (wgid % nig) / gsz; return true;
    }
    __device__ __forceinline__ void a_ready(const Unit&) const {}
    __device__ __forceinline__ void done(const Unit&) const {}
};

__device__ __forceinline__ unsigned cvt_pk_bf16(float lo, float hi) { unsigned r; asm volatile("v_cvt_pk_bf16_f32 %0, %1, %2" : "=v"(r) : "v"(lo), "v"(hi)); return r; }
struct EpiBf16 {
    static constexpr bool PERM = true, AFTER_DRAIN = false;
    bf16_t* O; int ldc; int split_cols; size_t split_stride;
    __device__ __forceinline__ void operator()(const f32x4 (&acc)[2][2][4][2], const Unit& u, int wr, int wc, int fr, int fq) const {
        const int row0 = u.pm * BM + wr * 64 + fr; int colt = u.pn * BM; bf16_t* base = O;
        if (split_cols) { const int t = colt / split_cols; base += (size_t)t * split_stride; colt -= t * split_cols; }
        const int col0 = colt + wc * 32 + 8 * fq;
#pragma unroll
        for (int ai = 0; ai < 2; ++ai)
#pragma unroll
            for (int m = 0; m < 4; ++m) { bf16_t* rowp = base + (size_t)(row0 + ai * HALF + m * 16) * ldc + col0;
#pragma unroll
                for (int bj = 0; bj < 2; ++bj) { const f32x4 v0 = acc[ai][bj][m][0], v1 = acc[ai][bj][m][1];
                    u32x4 w; w.x = cvt_pk_bf16(v0[0], v0[1]); w.y = cvt_pk_bf16(v0[2], v0[3]); w.z = cvt_pk_bf16(v1[0], v1[1]); w.w = cvt_pk_bf16(v1[2], v1[3]);
                    *(u32x4*)(rowp + bj * HALF) = w; } }
    }
};
template <int MODE> struct EpiGate {
    static constexpr bool PERM = true, AFTER_DRAIN = false;
    bf16_t* O; const bf16_t* G; const bf16_t* Add; int ldc, pad_;
    __device__ __forceinline__ void operator()(const f32x4 (&acc)[2][2][4][2], const Unit& u, int wr, int wc, int fr, int fq) const {
        const int row0 = u.pm * BM + wr * 64 + fr; const int col0 = u.pn * BM + wc * 32 + 8 * fq;
#pragma unroll
        for (int ai = 0; ai < 2; ++ai)
#pragma unroll
            for (int m = 0; m < 4; ++m) { const size_t ro = (size_t)(row0 + ai * HALF + m * 16) * ldc + col0;
#pragma unroll
                for (int bj = 0; bj < 2; ++bj) { const f32x4 v0 = acc[ai][bj][m][0], v1 = acc[ai][bj][m][1];
                    const u32x4 gw = *(const u32x4*)(G + ro + bj * HALF);
                    float r[8]; const float a[8] = {v0[0], v0[1], v0[2], v0[3], v1[0], v1[1], v1[2], v1[3]};
#pragma unroll
                    for (int i = 0; i < 4; ++i) { const unsigned w = gw[i]; const float g0 = __builtin_bit_cast(float, w << 16), g1 = __builtin_bit_cast(float, w & 0xffff0000u);
                        if (MODE == 0) { r[2 * i] = a[2 * i] * __builtin_amdgcn_rcpf(1.0f + __builtin_amdgcn_exp2f(-1.4426950408889634f * g0)); r[2 * i + 1] = a[2 * i + 1] * __builtin_amdgcn_rcpf(1.0f + __builtin_amdgcn_exp2f(-1.4426950408889634f * g1)); }
                        else { r[2 * i] = g0 * a[2 * i] * __builtin_amdgcn_rcpf(1.0f + __builtin_amdgcn_exp2f(-1.4426950408889634f * a[2 * i])); r[2 * i + 1] = g1 * a[2 * i + 1] * __builtin_amdgcn_rcpf(1.0f + __builtin_amdgcn_exp2f(-1.4426950408889634f * a[2 * i + 1])); } }
                    if (Add) { const u32x4 aw = *(const u32x4*)(Add + ro + bj * HALF);
#pragma unroll
                        for (int i = 0; i < 4; ++i) { const unsigned w = aw[i]; r[2 * i] += __builtin_bit_cast(float, w << 16); r[2 * i + 1] += __builtin_bit_cast(float, w & 0xffff0000u); } }
                    u32x4 w; w.x = cvt_pk_bf16(r[0], r[1]); w.y = cvt_pk_bf16(r[2], r[3]); w.z = cvt_pk_bf16(r[4], r[5]); w.w = cvt_pk_bf16(r[6], r[7]);
                    *(u32x4*)(O + ro + bj * HALF) = w; } }
    }
};
struct EpiF32 {
    static constexpr bool PERM = false, AFTER_DRAIN = false;
    float* O; int ldc, pad_;
    __device__ __forceinline__ void operator()(const f32x4 (&acc)[2][2][4][2], const Unit& u, int wr, int wc, int fr, int fq) const {
        const int row0 = u.pm * BM + wr * 64 + fr; const int col0 = u.pn * BM + wc * 32 + 4 * fq;
#pragma unroll
        for (int ai = 0; ai < 2; ++ai)
#pragma unroll
            for (int m = 0; m < 4; ++m) { float* rowp = O + (size_t)(row0 + ai * HALF + m * 16) * ldc + col0;
#pragma unroll
                for (int bj = 0; bj < 2; ++bj)
#pragma unroll
                    for (int n = 0; n < 2; ++n) *(f32x4*)(rowp + bj * HALF + n * 16) = acc[ai][bj][m][n]; }
    }
};
struct EpiP1b {
    static constexpr bool PERM = true, AFTER_DRAIN = false;
    const bf16_t* ob; bf16_t* gates; size_t gate_stride; bf16_t* ob_out;
    __device__ __forceinline__ void operator()(const f32x4 (&acc)[2][2][4][2], const Unit& u, int wr, int wc, int fr, int fq) const {
        if (u.pn < 4) { EpiGate<1> E{ob_out, ob, nullptr, 1024, 0}; E(acc, u, wr, wc, fr, fq); }
        else { Unit v = u; v.pn = (u.pn - 4) & 3; EpiBf16 E{gates + (size_t)((u.pn - 4) >> 2) * gate_stride, 1024, 0, 0}; E(acc, v, wr, wc, fr, fq); }
    }
};
struct EpiRmsRes {
    static constexpr bool PERM = false, AFTER_DRAIN = true;
    const float* xres; const float* w; float* out; float* xbuf; unsigned* cnt;
    __device__ __forceinline__ void fused(f32x4 (&acc)[2][2][4][2], const Unit& u, int wr, int wc, int fr, int fq, PG8_LAS unsigned char* lds, int wid, int lane) const {
        PG8_LAS float* P = (PG8_LAS float*)lds;
        PG8_LAS float* R = (PG8_LAS float*)(lds + 4096);
#pragma unroll
        for (int ai = 0; ai < 2; ++ai)
#pragma unroll
            for (int m = 0; m < 4; ++m) { float s = 0.f;
#pragma unroll
                for (int bj = 0; bj < 2; ++bj)
#pragma unroll
                    for (int n = 0; n < 2; ++n) { const f32x4 x = acc[ai][bj][m][n]; s += (x[0] * x[0] + x[1] * x[1]) + (x[2] * x[2] + x[3] * x[3]); }
                s += __shfl_xor(s, 16); s += __shfl_xor(s, 32);
                if (fq == 0) P[(ai * HALF + wr * 64 + m * 16 + fr) * 4 + wc] = s; }
        asm volatile("s_waitcnt lgkmcnt(0)" ::: "memory"); __builtin_amdgcn_s_barrier(); asm volatile("" ::: "memory");
        const int row = wid * 32 + (lane & 31);
        if (lane < 32) { const f32x4 p = *(const PG8_LAS f32x4*)(P + row * 4);
            __hip_atomic_store(xbuf + (size_t)(u.pm * BM + row) * 4 + u.pn, (p[0] + p[1]) + (p[2] + p[3]), __ATOMIC_RELAXED, __HIP_MEMORY_SCOPE_AGENT); }
        asm volatile("s_waitcnt vmcnt(0)" ::: "memory");
        if (lane == 0) __hip_atomic_fetch_add(cnt + 64 * u.pm, 1u, __ATOMIC_RELAXED, __HIP_MEMORY_SCOPE_AGENT);
        if (wid == 0) {
            for (unsigned sp = 0; (unsigned)__builtin_amdgcn_readfirstlane((int)__hip_atomic_load(cnt + 64 * u.pm, __ATOMIC_RELAXED, __HIP_MEMORY_SCOPE_AGENT)) < 32u && sp < (1u << 22); ++sp) __builtin_amdgcn_s_sleep(2);
        }
        asm volatile("s_waitcnt vmcnt(0) lgkmcnt(0)" ::: "memory"); __builtin_amdgcn_s_barrier(); asm volatile("" ::: "memory");
        if (lane < 32) { const float* sl = xbuf + (size_t)(u.pm * BM + row) * 4; float t = 0.f;
#pragma unroll
            for (int i = 0; i < 4; ++i) t += __hip_atomic_load(sl + i, __ATOMIC_RELAXED, __HIP_MEMORY_SCOPE_AGENT);
            R[row] = 1.0f / sqrtf(t * (1.0f / 1024.0f) + 1e-6f); }
        asm volatile("s_waitcnt vmcnt(0) lgkmcnt(0)" ::: "memory"); __builtin_amdgcn_s_barrier(); asm volatile("" ::: "memory");
        const int col0 = u.pn * BM + wc * 32 + 4 * fq;
#pragma unroll
        for (int ai = 0; ai < 2; ++ai)
#pragma unroll
            for (int m = 0; m < 4; ++m) { const int r = ai * HALF + wr * 64 + m * 16 + fr; const float rs = R[r]; const size_t off = (size_t)(u.pm * BM + r) * 1024 + col0;
#pragma unroll
                for (int bj = 0; bj < 2; ++bj)
#pragma unroll
                    for (int n = 0; n < 2; ++n) { const int c = bj * HALF + n * 16; const f32x4 xv = *(const f32x4*)(xres + off + c); const f32x4 wv = *(const f32x4*)(w + col0 + c);
                        *(f32x4*)(out + off + c) = xv + acc[ai][bj][m][n] * rs * wv; }
                if (m & 1) asm volatile("" ::: "memory"); }
    }
};
struct PairOrder {
    StaticOrder S; int nM, nN;
    __host__ __device__ void init(int M, int N, int G_, int c_) { S.init(M, N, G_, c_); nM = M / BM; nN = N / BM; }
    __host__ __device__ bool next(int i, Unit& u) const { if (i > 1) return false; Unit b; if (!S.next(0, b)) return false; u.pm = b.pm + i * nM; u.pn = b.pn + i * nN; return true; }
    __device__ __forceinline__ void a_ready(const Unit&) const {}
    __device__ __forceinline__ void done(const Unit&) const {}
};
struct EpiMerge {
    static constexpr bool PERM = true, AFTER_DRAIN = false;
    bf16_t* m1; bf16_t* merged; const bf16_t* gates; size_t gate_stride; int nM, nN;
    __device__ __forceinline__ void operator()(const f32x4 (&acc)[2][2][4][2], const Unit& u, int wr, int wc, int fr, int fq) const {
        if (u.pm < nM) { EpiGate<0> E{m1, gates, nullptr, 1024, 0}; E(acc, u, wr, wc, fr, fq); }
        else { Unit v; v.pm = u.pm - nM; v.pn = u.pn - nN; EpiGate<0> E{merged, gates + gate_stride, m1, 1024, 0}; E(acc, v, wr, wc, fr, fq); }
    }
};
template <class Epi, class Sched, bool ALIGN_EPI = false, bool SP2 = false>
__device__ __forceinline__ void gemm_phase(PG8_LAS unsigned char* lds, const Gemm g, const Sched& S, const Epi& E) {
    int tid_l = threadIdx.x; asm volatile("" : "+v"(tid_l));
    const int tid = tid_l, wid = __builtin_amdgcn_readfirstlane(tid >> 6), lane = tid & 63, wr = wid >> 2, wc = wid & 3, fr = lane & 15, fq = lane >> 4;
    const int K = g.K, nt = K / BK;
    unsigned voffA[2], voffB[2];
#pragma unroll
    for (int i = 0; i < 2; ++i) { int R, C; stage_rc(tid * 16 + i * 8192, R, C); const int Rb = Epi::PERM ? ((R & ~31) + perm32(R & 31)) : R;
        voffA[i] = (unsigned)(R * K + C) * 2u; voffB[i] = (unsigned)(Rb * K + C) * 2u; }
    const size_t kstep = (size_t)(BK * 2);
    const size_t hstep = (size_t)HALF * K * 2;
    const size_t tstep = 2 * hstep;
    const unsigned ldsw = (unsigned)wid * 1024u;
    const int aoff = lds_byte(wr * 64 + fr, fq * 8), boff = lds_byte(wc * 32 + fr, fq * 8);
#define PG8_SA(b, h) (((b) * 2 + (h)) * HTB)
#define PG8_SB(b, h) ((4 + (b) * 2 + (h)) * HTB)
#define PG8_STAGE(bufoff, gbase, voff) do { _Pragma("unroll") for (int _i = 0; _i < 2; ++_i) \
        __builtin_amdgcn_global_load_lds((const unsigned*)((const char*)(gbase) + (voff)[_i]), (PG8_LAS unsigned*)(lds + (bufoff) + ldsw + _i * 8192), 16, 0, 0); } while (0)
#define PG8_LDA(dst, b, h) do { _Pragma("unroll") for (int m = 0; m < 4; ++m) _Pragma("unroll") for (int k = 0; k < 2; ++k) dst[m][k] = *(const PG8_LAS bf16x8*)(lds + PG8_SA(b, h) + aoff + m * 2048 + k * 1024); } while (0)
#define PG8_LDB(dst, b, h) do { _Pragma("unroll") for (int n = 0; n < 2; ++n) _Pragma("unroll") for (int k = 0; k < 2; ++k) dst[n][k] = *(const PG8_LAS bf16x8*)(lds + PG8_SB(b, h) + boff + n * 2048 + k * 1024); } while (0)
#define PG8_MMA(ai, bj, At, Bt) do { __builtin_amdgcn_s_setprio(1); _Pragma("unroll") for (int m = 0; m < 4; ++m) _Pragma("unroll") for (int n = 0; n < 2; ++n) _Pragma("unroll") for (int k = 0; k < 2; ++k) \
        acc[ai][bj][m][n] = __builtin_amdgcn_mfma_f32_16x16x32_bf16(Bt[n][k], At[m][k], acc[ai][bj][m][n], 0, 0, 0); __builtin_amdgcn_s_setprio(0); } while (0)
#define PG8_WAIT_V(n) asm volatile("s_waitcnt vmcnt(" #n ")" ::: "memory")
#define PG8_WAIT_L(n) asm volatile("s_waitcnt lgkmcnt(" #n ")" ::: "memory")
#define PG8_BAR __builtin_amdgcn_s_barrier()
#define PG8_SCHED __builtin_amdgcn_sched_barrier(0)
    Unit cur, nxt; int ui = 0;
    if (!S.next(0, cur)) return;
    f32x4 acc[2][2][4][2];
#pragma unroll
    for (int a = 0; a < 2; ++a)
#pragma unroll
        for (int b = 0; b < 2; ++b)
#pragma unroll
            for (int m = 0; m < 4; ++m)
#pragma unroll
                for (int n = 0; n < 2; ++n) acc[a][b][m][n] = (f32x4){0.f, 0.f, 0.f, 0.f};
    bf16x8 At[4][2], B0[2][2], B1[2][2];
    const char* cA = g.atile(cur.pm, tstep); const char* cB = (const char*)g.Bt + (size_t)cur.pn * tstep;
    S.a_ready(cur);
    if constexpr (SP2) {
        PG8_STAGE(PG8_SB(0, 0), cB, voffB); PG8_STAGE(PG8_SB(0, 1), cB + hstep, voffB); PG8_STAGE(PG8_SA(0, 0), cA, voffA); PG8_STAGE(PG8_SA(0, 1), cA + hstep, voffA);
        if (wr == 1) PG8_BAR;
        PG8_WAIT_V(2); PG8_BAR;
        PG8_STAGE(PG8_SB(1, 0), cB + kstep, voffB); PG8_STAGE(PG8_SA(1, 0), cA + kstep, voffA); PG8_STAGE(PG8_SB(1, 1), cB + hstep + kstep, voffB);
        PG8_WAIT_V(6); PG8_BAR;
    } else {
        PG8_STAGE(PG8_SB(0, 0), cB, voffB); PG8_STAGE(PG8_SA(0, 0), cA, voffA); PG8_STAGE(PG8_SB(0, 1), cB + hstep, voffB); PG8_STAGE(PG8_SA(0, 1), cA + hstep, voffA);
        if (wr == 1) PG8_BAR;
        PG8_WAIT_V(4); PG8_BAR;
        PG8_STAGE(PG8_SB(1, 0), cB + kstep, voffB); PG8_STAGE(PG8_SA(1, 0), cA + kstep, voffA); PG8_STAGE(PG8_SB(1, 1), cB + hstep + kstep, voffB);
        PG8_WAIT_V(6); PG8_BAR;
    }
    for (;;) {
        const bool has_next = S.next(ui + 1, nxt);
        const char* nA = has_next ? g.atile(nxt.pm, tstep) : cA; const char* nB = has_next ? (const char*)g.Bt + (size_t)nxt.pn * tstep : cB;
        for (int t = 0; t < nt; t += 2) {
            const bool last = (t == nt - 2);
            const char* a1 = cA + (size_t)(t + 1) * kstep;
            const char* a2 = last ? nA : cA + (size_t)(t + 2) * kstep; const char* b2 = last ? nB : cB + (size_t)(t + 2) * kstep;
            const char* a3 = a2 + kstep; const char* b3 = b2 + kstep;
            if (last && has_next) S.a_ready(nxt);
            if constexpr (SP2) {
            PG8_LDB(B0, 0, 0); PG8_LDB(B1, 0, 1); PG8_SCHED; PG8_LDA(At, 0, 0); PG8_STAGE(PG8_SA(1, 1), a1 + hstep, voffA);
            PG8_WAIT_V(8); PG8_WAIT_L(0); PG8_BAR; PG8_MMA(0, 0, At, B0); PG8_MMA(0, 1, At, B1); PG8_BAR; PG8_SCHED;
            PG8_LDA(At, 0, 1); PG8_STAGE(PG8_SB(0, 0), b2, voffB); PG8_STAGE(PG8_SB(0, 1), b2 + hstep, voffB); PG8_STAGE(PG8_SA(0, 0), a2, voffA);
            PG8_WAIT_V(8); PG8_WAIT_L(0); PG8_BAR; PG8_MMA(1, 0, At, B0); PG8_MMA(1, 1, At, B1); PG8_BAR; PG8_SCHED;
            PG8_LDB(B0, 1, 0); PG8_LDB(B1, 1, 1); PG8_SCHED; PG8_LDA(At, 1, 0); PG8_STAGE(PG8_SA(0, 1), a2 + hstep, voffA);
            PG8_WAIT_V(8); PG8_WAIT_L(0); PG8_BAR; PG8_MMA(0, 0, At, B0); PG8_MMA(0, 1, At, B1); PG8_BAR; PG8_SCHED;
            PG8_LDA(At, 1, 1); PG8_STAGE(PG8_SB(1, 0), b3, voffB); PG8_STAGE(PG8_SB(1, 1), b3 + hstep, voffB); PG8_STAGE(PG8_SA(1, 0), a3, voffA);
            PG8_WAIT_V(8); PG8_WAIT_L(0); PG8_BAR; PG8_MMA(1, 0, At, B0); PG8_MMA(1, 1, At, B1); PG8_BAR; PG8_SCHED;
            } else {
            PG8_LDB(B0, 0, 0); PG8_SCHED; PG8_LDA(At, 0, 0); PG8_STAGE(PG8_SA(1, 1), a1 + hstep, voffA);
            PG8_WAIT_L(8); PG8_BAR; PG8_WAIT_L(0); PG8_MMA(0, 0, At, B0); PG8_BAR; PG8_SCHED;
            PG8_LDB(B1, 0, 1); PG8_STAGE(PG8_SB(0, 0), b2, voffB);
            PG8_BAR; PG8_WAIT_L(0); PG8_MMA(0, 1, At, B1); PG8_BAR;
            PG8_LDA(At, 0, 1); PG8_STAGE(PG8_SA(0, 0), a2, voffA);
            PG8_BAR; PG8_WAIT_L(0); PG8_MMA(1, 0, At, B0); PG8_BAR; PG8_SCHED;
            PG8_STAGE(PG8_SB(0, 1), b2 + hstep, voffB);
            PG8_WAIT_V(6); PG8_BAR; PG8_MMA(1, 1, At, B1); PG8_BAR;
            PG8_LDB(B0, 1, 0); PG8_SCHED; PG8_LDA(At, 1, 0); PG8_STAGE(PG8_SA(0, 1), a2 + hstep, voffA);
            PG8_WAIT_L(8); PG8_BAR; PG8_WAIT_L(0); PG8_MMA(0, 0, At, B0); PG8_BAR; PG8_SCHED;
            PG8_LDB(B1, 1, 1); PG8_STAGE(PG8_SB(1, 0), b3, voffB);
            PG8_BAR; PG8_WAIT_L(0); PG8_MMA(0, 1, At, B1); PG8_BAR;
            PG8_LDA(At, 1, 1); PG8_STAGE(PG8_SA(1, 0), a3, voffA);
            PG8_BAR; PG8_WAIT_L(0); PG8_MMA(1, 0, At, B0); PG8_BAR; PG8_SCHED;
            PG8_STAGE(PG8_SB(1, 1), b3 + hstep, voffB);
            PG8_WAIT_V(6); PG8_BAR; PG8_MMA(1, 1, At, B1); PG8_BAR;
            }
        }
        if constexpr (ALIGN_EPI) { if (wr == 0) PG8_BAR; }
        if constexpr (!Epi::AFTER_DRAIN) { E(acc, cur, wr, wc, fr, fq); S.done(cur); }
        if (!has_next) break;
#pragma unroll
        for (int a = 0; a < 2; ++a)
#pragma unroll
            for (int b = 0; b < 2; ++b)
#pragma unroll
                for (int m = 0; m < 4; ++m)
#pragma unroll
                    for (int n = 0; n < 2; ++n) acc[a][b][m][n] = (f32x4){0.f, 0.f, 0.f, 0.f};
        cur = nxt; cA = nA; cB = nB; ++ui;
        if constexpr (ALIGN_EPI) { if (wr == 1) PG8_BAR; }
    }
    PG8_WAIT_V(0);
    if constexpr (!ALIGN_EPI) { if (wr == 0) PG8_BAR; }
    PG8_BAR;
    if constexpr (Epi::AFTER_DRAIN) { E.fused(acc, cur, wr, wc, fr, fq, lds, wid, lane); S.done(cur); }
#undef PG8_SA
#undef PG8_SB
#undef PG8_STAGE
#undef PG8_LDA
#undef PG8_LDB
#undef PG8_MMA
#undef PG8_WAIT_V
#undef PG8_WAIT_L
#undef PG8_BAR
#undef PG8_SCHED
}
}
typedef __bf16 bf16x2_t __attribute__((ext_vector_type(2)));
typedef float f32x2_t __attribute__((ext_vector_type(2)));
typedef short bf16x8 __attribute__((ext_vector_type(8)));
typedef float f32x16 __attribute__((ext_vector_type(16)));
#define MFMA32(a, b, c) __builtin_amdgcn_mfma_f32_32x32x16_bf16((a), (b), (c), 0, 0, 0)
__device__ __forceinline__ unsigned pkbf(float a, float b) { bf16x2_t v = __builtin_convertvector((f32x2_t){a, b}, bf16x2_t); return __builtin_bit_cast(unsigned, v); }
__device__ __forceinline__ bf16x8 pack8(const f32x16& x, int s) { v4u p; p.x = pkbf(x[8 * s], x[8 * s + 1]); p.y = pkbf(x[8 * s + 2], x[8 * s + 3]); p.z = pkbf(x[8 * s + 4], x[8 * s + 5]); p.w = pkbf(x[8 * s + 6], x[8 * s + 7]); return __builtin_bit_cast(bf16x8, p); }
__device__ __forceinline__ f32x16 zero16() { f32x16 z;
#pragma unroll
    for (int i = 0; i < 16; ++i) z[i] = 0.f; return z; }
constexpr int CHUNK = 64, NCH = SEQ / CHUNK;
constexpr float QSCALE = 0.08838834764831845f;
__device__ __forceinline__ void glds_blocks(LAS unsigned char* dst, const unsigned char* src, int nblk, int wv, int nw, int lane) {
    for (int b = wv; b < nblk; b += nw)
        __builtin_amdgcn_global_load_lds((const unsigned*)(src + (size_t)b * 1024 + lane * 16), (LAS unsigned*)(dst + b * 1024), 16, 0, 0);
}
__device__ __forceinline__ bf16x8 lds_frag(const LAS unsigned char* base, int blk, int lane) { return *(const LAS bf16x8*)(base + blk * 1024 + lane * 16); }

namespace gdn {
constexpr int B_KA = 0, B_QA = 16384, B_SC = 32768, B_KT = 34816, B_TBF = 51200, B_AF = 59392, B_TBB = 67584, B_AB = 75776, B_VT = 83968, BLOB = 100352;
constexpr int XBLK = 34, YBLK = 32;
}

__device__ __forceinline__ float row16_sum(float v) {
    v += __builtin_bit_cast(float, __builtin_amdgcn_mov_dpp(__builtin_bit_cast(int, v), 0xB1, 0xF, 0xF, true));
    v += __builtin_bit_cast(float, __builtin_amdgcn_mov_dpp(__builtin_bit_cast(int, v), 0x4E, 0xF, 0xF, true));
    v += __builtin_bit_cast(float, __builtin_amdgcn_mov_dpp(__builtin_bit_cast(int, v), 0x141, 0xF, 0xF, true));
    v += __builtin_bit_cast(float, __builtin_amdgcn_mov_dpp(__builtin_bit_cast(int, v), 0x140, 0xF, 0xF, true));
    return v;
}
__device__ __forceinline__ float quad_sum(float v) {
    v += __builtin_bit_cast(float, __builtin_amdgcn_mov_dpp(__builtin_bit_cast(int, v), 0xB1, 0xF, 0xF, true));
    v += __builtin_bit_cast(float, __builtin_amdgcn_mov_dpp(__builtin_bit_cast(int, v), 0x4E, 0xF, 0xF, true));
    return v;
}
struct GdnPrepArgs {
    const bf16 *pq, *pk, *pv;
    const float* small;
    const float* conv_w;
    const float *a_log_f, *a_log_b, *dtb_f, *dtb_b;
    unsigned char* blob;
    int nseq, pad_;
};
namespace gdn {
constexpr int L_PRE = 0, L_QN = 52224, L_KN = L_QN + 17408, L_SC = L_KN + 17408, L_LPF = L_SC + 1024, L_LPB = L_LPF + 16384, L_AF = L_LPB + 16384, L_AB = L_AF + 9216, L_TBF = L_AB + 9216, L_TBB = L_TBF + 9216, L_END = L_TBB + 9216;
static_assert(L_END <= 160 * 1024 - 256, "gdn prep LDS");
constexpr int QS_ = 272, AS_ = 144;

__device__ __forceinline__ v4u frag_rm_perm(const LAS unsigned char* img, int st, int rt, int ks, int lane) {
    const int r = lane & 31, hh = lane >> 5; const LAS unsigned char* p = img + (32 * rt + r) * st + (16 * ks + 4 * hh) * 2;
    const v2u lo = *(const LAS v2u*)p, hi = *(const LAS v2u*)(p + 16);
    return (v4u){lo.x, lo.y, hi.x, hi.y};
}
__device__ __forceinline__ v4u frag_tr_perm(const LAS unsigned char* img, int st, int rt, int ks, int lane) {
    const int r = lane & 31, hh = lane >> 5; const LAS unsigned char* p = img + (16 * ks + 4 * hh) * st + (32 * rt + r) * 2;
    unsigned short e[8];
#pragma unroll
    for (int j = 0; j < 8; ++j) e[j] = *(const LAS unsigned short*)(p + (8 * (j >> 2) + (j & 3)) * st);
    return (v4u){(unsigned)e[0] | ((unsigned)e[1] << 16), (unsigned)e[2] | ((unsigned)e[3] << 16), (unsigned)e[4] | ((unsigned)e[5] << 16), (unsigned)e[6] | ((unsigned)e[7] << 16)};
}
__device__ __forceinline__ v4u frag16_rm(const LAS unsigned char* img, int st, int rt, int ks, int lane) {
    const int r = lane & 15, q = lane >> 4; const LAS unsigned char* p = img + (16 * rt + r) * st + (32 * ks + 4 * q) * 2;
    const v2u lo = *(const LAS v2u*)p, hi = *(const LAS v2u*)(p + 32);
    return (v4u){lo.x, lo.y, hi.x, hi.y};
}
__device__ __forceinline__ v4u frag16_tr(const LAS unsigned char* img, int st, int rt, int ks, int lane) {
    const int r = lane & 15, q = lane >> 4; const LAS unsigned char* p = img + (32 * ks + 4 * q) * st + (16 * rt + r) * 2;
    unsigned short e[8];
#pragma unroll
    for (int j = 0; j < 8; ++j) e[j] = *(const LAS unsigned short*)(p + (16 * (j >> 2) + (j & 3)) * st);
    return (v4u){(unsigned)e[0] | ((unsigned)e[1] << 16), (unsigned)e[2] | ((unsigned)e[3] << 16), (unsigned)e[4] | ((unsigned)e[5] << 16), (unsigned)e[6] | ((unsigned)e[7] << 16)};
}
}

#define LBAR() do { asm volatile("s_waitcnt lgkmcnt(0)" ::: "memory"); __builtin_amdgcn_s_barrier(); asm volatile("" ::: "memory"); } while (0)
__device__ __forceinline__ void gdn_prep_issue(LAS unsigned char* lds, const GdnPrepArgs& A, int unit, int w, int lane, const unsigned char* zero_page) {
    using namespace gdn;
    const int n = unit % NCH, h = (unit / NCH) % 8, sq = unit / (NCH * 8); const size_t row0 = (size_t)sq * SEQ; const int t0 = n * CHUNK;
    for (int q4 = w; q4 < 51; q4 += 8) {
        const int seg = q4 * 4 + (lane >> 4), r = seg / 3, m = seg % 3, tl = t0 - 2 + r;
        const bf16* pmat = A.pq + (size_t)m * (size_t)(A.pk - A.pq);
        const unsigned char* src = (tl >= 0 && tl < SEQ) ? (const unsigned char*)(pmat + (row0 + tl) * 1024 + h * 128) : zero_page;
        __builtin_amdgcn_global_load_lds((const unsigned*)(src + (lane & 15) * 16), (LAS unsigned*)(lds + L_PRE + q4 * 1024), 16, 0, 0);
    }
}
__device__ __forceinline__ f32x4 gdn_prep_scal(const GdnPrepArgs& A, int unit, int lane) {
    const int n = unit % NCH, h = (unit / NCH) % 8, sq = unit / (NCH * 8);
    const float* sm = A.small + ((size_t)sq * SEQ + n * CHUNK + lane) * 64;
    return (f32x4){sm[h], sm[8 + h], sm[16 + h], sm[24 + h]};
}
__device__ __forceinline__ void gdn_prep_phase(LAS unsigned char* lds, const GdnPrepArgs& A, int bid, int G, const unsigned char* zero_page) {
    using namespace gdn;
    int tid_l = threadIdx.x; asm volatile("" : "+v"(tid_l));
    const int tid = tid_l, lane = tid & 63, w = __builtin_amdgcn_readfirstlane(tid >> 6);
    const int nunits = A.nseq * 8 * NCH; const int pflg = A.pad_;
    int unit = bid;
    f32x4 smn = (f32x4){0.f, 0.f, 0.f, 0.f};
    if (unit < nunits) { gdn_prep_issue(lds, A, unit, w, lane, zero_page); if (w == 0) smn = gdn_prep_scal(A, unit, lane); }
  for (; unit < nunits; unit += G) {
    const int h = (unit / NCH) % 8;
    unsigned char* blob = A.blob + (size_t)unit * BLOB;
    if (w == 0) {
        const float xf = smn.x + A.dtb_f[h], xb = smn.y + A.dtb_b[h];
        const float spf = xf > 20.f ? xf : 0.6931471805599453f * __builtin_amdgcn_logf(1.0f + __builtin_amdgcn_exp2f(1.4426950408889634f * xf));
        const float spb = xb > 20.f ? xb : 0.6931471805599453f * __builtin_amdgcn_logf(1.0f + __builtin_amdgcn_exp2f(1.4426950408889634f * xb));
        const float gf = -__expf(A.a_log_f[h]) * spf, gb = -__expf(A.a_log_b[h]) * spb;
        float pf = gf, pb = gb;
#define SCAN_STEP(ctrl, rmask) do { pf += __builtin_bit_cast(float, __builtin_amdgcn_update_dpp(0, __builtin_bit_cast(int, pf), ctrl, rmask, 0xf, false)); \
                                     pb += __builtin_bit_cast(float, __builtin_amdgcn_update_dpp(0, __builtin_bit_cast(int, pb), ctrl, rmask, 0xf, false)); } while (0)
        SCAN_STEP(0x111, 0xf); SCAN_STEP(0x112, 0xf); SCAN_STEP(0x114, 0xf); SCAN_STEP(0x118, 0xf); SCAN_STEP(0x142, 0xa); SCAN_STEP(0x143, 0xc);
#undef SCAN_STEP
        const float totb = __builtin_bit_cast(float, __builtin_amdgcn_readlane(__builtin_bit_cast(int, pb), 63));
        const float gcf = pf, gcb = totb - pb + gb;
        LAS float* sc = (LAS float*)(lds + L_SC);
        sc[lane] = gcf; sc[64 + lane] = gcb; sc[128 + lane] = sigmoidf_(smn.z); sc[192 + lane] = sigmoidf_(smn.w);
        float* gsc = (float*)(blob + B_SC); if (pflg & 8) gsc = (float*)(lds + L_LPF);
        const float glf = __builtin_bit_cast(float, __builtin_amdgcn_readlane(__builtin_bit_cast(int, pf), 63)), glb = totb;
        gsc[lane] = gcf; gsc[64 + lane] = gcb; gsc[128 + lane] = __expf(gcf); gsc[192 + lane] = __expf(gcb); gsc[256 + lane] = __expf(glf - gcf); gsc[320 + lane] = __expf(glb - gcb);
        if (lane < 2) gsc[384 + lane] = __expf(lane ? glb : glf);
    }
    __syncthreads();
    if (!(pflg & 32)) {
        const int p0 = 8 * w;
#pragma unroll
        for (int m = 0; m < 3; ++m) {
            float wc[5][2];
#pragma unroll
            for (int tau = 0; tau < 5; ++tau) { const f32x2_t t2 = *(const f32x2_t*)(A.conv_w + tau * 3072 + m * 1024 + h * 128 + 2 * lane); wc[tau][0] = t2.x; wc[tau][1] = t2.y; }
            float in[12][2];
#pragma unroll
            for (int i = 0; i < 12; ++i) { const unsigned u = *(const LAS unsigned*)(lds + L_PRE + ((p0 + i) * 3 + m) * 256 + lane * 4); in[i][0] = bflo(u); in[i][1] = bfhi(u); }
            float y[8][2];
#pragma unroll
            for (int pp = 0; pp < 8; ++pp)
#pragma unroll
                for (int c = 0; c < 2; ++c) { float s = 0.f;
#pragma unroll
                    for (int tau = 0; tau < 5; ++tau) s += wc[tau][c] * in[pp + tau][c];
                    y[pp][c] = s * __builtin_amdgcn_rcpf(1.0f + __builtin_amdgcn_exp2f(-1.4426950408889634f * s)); }
            if (m < 2) {
#pragma unroll
                for (int pp = 0; pp < 8; ++pp) { float ss = row16_sum(y[pp][0] * y[pp][0] + y[pp][1] * y[pp][1]); ss += __shfl_xor(ss, 16); ss += __shfl_xor(ss, 32); const float rn = __builtin_amdgcn_rsqf(ss + EPS);
                    *(LAS unsigned*)(lds + (m == 0 ? L_QN : L_KN) + (p0 + pp) * QS_ + lane * 4) = pkbf(y[pp][0] * rn, y[pp][1] * rn); }
            } else {
#pragma unroll
                for (int c = 0; c < 2; ++c) { v4u o; o.x = pkbf(y[0][c], y[1][c]); o.y = pkbf(y[2][c], y[3][c]); o.z = pkbf(y[4][c], y[5][c]); o.w = pkbf(y[6][c], y[7][c]);
                    if (!(pflg & 8)) *(v4u*)(blob + B_VT + (2 * lane + c) * 128 + p0 * 2) = o; }
            }
        }
    }
    __syncthreads();
    { const int un = unit + G; if (un < nunits) { gdn_prep_issue(lds, A, un, w, lane, zero_page); if (w == 0) smn = gdn_prep_scal(A, un, lane); } }
    {
        const int which = w >> 2, rt = (w >> 1) & 1, ct = w & 1, r = lane & 31, hh = lane >> 5;
        const LAS unsigned char* ia = lds + (which ? L_QN : L_KN) + (32 * rt + r) * QS_ + 16 * hh;
        const LAS unsigned char* ib = lds + L_KN + (32 * ct + r) * QS_ + 16 * hh;
        f32x16 acc = zero16();
#pragma unroll
        for (int ks = 0; ks < 8; ++ks) acc = MFMA32(*(const LAS bf16x8*)(ia + 32 * ks), *(const LAS bf16x8*)(ib + 32 * ks), acc);
        const LAS float* sc = (const LAS float*)(lds + L_SC);
        const int j = 32 * ct + r; const float gfj = sc[j], gbj = sc[64 + j];
#pragma unroll
        for (int reg = 0; reg < 16; ++reg) {
            const int i = 32 * rt + (reg & 3) + 8 * (reg >> 2) + 4 * hh; const float val = acc[reg];
            const float ef = __expf(sc[i] - gfj), eb = __expf(sc[64 + i] - gbj);
            if (which == 0) {
                const float lf = (i > j) ? sc[128 + i] * val * ef : 0.f, lb = (i < j) ? sc[192 + i] * val * eb : 0.f;
                ((LAS float*)(lds + L_LPF))[i * 64 + (j & 3) * 16 + (j >> 2)] = lf;
                const int i2 = 63 - i, j2 = 63 - j;
                ((LAS float*)(lds + L_LPB))[i2 * 64 + (j2 & 3) * 16 + (j2 >> 2)] = lb;
            } else {
                const float af = (i >= j) ? QSCALE * val * ef : 0.f, ab = (i <= j) ? QSCALE * val * eb : 0.f;
                *(LAS unsigned short*)(lds + L_AF + i * AS_ + j * 2) = (unsigned short)(pkbf(af, 0.f) & 0xffffu);
                *(LAS unsigned short*)(lds + L_AB + i * AS_ + j * 2) = (unsigned short)(pkbf(ab, 0.f) & 0xffffu);
            }
        }
    }
    LBAR();
    if (!(pflg & 16)) {
        const int dir = w >> 2, li = (w & 3) * 64 + lane, j = li >> 2, q = li & 3;
        const LAS float* LP = (const LAS float*)(lds + (dir ? L_LPB : L_LPF)) + q * 16;
        float t[16];
#pragma unroll
        for (int a = 0; a < 16; ++a) t[a] = 0.f;
        f32x4 lq[3][4];
#define SOLVE_LD(i_) do { _Pragma("unroll") for (int a4 = 0; a4 < ((i_) + 15) / 16; ++a4) lq[(i_) % 3][a4] = *(const LAS f32x4*)(LP + (i_) * 64 + 4 * a4); } while (0)
        SOLVE_LD(0); SOLVE_LD(1);
#pragma unroll
        for (int i = 0; i < 64; ++i) {
            if (i + 2 < 48) SOLVE_LD(i + 2);
            else if (i + 1 >= 48 && i + 1 < 64) SOLVE_LD(i + 1);
            float p0 = 0.f, p1 = 0.f;
#pragma unroll
            for (int a4 = 0; a4 < (i + 15) / 16; ++a4) { const f32x4 lv = lq[i % 3][a4];
                p0 = __builtin_fmaf(lv.x, t[4 * a4], p0); p1 = __builtin_fmaf(lv.y, t[4 * a4 + 1], p1); p0 = __builtin_fmaf(lv.z, t[4 * a4 + 2], p0); p1 = __builtin_fmaf(lv.w, t[4 * a4 + 3], p1); }
            float p = quad_sum(p0 + p1);
            const float ti = (i == j ? 1.f : 0.f) - p;
            if (q == (i & 3)) t[i >> 2] = ti;
            __builtin_amdgcn_sched_barrier(0);
        }
#undef SOLVE_LD
        const LAS float* sc = (const LAS float*)(lds + L_SC);
        if (dir == 0) { const float bj = sc[128 + j];
#pragma unroll
            for (int a = 0; a < 16; ++a) *(LAS unsigned short*)(lds + L_TBF + (4 * a + q) * AS_ + j * 2) = (unsigned short)(pkbf(t[a] * bj, 0.f) & 0xffffu);
        } else { const int jo = 63 - j; const float bj = sc[192 + jo];
#pragma unroll
            for (int a = 0; a < 16; ++a) *(LAS unsigned short*)(lds + L_TBB + (63 - (4 * a + q)) * AS_ + jo * 2) = (unsigned short)(pkbf(t[a] * bj, 0.f) & 0xffffu);
        }
    }
    LBAR();
    if (!(pflg & 64)) for (int blk = w; blk < 80; blk += 8) {
        v4u f; int off;
        if (blk < 16)      { f = frag16_rm(lds + L_KN, QS_, blk >> 2, blk & 3, lane); off = B_KA + blk * 1024; }
        else if (blk < 32) { const int b = blk - 16; f = frag16_rm(lds + L_QN, QS_, b >> 2, b & 3, lane); off = B_QA + b * 1024; }
        else if (blk < 48) { const int b = blk - 32; f = frag16_tr(lds + L_KN, QS_, b >> 1, b & 1, lane); off = B_KT + b * 1024; }
        else { const int b = blk - 48, wh = b >> 3, bb = b & 7; const int lo = wh == 0 ? L_TBF : wh == 1 ? L_AF : wh == 2 ? L_TBB : L_AB;
               f = frag16_rm(lds + lo, AS_, bb >> 1, bb & 1, lane); off = B_TBF + b * 1024; }
        if (!(pflg & 8)) *(v4u*)(blob + off + lane * 16) = f; else asm volatile("" :: "v"(f));
    }
    LBAR();
  }
}
struct GdnChainArgs {
    const unsigned char* blob;
    unsigned char* stg;
    unsigned* flag;
    int nseq, flags;
};
namespace gdn { constexpr int C_Y = XBLK * 1024, C_BUF = C_Y + YBLK * 1024, C_END = 2 * C_BUF; }
#define CHAIN_SPIN_CAP (1u << 22)
#define MFMA16(a, b, c) __builtin_amdgcn_mfma_f32_16x16x32_bf16((a), (b), (c), 0, 0, 0)
__device__ __forceinline__ bf16x8 pack16(const f32x4& a, const f32x4& b) { v4u p; p.x = pkbf(a.x, a.y); p.y = pkbf(a.z, a.w); p.z = pkbf(b.x, b.y); p.w = pkbf(b.z, b.w); return __builtin_bit_cast(bf16x8, p); }

__device__ __forceinline__ void gdn_chain_unit(LAS unsigned char* lds, const GdnChainArgs& A, int item) {
    using namespace gdn;
    int tid_l = threadIdx.x; asm volatile("" : "+v"(tid_l));
    const int tid = tid_l, lane = tid & 63, w = __builtin_amdgcn_readfirstlane(tid >> 6);
    const int r = lane & 15, q = lane >> 4;
    const int c = item & 1, h = (item >> 1) & 7, sq = item >> 4; const int flags = A.flags;
    const size_t unit0 = (size_t)(sq * 8 + h) * NCH;
    const f32x4 z4 = (f32x4){0.f, 0.f, 0.f, 0.f};
    f32x4 S[8];
#pragma unroll
    for (int t = 0; t < 8; ++t) S[t] = z4;
    v2u vnext[4];
    unsigned long long pwn[4]; bool have = false; unsigned fnext = 0u;
#define GDN_ISSUE(s_, buf_) do { const int n_ = c ? NCH - 1 - (s_) : (s_); const unsigned char* bl_ = A.blob + (unit0 + n_) * BLOB; LAS unsigned char* d_ = lds + (buf_) * C_BUF; \
        { const unsigned char* vp_ = bl_ + B_VT + (16 * w + r) * 128 + 8 * q; _Pragma("unroll") for (int i = 0; i < 4; ++i) vnext[i] = *(const v2u*)(vp_ + 32 * i); } \
        if (!(flags & 4)) { glds_blocks(d_, bl_, XBLK, w, 8, lane); \
            if (c == 0) glds_blocks(d_ + C_Y, bl_ + B_KT, YBLK, w, 8, lane); \
            else { glds_blocks(d_ + C_Y, bl_ + B_KT, 16, w, 8, lane); glds_blocks(d_ + C_Y + 16384, bl_ + B_TBB, 16, w, 8, lane); } } } while (0)
    GDN_ISSUE(0, 0);
    __syncthreads();
    for (int s = 0; s < NCH; ++s) {
        const int n = c ? NCH - 1 - s : s;
        v2u vcur[4];
#pragma unroll
        for (int i = 0; i < 4; ++i) vcur[i] = vnext[i];
        unsigned long long* sp = (unsigned long long*)(A.stg + (unit0 + n) * 16384 + w * 2048) + lane;
        unsigned* fl = A.flag + (unit0 + n) * 8 + w;
        unsigned long long pw[4];
        if (s >= NCH / 2 && !(flags & 1)) {
            if (have) {
#pragma unroll
                for (int i = 0; i < 4; ++i) pw[i] = pwn[i];
            } else {
                for (unsigned sp_ = 0; __builtin_amdgcn_readfirstlane((int)__hip_atomic_load(fl, __ATOMIC_RELAXED, __HIP_MEMORY_SCOPE_AGENT)) == 0 && sp_ < CHAIN_SPIN_CAP; ++sp_) __builtin_amdgcn_s_sleep(2);
#pragma unroll
                for (int i = 0; i < 4; ++i) pw[i] = __hip_atomic_load(sp + i * 64, __ATOMIC_RELAXED, __HIP_MEMORY_SCOPE_AGENT);
            }
        }
        have = false;
        if (s + 1 >= NCH / 2 && s + 1 < NCH && !(flags & 1) && __builtin_amdgcn_readfirstlane((int)fnext) != 0) {
            const int n1 = c ? NCH - 2 - s : s + 1; const unsigned long long* sp1 = (const unsigned long long*)(A.stg + (unit0 + n1) * 16384 + w * 2048) + lane;
#pragma unroll
            for (int i = 0; i < 4; ++i) pwn[i] = __hip_atomic_load(sp1 + i * 64, __ATOMIC_RELAXED, __HIP_MEMORY_SCOPE_AGENT);
            have = true;
        }
        if (s + 2 >= NCH / 2 && s + 2 < NCH && !(flags & 1)) { const int n2 = c ? NCH - 3 - s : s + 2; fnext = __hip_atomic_load(A.flag + (unit0 + n2) * 8 + w, __ATOMIC_RELAXED, __HIP_MEMORY_SCOPE_AGENT); }
        if (s + 1 < NCH) GDN_ISSUE(s + 1, (s + 1) & 1);
        const LAS unsigned char* X = lds + (s & 1) * C_BUF; const LAS unsigned char* Y = X + C_Y; const LAS unsigned char* YT = Y + 16384;
        const LAS float* sc = (const LAS float*)(X + B_SC);
        bf16x8 sb[4];
#pragma unroll
        for (int k = 0; k < 4; ++k) sb[k] = pack16(S[2 * k], S[2 * k + 1]);
        f32x4 KS[4], QS[4];
#pragma unroll
        for (int rt = 0; rt < 4; ++rt) { KS[rt] = z4; QS[rt] = z4; }
        {
            constexpr int R = 8; bf16x8 ring[R];
#define G1_LD(i_) lds_frag(X + (((i_) & 1) ? B_QA : B_KA), ((i_) >> 3) * 4 + (((i_) >> 1) & 3), lane)
#pragma unroll
            for (int i = 0; i < R; ++i) ring[i] = G1_LD(i);
#pragma unroll
            for (int i = 0; i < 32; ++i) { const int rt = i >> 3, ks = (i >> 1) & 3;
                if (i & 1) QS[rt] = MFMA16(ring[i % R], sb[ks], QS[rt]); else KS[rt] = MFMA16(ring[i % R], sb[ks], KS[rt]);
                if (i + R < 32) ring[i % R] = G1_LD(i + R);
                __builtin_amdgcn_sched_barrier(0); }
#undef G1_LD
        }
#pragma unroll
        for (int rt = 0; rt < 4; ++rt) { const v2u vv = vcur[rt]; const f32x4 ev = *(const LAS f32x4*)(sc + 128 + c * 64 + 16 * rt + 4 * q);
            KS[rt].x = bflo(vv.x) - ev.x * KS[rt].x; KS[rt].y = bfhi(vv.x) - ev.y * KS[rt].y; KS[rt].z = bflo(vv.y) - ev.z * KS[rt].z; KS[rt].w = bfhi(vv.y) - ev.w * KS[rt].w; }
        bf16x8 rb[2] = {pack16(KS[0], KS[1]), pack16(KS[2], KS[3])};
        f32x4 vn[4];
#pragma unroll
        for (int rt = 0; rt < 4; ++rt) vn[rt] = z4;
        {   constexpr int R = 8; bf16x8 ring[R];
#pragma unroll
            for (int i = 0; i < R; ++i) ring[i] = lds_frag(YT, i, lane);
#pragma unroll
            for (int i = 0; i < 8; ++i) { vn[i >> 1] = MFMA16(ring[i], rb[i & 1], vn[i >> 1]); __builtin_amdgcn_sched_barrier(0); }
        }
        bf16x8 vb[2] = {pack16(vn[0], vn[1]), pack16(vn[2], vn[3])};
        f32x4 (&o)[4] = QS;
#pragma unroll
        for (int rt = 0; rt < 4; ++rt) { const f32x4 ev = *(const LAS f32x4*)(sc + 128 + c * 64 + 16 * rt + 4 * q);
            o[rt].x *= QSCALE * ev.x; o[rt].y *= QSCALE * ev.y; o[rt].z *= QSCALE * ev.z; o[rt].w *= QSCALE * ev.w; }
        {   constexpr int R = 8; bf16x8 ring[R];
#pragma unroll
            for (int i = 0; i < R; ++i) ring[i] = lds_frag(YT + 8192, i, lane);
#pragma unroll
            for (int i = 0; i < 8; ++i) { o[i >> 1] = MFMA16(ring[i], vb[i & 1], o[i >> 1]); __builtin_amdgcn_sched_barrier(0); }
        }
        if (!(flags & 1)) {
            if (s < NCH / 2) {
#pragma unroll
                for (int rt = 0; rt < 4; ++rt) __hip_atomic_store(sp + rt * 64, (unsigned long long)pkbf(o[rt].x, o[rt].y) | ((unsigned long long)pkbf(o[rt].z, o[rt].w) << 32), __ATOMIC_RELAXED, __HIP_MEMORY_SCOPE_AGENT);
            } else {
#pragma unroll
                for (int rt = 0; rt < 4; ++rt) { const unsigned plo = (unsigned)pw[rt], phi = (unsigned)(pw[rt] >> 32);
                    __hip_atomic_store(sp + rt * 64, (unsigned long long)pkbf(o[rt].x + bflo(plo), o[rt].y + bfhi(plo)) | ((unsigned long long)pkbf(o[rt].z + bflo(phi), o[rt].w + bfhi(phi)) << 32), __ATOMIC_RELAXED, __HIP_MEMORY_SCOPE_AGENT); }
            }
        }
#pragma unroll
        for (int rt = 0; rt < 4; ++rt) { const f32x4 ev = *(const LAS f32x4*)(sc + 256 + c * 64 + 16 * rt + 4 * q);
            vn[rt].x *= ev.x; vn[rt].y *= ev.y; vn[rt].z *= ev.z; vn[rt].w *= ev.w; }
        vb[0] = pack16(vn[0], vn[1]); vb[1] = pack16(vn[2], vn[3]);
        const float egl = sc[384 + c];
#pragma unroll
        for (int t = 0; t < 8; ++t) { S[t].x *= egl; S[t].y *= egl; S[t].z *= egl; S[t].w *= egl; }
        {   constexpr int R = 8; bf16x8 ring[R];
#pragma unroll
            for (int i = 0; i < R; ++i) ring[i] = lds_frag(Y, i, lane);
#pragma unroll
            for (int i = 0; i < 16; ++i) { S[i >> 1] = MFMA16(ring[i % R], vb[i & 1], S[i >> 1]); if (i + R < 16) ring[i % R] = lds_frag(Y, i + R, lane); __builtin_amdgcn_sched_barrier(0); }
        }
        if (!(flags & 1)) { asm volatile("s_waitcnt vmcnt(0)" ::: "memory"); if (lane == 0) __hip_atomic_store(fl, s < NCH / 2 ? 1u : 2u, __ATOMIC_RELAXED, __HIP_MEMORY_SCOPE_AGENT); }
        __syncthreads();
    }
#undef GDN_ISSUE
}
namespace gla {
constexpr int B_QGF = 0, B_QGB = 16384, B_SC = 32768, B_KDTF = 33792, B_KDTB = 50176, BLOBA = 66560;
constexpr int B_VB = 0, B_INTRA = 32768, BLOBB = 65536;
constexpr int L_R = 0, L_QGF = 8192, L_KGF = L_QGF + 17408, L_KDF = L_KGF + 17408, L_QGB = L_KDF + 17408, L_KGB = L_QGB + 17408, L_KDB = L_KGB + 17408, L_V = L_KDB + 17408, L_TOT = L_V + 33792, L_AS = L_TOT + 4096, L_END = L_AS + 9216;
static_assert(L_END <= 160 * 1024 - 256, "gla prep LDS");
constexpr int QS_ = 272, VS_ = 528, AS_ = 144;
constexpr int C_X = 0, C_Y = 17408, C_CHAIN = 66560, C_EG = 2 * C_CHAIN, C_END = C_EG + 1024;
__device__ __forceinline__ v4u frag_tr_nat(const LAS unsigned char* img, int st, int colbase, int ks, int lane) {
    const int r = lane & 31, hh = lane >> 5; const LAS unsigned char* p = img + (16 * ks + 8 * hh) * st + (colbase + r) * 2;
    unsigned short e[8];
#pragma unroll
    for (int j = 0; j < 8; ++j) e[j] = *(const LAS unsigned short*)(p + j * st);
    return (v4u){(unsigned)e[0] | ((unsigned)e[1] << 16), (unsigned)e[2] | ((unsigned)e[3] << 16), (unsigned)e[4] | ((unsigned)e[5] << 16), (unsigned)e[6] | ((unsigned)e[7] << 16)};
}
__device__ __forceinline__ float logsig2(float x) { const float xc = fminf(fmaxf(x, -60.f), 60.f); return -__builtin_amdgcn_logf(1.0f + __builtin_amdgcn_exp2f(-1.4426950408889634f * xc)); }
}

struct GlaPrepArgs {
    const bf16* qk;
    const bf16* vb;
    const float* small;
    const float *w2f, *b2f, *w2b, *b2b;
    unsigned char* blobA;
    unsigned char* blobB;
    int nseq, pad_;
};

__device__ __forceinline__ void gla_prep_phase(LAS unsigned char* lds, const GlaPrepArgs& A, int bid, int G) {
    using namespace gla;
    int tid_l = threadIdx.x; asm volatile("" : "+v"(tid_l));
    const int tid = tid_l, lane = tid & 63, w = __builtin_amdgcn_readfirstlane(tid >> 6);
    const int nunits = A.nseq * 4 * NCH;
    f32x4 pr; v4u pv[4], pq[2], pk[2];
#define GLA_PREFETCH(u_) do { const int n_ = (u_) % NCH, h_ = ((u_) / NCH) % 4, sq_ = (u_) / (NCH * 4); const size_t r_ = (size_t)sq_ * SEQ + n_ * CHUNK; \
        pr = *(const f32x4*)(A.small + (r_ + (tid >> 3)) * 64 + 32 + (tid & 7) * 4); \
        _Pragma("unroll") for (int i = 0; i < 4; ++i) { const int id = i * 512 + tid; pv[i] = *(const v4u*)(A.vb + (r_ + (id >> 5)) * 1024 + h_ * 256 + (id & 31) * 8); } \
        _Pragma("unroll") for (int i = 0; i < 2; ++i) { const int id = i * 512 + tid; const bf16* qp_ = A.qk + (r_ + (id >> 4)) * 1024 + h_ * 128 + (id & 15) * 8; pq[i] = *(const v4u*)qp_; pk[i] = *(const v4u*)(qp_ + 512); } } while (0)
    int unit = bid;
    if (unit < nunits) GLA_PREFETCH(unit);
  for (; unit < nunits; unit += G) {
    const int h = (unit / NCH) % 4;
    unsigned char* blob = A.blobA + (size_t)unit * BLOBA; unsigned char* blobB = A.blobB + (size_t)unit * BLOBB;
    *(LAS f32x4*)(lds + L_R + (tid >> 3) * 128 + (tid & 7) * 16) = pr;
#pragma unroll
    for (int i = 0; i < 4; ++i) { const int id = i * 512 + tid; *(LAS v4u*)(lds + L_V + (id >> 5) * VS_ + (id & 31) * 16) = pv[i]; }
#pragma unroll
    for (int i = 0; i < 2; ++i) { const int id = i * 512 + tid; *(LAS v4u*)(lds + L_QGF + (id >> 4) * QS_ + (id & 15) * 16) = pq[i]; *(LAS v4u*)(lds + L_KGF + (id >> 4) * QS_ + (id & 15) * 16) = pk[i]; }
    LBAR();
    {
        const int dd = tid & 127, pg = tid >> 7, d = h * 128 + dd;
        float wf[16], wb[16];
#pragma unroll
        for (int i = 0; i < 16; ++i) { wf[i] = A.w2f[i * 512 + d]; wb[i] = A.w2b[i * 512 + d]; }
        const float bf_ = A.b2f[d], bb_ = A.b2b[d];
        float lf[16], lb[16];
#pragma unroll
        for (int pp = 0; pp < 16; ++pp) {
            const LAS float* rr = (const LAS float*)(lds + L_R) + (pg * 16 + pp) * 32;
            float xf = bf_, xb = bb_;
#pragma unroll
            for (int i4 = 0; i4 < 4; ++i4) { const f32x4 a = *(const LAS f32x4*)(rr + 4 * i4), b = *(const LAS f32x4*)(rr + 16 + 4 * i4);
                xf += a.x * wf[4 * i4] + a.y * wf[4 * i4 + 1] + a.z * wf[4 * i4 + 2] + a.w * wf[4 * i4 + 3];
                xb += b.x * wb[4 * i4] + b.y * wb[4 * i4 + 1] + b.z * wb[4 * i4 + 2] + b.w * wb[4 * i4 + 3]; }
            lf[pp] = logsig2(xf) * (1.f / 16.f); lb[pp] = logsig2(xb) * (1.f / 16.f);
        }
#pragma unroll
        for (int pp = 1; pp < 16; ++pp) lf[pp] += lf[pp - 1];
#pragma unroll
        for (int pp = 14; pp >= 0; --pp) lb[pp] += lb[pp + 1];
        LAS float* tot = (LAS float*)(lds + L_TOT);
        tot[pg * 128 + dd] = lf[15]; tot[512 + pg * 128 + dd] = lb[0];
        LBAR();
        float offf = 0.f, offb = 0.f, glf = 0.f, glb = 0.f;
#pragma unroll
        for (int g = 0; g < 4; ++g) { const float tf = tot[g * 128 + dd], tb = tot[512 + g * 128 + dd]; glf += tf; glb += tb; if (g < pg) offf += tf; if (g > pg) offb += tb; }
        const float eglf = __builtin_amdgcn_exp2f(glf), eglb = __builtin_amdgcn_exp2f(glb);
        if (pg == 0) { float* sc = (float*)(blob + B_SC); sc[dd] = eglf; sc[128 + dd] = eglb; }
#pragma unroll
        for (int pp = 0; pp < 16; ++pp) {
            const int o = (pg * 16 + pp) * QS_ + dd * 2;
            const float qv = bf2f(*(const LAS unsigned short*)(lds + L_QGF + o)) * QSCALE, kv = bf2f(*(const LAS unsigned short*)(lds + L_KGF + o));
            const float ef = __builtin_amdgcn_exp2f(lf[pp] + offf), eb = __builtin_amdgcn_exp2f(lb[pp] + offb);
            const float rf = __builtin_amdgcn_rcpf(ef), rb = __builtin_amdgcn_rcpf(eb);
            *(LAS unsigned short*)(lds + L_QGF + o) = (unsigned short)(pkbf(qv * ef, 0.f) & 0xffffu);
            *(LAS unsigned short*)(lds + L_KGF + o) = (unsigned short)(pkbf(kv * rf, 0.f) & 0xffffu);
            *(LAS unsigned short*)(lds + L_KDF + o) = (unsigned short)(pkbf(kv * rf * eglf, 0.f) & 0xffffu);
            *(LAS unsigned short*)(lds + L_QGB + o) = (unsigned short)(pkbf(qv * eb, 0.f) & 0xffffu);
            *(LAS unsigned short*)(lds + L_KGB + o) = (unsigned short)(pkbf(kv * rb, 0.f) & 0xffffu);
            *(LAS unsigned short*)(lds + L_KDB + o) = (unsigned short)(pkbf(kv * rb * eglb, 0.f) & 0xffffu);
        }
    }
    LBAR();
    { const int un = unit + G; if (un < nunits) GLA_PREFETCH(un); }
    if (w < 4) {
        const int rt = w >> 1, ct = w & 1, r = lane & 31, hh = lane >> 5;
        f32x16 af = zero16(), ab = zero16();
        if (rt >= ct) { const LAS unsigned char* ia = lds + L_QGF + (32 * rt + r) * QS_ + 16 * hh; const LAS unsigned char* ib = lds + L_KGF + (32 * ct + r) * QS_ + 16 * hh;
#pragma unroll
            for (int ks = 0; ks < 8; ++ks) af = MFMA32(*(const LAS bf16x8*)(ia + 32 * ks), *(const LAS bf16x8*)(ib + 32 * ks), af); }
        if (rt <= ct) { const LAS unsigned char* ia = lds + L_QGB + (32 * rt + r) * QS_ + 16 * hh; const LAS unsigned char* ib = lds + L_KGB + (32 * ct + r) * QS_ + 16 * hh;
#pragma unroll
            for (int ks = 0; ks < 8; ++ks) ab = MFMA32(*(const LAS bf16x8*)(ia + 32 * ks), *(const LAS bf16x8*)(ib + 32 * ks), ab); }
        const int j = 32 * ct + r;
#pragma unroll
        for (int reg = 0; reg < 16; ++reg) { const int i = 32 * rt + (reg & 3) + 8 * (reg >> 2) + 4 * hh;
            const float val = (i >= j ? af[reg] : 0.f) + (i <= j ? ab[reg] : 0.f);
            *(LAS unsigned short*)(lds + L_AS + i * AS_ + j * 2) = (unsigned short)(pkbf(val, 0.f) & 0xffffu); }
    } else {
        for (int blk = w - 4; blk < 64; blk += 4) {
            const int wh = blk >> 4, b = blk & 15; v4u f; int off;
            if (wh == 0)      { f = gdn::frag_rm_perm(lds + L_QGF, QS_, b >> 3, b & 7, lane); off = B_QGF; }
            else if (wh == 1) { f = gdn::frag_rm_perm(lds + L_QGB, QS_, b >> 3, b & 7, lane); off = B_QGB; }
            else if (wh == 2) { f = frag_tr_nat(lds + L_KDF, QS_, 32 * (b >> 2), b & 3, lane); off = B_KDTF; }
            else              { f = frag_tr_nat(lds + L_KDB, QS_, 32 * (b >> 2), b & 3, lane); off = B_KDTB; }
            *(v4u*)(blob + off + b * 1024 + lane * 16) = f;
        }
    }
    LBAR();
    {
        const int ct = w, r = lane & 31, hh = lane >> 5;
        f32x16 o[2] = {zero16(), zero16()};
#pragma unroll
        for (int ks = 0; ks < 4; ++ks) {
            const v4u fb = frag_tr_nat(lds + L_V, VS_, 32 * ct, ks, lane);
            *(v4u*)(blobB + B_VB + (ct * 4 + ks) * 1024 + lane * 16) = fb;
            const bf16x8 bfr = __builtin_bit_cast(bf16x8, fb);
#pragma unroll
            for (int rt = 0; rt < 2; ++rt) o[rt] = MFMA32(*(const LAS bf16x8*)(lds + L_AS + (32 * rt + r) * AS_ + (16 * ks + 8 * hh) * 2), bfr, o[rt]);
        }
        unsigned long long* ip = (unsigned long long*)(blobB + B_INTRA) + (size_t)ct * 512 + lane;
#pragma unroll
        for (int rt = 0; rt < 2; ++rt)
#pragma unroll
            for (int g = 0; g < 4; ++g) ip[(rt * 4 + g) * 64] = (unsigned long long)pkbf(o[rt][4 * g], o[rt][4 * g + 1]) | ((unsigned long long)pkbf(o[rt][4 * g + 2], o[rt][4 * g + 3]) << 32);
    }
    LBAR();
  }
#undef GLA_PREFETCH
}

struct GlaChainArgs {
    const unsigned char* blobA;
    const unsigned char* blobB;
    unsigned char* stg;
    unsigned* flag;
    int nseq, flags;
};
namespace gla { constexpr int CB_Y = 17408, CB_BUF = 66560, CB_END = 2 * CB_BUF; }
__device__ __forceinline__ void gla_chain_unit(LAS unsigned char* lds, const GlaChainArgs& A, int item) {
    using namespace gla;
    int tid_l = threadIdx.x; asm volatile("" : "+v"(tid_l));
    const int tid = tid_l, lane = tid & 63, w = __builtin_amdgcn_readfirstlane(tid >> 6);
    const int hh = lane >> 5;
    const int c = item & 1, h = (item >> 1) & 3, sq = item >> 3; const int flags = A.flags;
    const size_t unit0 = (size_t)(sq * 4 + h) * NCH;
    f32x16 S[4];
#pragma unroll
    for (int t = 0; t < 4; ++t) S[t] = zero16();
    unsigned long long pwn[8]; bool have = false; unsigned fnext = 0u;
#define GLA_ISSUE(s_, buf_) do { if (!(flags & 4)) { const int n_ = c ? NCH - 1 - (s_) : (s_); const unsigned char* bl_ = A.blobA + (unit0 + n_) * BLOBA; const unsigned char* bb_ = A.blobB + (unit0 + n_) * BLOBB; \
        LAS unsigned char* d_ = lds + (buf_) * CB_BUF; glds_blocks(d_, bl_ + (c ? B_QGB : B_QGF), 16, w, 8, lane); if (w == 7) glds_blocks(d_ + 16384, bl_ + B_SC, 1, 0, 1, lane); \
        glds_blocks(d_ + CB_Y, bl_ + (c ? B_KDTB : B_KDTF), 16, w, 8, lane); glds_blocks(d_ + CB_Y + 16384, bb_ + B_VB, 32, w, 8, lane); } } while (0)
    GLA_ISSUE(0, 0);
    __syncthreads();
    for (int s = 0; s < NCH; ++s) {
        const int n = c ? NCH - 1 - s : s;
        unsigned long long* sp = (unsigned long long*)(A.stg + (unit0 + n) * 32768) + (size_t)w * 512 + lane;
        unsigned* fl = A.flag + (unit0 + n) * 8 + w;
        unsigned long long pw[8];
        if (s >= NCH / 2 && !(flags & 1)) {
            if (have) {
#pragma unroll
                for (int i = 0; i < 8; ++i) pw[i] = pwn[i];
            } else {
                for (unsigned sp_ = 0; __builtin_amdgcn_readfirstlane((int)__hip_atomic_load(fl, __ATOMIC_RELAXED, __HIP_MEMORY_SCOPE_AGENT)) == 0 && sp_ < CHAIN_SPIN_CAP; ++sp_) __builtin_amdgcn_s_sleep(2);
#pragma unroll
                for (int i = 0; i < 8; ++i) pw[i] = __hip_atomic_load(sp + i * 64, __ATOMIC_RELAXED, __HIP_MEMORY_SCOPE_AGENT);
            }
        }
        have = false;
        if (s + 1 >= NCH / 2 && s + 1 < NCH && !(flags & 1) && __builtin_amdgcn_readfirstlane((int)fnext) != 0) {
            const int n1 = c ? NCH - 2 - s : s + 1; const unsigned long long* sp1 = (const unsigned long long*)(A.stg + (unit0 + n1) * 32768) + (size_t)w * 512 + lane;
#pragma unroll
            for (int i = 0; i < 8; ++i) pwn[i] = __hip_atomic_load(sp1 + i * 64, __ATOMIC_RELAXED, __HIP_MEMORY_SCOPE_AGENT);
            have = true;
        }
        if (s + 2 >= NCH / 2 && s + 2 < NCH && !(flags & 1)) { const int n2 = c ? NCH - 3 - s : s + 2; fnext = __hip_atomic_load(A.flag + (unit0 + n2) * 8 + w, __ATOMIC_RELAXED, __HIP_MEMORY_SCOPE_AGENT); }
        if (s + 1 < NCH) GLA_ISSUE(s + 1, (s + 1) & 1);
        const LAS unsigned char* X = lds + (s & 1) * CB_BUF; const LAS unsigned char* Y = X + CB_Y;
        const LAS float* EG = (const LAS float*)(X + 16384) + c * 128;
        bf16x8 sb[8];
#pragma unroll
        for (int t = 0; t < 4; ++t) { sb[2 * t] = pack8(S[t], 0); sb[2 * t + 1] = pack8(S[t], 1); }
        f32x16 o[2] = {zero16(), zero16()};
        {   constexpr int R = 6; bf16x8 ring[R];
#pragma unroll
            for (int i = 0; i < R; ++i) ring[i] = lds_frag(X, i, lane);
#pragma unroll
            for (int i = 0; i < 16; ++i) { o[i >> 3] = MFMA32(ring[i % R], sb[i & 7], o[i >> 3]); if (i + R < 16) ring[i % R] = lds_frag(X, i + R, lane); __builtin_amdgcn_sched_barrier(0); }
        }
        if (!(flags & 1)) {
            if (s < NCH / 2) {
#pragma unroll
                for (int rt = 0; rt < 2; ++rt)
#pragma unroll
                    for (int g = 0; g < 4; ++g) __hip_atomic_store(sp + (rt * 4 + g) * 64, (unsigned long long)pkbf(o[rt][4 * g], o[rt][4 * g + 1]) | ((unsigned long long)pkbf(o[rt][4 * g + 2], o[rt][4 * g + 3]) << 32), __ATOMIC_RELAXED, __HIP_MEMORY_SCOPE_AGENT);
            } else {
#pragma unroll
                for (int rt = 0; rt < 2; ++rt)
#pragma unroll
                    for (int g = 0; g < 4; ++g) { const unsigned plo = (unsigned)pw[rt * 4 + g], phi = (unsigned)(pw[rt * 4 + g] >> 32);
                        __hip_atomic_store(sp + (rt * 4 + g) * 64, (unsigned long long)pkbf(o[rt][4 * g] + bflo(plo), o[rt][4 * g + 1] + bfhi(plo)) | ((unsigned long long)pkbf(o[rt][4 * g + 2] + bflo(phi), o[rt][4 * g + 3] + bfhi(phi)) << 32), __ATOMIC_RELAXED, __HIP_MEMORY_SCOPE_AGENT); }
            }
        }
        {
            bf16x8 bfr[4];
#pragma unroll
            for (int ks = 0; ks < 4; ++ks) bfr[ks] = lds_frag(Y + 16384, w * 4 + ks, lane);
#pragma unroll
            for (int t = 0; t < 4; ++t)
#pragma unroll
                for (int g = 0; g < 4; ++g) { const f32x4 ev = *(const LAS f32x4*)(EG + 32 * t + 8 * g + 4 * hh);
                    S[t][4 * g] *= ev.x; S[t][4 * g + 1] *= ev.y; S[t][4 * g + 2] *= ev.z; S[t][4 * g + 3] *= ev.w; }
            constexpr int R = 5; bf16x8 ring[R];
#pragma unroll
            for (int i = 0; i < R; ++i) ring[i] = lds_frag(Y, i, lane);
#pragma unroll
            for (int i = 0; i < 16; ++i) { S[i >> 2] = MFMA32(ring[i % R], bfr[i & 3], S[i >> 2]); if (i + R < 16) ring[i % R] = lds_frag(Y, i + R, lane); __builtin_amdgcn_sched_barrier(0); }
        }
        if (!(flags & 1)) { asm volatile("s_waitcnt vmcnt(0)" ::: "memory"); if (lane == 0) __hip_atomic_store(fl, s < NCH / 2 ? 1u : 2u, __ATOMIC_RELAXED, __HIP_MEMORY_SCOPE_AGENT); }
        __syncthreads();
    }
#undef GLA_ISSUE
}

template <int NC, bool S16>
__device__ __forceinline__ void p4_unit(LAS unsigned char* lds, const unsigned char* slot, const unsigned char* intra, const bf16* zg, const float* nw, bf16* out, const unsigned* done) {
    int tid_l = threadIdx.x; asm volatile("" : "+v"(tid_l));
    const int tid = tid_l, lane = tid & 63, w = __builtin_amdgcn_readfirstlane(tid >> 6), r = lane & 31, hh = lane >> 5;
    constexpr int ST = NC * 2 + 16, NB = (NC / 32) * 8, CPR = NC / 8;
    if (done) {
        for (unsigned sp_ = 0; sp_ < (1u << 22); ++sp_) { const unsigned f = lane < 8 ? __hip_atomic_load(done + lane, __ATOMIC_RELAXED, __HIP_MEMORY_SCOPE_AGENT) : 2u; if (__all(f == 2u)) break; __builtin_amdgcn_s_sleep(8); }
    }
    for (int b = w; b < NB; b += 8) {
        const unsigned long long v = __hip_atomic_load((const unsigned long long*)slot + b * 64 + lane, __ATOMIC_RELAXED, __HIP_MEMORY_SCOPE_AGENT);
        float x0 = bflo((unsigned)v), x1 = bfhi((unsigned)v), x2 = bflo((unsigned)(v >> 32)), x3 = bfhi((unsigned)(v >> 32));
        if (intra) { const unsigned long long iv = ((const unsigned long long*)intra)[b * 64 + lane];
            x0 += bflo((unsigned)iv); x1 += bfhi((unsigned)iv); x2 += bflo((unsigned)(iv >> 32)); x3 += bfhi((unsigned)(iv >> 32)); }
        int row, col;
        if (S16) { row = 16 * (b & 3) + 4 * (lane >> 4); col = 16 * (b >> 2) + (lane & 15); }
        else { row = 32 * ((b >> 2) & 1) + 8 * (b & 3) + 4 * hh; col = 32 * (b >> 3) + r; }
        LAS unsigned char* p = lds + row * ST + col * 2;
        const unsigned a = pkbf(x0, x1), bq = pkbf(x2, x3);
        *(LAS unsigned short*)p = (unsigned short)(a & 0xffffu); *(LAS unsigned short*)(p + ST) = (unsigned short)(a >> 16);
        *(LAS unsigned short*)(p + 2 * ST) = (unsigned short)(bq & 0xffffu); *(LAS unsigned short*)(p + 3 * ST) = (unsigned short)(bq >> 16);
    }
    __syncthreads();
#pragma unroll
    for (int it = 0; it < (64 * CPR) / 512; ++it) {
        const int idx = it * 512 + tid, row = idx / CPR, ch = idx % CPR;
        const v4u xw = *(const LAS v4u*)(lds + row * ST + ch * 16);
        float x[8] = {bflo(xw.x), bfhi(xw.x), bflo(xw.y), bfhi(xw.y), bflo(xw.z), bfhi(xw.z), bflo(xw.w), bfhi(xw.w)};
        float ss = 0.f;
#pragma unroll
        for (int i = 0; i < 8; ++i) ss += x[i] * x[i];
        ss = row16_sum(ss);
        if (NC == 256) ss += __shfl_xor(ss, 16);
        const float rstd = 1.0f / sqrtf(ss * (1.0f / NC) + EPS);
        f32x4 w0 = *(const f32x4*)(nw + ch * 8), w1 = *(const f32x4*)(nw + ch * 8 + 4);
        if (zg) { const v4u zw = *(const v4u*)(zg + (size_t)row * 1024 + ch * 8);
            const float z[8] = {bflo(zw.x), bfhi(zw.x), bflo(zw.y), bfhi(zw.y), bflo(zw.z), bfhi(zw.z), bflo(zw.w), bfhi(zw.w)};
            w0.x *= z[0] * __builtin_amdgcn_rcpf(1.0f + __expf(-z[0])); w0.y *= z[1] * __builtin_amdgcn_rcpf(1.0f + __expf(-z[1])); w0.z *= z[2] * __builtin_amdgcn_rcpf(1.0f + __expf(-z[2])); w0.w *= z[3] * __builtin_amdgcn_rcpf(1.0f + __expf(-z[3]));
            w1.x *= z[4] * __builtin_amdgcn_rcpf(1.0f + __expf(-z[4])); w1.y *= z[5] * __builtin_amdgcn_rcpf(1.0f + __expf(-z[5])); w1.z *= z[6] * __builtin_amdgcn_rcpf(1.0f + __expf(-z[6])); w1.w *= z[7] * __builtin_amdgcn_rcpf(1.0f + __expf(-z[7])); }
        v4u o; o.x = pkbf(x[0] * rstd * w0.x, x[1] * rstd * w0.y); o.y = pkbf(x[2] * rstd * w0.z, x[3] * rstd * w0.w); o.z = pkbf(x[4] * rstd * w1.x, x[5] * rstd * w1.y); o.w = pkbf(x[6] * rstd * w1.z, x[7] * rstd * w1.w);
        *(v4u*)(out + (size_t)row * 1024 + ch * 8) = o;
    }
    __syncthreads();
}
#define XB_TMO      128
#define XB_XCNT(j)  (256  + 64 * (j))
#define XB_XSUB(j)  (1280 + 64 * (j))
#define XB_XGEN(j)  (2304 + 64 * (j))
#define XB_TOP      3328
#define XB_TOPGEN   3392
#define XCD_BAR_WORDS 3456
#define XB_SPIN_CAP (1u << 18)

__device__ __forceinline__ unsigned xb_ld(unsigned* p)              { return __hip_atomic_load(p, __ATOMIC_RELAXED, __HIP_MEMORY_SCOPE_AGENT); }
__device__ __forceinline__ unsigned xb_add(unsigned* p, unsigned v) { return __hip_atomic_fetch_add(p, v, __ATOMIC_RELAXED, __HIP_MEMORY_SCOPE_AGENT); }
__device__ __forceinline__ unsigned xb_xcc_id() { return (unsigned)__builtin_amdgcn_s_getreg((3 << 11) | 20) & 0xFu; }
#define XB_SPIN(cond, bar) do { unsigned _sp = 0; while (cond) { __builtin_amdgcn_s_sleep(1); \
    if ((++_sp & 255u) == 0u) { if (xb_ld(&(bar)[XB_TMO])) break; if (_sp > XB_SPIN_CAP) { atomicAdd(&(bar)[XB_TMO], 1u); break; } } } } while (0)

struct XcdBarrier {
    unsigned* bar; unsigned x;
    volatile LAS unsigned* st;
};

__device__ __forceinline__ XcdBarrier xcd_barrier_post(unsigned* bar, volatile LAS unsigned* st) {
    XcdBarrier b; b.bar = bar; b.x = xb_xcc_id(); b.st = st;
    if (threadIdx.x == 0) (void)xb_add(&bar[XB_XCNT(b.x)], 1u);
    return b;
}
__device__ __forceinline__ void xcd_barrier_complete(unsigned* bar, unsigned x, unsigned& nloc, unsigned& nx) {
    const unsigned G = gridDim.x * gridDim.y * gridDim.z;
    unsigned sum, cnt, mine, sp = 0u;
    for (;;) {
        sum = 0u; cnt = 0u; mine = 0u;
#pragma unroll
        for (unsigned j = 0; j < 16; ++j) { const unsigned c = xb_ld(&bar[XB_XCNT(j)]); sum += c; cnt += (c > 0u) ? 1u : 0u; mine = (j == x) ? c : mine; }
        if (sum == G) break;
        __builtin_amdgcn_s_sleep(1);
        if ((++sp & 255u) == 0u) { if (xb_ld(&bar[XB_TMO])) break; if (sp > XB_SPIN_CAP) { atomicAdd(&bar[XB_TMO], 1u); break; } }
    }
    nloc = mine > 0u ? mine : 1u; nx = cnt > 0u ? cnt : 1u;
}

__device__ __forceinline__ void xcd_barrier(const XcdBarrier& b) {
    asm volatile("s_waitcnt vmcnt(0)" ::: "memory");
    __syncthreads();
    if (threadIdx.x == 0) {
        unsigned* bar = b.bar;
        __builtin_amdgcn_s_waitcnt(0);
        unsigned nloc = b.st[0], nx = b.st[1];
        if (nloc == 0u) { xcd_barrier_complete(bar, b.x, nloc, nx); b.st[0] = nloc; b.st[1] = nx; }
        const unsigned old = xb_add(&bar[XB_XSUB(b.x)], 1u);
        const unsigned gen = old / nloc;
        if (old + 1u == (gen + 1u) * nloc) {
            __builtin_amdgcn_fence(__ATOMIC_RELEASE, "agent");
            asm volatile("s_waitcnt vmcnt(0)" ::: "memory");
            const unsigned og = xb_add(&bar[XB_TOP], 1u);
            const unsigned tg = og / nx;
            if (og + 1u == (tg + 1u) * nx) xb_add(&bar[XB_TOPGEN], 1u);
            else XB_SPIN(xb_ld(&bar[XB_TOPGEN]) == tg, bar);
            __builtin_amdgcn_fence(__ATOMIC_ACQUIRE, "agent");
            xb_add(&bar[XB_XGEN(b.x)], 1u);
            asm volatile("s_waitcnt vmcnt(0)" ::: "memory");
        } else {
            XB_SPIN(xb_ld(&bar[XB_XGEN(b.x)]) == gen, bar);
            __builtin_amdgcn_fence(__ATOMIC_ACQUIRE, "agent");
            asm volatile("s_waitcnt vmcnt(0)" ::: "memory");
        }
    }
    __syncthreads();
}
__device__ __forceinline__ void transpose_item(const float* W, int ldw, int src_col0, int K, int ncols, bf16* WT, int dst_row0, LAS float* scr, int item, int lane) {
    asm volatile("" : "+v"(lane));
    const int nblk = ncols / 32, kb = item / nblk, nb = item % nblk, k0 = 64 * kb, n0 = 32 * nb;
#pragma unroll 8
    for (int i = 0; i < 32; ++i) { const int kk = 2 * i + (lane >> 5); scr[kk * 33 + (lane & 31)] = W[(size_t)(k0 + kk) * ldw + src_col0 + n0 + (lane & 31)]; }
    LDS_WAIT();
    const int c = lane & 7;
#pragma unroll
    for (int j = 0; j < 4; ++j) { const int n = (lane >> 3) + 8 * j; const LAS float* s = scr + (8 * c) * 33 + n;
        v4u o; o.x = pk2(s[0 * 33], s[1 * 33]); o.y = pk2(s[2 * 33], s[3 * 33]); o.z = pk2(s[4 * 33], s[5 * 33]); o.w = pk2(s[6 * 33], s[7 * 33]);
        *(v4u*)(WT + (size_t)(dst_row0 + n0 + n) * K + k0 + 8 * c) = o; }
    LDS_WAIT();
}

constexpr int WCV_MIX = 16 * ((1024 + 3072 + 1024 + 1024 + 32 + 32) / 32), WCV_ALL = WCV_MIX + 16 * ((1024 + 2048) / 32) + 3 * 512;
__device__ __forceinline__ void wconv_item(int it, const float* w_in, const float* wa, const float* wb, const float* wo, bf16* WT_IN, bf16* WT_A, bf16* WT_B, bf16* WT_O, LAS float* scr, int lane) {
    constexpr int c0 = 512, c1 = c0 + 1536, c2 = c1 + 512, c3 = c2 + 512, c4 = c3 + 16, c5 = c4 + 16, c6 = c5 + 512, c7 = c6 + 1024, c8 = c7 + 512, c9 = c8 + 512;
    static_assert(c5 == WCV_MIX && c9 + 512 == WCV_ALL, "weight conversion item list");
    if (it < c0) transpose_item(w_in, NIN, SRC_ZA, D, 1024, WT_IN, 0, scr, it, lane);
    else if (it < c1) transpose_item(w_in, NIN, SRC_QKVA, D, 3072, WT_IN, 1024, scr, it - c0, lane);
    else if (it < c2) transpose_item(w_in, NIN, SRC_QB, D, 1024, WT_IN, 4096, scr, it - c1, lane);
    else if (it < c3) transpose_item(w_in, NIN, SRC_VB, D, 1024, WT_IN, 5120, scr, it - c2, lane);
    else if (it < c4) transpose_item(w_in, NIN, SRC_AF, D, 32, WT_IN, 9216, scr, it - c3, lane);
    else if (it < c5) transpose_item(w_in, NIN, SRC_RF, D, 32, WT_IN, 9248, scr, it - c4, lane);
    else if (it < c6) transpose_item(w_in, NIN, SRC_GB, D, 1024, WT_IN, 6144, scr, it - c5, lane);
    else if (it < c7) transpose_item(w_in, NIN, SRC_GA, D, 2048, WT_IN, 7168, scr, it - c6, lane);
    else if (it < c8) transpose_item(wa, D, 0, D, D, WT_A, 0, scr, it - c7, lane);
    else if (it < c9) transpose_item(wb, D, 0, D, D, WT_B, 0, scr, it - c8, lane);
    else transpose_item(wo, D, 0, D, D, WT_O, 0, scr, it - c9, lane);
}
__device__ __forceinline__ void h_rows(const float* x, const float* w, bf16* h, int nrows, int gw, int ngw, int lane) {
    asm volatile("" : "+v"(lane));
    for (int m = gw; m < nrows; m += ngw) {
        const f32x4* xr = (const f32x4*)(x + (size_t)m * D) + lane; f32x4 v[4]; float s = 0.f;
#pragma unroll
        for (int j = 0; j < 4; ++j) { v[j] = xr[64 * j]; s += (v[j].x * v[j].x + v[j].y * v[j].y) + (v[j].z * v[j].z + v[j].w * v[j].w); }
        const float rstd = 1.0f / sqrtf(wave_sum(s) * (1.f / D) + EPS);
        unsigned long long* o8 = (unsigned long long*)(h + (size_t)m * D) + lane;
#pragma unroll
        for (int j = 0; j < 4; ++j) { const f32x4 ww = ((const f32x4*)w)[lane + 64 * j];
            o8[64 * j] = (unsigned long long)pkbf(v[j].x * rstd * ww.x, v[j].y * rstd * ww.y) | ((unsigned long long)pkbf(v[j].z * rstd * ww.z, v[j].w * rstd * ww.w) << 32); }
    }
}
__device__ __forceinline__ void h_rows_tiles(const float* x, const float* w, const pg8::Gemm& gt, int nrows, int gw, int ngw, int lane) {
    asm volatile("" : "+v"(lane));
    for (int m = gw; m < nrows; m += ngw) {
        const f32x4* xr = (const f32x4*)(x + (size_t)m * D) + lane; f32x4 v[4]; float s = 0.f;
#pragma unroll
        for (int j = 0; j < 4; ++j) { v[j] = xr[64 * j]; s += (v[j].x * v[j].x + v[j].y * v[j].y) + (v[j].z * v[j].z + v[j].w * v[j].w); }
        const float rstd = 1.0f / sqrtf(wave_sum(s) * (1.f / D) + EPS);
        unsigned long long* o8 = (unsigned long long*)(gt.atile(m >> 8, (size_t)256 * D * 2) + (size_t)(m & 255) * D * 2) + lane;
#pragma unroll
        for (int j = 0; j < 4; ++j) { const f32x4 ww = ((const f32x4*)w)[lane + 64 * j];
            o8[64 * j] = (unsigned long long)pkbf(v[j].x * rstd * ww.x, v[j].y * rstd * ww.y) | ((unsigned long long)pkbf(v[j].z * rstd * ww.z, v[j].w * rstd * ww.w) << 32); }
    }
}
__device__ __forceinline__ void final_rows(const float* x, const float* pre, const float* w, float* out, int nrows, int gw, int ngw, int lane) {
    asm volatile("" : "+v"(lane));
    for (int m = gw; m < nrows; m += ngw) {
        const f32x4* pr = (const f32x4*)(pre + (size_t)m * D) + lane; const f32x4* xr = (const f32x4*)(x + (size_t)m * D) + lane; f32x4 v[4]; float s = 0.f;
#pragma unroll
        for (int j = 0; j < 4; ++j) { v[j] = pr[64 * j]; s += (v[j].x * v[j].x + v[j].y * v[j].y) + (v[j].z * v[j].z + v[j].w * v[j].w); }
        const float rstd = 1.0f / sqrtf(wave_sum(s) * (1.f / D) + EPS);
        f32x4* orow = (f32x4*)(out + (size_t)m * D) + lane;
#pragma unroll
        for (int j = 0; j < 4; ++j) { const f32x4 ww = ((const f32x4*)w)[lane + 64 * j]; const f32x4 xv = xr[64 * j]; orow[64 * j] = xv + v[j] * rstd * ww; }
    }
}
__device__ __forceinline__ void small_unit(LAS unsigned char* lds, const bf16* h, const bf16* wsm, float* out, int unit) {
    int tid_l = threadIdx.x; asm volatile("" : "+v"(tid_l));
    const int tid = tid_l, lane = tid & 63, w = __builtin_amdgcn_readfirstlane(tid >> 6), r = lane & 31, hh = lane >> 5;
    const int ct = w & 1, kq = w >> 1;
    const bf16* ap = h + (size_t)(unit * 32 + r) * D + kq * 256 + 8 * hh;
    const bf16* bp = wsm + (size_t)(32 * ct + r) * D + kq * 256 + 8 * hh;
    f32x16 acc = zero16();
#pragma unroll 8
    for (int ks = 0; ks < 16; ++ks) acc = MFMA32(*(const bf16x8*)(ap + 16 * ks), *(const bf16x8*)(bp + 16 * ks), acc);
    LAS float* red = (LAS float*)lds + (size_t)w * 1024 + lane;
    if (kq != 0) {
#pragma unroll
        for (int i = 0; i < 16; ++i) red[i * 64] = acc[i]; }
    __syncthreads();
    if (kq == 0) {
        float* op = out + (size_t)(unit * 32 + 4 * hh) * 64 + 32 * ct + r;
#pragma unroll
        for (int i = 0; i < 16; ++i) op[((i & 3) + 8 * (i >> 2)) * 64] = ((acc[i] + red[2048 + i * 64]) + red[4096 + i * 64]) + red[6144 + i * 64]; }
    __syncthreads();
}

constexpr int NG = 2, MG = M / NG, NSEQG = BATCH / NG;
constexpr size_t KiB = 1024;
constexpr size_t WS_CTL = 0  , WS_WTIN = 320 * KiB, WS_WTA = WS_WTIN + 18560 * KiB, WS_WTB = WS_WTA + 2 * MiB, WS_WTO = WS_WTB + 2 * MiB, WS_SMALL = WS_WTO + 2 * MiB  ,
    WS_Z = WS_SMALL + 2 * MiB  , WS_PG = WS_Z + 16 * MiB  , WS_GBLOB = WS_PG + 80 * MiB  , WS_LBLOBB = WS_GBLOB + 98 * MiB  , WS_END = WS_LBLOBB + 32 * MiB;
static_assert(WS_END <= 256 * MiB, "workspace");
constexpr size_t WS_GATES = WS_GBLOB  , WS_M1 = WS_GATES + 64 * MiB  , WS_MERGED = WS_M1 + 32 * MiB  , WS_PRE = WS_MERGED + 32 * MiB  ;
static_assert(WS_PRE + 1 * MiB <= WS_END, "overlays");
constexpr size_t HT_TILE = 256 * 1024 * 2, WS_H0 = WS_WTIN, WS_H1 = WS_PG + (size_t)NSEQG * 4 * NCH * gla::BLOBA, WS_H2 = WS_SMALL, WS_H3 = WS_END;
constexpr int HT1 = 24, HT2 = 55, HT3 = 59;
static_assert(((size_t)NSEQG * 4 * NCH * gla::BLOBA) % HT_TILE == 0 && WS_H1 + (HT2 - HT1) * HT_TILE <= WS_PG + 3 * ((size_t)MG * 2048) && HT1 * HT_TILE <= (size_t)6144 * 2048 && (HT3 - HT2) * HT_TILE <= 2 * MiB && WS_H3 + (64 - HT3) * HT_TILE <= 256 * MiB, "h tiles");
constexpr size_t PGMAT = (size_t)MG * 1024 * 2;
static_assert((size_t)NSEQG * 4 * NCH * gla::BLOBA <= 3 * PGMAT && (size_t)NSEQG * 4 * NCH * 32768 <= PGMAT && (size_t)NSEQG * 8 * NCH * 16384 <= PGMAT, "overlays");
static_assert((size_t)NSEQG * 8 * NCH * gdn::BLOB <= 98 * MiB && (size_t)NSEQG * 4 * NCH * gla::BLOBB <= 32 * MiB, "blobs");
constexpr int LDS_BYTES = 160 * 1024, LDS_BAR = LDS_BYTES - 16;
static_assert(gla::L_END <= LDS_BAR && gdn::L_END <= LDS_BAR && gdn::C_END <= LDS_BAR && gla::CB_END <= LDS_BAR && pg8::STAGE_BYTES <= LDS_BAR, "LDS");
constexpr int N_PHASES = 12;

struct MegaArgs { const float* in[18]; float* out; unsigned char* ws; int ph_lo, ph_hi; };

__global__ void __launch_bounds__(512, 2) mega(MegaArgs a) {
    extern __shared__ __attribute__((aligned(16))) unsigned char lds_raw[];
    LAS unsigned char* lds = (LAS unsigned char*)lds_raw;
    const int tid = threadIdx.x, lane = tid & 63, wave = __builtin_amdgcn_readfirstlane(tid >> 6);
    const int G = gridDim.x, bid = blockIdx.x, gw = bid * 8 + wave, ngw = G * 8;
    unsigned char* ws = a.ws;
    const float* x = a.in[0]; const float* ln_pre_w = a.in[1]; const float* w_in = a.in[2]; const float* conv_w = a.in[3];
    if (tid < 4) ((LAS unsigned*)(lds + LDS_BAR))[tid] = 0u;
    __syncthreads();
    XcdBarrier bar = xcd_barrier_post((unsigned*)(ws + WS_CTL), (volatile LAS unsigned*)(lds + LDS_BAR));
    const int lo = a.ph_lo, hi = a.ph_hi;
#define IN(k) (lo <= (k) && (k) < hi)
#define SEAM(k) do { if (IN(k) && IN((k) + 1)) xcd_barrier(bar); } while (0)
#ifndef PROBE_REPEAT
#define PROBE_REPEAT 0
#endif
#ifndef PROBE_FLAGS
#define PROBE_FLAGS 0
#endif
#define PH(k) if (IN(k)) for (int rep_ = 0; rep_ <= ((PROBE_REPEAT >> (k)) & 1); ++rep_)
#define REPBAR() do { if (rep_) xcd_barrier(bar); } while (0)
    bf16* WT_IN = (bf16*)(ws + WS_WTIN); bf16* WT_A = (bf16*)(ws + WS_WTA); bf16* WT_B = (bf16*)(ws + WS_WTB); bf16* WT_O = (bf16*)(ws + WS_WTO);
    bf16* PG = (bf16*)(ws + WS_PG); float* SMALL = (float*)(ws + WS_SMALL);
    bf16* ORAWA = (bf16*)a.out; bf16* ORAWB = (bf16*)a.out + (size_t)M * 1024;
    pg8::Gemm gh{(const bf16*)(ws + WS_H0), WT_IN + (size_t)6144 * D, M, 3072, D, 0, (const bf16*)(ws + WS_H1), (const bf16*)(ws + WS_H2), (const bf16*)(ws + WS_H3), HT1, HT2, HT3};

    PH(0) { REPBAR();
        LAS float* scr = (LAS float*)lds + wave * (64 * 33);
        for (int it = gw; it < WCV_MIX; it += ngw) wconv_item(it, w_in, a.in[9], a.in[15], a.in[16], WT_IN, WT_A, WT_B, WT_O, scr, lane);
        h_rows(x, ln_pre_w, ORAWB + (size_t)MG * 1024, MG, gw, ngw, lane);
    }
    SEAM(0);
#ifdef PROBE_BARRIERS
    for (int i = 0; i < PROBE_BARRIERS; ++i) xcd_barrier(bar);
#endif
    for (int g = 0; g < NG; ++g) {
        const int pb = 1 + 4 * g;
        const size_t r0 = (size_t)g * MG;
        const bf16* hsrc = (g == 0 ? ORAWB : ORAWA) + (size_t)MG * 1024;
        PH(pb) { REPBAR();
            for (int u = bid; u < MG / 32; u += G) small_unit(lds, hsrc, WT_IN + (size_t)9216 * D, SMALL, u);
            pg8::Gemm gm{hsrc, WT_IN, MG, 6144, D, 0}; pg8::StaticOrder S; S.init(MG, 6144, G, bid);
            pg8::EpiBf16 E{(bf16*)(ws + WS_Z), 1024, 1024, (size_t)MG * 1024};
            pg8::gemm_phase<pg8::EpiBf16, pg8::StaticOrder, true, true>(lds, gm, S, E);
        }
        SEAM(pb);
        PH(pb + 1) { REPBAR();
            GdnPrepArgs pa{PG, PG + (size_t)MG * 1024, PG + (size_t)2 * MG * 1024, SMALL, conv_w, a.in[4], a.in[5], a.in[6], a.in[7], ws + WS_GBLOB, NSEQG, rep_ ? PROBE_FLAGS : 0};
            gdn_prep_phase(lds, pa, bid, G, ws + WS_CTL + 300 * KiB);
        }
        SEAM(pb + 1);
        PH(pb + 2) { REPBAR();
            GlaPrepArgs pa{PG + (size_t)3 * MG * 1024, PG + (size_t)4 * MG * 1024, SMALL, a.in[10], a.in[11], a.in[12], a.in[13], ws + WS_PG, ws + WS_LBLOBB, NSEQG, 0};
            gla_prep_phase(lds, pa, bid, G);
        }
        SEAM(pb + 2);
        PH(pb + 3) { REPBAR();
            constexpr int NGI = NSEQG * 8 * 2, NLI = NSEQG * 4 * 2;
            unsigned* gflag = (unsigned*)(ws + WS_CTL + 32 * KiB) + (size_t)g * (NSEQG * 8 * NCH * 8); unsigned* lflag = (unsigned*)(ws + WS_CTL + 96 * KiB) + (size_t)g * (NSEQG * 4 * NCH * 8);
            if (rep_) { gflag += 32 * 1024; lflag += 32 * 1024; }
            if (bid < NGI) { if (!(rep_ && (PROBE_FLAGS & 16))) { GdnChainArgs ca{ws + WS_GBLOB, ws + WS_PG + 4 * PGMAT, gflag, NSEQG, rep_ ? PROBE_FLAGS : 0}; gdn_chain_unit(lds, ca, bid); } }
            else if (bid < NGI + NLI) { if (!(rep_ && (PROBE_FLAGS & 32))) { GlaChainArgs ca{ws + WS_PG, ws + WS_LBLOBB, ws + WS_PG + 3 * PGMAT, lflag, NSEQG, rep_ ? PROBE_FLAGS : 0}; gla_chain_unit(lds, ca, bid - NGI); } }
            else if (!rep_) {
                const int wk = bid - NGI - NLI, nwk = G - NGI - NLI;
                if (g == 0) h_rows(x + (size_t)MG * D, ln_pre_w, ORAWA + (size_t)MG * 1024, MG, wk * 8 + wave, nwk * 8, lane);
                if (g == 0) { LAS float* scr = (LAS float*)lds + wave * (64 * 33);
                    for (int it = WCV_MIX + wk * 8 + wave; it < WCV_ALL; it += nwk * 8) wconv_item(it, w_in, a.in[9], a.in[15], a.in[16], WT_IN, WT_A, WT_B, WT_O, scr, lane);
                    __syncthreads(); }
                if (g == NG - 1) h_rows_tiles(x, ln_pre_w, gh, M, wk * 8 + wave, nwk * 8, lane);
            }
            if (!rep_) {
                constexpr int NPG = NSEQG * 8, NPL = NSEQG * 4;
                unsigned* qhead = (unsigned*)(ws + WS_CTL + 301 * KiB) + 64 * g;
                for (;;) {
                    if (tid == 0) ((LAS unsigned*)(lds + LDS_BAR))[3] = __hip_atomic_fetch_add(qhead, 1u, __ATOMIC_RELAXED, __HIP_MEMORY_SCOPE_AGENT);
                    __syncthreads();
                    const int j = (int)((LAS unsigned*)(lds + LDS_BAR))[3];
                    __syncthreads();
                    if (j >= NCH * (NPG + NPL)) break;
                    const int rk = j / (NPG + NPL), idx = j % (NPG + NPL), n = (rk & 1) ? (NCH / 2 - 1 - (rk >> 1)) : (NCH / 2 + (rk >> 1));
                    if (idx < NPG) { const int u = idx * NCH + n, hd = idx % 8, sq = idx / 8;
                        p4_unit<128, true>(lds, ws + WS_PG + 4 * PGMAT + (size_t)u * 16384, nullptr, (const bf16*)(ws + WS_Z) + ((size_t)sq * SEQ + n * CHUNK) * 1024 + hd * 128, a.in[8], ORAWA + (r0 + (size_t)sq * SEQ + n * CHUNK) * 1024 + hd * 128, gflag + (size_t)u * 8); }
                    else { const int pi = idx - NPG, u = pi * NCH + n, hd = pi % 4, sq = pi / 4;
                        p4_unit<256, false>(lds, ws + WS_PG + 3 * PGMAT + (size_t)u * 32768, ws + WS_LBLOBB + (size_t)u * gla::BLOBB + gla::B_INTRA, nullptr, a.in[14], ORAWB + (r0 + (size_t)sq * SEQ + n * CHUNK) * 1024 + hd * 256, lflag + (size_t)u * 8); }
                }
            }
        }
        SEAM(pb + 3);
    }
    PH(9) { REPBAR();
        const pg8::Gemm& gm = gh; pg8::StaticOrder S; S.init(M, 3072, G, bid);
        if (rep_ == 0) { pg8::EpiP1b E{ORAWB, (bf16*)(ws + WS_GATES), (size_t)M * 1024, ORAWB};
            pg8::gemm_phase<pg8::EpiP1b, pg8::StaticOrder, true, true>(lds, gm, S, E); }
        else { pg8::EpiP1b E{ORAWB, (bf16*)(ws + WS_GATES), (size_t)M * 1024, (bf16*)(ws + WS_MERGED)};
            pg8::gemm_phase<pg8::EpiP1b, pg8::StaticOrder, true, true>(lds, gm, S, E); }
    }
    SEAM(9);
    PH(10) { REPBAR();
        pg8::Gemm gm{ORAWA, WT_A, 2 * M, 2 * D, D, 0}; pg8::PairOrder S; S.init(M, D, G, bid);
        pg8::EpiMerge E{(bf16*)(ws + WS_M1), (bf16*)(ws + WS_MERGED), (const bf16*)(ws + WS_GATES), (size_t)M * 1024, M / 256, D / 256};
        pg8::gemm_phase<pg8::EpiMerge, pg8::PairOrder, true, true>(lds, gm, S, E);
    }
    SEAM(10);
    if (IN(11)) {
        pg8::Gemm gm{(const bf16*)(ws + WS_MERGED), WT_O, M, D, D, 0}; pg8::StaticOrder S; S.init(M, D, G, bid);
        pg8::EpiRmsRes E{x, a.in[17], a.out, (float*)(ws + WS_PRE), (unsigned*)(ws + WS_CTL + 304 * KiB)};
        pg8::gemm_phase<pg8::EpiRmsRes, pg8::StaticOrder, false, true>(lds, gm, S, E);
    }
#undef IN
#undef SEAM
}

#ifndef MK_N_LAUNCHES
#define MK_N_LAUNCHES 1
#endif
extern "C" void kernel_launch(void* const* d_in, const int* in_sizes, int n_in, void* d_out, int out_size, void* d_ws, size_t ws_size, hipStream_t stream) {
    static int ready = 0;
    if (!ready) {
        if (n_in != 18 || ws_size < 256 * MiB || out_size != M * D) { fprintf(stderr, "kernel_launch: unexpected problem shape / workspace (%d inputs, ws %zu)\n", n_in, ws_size); ready = -1; return; }
        if (hipFuncSetAttribute((const void*)mega, hipFuncAttributeMaxDynamicSharedMemorySize, LDS_BYTES) != hipSuccess) { fprintf(stderr, "kernel_launch: hipFuncSetAttribute failed\n"); ready = -1; return; }
        ready = 1;
    }
    if (ready < 0) return;
    (void)hipMemsetAsync((char*)d_ws + WS_CTL, 0, 320 * 1024, stream);
    MegaArgs a{};
    for (int i = 0; i < 18; ++i) a.in[i] = (const float*)d_in[i];
    a.out = (float*)d_out; a.ws = (unsigned char*)d_ws;
#if MK_N_LAUNCHES == 1
    a.ph_lo = 0; a.ph_hi = N_PHASES;
    hipLaunchKernelGGL(mega, dim3(256), dim3(512), LDS_BYTES, stream, a);
#else
    for (int p = 0; p < N_PHASES; ++p) { a.ph_lo = p; a.ph_hi = p + 1; hipLaunchKernelGGL(mega, dim3(256), dim3(512), LDS_BYTES, stream, a); }
#endif
}
```

```cpp
#include <hip/hip_runtime.h>
#include <cstdio>
#include <cstdint>

#define GAS __attribute__((address_space(1)))
#define LAS __attribute__((address_space(3)))
typedef unsigned short bf16;
typedef unsigned v4u __attribute__((ext_vector_type(4)));
typedef unsigned v2u __attribute__((ext_vector_type(2)));
typedef float f32x4 __attribute__((ext_vector_type(4)));
#define LDS_WAIT() asm volatile("s_waitcnt lgkmcnt(0)" ::: "memory")

constexpr int BATCH = 8, SEQ = 2048, D = 1024, M = BATCH * SEQ, NIN = 9280;
constexpr float EPS = 1e-6f;
constexpr size_t MiB = 1 << 20;
constexpr int SRC_QKVA = 0, SRC_ZA = 3072, SRC_AF = 4096, SRC_QB = 4128, SRC_KB = 4640, SRC_VB = 5152, SRC_GB = 6176, SRC_RF = 7200, SRC_GA = 7232, SRC_GBm = 8256;

__device__ __forceinline__ unsigned f2bf(float f) { unsigned u = __builtin_bit_cast(unsigned, f); return (u + 0x7fffu + ((u >> 16) & 1u)) >> 16; }
__device__ __forceinline__ unsigned pk2(float lo, float hi) { return f2bf(lo) | (f2bf(hi) << 16); }
__device__ __forceinline__ float bf2f(unsigned short b) { return __builtin_bit_cast(float, (unsigned)b << 16); }
__device__ __forceinline__ float bflo(unsigned w) { return __builtin_bit_cast(float, w << 16); }
__device__ __forceinline__ float bfhi(unsigned w) { return __builtin_bit_cast(float, w & 0xffff0000u); }
__device__ __forceinline__ float sigmoidf_(float x) { return 1.0f / (1.0f + __expf(-x)); }
__device__ __forceinline__ float siluf_(float x) { return x / (1.0f + __expf(-x)); }
__device__ __forceinline__ float wave_sum(float v) {
#pragma unroll
    for (int o = 1; o < 64; o <<= 1) v += __shfl_xor(v, o);
    return v;
}
namespace pg8 {
#define PG8_LAS __attribute__((address_space(3)))
typedef unsigned short bf16_t;
typedef short bf16x8 __attribute__((ext_vector_type(8)));
typedef float f32x4 __attribute__((ext_vector_type(4)));
typedef unsigned u32x4 __attribute__((ext_vector_type(4)));
constexpr int BM = 256, BK = 64, HALF = 128, HTB = HALF * BK * 2  , STAGE_BYTES = 8 * HTB, NXCD = 8, WGM = 8;

__host__ __device__ __forceinline__ int lds_byte(int r, int c) { const int st = (r >> 4) * 2 + (c >> 5), rr = r & 15, cc = c & 31, ob = rr * 64 + cc * 2; return st * 1024 + (ob ^ (((ob >> 9) & 1) << 5)); }
__host__ __device__ __forceinline__ void stage_rc(int b, int& R, int& C) { const int st = b / 1024, sb = b % 1024, swz = sb ^ (((sb >> 9) & 1) << 5); R = (st >> 1) * 16 + swz / 64; C = (st & 1) * 32 + (swz % 64) / 2; }
__host__ __device__ __forceinline__ int perm32(int rho) { const int n = rho >> 4, i = rho & 15; return 8 * (i >> 2) + 4 * n + (i & 3); }

struct Unit { int pm, pn; };
struct Gemm { const bf16_t* A; const bf16_t* Bt; int M, N, K, pad_;
    const bf16_t* A1 = nullptr; const bf16_t* A2 = nullptr; const bf16_t* A3 = nullptr; int t1 = 1 << 30, t2 = 1 << 30, t3 = 1 << 30;
    __host__ __device__ __forceinline__ const char* atile(int pm, size_t tstep) const {
        if (pm < t1) return (const char*)A + (size_t)pm * tstep;
        if (pm < t2) return (const char*)A1 + (size_t)(pm - t1) * tstep;
        if (pm < t3) return (const char*)A2 + (size_t)(pm - t2) * tstep;
        return (const char*)A3 + (size_t)(pm - t3) * tstep; }
};

struct StaticOrder {
    int nM, nN, nwg, G, c;
    __host__ __device__ void init(int M, int N, int G_, int c_) { nM = M / BM; nN = N / BM; nwg = nM * nN; G = G_; c = c_; }
    __host__ __device__ bool next(int i, Unit& u) const {
        const long L = (long)i * G + c; if (L >= nwg) return false;
        int wgid = (int)L; { const int q = nwg / NXCD, r = nwg % NXCD, xcd = wgid % NXCD, off = wgid / NXCD; wgid = (xcd < r ? xcd * (q + 1) : r * (q + 1) + (xcd - r) * q) + off; }
        const int nig = WGM * nN, gid = wgid / nig, fm = gid * WGM, gsz = (nM - fm) < WGM ? (nM - fm) : WGM;
        u.pm = fm + ((wgid % nig) % gsz); u.pn = (wgid % nig) / gsz; return true;
    }
    __device__ __forceinline__ void a_ready(const Unit&) const {}
    __device__ __forceinline__ void done(const Unit&) const {}
};

__device__ __forceinline__ unsigned cvt_pk_bf16(float lo, float hi) { unsigned r; asm volatile("v_cvt_pk_bf16_f32 %0, %1, %2" : "=v"(r) : "v"(lo), "v"(hi)); return r; }
struct EpiBf16 {
    static constexpr bool PERM = true, AFTER_DRAIN = false;
    bf16_t* O; int ldc; int split_cols; size_t split_stride;
    __device__ __forceinline__ void operator()(const f32x4 (&acc)[2][2][4][2], const Unit& u, int wr, int wc, int fr, int fq) const {
        const int row0 = u.pm * BM + wr * 64 + fr; int colt = u.pn * BM; bf16_t* base = O;
        if (split_cols) { const int t = colt / split_cols; base += (size_t)t * split_stride; colt -= t * split_cols; }
        const int col0 = colt + wc * 32 + 8 * fq;
#pragma unroll
        for (int ai = 0; ai < 2; ++ai)
#pragma unroll
            for (int m = 0; m < 4; ++m) { bf16_t* rowp = base + (size_t)(row0 + ai * HALF + m * 16) * ldc + col0;
#pragma unroll
                for (int bj = 0; bj < 2; ++bj) { const f32x4 v0 = acc[ai][bj][m][0], v1 = acc[ai][bj][m][1];
                    u32x4 w; w.x = cvt_pk_bf16(v0[0], v0[1]); w.y = cvt_pk_bf16(v0[2], v0[3]); w.z = cvt_pk_bf16(v1[0], v1[1]); w.w = cvt_pk_bf16(v1[2], v1[3]);
                    *(u32x4*)(rowp + bj * HALF) = w; } }
    }
};
template <int MODE> struct EpiGate {
    static constexpr bool PERM = true, AFTER_DRAIN = false;
    bf16_t* O; const bf16_t* G; const bf16_t* Add; int ldc, pad_;
    __device__ __forceinline__ void operator()(const f32x4 (&acc)[2][2][4][2], const Unit& u, int wr, int wc, int fr, int fq) const {
        const int row0 = u.pm * BM + wr * 64 + fr; const int col0 = u.pn * BM + wc * 32 + 8 * fq;
#pragma unroll
        for (int ai = 0; ai < 2; ++ai)
#pragma unroll
            for (int m = 0; m < 4; ++m) { const size_t ro = (size_t)(row0 + ai * HALF + m * 16) * ldc + col0;
#pragma unroll
                for (int bj = 0; bj < 2; ++bj) { const f32x4 v0 = acc[ai][bj][m][0], v1 = acc[ai][bj][m][1];
                    const u32x4 gw = *(const u32x4*)(G + ro + bj * HALF);
                    float r[8]; const float a[8] = {v0[0], v0[1], v0[2], v0[3], v1[0], v1[1], v1[2], v1[3]};
#pragma unroll
                    for (int i = 0; i < 4; ++i) { const unsigned w = gw[i]; const float g0 = __builtin_bit_cast(float, w << 16), g1 = __builtin_bit_cast(float, w & 0xffff0000u);
                        if (MODE == 0) { r[2 * i] = a[2 * i] * __builtin_amdgcn_rcpf(1.0f + __builtin_amdgcn_exp2f(-1.4426950408889634f * g0)); r[2 * i + 1] = a[2 * i + 1] * __builtin_amdgcn_rcpf(1.0f + __builtin_amdgcn_exp2f(-1.4426950408889634f * g1)); }
                        else { r[2 * i] = g0 * a[2 * i] * __builtin_amdgcn_rcpf(1.0f + __builtin_amdgcn_exp2f(-1.4426950408889634f * a[2 * i])); r[2 * i + 1] = g1 * a[2 * i + 1] * __builtin_amdgcn_rcpf(1.0f + __builtin_amdgcn_exp2f(-1.4426950408889634f * a[2 * i + 1])); } }
                    if (Add) { const u32x4 aw = *(const u32x4*)(Add + ro + bj * HALF);
#pragma unroll
                        for (int i = 0; i < 4; ++i) { const unsigned w = aw[i]; r[2 * i] += __builtin_bit_cast(float, w << 16); r[2 * i + 1] += __builtin_bit_cast(float, w & 0xffff0000u); } }
                    u32x4 w; w.x = cvt_pk_bf16(r[0], r[1]); w.y = cvt_pk_bf16(r[2], r[3]); w.z = cvt_pk_bf16(r[4], r[5]); w.w = cvt_pk_bf16(r[6], r[7]);
                    *(u32x4*)(O + ro + bj * HALF) = w; } }
    }
};
struct EpiF32 {
    static constexpr bool PERM = false, AFTER_DRAIN = false;
    float* O; int ldc, pad_;
    __device__ __forceinline__ void operator()(const f32x4 (&acc)[2][2][4][2], const Unit& u, int wr, int wc, int fr, int fq) const {
        const int row0 = u.pm * BM + wr * 64 + fr; const int col0 = u.pn * BM + wc * 32 + 4 * fq;
#pragma unroll
        for (int ai = 0; ai < 2; ++ai)
#pragma unroll
            for (int m = 0; m < 4; ++m) { float* rowp = O + (size_t)(row0 + ai * HALF + m * 16) * ldc + col0;
#pragma unroll
                for (int bj = 0; bj < 2; ++bj)
#pragma unroll
                    for (int n = 0; n < 2; ++n) *(f32x4*)(rowp + bj * HALF + n * 16) = acc[ai][bj][m][n]; }
    }
};
struct EpiP1b {
    static constexpr bool PERM = true, AFTER_DRAIN = false;
    const bf16_t* ob; bf16_t* gates; size_t gate_stride; bf16_t* ob_out;
    __device__ __forceinline__ void operator()(const f32x4 (&acc)[2][2][4][2], const Unit& u, int wr, int wc, int fr, int fq) const {
        if (u.pn < 4) { EpiGate<1> E{ob_out, ob, nullptr, 1024, 0}; E(acc, u, wr, wc, fr, fq); }
        else { Unit v = u; v.pn = (u.pn - 4) & 3; EpiBf16 E{gates + (size_t)((u.pn - 4) >> 2) * gate_stride, 1024, 0, 0}; E(acc, v, wr, wc, fr, fq); }
    }
};
struct EpiRmsRes {
    static constexpr bool PERM = false, AFTER_DRAIN = true;
    const float* xres; const float* w; float* out; float* xbuf; unsigned* cnt;
    __device__ __forceinline__ void fused(f32x4 (&acc)[2][2][4][2], const Unit& u, int wr, int wc, int fr, int fq, PG8_LAS unsigned char* lds, int wid, int lane) const {
        PG8_LAS float* P = (PG8_LAS float*)lds;
        PG8_LAS float* R = (PG8_LAS float*)(lds + 4096);
#pragma unroll
        for (int ai = 0; ai < 2; ++ai)
#pragma unroll
            for (int m = 0; m < 4; ++m) { float s = 0.f;
#pragma unroll
                for (int bj = 0; bj < 2; ++bj)
#pragma unroll
                    for (int n = 0; n < 2; ++n) { const f32x4 x = acc[ai][bj][m][n]; s += (x[0] * x[0] + x[1] * x[1]) + (x[2] * x[2] + x[3] * x[3]); }
                s += __shfl_xor(s, 16); s += __shfl_xor(s, 32);
                if (fq == 0) P[(ai * HALF + wr * 64 + m * 16 + fr) * 4 + wc] = s; }
        asm volatile("s_waitcnt lgkmcnt(0)" ::: "memory"); __builtin_amdgcn_s_barrier(); asm volatile("" ::: "memory");
        const int row = wid * 32 + (lane & 31);
        if (lane < 32) { const f32x4 p = *(const PG8_LAS f32x4*)(P + row * 4);
            __hip_atomic_store(xbuf + (size_t)(u.pm * BM + row) * 4 + u.pn, (p[0] + p[1]) + (p[2] + p[3]), __ATOMIC_RELAXED, __HIP_MEMORY_SCOPE_AGENT); }
        asm volatile("s_waitcnt vmcnt(0)" ::: "memory");
        if (lane == 0) __hip_atomic_fetch_add(cnt + 64 * u.pm, 1u, __ATOMIC_RELAXED, __HIP_MEMORY_SCOPE_AGENT);
        if (wid == 0) {
            for (unsigned sp = 0; (unsigned)__builtin_amdgcn_readfirstlane((int)__hip_atomic_load(cnt + 64 * u.pm, __ATOMIC_RELAXED, __HIP_MEMORY_SCOPE_AGENT)) < 32u && sp < (1u << 22); ++sp) __builtin_amdgcn_s_sleep(2);
        }
        asm volatile("s_waitcnt vmcnt(0) lgkmcnt(0)" ::: "memory"); __builtin_amdgcn_s_barrier(); asm volatile("" ::: "memory");
        if (lane < 32) { const float* sl = xbuf + (size_t)(u.pm * BM + row) * 4; float t = 0.f;
#pragma unroll
            for (int i = 0; i < 4; ++i) t += __hip_atomic_load(sl + i, __ATOMIC_RELAXED, __HIP_MEMORY_SCOPE_AGENT);
            R[row] = 1.0f / sqrtf(t * (1.0f / 1024.0f) + 1e-6f); }
        asm volatile("s_waitcnt vmcnt(0) lgkmcnt(0)" ::: "memory"); __builtin_amdgcn_s_barrier(); asm volatile("" ::: "memory");
        const int col0 = u.pn * BM + wc * 32 + 4 * fq;
#pragma unroll
        for (int ai = 0; ai < 2; ++ai)
#pragma unroll
            for (int m = 0; m < 4; ++m) { const int r = ai * HALF + wr * 64 + m * 16 + fr; const float rs = R[r]; const size_t off = (size_t)(u.pm * BM + r) * 1024 + col0;
#pragma unroll
                for (int bj = 0; bj < 2; ++bj)
#pragma unroll
                    for (int n = 0; n < 2; ++n) { const int c = bj * HALF + n * 16; const f32x4 xv = *(const f32x4*)(xres + off + c); const f32x4 wv = *(const f32x4*)(w + col0 + c);
                        *(f32x4*)(out + off + c) = xv + acc[ai][bj][m][n] * rs * wv; }
                if (m & 1) asm volatile("" ::: "memory"); }
    }
};
struct PairOrder {
    StaticOrder S; int nM, nN;
    __host__ __device__ void init(int M, int N, int G_, int c_) { S.init(M, N, G_, c_); nM = M / BM; nN = N / BM; }
    __host__ __device__ bool next(int i, Unit& u) const { if (i > 1) return false; Unit b; if (!S.next(0, b)) return false; u.pm = b.pm + i * nM; u.pn = b.pn + i * nN; return true; }
    __device__ __forceinline__ void a_ready(const Unit&) const {}
    __device__ __forceinline__ void done(const Unit&) const {}
};
struct EpiMerge {
    static constexpr bool PERM = true, AFTER_DRAIN = false;
    bf16_t* m1; bf16_t* merged; const bf16_t* gates; size_t gate_stride; int nM, nN;
    __device__ __forceinline__ void operator()(const f32x4 (&acc)[2][2][4][2], const Unit& u, int wr, int wc, int fr, int fq) const {
        if (u.pm < nM) { EpiGate<0> E{m1, gates, nullptr, 1024, 0}; E(acc, u, wr, wc, fr, fq); }
        else { Unit v; v.pm = u.pm - nM; v.pn = u.pn - nN; EpiGate<0> E{merged, gates + gate_stride, m1, 1024, 0}; E(acc, v, wr, wc, fr, fq); }
    }
};
template <class Epi, class Sched, bool ALIGN_EPI = false, bool SP2 = false>
__device__ __forceinline__ void gemm_phase(PG8_LAS unsigned char* lds, const Gemm g, const Sched& S, const Epi& E) {
    int tid_l = threadIdx.x; asm volatile("" : "+v"(tid_l));
    const int tid = tid_l, wid = __builtin_amdgcn_readfirstlane(tid >> 6), lane = tid & 63, wr = wid >> 2, wc = wid & 3, fr = lane & 15, fq = lane >> 4;
    const int K = g.K, nt = K / BK;
    unsigned voffA[2], voffB[2];
#pragma unroll
    for (int i = 0; i < 2; ++i) { int R, C; stage_rc(tid * 16 + i * 8192, R, C); const int Rb = Epi::PERM ? ((R & ~31) + perm32(R & 31)) : R;
        voffA[i] = (unsigned)(R * K + C) * 2u; voffB[i] = (unsigned)(Rb * K + C) * 2u; }
    const size_t kstep = (size_t)(BK * 2);
    const size_t hstep = (size_t)HALF * K * 2;
    const size_t tstep = 2 * hstep;
    const unsigned ldsw = (unsigned)wid * 1024u;
    const int aoff = lds_byte(wr * 64 + fr, fq * 8), boff = lds_byte(wc * 32 + fr, fq * 8);
#define PG8_SA(b, h) (((b) * 2 + (h)) * HTB)
#define PG8_SB(b, h) ((4 + (b) * 2 + (h)) * HTB)
#define PG8_STAGE(bufoff, gbase, voff) do { _Pragma("unroll") for (int _i = 0; _i < 2; ++_i) \
        __builtin_amdgcn_global_load_lds((const unsigned*)((const char*)(gbase) + (voff)[_i]), (PG8_LAS unsigned*)(lds + (bufoff) + ldsw + _i * 8192), 16, 0, 0); } while (0)
#define PG8_LDA(dst, b, h) do { _Pragma("unroll") for (int m = 0; m < 4; ++m) _Pragma("unroll") for (int k = 0; k < 2; ++k) dst[m][k] = *(const PG8_LAS bf16x8*)(lds + PG8_SA(b, h) + aoff + m * 2048 + k * 1024); } while (0)
#define PG8_LDB(dst, b, h) do { _Pragma("unroll") for (int n = 0; n < 2; ++n) _Pragma("unroll") for (int k = 0; k < 2; ++k) dst[n][k] = *(const PG8_LAS bf16x8*)(lds + PG8_SB(b, h) + boff + n * 2048 + k * 1024); } while (0)
#define PG8_MMA(ai, bj, At, Bt) do { __builtin_amdgcn_s_setprio(1); _Pragma("unroll") for (int m = 0; m < 4; ++m) _Pragma("unroll") for (int n = 0; n < 2; ++n) _Pragma("unroll") for (int k = 0; k < 2; ++k) \
        acc[ai][bj][m][n] = __builtin_amdgcn_mfma_f32_16x16x32_bf16(Bt[n][k], At[m][k], acc[ai][bj][m][n], 0, 0, 0); __builtin_amdgcn_s_setprio(0); } while (0)
#define PG8_WAIT_V(n) asm volatile("s_waitcnt vmcnt(" #n ")" ::: "memory")
#define PG8_WAIT_L(n) asm volatile("s_waitcnt lgkmcnt(" #n ")" ::: "memory")
#define PG8_BAR __builtin_amdgcn_s_barrier()
#define PG8_SCHED __builtin_amdgcn_sched_barrier(0)
    Unit cur, nxt; int ui = 0;
    if (!S.next(0, cur)) return;
    f32x4 acc[2][2][4][2];
#pragma unroll
    for (int a = 0; a < 2; ++a)
#pragma unroll
        for (int b = 0; b < 2; ++b)
#pragma unroll
            for (int m = 0; m < 4; ++m)
#pragma unroll
                for (int n = 0; n < 2; ++n) acc[a][b][m][n] = (f32x4){0.f, 0.f, 0.f, 0.f};
    bf16x8 At[4][2], B0[2][2], B1[2][2];
    const char* cA = g.atile(cur.pm, tstep); const char* cB = (const char*)g.Bt + (size_t)cur.pn * tstep;
    S.a_ready(cur);
    if constexpr (SP2) {
        PG8_STAGE(PG8_SB(0, 0), cB, voffB); PG8_STAGE(PG8_SB(0, 1), cB + hstep, voffB); PG8_STAGE(PG8_SA(0, 0), cA, voffA); PG8_STAGE(PG8_SA(0, 1), cA + hstep, voffA);
        if (wr == 1) PG8_BAR;
        PG8_WAIT_V(2); PG8_BAR;
        PG8_STAGE(PG8_SB(1, 0), cB + kstep, voffB); PG8_STAGE(PG8_SA(1, 0), cA + kstep, voffA); PG8_STAGE(PG8_SB(1, 1), cB + hstep + kstep, voffB);
        PG8_WAIT_V(6); PG8_BAR;
    } else {
        PG8_STAGE(PG8_SB(0, 0), cB, voffB); PG8_STAGE(PG8_SA(0, 0), cA, voffA); PG8_STAGE(PG8_SB(0, 1), cB + hstep, voffB); PG8_STAGE(PG8_SA(0, 1), cA + hstep, voffA);
        if (wr == 1) PG8_BAR;
        PG8_WAIT_V(4); PG8_BAR;
        PG8_STAGE(PG8_SB(1, 0), cB + kstep, voffB); PG8_STAGE(PG8_SA(1, 0), cA + kstep, voffA); PG8_STAGE(PG8_SB(1, 1), cB + hstep + kstep, voffB);
        PG8_WAIT_V(6); PG8_BAR;
    }
    for (;;) {
        const bool has_next = S.next(ui + 1, nxt);
        const char* nA = has_next ? g.atile(nxt.pm, tstep) : cA; const char* nB = has_next ? (const char*)g.Bt + (size_t)nxt.pn * tstep : cB;
        for (int t = 0; t < nt; t += 2) {
            const bool last = (t == nt - 2);
            const char* a1 = cA + (size_t)(t + 1) * kstep;
            const char* a2 = last ? nA : cA + (size_t)(t + 2) * kstep; const char* b2 = last ? nB : cB + (size_t)(t + 2) * kstep;
            const char* a3 = a2 + kstep; const char* b3 = b2 + kstep;
            if (last && has_next) S.a_ready(nxt);
            if constexpr (SP2) {
            PG8_LDB(B0, 0, 0); PG8_LDB(B1, 0, 1); PG8_SCHED; PG8_LDA(At, 0, 0); PG8_STAGE(PG8_SA(1, 1), a1 + hstep, voffA);
            PG8_WAIT_V(8); PG8_WAIT_L(0); PG8_BAR; PG8_MMA(0, 0, At, B0); PG8_MMA(0, 1, At, B1); PG8_BAR; PG8_SCHED;
            PG8_LDA(At, 0, 1); PG8_STAGE(PG8_SB(0, 0), b2, voffB); PG8_STAGE(PG8_SB(0, 1), b2 + hstep, voffB); PG8_STAGE(PG8_SA(0, 0), a2, voffA);
            PG8_WAIT_V(8); PG8_WAIT_L(0); PG8_BAR; PG8_MMA(1, 0, At, B0); PG8_MMA(1, 1, At, B1); PG8_BAR; PG8_SCHED;
            PG8_LDB(B0, 1, 0); PG8_LDB(B1, 1, 1); PG8_SCHED; PG8_LDA(At, 1, 0); PG8_STAGE(PG8_SA(0, 1), a2 + hstep, voffA);
            PG8_WAIT_V(8); PG8_WAIT_L(0); PG8_BAR; PG8_MMA(0, 0, At, B0); PG8_MMA(0, 1, At, B1); PG8_BAR; PG8_SCHED;
            PG8_LDA(At, 1, 1); PG8_STAGE(PG8_SB(1, 0), b3, voffB); PG8_STAGE(PG8_SB(1, 1), b3 + hstep, voffB); PG8_STAGE(PG8_SA(1, 0), a3, voffA);
            PG8_WAIT_V(8); PG8_WAIT_L(0); PG8_BAR; PG8_MMA(1, 0, At, B0); PG8_MMA(1, 1, At, B1); PG8_BAR; PG8_SCHED;
            } else {
            PG8_LDB(B0, 0, 0); PG8_SCHED; PG8_LDA(At, 0, 0); PG8_STAGE(PG8_SA(1, 1), a1 + hstep, voffA);
            PG8_WAIT_L(8); PG8_BAR; PG8_WAIT_L(0); PG8_MMA(0, 0, At, B0); PG8_BAR; PG8_SCHED;
            PG8_LDB(B1, 0, 1); PG8_STAGE(PG8_SB(0, 0), b2, voffB);
            PG8_BAR; PG8_WAIT_L(0); PG8_MMA(0, 1, At, B1); PG8_BAR;
            PG8_LDA(At, 0, 1); PG8_STAGE(PG8_SA(0, 0), a2, voffA);
            PG8_BAR; PG8_WAIT_L(0); PG8_MMA(1, 0, At, B0); PG8_BAR; PG8_SCHED;
            PG8_STAGE(PG8_SB(0, 1), b2 + hstep, voffB);
            PG8_WAIT_V(6); PG8_BAR; PG8_MMA(1, 1, At, B1); PG8_BAR;
            PG8_LDB(B0, 1, 0); PG8_SCHED; PG8_LDA(At, 1, 0); PG8_STAGE(PG8_SA(0, 1), a2 + hstep, voffA);
            PG8_WAIT_L(8); PG8_BAR; PG8_WAIT_L(0); PG8_MMA(0, 0, At, B0); PG8_BAR; PG8_SCHED;
            PG8_LDB(B1, 1, 1); PG8_STAGE(PG8_SB(1, 0), b3, voffB);
            PG8_BAR; PG8_WAIT_L(0); PG8_MMA(0, 1, At, B1); PG8_BAR;
            PG8_LDA(At, 1, 1); PG8_STAGE(PG8_SA(1, 0), a3, voffA);
            PG8_BAR; PG8_WAIT_L(0); PG8_MMA(1, 0, At, B0); PG8_BAR; PG8_SCHED;
            PG8_STAGE(PG8_SB(1, 1), b3 + hstep, voffB);
            PG8_WAIT_V(6); PG8_BAR; PG8_MMA(1, 1, At, B1); PG8_BAR;
            }
        }
        if constexpr (ALIGN_EPI) { if (wr == 0) PG8_BAR; }
        if constexpr (!Epi::AFTER_DRAIN) { E(acc, cur, wr, wc, fr, fq); S.done(cur); }
        if (!has_next) break;
#pragma unroll
        for (int a = 0; a < 2; ++a)
#pragma unroll
            for (int b = 0; b < 2; ++b)
#pragma unroll
                for (int m = 0; m < 4; ++m)
#pragma unroll
                    for (int n = 0; n < 2; ++n) acc[a][b][m][n] = (f32x4){0.f, 0.f, 0.f, 0.f};
        cur = nxt; cA = nA; cB = nB; ++ui;
        if constexpr (ALIGN_EPI) { if (wr == 1) PG8_BAR; }
    }
    PG8_WAIT_V(0);
    if constexpr (!ALIGN_EPI) { if (wr == 0) PG8_BAR; }
    PG8_BAR;
    if constexpr (Epi::AFTER_DRAIN) { E.fused(acc, cur, wr, wc, fr, fq, lds, wid, lane); S.done(cur); }
#undef PG8_SA
#undef PG8_SB
#undef PG8_STAGE
#undef PG8_LDA
#undef PG8_LDB
#undef PG8_MMA
#undef PG8_WAIT_V
#undef PG8_WAIT_L
#undef PG8_BAR
#undef PG8_SCHED
}
}
typedef __bf16 bf16x2_t __attribute__((ext_vector_type(2)));
typedef float f32x2_t __attribute__((ext_vector_type(2)));
typedef short bf16x8 __attribute__((ext_vector_type(8)));
typedef float f32x16 __attribute__((ext_vector_type(16)));
#define MFMA32(a, b, c) __builtin_amdgcn_mfma_f32_32x32x16_bf16((a), (b), (c), 0, 0, 0)
__device__ __forceinline__ unsigned pkbf(float a, float b) { bf16x2_t v = __builtin_convertvector((f32x2_t){a, b}, bf16x2_t); return __builtin_bit_cast(unsigned, v); }
__device__ __forceinline__ bf16x8 pack8(const f32x16& x, int s) { v4u p; p.x = pkbf(x[8 * s], x[8 * s + 1]); p.y = pkbf(x[8 * s + 2], x[8 * s + 3]); p.z = pkbf(x[8 * s + 4], x[8 * s + 5]); p.w = pkbf(x[8 * s + 6], x[8 * s + 7]); return __builtin_bit_cast(bf16x8, p); }
__device__ __forceinline__ f32x16 zero16() { f32x16 z;
#pragma unroll
    for (int i = 0; i < 16; ++i) z[i] = 0.f; return z; }
constexpr int CHUNK = 64, NCH = SEQ / CHUNK;
constexpr float QSCALE = 0.08838834764831845f;
__device__ __forceinline__ void glds_blocks(LAS unsigned char* dst, const unsigned char* src, int nblk, int wv, int nw, int lane) {
    for (int b = wv; b < nblk; b += nw)
        __builtin_amdgcn_global_load_lds((const unsigned*)(src + (size_t)b * 1024 + lane * 16), (LAS unsigned*)(dst + b * 1024), 16, 0, 0);
}
__device__ __forceinline__ void glds_blocks_asm(LAS unsigned char* dst, const unsigned char* src, int nblk, int wv, int nw, int lane) {
    for (int b = wv; b < nblk; b += nw) {
        const unsigned la = (unsigned)(size_t)(dst + b * 1024);
        asm volatile("s_mov_b32 m0, %1\n\ts_nop 0\n\tglobal_load_lds_dwordx4 %0, off" :: "v"(src + (size_t)b * 1024 + lane * 16), "s"(la) : "memory");
    }
}
__device__ __forceinline__ bf16x8 lds_frag(const LAS unsigned char* base, int blk, int lane) { return *(const LAS bf16x8*)(base + blk * 1024 + lane * 16); }

namespace gdn {
constexpr int B_KA = 0, B_QA = 16384, B_SC = 32768, B_KT = 34816, B_TBF = 51200, B_AF = 59392, B_TBB = 67584, B_AB = 75776, B_VT = 83968, BLOB = 100352;
constexpr int XBLK = 34, YBLK = 32;
}

__device__ __forceinline__ float row16_sum(float v) {
    v += __builtin_bit_cast(float, __builtin_amdgcn_mov_dpp(__builtin_bit_cast(int, v), 0xB1, 0xF, 0xF, true));
    v += __builtin_bit_cast(float, __builtin_amdgcn_mov_dpp(__builtin_bit_cast(int, v), 0x4E, 0xF, 0xF, true));
    v += __builtin_bit_cast(float, __builtin_amdgcn_mov_dpp(__builtin_bit_cast(int, v), 0x141, 0xF, 0xF, true));
    v += __builtin_bit_cast(float, __builtin_amdgcn_mov_dpp(__builtin_bit_cast(int, v), 0x140, 0xF, 0xF, true));
    return v;
}
__device__ __forceinline__ float quad_sum(float v) {
    v += __builtin_bit_cast(float, __builtin_amdgcn_mov_dpp(__builtin_bit_cast(int, v), 0xB1, 0xF, 0xF, true));
    v += __builtin_bit_cast(float, __builtin_amdgcn_mov_dpp(__builtin_bit_cast(int, v), 0x4E, 0xF, 0xF, true));
    return v;
}
struct GdnPrepArgs {
    const bf16 *pq, *pk, *pv;
    const float* small;
    const float* conv_w;
    const float *a_log_f, *a_log_b, *dtb_f, *dtb_b;
    unsigned char* blob;
    int nseq, pad_;
};
namespace gdn {
constexpr int L_PRE = 0, L_QN = 52224, L_KN = L_QN + 17408, L_SC = L_KN + 17408, L_LPF = L_SC + 1024, L_LPB = L_LPF + 16384, L_AF = L_LPB + 16384, L_AB = L_AF + 9216, L_TBF = L_AB + 9216, L_TBB = L_TBF + 9216, L_END = L_TBB + 9216;
static_assert(L_END <= 160 * 1024 - 256, "gdn prep LDS");
constexpr int QS_ = 272, AS_ = 144;

__device__ __forceinline__ v4u frag_rm_perm(const LAS unsigned char* img, int st, int rt, int ks, int lane) {
    const int r = lane & 31, hh = lane >> 5; const LAS unsigned char* p = img + (32 * rt + r) * st + (16 * ks + 4 * hh) * 2;
    const v2u lo = *(const LAS v2u*)p, hi = *(const LAS v2u*)(p + 16);
    return (v4u){lo.x, lo.y, hi.x, hi.y};
}
__device__ __forceinline__ v4u frag_tr_perm(const LAS unsigned char* img, int st, int rt, int ks, int lane) {
    const int r = lane & 31, hh = lane >> 5; const LAS unsigned char* p = img + (16 * ks + 4 * hh) * st + (32 * rt + r) * 2;
    unsigned short e[8];
#pragma unroll
    for (int j = 0; j < 8; ++j) e[j] = *(const LAS unsigned short*)(p + (8 * (j >> 2) + (j & 3)) * st);
    return (v4u){(unsigned)e[0] | ((unsigned)e[1] << 16), (unsigned)e[2] | ((unsigned)e[3] << 16), (unsigned)e[4] | ((unsigned)e[5] << 16), (unsigned)e[6] | ((unsigned)e[7] << 16)};
}
__device__ __forceinline__ v4u frag16_rm(const LAS unsigned char* img, int st, int rt, int ks, int lane) {
    const int r = lane & 15, q = lane >> 4; const LAS unsigned char* p = img + (16 * rt + r) * st + (32 * ks + 4 * q) * 2;
    const v2u lo = *(const LAS v2u*)p, hi = *(const LAS v2u*)(p + 32);
    return (v4u){lo.x, lo.y, hi.x, hi.y};
}
__device__ __forceinline__ v4u frag16_tr(const LAS unsigned char* img, int st, int rt, int ks, int lane) {
    const int r = lane & 15, q = lane >> 4; const LAS unsigned char* p = img + (32 * ks + 4 * q) * st + (16 * rt + r) * 2;
    unsigned short e[8];
#pragma unroll
    for (int j = 0; j < 8; ++j) e[j] = *(const LAS unsigned short*)(p + (16 * (j >> 2) + (j & 3)) * st);
    return (v4u){(unsigned)e[0] | ((unsigned)e[1] << 16), (unsigned)e[2] | ((unsigned)e[3] << 16), (unsigned)e[4] | ((unsigned)e[5] << 16), (unsigned)e[6] | ((unsigned)e[7] << 16)};
}
}

#define LBAR() do { asm volatile("s_waitcnt lgkmcnt(0)" ::: "memory"); __builtin_amdgcn_s_barrier(); asm volatile("" ::: "memory"); } while (0)
__device__ __forceinline__ void gdn_prep_issue(LAS unsigned char* lds, const GdnPrepArgs& A, int unit, int w, int lane, const unsigned char* zero_page) {
    using namespace gdn;
    const int n = unit % NCH, h = (unit / NCH) % 8, sq = unit / (NCH * 8); const size_t row0 = (size_t)sq * SEQ; const int t0 = n * CHUNK;
    for (int q4 = w; q4 < 51; q4 += 8) {
        const int seg = q4 * 4 + (lane >> 4), r = seg / 3, m = seg % 3, tl = t0 - 2 + r;
        const bf16* pmat = A.pq + (size_t)m * (size_t)(A.pk - A.pq);
        const unsigned char* src = (tl >= 0 && tl < SEQ) ? (const unsigned char*)(pmat + (row0 + tl) * 1024 + h * 128) : zero_page;
        __builtin_amdgcn_global_load_lds((const unsigned*)(src + (lane & 15) * 16), (LAS unsigned*)(lds + L_PRE + q4 * 1024), 16, 0, 0);
    }
}
__device__ __forceinline__ f32x4 gdn_prep_scal(const GdnPrepArgs& A, int unit, int lane) {
    const int n = unit % NCH, h = (unit / NCH) % 8, sq = unit / (NCH * 8);
    const float* sm = A.small + ((size_t)sq * SEQ + n * CHUNK + lane) * 64;
    return (f32x4){sm[h], sm[8 + h], sm[16 + h], sm[24 + h]};
}
__device__ __forceinline__ void gdn_prep_phase(LAS unsigned char* lds, const GdnPrepArgs& A, int bid, int G, const unsigned char* zero_page) {
    using namespace gdn;
    int tid_l = threadIdx.x; asm volatile("" : "+v"(tid_l));
    const int tid = tid_l, lane = tid & 63, w = __builtin_amdgcn_readfirstlane(tid >> 6);
    const int nunits = A.nseq * 8 * NCH; const int pflg = A.pad_;
    int unit = bid;
    f32x4 smn = (f32x4){0.f, 0.f, 0.f, 0.f};
    if (unit < nunits) { gdn_prep_issue(lds, A, unit, w, lane, zero_page); if (w == 0) smn = gdn_prep_scal(A, unit, lane); }
  for (; unit < nunits; unit += G) {
    const int h = (unit / NCH) % 8;
    unsigned char* blob = A.blob + (size_t)unit * BLOB;
    if (w == 0) {
        const float xf = smn.x + A.dtb_f[h], xb = smn.y + A.dtb_b[h];
        const float spf = xf > 20.f ? xf : 0.6931471805599453f * __builtin_amdgcn_logf(1.0f + __builtin_amdgcn_exp2f(1.4426950408889634f * xf));
        const float spb = xb > 20.f ? xb : 0.6931471805599453f * __builtin_amdgcn_logf(1.0f + __builtin_amdgcn_exp2f(1.4426950408889634f * xb));
        const float gf = -__expf(A.a_log_f[h]) * spf, gb = -__expf(A.a_log_b[h]) * spb;
        float pf = gf, pb = gb;
#define SCAN_STEP(ctrl, rmask) do { pf += __builtin_bit_cast(float, __builtin_amdgcn_update_dpp(0, __builtin_bit_cast(int, pf), ctrl, rmask, 0xf, false)); \
                                     pb += __builtin_bit_cast(float, __builtin_amdgcn_update_dpp(0, __builtin_bit_cast(int, pb), ctrl, rmask, 0xf, false)); } while (0)
        SCAN_STEP(0x111, 0xf); SCAN_STEP(0x112, 0xf); SCAN_STEP(0x114, 0xf); SCAN_STEP(0x118, 0xf); SCAN_STEP(0x142, 0xa); SCAN_STEP(0x143, 0xc);
#undef SCAN_STEP
        const float totb = __builtin_bit_cast(float, __builtin_amdgcn_readlane(__builtin_bit_cast(int, pb), 63));
        const float gcf = pf, gcb = totb - pb + gb;
        LAS float* sc = (LAS float*)(lds + L_SC);
        sc[lane] = gcf; sc[64 + lane] = gcb; sc[128 + lane] = sigmoidf_(smn.z); sc[192 + lane] = sigmoidf_(smn.w);
        float* gsc = (float*)(blob + B_SC); if (pflg & 8) gsc = (float*)(lds + L_LPF);
        const float glf = __builtin_bit_cast(float, __builtin_amdgcn_readlane(__builtin_bit_cast(int, pf), 63)), glb = totb;
        gsc[lane] = gcf; gsc[64 + lane] = gcb; gsc[128 + lane] = __expf(gcf); gsc[192 + lane] = __expf(gcb); gsc[256 + lane] = __expf(glf - gcf); gsc[320 + lane] = __expf(glb - gcb);
        if (lane < 2) gsc[384 + lane] = __expf(lane ? glb : glf);
    }
    __syncthreads();
    if (!(pflg & 32)) {
        const int p0 = 8 * w;
#pragma unroll
        for (int m = 0; m < 3; ++m) {
            float wc[5][2];
#pragma unroll
            for (int tau = 0; tau < 5; ++tau) { const f32x2_t t2 = *(const f32x2_t*)(A.conv_w + tau * 3072 + m * 1024 + h * 128 + 2 * lane); wc[tau][0] = t2.x; wc[tau][1] = t2.y; }
            float in[12][2];
#pragma unroll
            for (int i = 0; i < 12; ++i) { const unsigned u = *(const LAS unsigned*)(lds + L_PRE + ((p0 + i) * 3 + m) * 256 + lane * 4); in[i][0] = bflo(u); in[i][1] = bfhi(u); }
            float y[8][2];
#pragma unroll
            for (int pp = 0; pp < 8; ++pp)
#pragma unroll
                for (int c = 0; c < 2; ++c) { float s = 0.f;
#pragma unroll
                    for (int tau = 0; tau < 5; ++tau) s += wc[tau][c] * in[pp + tau][c];
                    y[pp][c] = s * __builtin_amdgcn_rcpf(1.0f + __builtin_amdgcn_exp2f(-1.4426950408889634f * s)); }
            if (m < 2) {
#pragma unroll
                for (int pp = 0; pp < 8; ++pp) { float ss = row16_sum(y[pp][0] * y[pp][0] + y[pp][1] * y[pp][1]); ss += __shfl_xor(ss, 16); ss += __shfl_xor(ss, 32); const float rn = __builtin_amdgcn_rsqf(ss + EPS);
                    *(LAS unsigned*)(lds + (m == 0 ? L_QN : L_KN) + (p0 + pp) * QS_ + lane * 4) = pkbf(y[pp][0] * rn, y[pp][1] * rn); }
            } else {
#pragma unroll
                for (int c = 0; c < 2; ++c) { v4u o; o.x = pkbf(y[0][c], y[1][c]); o.y = pkbf(y[2][c], y[3][c]); o.z = pkbf(y[4][c], y[5][c]); o.w = pkbf(y[6][c], y[7][c]);
                    if (!(pflg & 8)) *(v4u*)(blob + B_VT + (2 * lane + c) * 128 + p0 * 2) = o; }
            }
        }
    }
    __syncthreads();
    { const int un = unit + G; if (un < nunits) { gdn_prep_issue(lds, A, un, w, lane, zero_page); if (w == 0) smn = gdn_prep_scal(A, un, lane); } }
    {
        const int which = w >> 2, rt = (w >> 1) & 1, ct = w & 1, r = lane & 31, hh = lane >> 5;
        const LAS unsigned char* ia = lds + (which ? L_QN : L_KN) + (32 * rt + r) * QS_ + 16 * hh;
        const LAS unsigned char* ib = lds + L_KN + (32 * ct + r) * QS_ + 16 * hh;
        f32x16 acc = zero16();
#pragma unroll
        for (int ks = 0; ks < 8; ++ks) acc = MFMA32(*(const LAS bf16x8*)(ia + 32 * ks), *(const LAS bf16x8*)(ib + 32 * ks), acc);
        const LAS float* sc = (const LAS float*)(lds + L_SC);
        const int j = 32 * ct + r; const float gfj = sc[j], gbj = sc[64 + j];
#pragma unroll
        for (int reg = 0; reg < 16; ++reg) {
            const int i = 32 * rt + (reg & 3) + 8 * (reg >> 2) + 4 * hh; const float val = acc[reg];
            const float ef = __expf(sc[i] - gfj), eb = __expf(sc[64 + i] - gbj);
            if (which == 0) {
                const float lf = (i > j) ? sc[128 + i] * val * ef : 0.f, lb = (i < j) ? sc[192 + i] * val * eb : 0.f;
                ((LAS float*)(lds + L_LPF))[i * 64 + (j & 3) * 16 + (j >> 2)] = lf;
                const int i2 = 63 - i, j2 = 63 - j;
                ((LAS float*)(lds + L_LPB))[i2 * 64 + (j2 & 3) * 16 + (j2 >> 2)] = lb;
            } else {
                const float af = (i >= j) ? QSCALE * val * ef : 0.f, ab = (i <= j) ? QSCALE * val * eb : 0.f;
                *(LAS unsigned short*)(lds + L_AF + i * AS_ + j * 2) = (unsigned short)(pkbf(af, 0.f) & 0xffffu);
                *(LAS unsigned short*)(lds + L_AB + i * AS_ + j * 2) = (unsigned short)(pkbf(ab, 0.f) & 0xffffu);
            }
        }
    }
    LBAR();
    if (!(pflg & 16)) {
        const int dir = w >> 2, li = (w & 3) * 64 + lane, j = li >> 2, q = li & 3;
        const LAS float* LP = (const LAS float*)(lds + (dir ? L_LPB : L_LPF)) + q * 16;
        float t[16];
#pragma unroll
        for (int a = 0; a < 16; ++a) t[a] = 0.f;
        f32x4 lq[3][4];
#define SOLVE_LD(i_) do { _Pragma("unroll") for (int a4 = 0; a4 < ((i_) + 15) / 16; ++a4) lq[(i_) % 3][a4] = *(const LAS f32x4*)(LP + (i_) * 64 + 4 * a4); } while (0)
        SOLVE_LD(0); SOLVE_LD(1);
#pragma unroll
        for (int i = 0; i < 64; ++i) {
            if (i + 2 < 48) SOLVE_LD(i + 2);
            else if (i + 1 >= 48 && i + 1 < 64) SOLVE_LD(i + 1);
            float p0 = 0.f, p1 = 0.f;
#pragma unroll
            for (int a4 = 0; a4 < (i + 15) / 16; ++a4) { const f32x4 lv = lq[i % 3][a4];
                p0 = __builtin_fmaf(lv.x, t[4 * a4], p0); p1 = __builtin_fmaf(lv.y, t[4 * a4 + 1], p1); p0 = __builtin_fmaf(lv.z, t[4 * a4 + 2], p0); p1 = __builtin_fmaf(lv.w, t[4 * a4 + 3], p1); }
            float p = quad_sum(p0 + p1);
            const float ti = (i == j ? 1.f : 0.f) - p;
            if (q == (i & 3)) t[i >> 2] = ti;
            __builtin_amdgcn_sched_barrier(0);
        }
#undef SOLVE_LD
        const LAS float* sc = (const LAS float*)(lds + L_SC);
        if (dir == 0) { const float bj = sc[128 + j];
#pragma unroll
            for (int a = 0; a < 16; ++a) *(LAS unsigned short*)(lds + L_TBF + (4 * a + q) * AS_ + j * 2) = (unsigned short)(pkbf(t[a] * bj, 0.f) & 0xffffu);
        } else { const int jo = 63 - j; const float bj = sc[192 + jo];
#pragma unroll
            for (int a = 0; a < 16; ++a) *(LAS unsigned short*)(lds + L_TBB + (63 - (4 * a + q)) * AS_ + jo * 2) = (unsigned short)(pkbf(t[a] * bj, 0.f) & 0xffffu);
        }
    }
    LBAR();
    if (!(pflg & 64)) for (int blk = w; blk < 80; blk += 8) {
        v4u f; int off;
        if (blk < 16)      { f = frag16_rm(lds + L_KN, QS_, blk >> 2, blk & 3, lane); off = B_KA + blk * 1024; }
        else if (blk < 32) { const int b = blk - 16; f = frag16_rm(lds + L_QN, QS_, b >> 2, b & 3, lane); off = B_QA + b * 1024; }
        else if (blk < 48) { const int b = blk - 32; f = frag16_tr(lds + L_KN, QS_, b >> 1, b & 1, lane); off = B_KT + b * 1024; }
        else { const int b = blk - 48, wh = b >> 3, bb = b & 7; const int lo = wh == 0 ? L_TBF : wh == 1 ? L_AF : wh == 2 ? L_TBB : L_AB;
               f = frag16_rm(lds + lo, AS_, bb >> 1, bb & 1, lane); off = B_TBF + b * 1024; }
        if (!(pflg & 8)) *(v4u*)(blob + off + lane * 16) = f; else asm volatile("" :: "v"(f));
    }
    LBAR();
  }
}
struct GdnChainArgs {
    const unsigned char* blob;
    unsigned char* stg;
    unsigned* flag;
    int nseq, flags;
};
namespace gdn { constexpr int C_Y = XBLK * 1024, C_BUF = C_Y + YBLK * 1024, C_END = 2 * C_BUF; }
#define CHAIN_SPIN_CAP (1u << 22)
#define MFMA16(a, b, c) __builtin_amdgcn_mfma_f32_16x16x32_bf16((a), (b), (c), 0, 0, 0)
__device__ __forceinline__ bf16x8 pack16(const f32x4& a, const f32x4& b) { v4u p; p.x = pkbf(a.x, a.y); p.y = pkbf(a.z, a.w); p.z = pkbf(b.x, b.y); p.w = pkbf(b.z, b.w); return __builtin_bit_cast(bf16x8, p); }

__device__ __forceinline__ void gdn_chain_unit(LAS unsigned char* lds, const GdnChainArgs& A, int item) {
    using namespace gdn;
    int tid_l = threadIdx.x; asm volatile("" : "+v"(tid_l));
    const int tid = tid_l, lane = tid & 63, w = __builtin_amdgcn_readfirstlane(tid >> 6);
    const int r = lane & 15, q = lane >> 4;
    const int c = item & 1, h = (item >> 1) & 7, sq = item >> 4; const int flags = A.flags;
    const size_t unit0 = (size_t)(sq * 8 + h) * NCH;
    const f32x4 z4 = (f32x4){0.f, 0.f, 0.f, 0.f};
    f32x4 S[8];
#pragma unroll
    for (int t = 0; t < 8; ++t) S[t] = z4;
    v2u vnext[4];
    unsigned long long pwn[4]; bool have = false; unsigned fnext = 0u;
#define GDN_ISSUE(s_, buf_) do { const int n_ = c ? NCH - 1 - (s_) : (s_); const unsigned char* bl_ = A.blob + (unit0 + n_) * BLOB; LAS unsigned char* d_ = lds + (buf_) * C_BUF; \
        { const unsigned char* vp_ = bl_ + B_VT + (16 * w + r) * 128 + 8 * q; _Pragma("unroll") for (int i = 0; i < 4; ++i) vnext[i] = *(const v2u*)(vp_ + 32 * i); } \
        if (!(flags & 4)) { glds_blocks_asm(d_, bl_, XBLK, w, 8, lane); \
            if (c == 0) glds_blocks_asm(d_ + C_Y, bl_ + B_KT, YBLK, w, 8, lane); \
            else { glds_blocks_asm(d_ + C_Y, bl_ + B_KT, 16, w, 8, lane); glds_blocks_asm(d_ + C_Y + 16384, bl_ + B_TBB, 16, w, 8, lane); } } } while (0)
    GDN_ISSUE(0, 0);
    __builtin_amdgcn_s_waitcnt(0x0F70);
    __syncthreads();
    for (int s = 0; s < NCH; ++s) {
        const int n = c ? NCH - 1 - s : s;
        v2u vcur[4];
#pragma unroll
        for (int i = 0; i < 4; ++i) vcur[i] = vnext[i];
        unsigned long long* sp = (unsigned long long*)(A.stg + (unit0 + n) * 16384 + w * 2048) + lane;
        unsigned* fl = A.flag + (unit0 + n) * 8 + w;
        unsigned long long pw[4];
        if (s >= NCH / 2 && !(flags & 1)) {
            if (have) {
#pragma unroll
                for (int i = 0; i < 4; ++i) pw[i] = pwn[i];
            } else {
                for (unsigned sp_ = 0; __builtin_amdgcn_readfirstlane((int)__hip_atomic_load(fl, __ATOMIC_RELAXED, __HIP_MEMORY_SCOPE_AGENT)) == 0 && sp_ < CHAIN_SPIN_CAP; ++sp_) __builtin_amdgcn_s_sleep(2);
#pragma unroll
                for (int i = 0; i < 4; ++i) pw[i] = __hip_atomic_load(sp + i * 64, __ATOMIC_RELAXED, __HIP_MEMORY_SCOPE_AGENT);
                __builtin_amdgcn_s_waitcnt(0x0F70);
            }
        }
        have = false;
        if (s + 1 >= NCH / 2 && s + 1 < NCH && !(flags & 1) && __builtin_amdgcn_readfirstlane((int)fnext) != 0) {
            const int n1 = c ? NCH - 2 - s : s + 1; const unsigned long long* sp1 = (const unsigned long long*)(A.stg + (unit0 + n1) * 16384 + w * 2048) + lane;
#pragma unroll
            for (int i = 0; i < 4; ++i) pwn[i] = __hip_atomic_load(sp1 + i * 64, __ATOMIC_RELAXED, __HIP_MEMORY_SCOPE_AGENT);
            have = true;
        }
        if (s + 2 >= NCH / 2 && s + 2 < NCH && !(flags & 1)) { const int n2 = c ? NCH - 3 - s : s + 2; fnext = __hip_atomic_load(A.flag + (unit0 + n2) * 8 + w, __ATOMIC_RELAXED, __HIP_MEMORY_SCOPE_AGENT); }
        if (s + 1 < NCH) GDN_ISSUE(s + 1, (s + 1) & 1);
        const LAS unsigned char* X = lds + (s & 1) * C_BUF; const LAS unsigned char* Y = X + C_Y; const LAS unsigned char* YT = Y + 16384;
        const LAS float* sc = (const LAS float*)(X + B_SC);
        bf16x8 sb[4];
#pragma unroll
        for (int k = 0; k < 4; ++k) sb[k] = pack16(S[2 * k], S[2 * k + 1]);
        f32x4 KS[4], QS[4];
#pragma unroll
        for (int rt = 0; rt < 4; ++rt) { KS[rt] = z4; QS[rt] = z4; }
        {
            constexpr int R = 8; bf16x8 ring[R];
#define G1_LD(i_) lds_frag(X + (((i_) & 1) ? B_QA : B_KA), ((i_) >> 3) * 4 + (((i_) >> 1) & 3), lane)
#pragma unroll
            for (int i = 0; i < R; ++i) ring[i] = G1_LD(i);
#pragma unroll
            for (int i = 0; i < 32; ++i) { const int rt = i >> 3, ks = (i >> 1) & 3;
                if (i & 1) QS[rt] = MFMA16(ring[i % R], sb[ks], QS[rt]); else KS[rt] = MFMA16(ring[i % R], sb[ks], KS[rt]);
                if (i + R < 32) ring[i % R] = G1_LD(i + R);
                __builtin_amdgcn_sched_barrier(0); }
#undef G1_LD
        }
#pragma unroll
        for (int rt = 0; rt < 4; ++rt) { const v2u vv = vcur[rt]; const f32x4 ev = *(const LAS f32x4*)(sc + 128 + c * 64 + 16 * rt + 4 * q);
            KS[rt].x = bflo(vv.x) - ev.x * KS[rt].x; KS[rt].y = bfhi(vv.x) - ev.y * KS[rt].y; KS[rt].z = bflo(vv.y) - ev.z * KS[rt].z; KS[rt].w = bfhi(vv.y) - ev.w * KS[rt].w; }
        bf16x8 rb[2] = {pack16(KS[0], KS[1]), pack16(KS[2], KS[3])};
        f32x4 vn[4];
#pragma unroll
        for (int rt = 0; rt < 4; ++rt) vn[rt] = z4;
        {   constexpr int R = 8; bf16x8 ring[R];
#pragma unroll
            for (int i = 0; i < R; ++i) ring[i] = lds_frag(YT, i, lane);
#pragma unroll
            for (int i = 0; i < 8; ++i) { vn[i >> 1] = MFMA16(ring[i], rb[i & 1], vn[i >> 1]); __builtin_amdgcn_sched_barrier(0); }
        }
        bf16x8 vb[2] = {pack16(vn[0], vn[1]), pack16(vn[2], vn[3])};
        f32x4 (&o)[4] = QS;
#pragma unroll
        for (int rt = 0; rt < 4; ++rt) { const f32x4 ev = *(const LAS f32x4*)(sc + 128 + c * 64 + 16 * rt + 4 * q);
            o[rt].x *= QSCALE * ev.x; o[rt].y *= QSCALE * ev.y; o[rt].z *= QSCALE * ev.z; o[rt].w *= QSCALE * ev.w; }
        {   constexpr int R = 8; bf16x8 ring[R];
#pragma unroll
            for (int i = 0; i < R; ++i) ring[i] = lds_frag(YT + 8192, i, lane);
#pragma unroll
            for (int i = 0; i < 8; ++i) { o[i >> 1] = MFMA16(ring[i], vb[i & 1], o[i >> 1]); __builtin_amdgcn_sched_barrier(0); }
        }
        if (!(flags & 1)) {
            if (s < NCH / 2) {
#pragma unroll
                for (int rt = 0; rt < 4; ++rt) __hip_atomic_store(sp + rt * 64, (unsigned long long)pkbf(o[rt].x, o[rt].y) | ((unsigned long long)pkbf(o[rt].z, o[rt].w) << 32), __ATOMIC_RELAXED, __HIP_MEMORY_SCOPE_AGENT);
            } else {
#pragma unroll
                for (int rt = 0; rt < 4; ++rt) { const unsigned plo = (unsigned)pw[rt], phi = (unsigned)(pw[rt] >> 32);
                    __hip_atomic_store(sp + rt * 64, (unsigned long long)pkbf(o[rt].x + bflo(plo), o[rt].y + bfhi(plo)) | ((unsigned long long)pkbf(o[rt].z + bflo(phi), o[rt].w + bfhi(phi)) << 32), __ATOMIC_RELAXED, __HIP_MEMORY_SCOPE_AGENT); }
            }
        }
#pragma unroll
        for (int rt = 0; rt < 4; ++rt) { const f32x4 ev = *(const LAS f32x4*)(sc + 256 + c * 64 + 16 * rt + 4 * q);
            vn[rt].x *= ev.x; vn[rt].y *= ev.y; vn[rt].z *= ev.z; vn[rt].w *= ev.w; }
        vb[0] = pack16(vn[0], vn[1]); vb[1] = pack16(vn[2], vn[3]);
        const float egl = sc[384 + c];
#pragma unroll
        for (int t = 0; t < 8; ++t) { S[t].x *= egl; S[t].y *= egl; S[t].z *= egl; S[t].w *= egl; }
        {   constexpr int R = 8; bf16x8 ring[R];
#pragma unroll
            for (int i = 0; i < R; ++i) ring[i] = lds_frag(Y, i, lane);
#pragma unroll
            for (int i = 0; i < 16; ++i) { S[i >> 1] = MFMA16(ring[i % R], vb[i & 1], S[i >> 1]); if (i + R < 16) ring[i % R] = lds_frag(Y, i + R, lane); __builtin_amdgcn_sched_barrier(0); }
        }
        __builtin_amdgcn_s_waitcnt(0x0F70);
        if (!(flags & 1) && lane == 0) __hip_atomic_store(fl, s < NCH / 2 ? 1u : 2u, __ATOMIC_RELAXED, __HIP_MEMORY_SCOPE_AGENT);
        __syncthreads();
    }
#undef GDN_ISSUE
}
namespace gla {
constexpr int B_QGF = 0, B_QGB = 16384, B_SC = 32768, B_KDTF = 33792, B_KDTB = 50176, BLOBA = 66560;
constexpr int B_VB = 0, B_INTRA = 32768, BLOBB = 65536;
constexpr int L_R = 0, L_QGF = 8192, L_KGF = L_QGF + 17408, L_KDF = L_KGF + 17408, L_QGB = L_KDF + 17408, L_KGB = L_QGB + 17408, L_KDB = L_KGB + 17408, L_V = L_KDB + 17408, L_TOT = L_V + 33792, L_AS = L_TOT + 4096, L_END = L_AS + 9216;
static_assert(L_END <= 160 * 1024 - 256, "gla prep LDS");
constexpr int QS_ = 272, VS_ = 528, AS_ = 144;
constexpr int C_X = 0, C_Y = 17408, C_CHAIN = 66560, C_EG = 2 * C_CHAIN, C_END = C_EG + 1024;
__device__ __forceinline__ v4u frag_tr_nat(const LAS unsigned char* img, int st, int colbase, int ks, int lane) {
    const int r = lane & 31, hh = lane >> 5; const LAS unsigned char* p = img + (16 * ks + 8 * hh) * st + (colbase + r) * 2;
    unsigned short e[8];
#pragma unroll
    for (int j = 0; j < 8; ++j) e[j] = *(const LAS unsigned short*)(p + j * st);
    return (v4u){(unsigned)e[0] | ((unsigned)e[1] << 16), (unsigned)e[2] | ((unsigned)e[3] << 16), (unsigned)e[4] | ((unsigned)e[5] << 16), (unsigned)e[6] | ((unsigned)e[7] << 16)};
}
__device__ __forceinline__ float logsig2(float x) { const float xc = fminf(fmaxf(x, -60.f), 60.f); return -__builtin_amdgcn_logf(1.0f + __builtin_amdgcn_exp2f(-1.4426950408889634f * xc)); }
}

struct GlaPrepArgs {
    const bf16* qk;
    const bf16* vb;
    const float* small;
    const float *w2f, *b2f, *w2b, *b2b;
    unsigned char* blobA;
    unsigned char* blobB;
    int nseq, pad_;
};

__device__ __forceinline__ void gla_prep_phase(LAS unsigned char* lds, const GlaPrepArgs& A, int bid, int G) {
    using namespace gla;
    int tid_l = threadIdx.x; asm volatile("" : "+v"(tid_l));
    const int tid = tid_l, lane = tid & 63, w = __builtin_amdgcn_readfirstlane(tid >> 6);
    const int nunits = A.nseq * 4 * NCH;
    f32x4 pr; v4u pv[4], pq[2], pk[2];
#define GLA_PREFETCH(u_) do { const int n_ = (u_) % NCH, h_ = ((u_) / NCH) % 4, sq_ = (u_) / (NCH * 4); const size_t r_ = (size_t)sq_ * SEQ + n_ * CHUNK; \
        pr = *(const f32x4*)(A.small + (r_ + (tid >> 3)) * 64 + 32 + (tid & 7) * 4); \
        _Pragma("unroll") for (int i = 0; i < 4; ++i) { const int id = i * 512 + tid; pv[i] = *(const v4u*)(A.vb + (r_ + (id >> 5)) * 1024 + h_ * 256 + (id & 31) * 8); } \
        _Pragma("unroll") for (int i = 0; i < 2; ++i) { const int id = i * 512 + tid; const bf16* qp_ = A.qk + (r_ + (id >> 4)) * 1024 + h_ * 128 + (id & 15) * 8; pq[i] = *(const v4u*)qp_; pk[i] = *(const v4u*)(qp_ + 512); } } while (0)
    int unit = bid;
    if (unit < nunits) GLA_PREFETCH(unit);
  for (; unit < nunits; unit += G) {
    const int h = (unit / NCH) % 4;
    unsigned char* blob = A.blobA + (size_t)unit * BLOBA; unsigned char* blobB = A.blobB + (size_t)unit * BLOBB;
    *(LAS f32x4*)(lds + L_R + (tid >> 3) * 128 + (tid & 7) * 16) = pr;
#pragma unroll
    for (int i = 0; i < 4; ++i) { const int id = i * 512 + tid; *(LAS v4u*)(lds + L_V + (id >> 5) * VS_ + (id & 31) * 16) = pv[i]; }
#pragma unroll
    for (int i = 0; i < 2; ++i) { const int id = i * 512 + tid; *(LAS v4u*)(lds + L_QGF + (id >> 4) * QS_ + (id & 15) * 16) = pq[i]; *(LAS v4u*)(lds + L_KGF + (id >> 4) * QS_ + (id & 15) * 16) = pk[i]; }
    LBAR();
    {
        const int dd = tid & 127, pg = tid >> 7, d = h * 128 + dd;
        float wf[16], wb[16];
#pragma unroll
        for (int i = 0; i < 16; ++i) { wf[i] = A.w2f[i * 512 + d]; wb[i] = A.w2b[i * 512 + d]; }
        const float bf_ = A.b2f[d], bb_ = A.b2b[d];
        float lf[16], lb[16];
#pragma unroll
        for (int pp = 0; pp < 16; ++pp) {
            const LAS float* rr = (const LAS float*)(lds + L_R) + (pg * 16 + pp) * 32;
            float xf = bf_, xb = bb_;
#pragma unroll
            for (int i4 = 0; i4 < 4; ++i4) { const f32x4 a = *(const LAS f32x4*)(rr + 4 * i4), b = *(const LAS f32x4*)(rr + 16 + 4 * i4);
                xf += a.x * wf[4 * i4] + a.y * wf[4 * i4 + 1] + a.z * wf[4 * i4 + 2] + a.w * wf[4 * i4 + 3];
                xb += b.x * wb[4 * i4] + b.y * wb[4 * i4 + 1] + b.z * wb[4 * i4 + 2] + b.w * wb[4 * i4 + 3]; }
            lf[pp] = logsig2(xf) * (1.f / 16.f); lb[pp] = logsig2(xb) * (1.f / 16.f);
        }
#pragma unroll
        for (int pp = 1; pp < 16; ++pp) lf[pp] += lf[pp - 1];
#pragma unroll
        for (int pp = 14; pp >= 0; --pp) lb[pp] += lb[pp + 1];
        LAS float* tot = (LAS float*)(lds + L_TOT);
        tot[pg * 128 + dd] = lf[15]; tot[512 + pg * 128 + dd] = lb[0];
        LBAR();
        float offf = 0.f, offb = 0.f, glf = 0.f, glb = 0.f;
#pragma unroll
        for (int g = 0; g < 4; ++g) { const float tf = tot[g * 128 + dd], tb = tot[512 + g * 128 + dd]; glf += tf; glb += tb; if (g < pg) offf += tf; if (g > pg) offb += tb; }
        const float eglf = __builtin_amdgcn_exp2f(glf), eglb = __builtin_amdgcn_exp2f(glb);
        if (pg == 0) { float* sc = (float*)(blob + B_SC); sc[dd] = eglf; sc[128 + dd] = eglb; }
#pragma unroll
        for (int pp = 0; pp < 16; ++pp) {
            const int o = (pg * 16 + pp) * QS_ + dd * 2;
            const float qv = bf2f(*(const LAS unsigned short*)(lds + L_QGF + o)) * QSCALE, kv = bf2f(*(const LAS unsigned short*)(lds + L_KGF + o));
            const float ef = __builtin_amdgcn_exp2f(lf[pp] + offf), eb = __builtin_amdgcn_exp2f(lb[pp] + offb);
            const float rf = __builtin_amdgcn_rcpf(ef), rb = __builtin_amdgcn_rcpf(eb);
            *(LAS unsigned short*)(lds + L_QGF + o) = (unsigned short)(pkbf(qv * ef, 0.f) & 0xffffu);
            *(LAS unsigned short*)(lds + L_KGF + o) = (unsigned short)(pkbf(kv * rf, 0.f) & 0xffffu);
            *(LAS unsigned short*)(lds + L_KDF + o) = (unsigned short)(pkbf(kv * rf * eglf, 0.f) & 0xffffu);
            *(LAS unsigned short*)(lds + L_QGB + o) = (unsigned short)(pkbf(qv * eb, 0.f) & 0xffffu);
            *(LAS unsigned short*)(lds + L_KGB + o) = (unsigned short)(pkbf(kv * rb, 0.f) & 0xffffu);
            *(LAS unsigned short*)(lds + L_KDB + o) = (unsigned short)(pkbf(kv * rb * eglb, 0.f) & 0xffffu);
        }
    }
    LBAR();
    { const int un = unit + G; if (un < nunits) GLA_PREFETCH(un); }
    if (w < 4) {
        const int rt = w >> 1, ct = w & 1, r = lane & 31, hh = lane >> 5;
        f32x16 af = zero16(), ab = zero16();
        if (rt >= ct) { const LAS unsigned char* ia = lds + L_QGF + (32 * rt + r) * QS_ + 16 * hh; const LAS unsigned char* ib = lds + L_KGF + (32 * ct + r) * QS_ + 16 * hh;
#pragma unroll
            for (int ks = 0; ks < 8; ++ks) af = MFMA32(*(const LAS bf16x8*)(ia + 32 * ks), *(const LAS bf16x8*)(ib + 32 * ks), af); }
        if (rt <= ct) { const LAS unsigned char* ia = lds + L_QGB + (32 * rt + r) * QS_ + 16 * hh; const LAS unsigned char* ib = lds + L_KGB + (32 * ct + r) * QS_ + 16 * hh;
#pragma unroll
            for (int ks = 0; ks < 8; ++ks) ab = MFMA32(*(const LAS bf16x8*)(ia + 32 * ks), *(const LAS bf16x8*)(ib + 32 * ks), ab); }
        const int j = 32 * ct + r;
#pragma unroll
        for (int reg = 0; reg < 16; ++reg) { const int i = 32 * rt + (reg & 3) + 8 * (reg >> 2) + 4 * hh;
            const float val = (i >= j ? af[reg] : 0.f) + (i <= j ? ab[reg] : 0.f);
            *(LAS unsigned short*)(lds + L_AS + i * AS_ + j * 2) = (unsigned short)(pkbf(val, 0.f) & 0xffffu); }
    } else {
        for (int blk = w - 4; blk < 64; blk += 4) {
            const int wh = blk >> 4, b = blk & 15; v4u f; int off;
            if (wh == 0)      { f = gdn::frag_rm_perm(lds + L_QGF, QS_, b >> 3, b & 7, lane); off = B_QGF; }
            else if (wh == 1) { f = gdn::frag_rm_perm(lds + L_QGB, QS_, b >> 3, b & 7, lane); off = B_QGB; }
            else if (wh == 2) { f = frag_tr_nat(lds + L_KDF, QS_, 32 * (b >> 2), b & 3, lane); off = B_KDTF; }
            else              { f = frag_tr_nat(lds + L_KDB, QS_, 32 * (b >> 2), b & 3, lane); off = B_KDTB; }
            *(v4u*)(blob + off + b * 1024 + lane * 16) = f;
        }
    }
    LBAR();
    {
        const int ct = w, r = lane & 31, hh = lane >> 5;
        f32x16 o[2] = {zero16(), zero16()};
#pragma unroll
        for (int ks = 0; ks < 4; ++ks) {
            const v4u fb = frag_tr_nat(lds + L_V, VS_, 32 * ct, ks, lane);
            *(v4u*)(blobB + B_VB + (ct * 4 + ks) * 1024 + lane * 16) = fb;
            const bf16x8 bfr = __builtin_bit_cast(bf16x8, fb);
#pragma unroll
            for (int rt = 0; rt < 2; ++rt) o[rt] = MFMA32(*(const LAS bf16x8*)(lds + L_AS + (32 * rt + r) * AS_ + (16 * ks + 8 * hh) * 2), bfr, o[rt]);
        }
        unsigned long long* ip = (unsigned long long*)(blobB + B_INTRA) + (size_t)ct * 512 + lane;
#pragma unroll
        for (int rt = 0; rt < 2; ++rt)
#pragma unroll
            for (int g = 0; g < 4; ++g) ip[(rt * 4 + g) * 64] = (unsigned long long)pkbf(o[rt][4 * g], o[rt][4 * g + 1]) | ((unsigned long long)pkbf(o[rt][4 * g + 2], o[rt][4 * g + 3]) << 32);
    }
    LBAR();
  }
#undef GLA_PREFETCH
}

struct GlaChainArgs {
    const unsigned char* blobA;
    const unsigned char* blobB;
    unsigned char* stg;
    unsigned* flag;
    int nseq, flags;
};
namespace gla { constexpr int CB_Y = 17408, CB_BUF = 66560, CB_END = 2 * CB_BUF; }
__device__ __forceinline__ void gla_chain_unit(LAS unsigned char* lds, const GlaChainArgs& A, int item) {
    using namespace gla;
    int tid_l = threadIdx.x; asm volatile("" : "+v"(tid_l));
    const int tid = tid_l, lane = tid & 63, w = __builtin_amdgcn_readfirstlane(tid >> 6);
    const int hh = lane >> 5;
    const int c = item & 1, h = (item >> 1) & 3, sq = item >> 3; const int flags = A.flags;
    const size_t unit0 = (size_t)(sq * 4 + h) * NCH;
    f32x16 S[4];
#pragma unroll
    for (int t = 0; t < 4; ++t) S[t] = zero16();
    unsigned long long pwn[8]; bool have = false; unsigned fnext = 0u;
#define GLA_ISSUE(s_, buf_) do { if (!(flags & 4)) { const int n_ = c ? NCH - 1 - (s_) : (s_); const unsigned char* bl_ = A.blobA + (unit0 + n_) * BLOBA; const unsigned char* bb_ = A.blobB + (unit0 + n_) * BLOBB; \
        LAS unsigned char* d_ = lds + (buf_) * CB_BUF; glds_blocks_asm(d_, bl_ + (c ? B_QGB : B_QGF), 16, w, 8, lane); if (w == 7) glds_blocks_asm(d_ + 16384, bl_ + B_SC, 1, 0, 1, lane); \
        glds_blocks_asm(d_ + CB_Y, bl_ + (c ? B_KDTB : B_KDTF), 16, w, 8, lane); glds_blocks_asm(d_ + CB_Y + 16384, bb_ + B_VB, 32, w, 8, lane); } } while (0)
    GLA_ISSUE(0, 0);
    __builtin_amdgcn_s_waitcnt(0x0F70);
    __syncthreads();
    for (int s = 0; s < NCH; ++s) {
        const int n = c ? NCH - 1 - s : s;
        unsigned long long* sp = (unsigned long long*)(A.stg + (unit0 + n) * 32768) + (size_t)w * 512 + lane;
        unsigned* fl = A.flag + (unit0 + n) * 8 + w;
        unsigned long long pw[8];
        if (s >= NCH / 2 && !(flags & 1)) {
            if (have) {
#pragma unroll
                for (int i = 0; i < 8; ++i) pw[i] = pwn[i];
            } else {
                for (unsigned sp_ = 0; __builtin_amdgcn_readfirstlane((int)__hip_atomic_load(fl, __ATOMIC_RELAXED, __HIP_MEMORY_SCOPE_AGENT)) == 0 && sp_ < CHAIN_SPIN_CAP; ++sp_) __builtin_amdgcn_s_sleep(2);
#pragma unroll
                for (int i = 0; i < 8; ++i) pw[i] = __hip_atomic_load(sp + i * 64, __ATOMIC_RELAXED, __HIP_MEMORY_SCOPE_AGENT);
                __builtin_amdgcn_s_waitcnt(0x0F70);
            }
        }
        have = false;
        if (s + 1 >= NCH / 2 && s + 1 < NCH && !(flags & 1) && __builtin_amdgcn_readfirstlane((int)fnext) != 0) {
            const int n1 = c ? NCH - 2 - s : s + 1; const unsigned long long* sp1 = (const unsigned long long*)(A.stg + (unit0 + n1) * 32768) + (size_t)w * 512 + lane;
#pragma unroll
            for (int i = 0; i < 8; ++i) pwn[i] = __hip_atomic_load(sp1 + i * 64, __ATOMIC_RELAXED, __HIP_MEMORY_SCOPE_AGENT);
            have = true;
        }
        if (s + 2 >= NCH / 2 && s + 2 < NCH && !(flags & 1)) { const int n2 = c ? NCH - 3 - s : s + 2; fnext = __hip_atomic_load(A.flag + (unit0 + n2) * 8 + w, __ATOMIC_RELAXED, __HIP_MEMORY_SCOPE_AGENT); }
        if (s + 1 < NCH) GLA_ISSUE(s + 1, (s + 1) & 1);
        const LAS unsigned char* X = lds + (s & 1) * CB_BUF; const LAS unsigned char* Y = X + CB_Y;
        const LAS float* EG = (const LAS float*)(X + 16384) + c * 128;
        bf16x8 sb[8];
#pragma unroll
        for (int t = 0; t < 4; ++t) { sb[2 * t] = pack8(S[t], 0); sb[2 * t + 1] = pack8(S[t], 1); }
        f32x16 o[2] = {zero16(), zero16()};
        {   constexpr int R = 6; bf16x8 ring[R];
#pragma unroll
            for (int i = 0; i < R; ++i) ring[i] = lds_frag(X, i, lane);
#pragma unroll
            for (int i = 0; i < 16; ++i) { o[i >> 3] = MFMA32(ring[i % R], sb[i & 7], o[i >> 3]); if (i + R < 16) ring[i % R] = lds_frag(X, i + R, lane); __builtin_amdgcn_sched_barrier(0); }
        }
        if (!(flags & 1)) {
            if (s < NCH / 2) {
#pragma unroll
                for (int rt = 0; rt < 2; ++rt)
#pragma unroll
                    for (int g = 0; g < 4; ++g) __hip_atomic_store(sp + (rt * 4 + g) * 64, (unsigned long long)pkbf(o[rt][4 * g], o[rt][4 * g + 1]) | ((unsigned long long)pkbf(o[rt][4 * g + 2], o[rt][4 * g + 3]) << 32), __ATOMIC_RELAXED, __HIP_MEMORY_SCOPE_AGENT);
            } else {
#pragma unroll
                for (int rt = 0; rt < 2; ++rt)
#pragma unroll
                    for (int g = 0; g < 4; ++g) { const unsigned plo = (unsigned)pw[rt * 4 + g], phi = (unsigned)(pw[rt * 4 + g] >> 32);
                        __hip_atomic_store(sp + (rt * 4 + g) * 64, (unsigned long long)pkbf(o[rt][4 * g] + bflo(plo), o[rt][4 * g + 1] + bfhi(plo)) | ((unsigned long long)pkbf(o[rt][4 * g + 2] + bflo(phi), o[rt][4 * g + 3] + bfhi(phi)) << 32), __ATOMIC_RELAXED, __HIP_MEMORY_SCOPE_AGENT); }
            }
        }
        {
            bf16x8 bfr[4];
#pragma unroll
            for (int ks = 0; ks < 4; ++ks) bfr[ks] = lds_frag(Y + 16384, w * 4 + ks, lane);
#pragma unroll
            for (int t = 0; t < 4; ++t)
#pragma unroll
                for (int g = 0; g < 4; ++g) { const f32x4 ev = *(const LAS f32x4*)(EG + 32 * t + 8 * g + 4 * hh);
                    S[t][4 * g] *= ev.x; S[t][4 * g + 1] *= ev.y; S[t][4 * g + 2] *= ev.z; S[t][4 * g + 3] *= ev.w; }
            constexpr int R = 5; bf16x8 ring[R];
#pragma unroll
            for (int i = 0; i < R; ++i) ring[i] = lds_frag(Y, i, lane);
#pragma unroll
            for (int i = 0; i < 16; ++i) { S[i >> 2] = MFMA32(ring[i % R], bfr[i & 3], S[i >> 2]); if (i + R < 16) ring[i % R] = lds_frag(Y, i + R, lane); __builtin_amdgcn_sched_barrier(0); }
        }
        __builtin_amdgcn_s_waitcnt(0x0F70);
        if (!(flags & 1) && lane == 0) __hip_atomic_store(fl, s < NCH / 2 ? 1u : 2u, __ATOMIC_RELAXED, __HIP_MEMORY_SCOPE_AGENT);
        __syncthreads();
    }
#undef GLA_ISSUE
}

template <int NC, bool S16>
__device__ __forceinline__ void p4_unit(LAS unsigned char* lds, const unsigned char* slot, const unsigned char* intra, const bf16* zg, const float* nw, bf16* out, const unsigned* done) {
    int tid_l = threadIdx.x; asm volatile("" : "+v"(tid_l));
    const int tid = tid_l, lane = tid & 63, w = __builtin_amdgcn_readfirstlane(tid >> 6), r = lane & 31, hh = lane >> 5;
    constexpr int ST = NC * 2 + 16, NB = (NC / 32) * 8, CPR = NC / 8;
    if (done) {
        for (unsigned sp_ = 0; sp_ < (1u << 22); ++sp_) { const unsigned f = lane < 8 ? __hip_atomic_load(done + lane, __ATOMIC_RELAXED, __HIP_MEMORY_SCOPE_AGENT) : 2u; if (__all(f == 2u)) break; __builtin_amdgcn_s_sleep(8); }
    }
    for (int b = w; b < NB; b += 8) {
        const unsigned long long v = __hip_atomic_load((const unsigned long long*)slot + b * 64 + lane, __ATOMIC_RELAXED, __HIP_MEMORY_SCOPE_AGENT);
        float x0 = bflo((unsigned)v), x1 = bfhi((unsigned)v), x2 = bflo((unsigned)(v >> 32)), x3 = bfhi((unsigned)(v >> 32));
        if (intra) { const unsigned long long iv = ((const unsigned long long*)intra)[b * 64 + lane];
            x0 += bflo((unsigned)iv); x1 += bfhi((unsigned)iv); x2 += bflo((unsigned)(iv >> 32)); x3 += bfhi((unsigned)(iv >> 32)); }
        int row, col;
        if (S16) { row = 16 * (b & 3) + 4 * (lane >> 4); col = 16 * (b >> 2) + (lane & 15); }
        else { row = 32 * ((b >> 2) & 1) + 8 * (b & 3) + 4 * hh; col = 32 * (b >> 3) + r; }
        LAS unsigned char* p = lds + row * ST + col * 2;
        const unsigned a = pkbf(x0, x1), bq = pkbf(x2, x3);
        *(LAS unsigned short*)p = (unsigned short)(a & 0xffffu); *(LAS unsigned short*)(p + ST) = (unsigned short)(a >> 16);
        *(LAS unsigned short*)(p + 2 * ST) = (unsigned short)(bq & 0xffffu); *(LAS unsigned short*)(p + 3 * ST) = (unsigned short)(bq >> 16);
    }
    __syncthreads();
#pragma unroll
    for (int it = 0; it < (64 * CPR) / 512; ++it) {
        const int idx = it * 512 + tid, row = idx / CPR, ch = idx % CPR;
        const v4u xw = *(const LAS v4u*)(lds + row * ST + ch * 16);
        float x[8] = {bflo(xw.x), bfhi(xw.x), bflo(xw.y), bfhi(xw.y), bflo(xw.z), bfhi(xw.z), bflo(xw.w), bfhi(xw.w)};
        float ss = 0.f;
#pragma unroll
        for (int i = 0; i < 8; ++i) ss += x[i] * x[i];
        ss = row16_sum(ss);
        if (NC == 256) ss += __shfl_xor(ss, 16);
        const float rstd = 1.0f / sqrtf(ss * (1.0f / NC) + EPS);
        f32x4 w0 = *(const f32x4*)(nw + ch * 8), w1 = *(const f32x4*)(nw + ch * 8 + 4);
        if (zg) { const v4u zw = *(const v4u*)(zg + (size_t)row * 1024 + ch * 8);
            const float z[8] = {bflo(zw.x), bfhi(zw.x), bflo(zw.y), bfhi(zw.y), bflo(zw.z), bfhi(zw.z), bflo(zw.w), bfhi(zw.w)};
            w0.x *= z[0] * __builtin_amdgcn_rcpf(1.0f + __expf(-z[0])); w0.y *= z[1] * __builtin_amdgcn_rcpf(1.0f + __expf(-z[1])); w0.z *= z[2] * __builtin_amdgcn_rcpf(1.0f + __expf(-z[2])); w0.w *= z[3] * __builtin_amdgcn_rcpf(1.0f + __expf(-z[3]));
            w1.x *= z[4] * __builtin_amdgcn_rcpf(1.0f + __expf(-z[4])); w1.y *= z[5] * __builtin_amdgcn_rcpf(1.0f + __expf(-z[5])); w1.z *= z[6] * __builtin_amdgcn_rcpf(1.0f + __expf(-z[6])); w1.w *= z[7] * __builtin_amdgcn_rcpf(1.0f + __expf(-z[7])); }
        v4u o; o.x = pkbf(x[0] * rstd * w0.x, x[1] * rstd * w0.y); o.y = pkbf(x[2] * rstd * w0.z, x[3] * rstd * w0.w); o.z = pkbf(x[4] * rstd * w1.x, x[5] * rstd * w1.y); o.w = pkbf(x[6] * rstd * w1.z, x[7] * rstd * w1.w);
        *(v4u*)(out + (size_t)row * 1024 + ch * 8) = o;
    }
    __syncthreads();
}
#define XB_TMO      128
#define XB_XCNT(j)  (256  + 64 * (j))
#define XB_XSUB(j)  (1280 + 64 * (j))
#define XB_XGEN(j)  (2304 + 64 * (j))
#define XB_TOP      3328
#define XB_TOPGEN   3392
#define XCD_BAR_WORDS 3456
#define XB_SPIN_CAP (1u << 18)

__device__ __forceinline__ unsigned xb_ld(unsigned* p)              { return __hip_atomic_load(p, __ATOMIC_RELAXED, __HIP_MEMORY_SCOPE_AGENT); }
__device__ __forceinline__ unsigned xb_add(unsigned* p, unsigned v) { return __hip_atomic_fetch_add(p, v, __ATOMIC_RELAXED, __HIP_MEMORY_SCOPE_AGENT); }
__device__ __forceinline__ unsigned xb_xcc_id() { return (unsigned)__builtin_amdgcn_s_getreg((3 << 11) | 20) & 0xFu; }
#define XB_SPIN(cond, bar) do { unsigned _sp = 0; while (cond) { __builtin_amdgcn_s_sleep(1); \
    if ((++_sp & 255u) == 0u) { if (xb_ld(&(bar)[XB_TMO])) break; if (_sp > XB_SPIN_CAP) { atomicAdd(&(bar)[XB_TMO], 1u); break; } } } } while (0)

struct XcdBarrier {
    unsigned* bar; unsigned x;
    volatile LAS unsigned* st;
};

__device__ __forceinline__ XcdBarrier xcd_barrier_post(unsigned* bar, volatile LAS unsigned* st) {
    XcdBarrier b; b.bar = bar; b.x = xb_xcc_id(); b.st = st;
    if (threadIdx.x == 0) (void)xb_add(&bar[XB_XCNT(b.x)], 1u);
    return b;
}
__device__ __forceinline__ void xcd_barrier_complete(unsigned* bar, unsigned x, unsigned& nloc, unsigned& nx) {
    const unsigned G = gridDim.x * gridDim.y * gridDim.z;
    unsigned sum, cnt, mine, sp = 0u;
    for (;;) {
        sum = 0u; cnt = 0u; mine = 0u;
#pragma unroll
        for (unsigned j = 0; j < 16; ++j) { const unsigned c = xb_ld(&bar[XB_XCNT(j)]); sum += c; cnt += (c > 0u) ? 1u : 0u; mine = (j == x) ? c : mine; }
        if (sum == G) break;
        __builtin_amdgcn_s_sleep(1);
        if ((++sp & 255u) == 0u) { if (xb_ld(&bar[XB_TMO])) break; if (sp > XB_SPIN_CAP) { atomicAdd(&bar[XB_TMO], 1u); break; } }
    }
    nloc = mine > 0u ? mine : 1u; nx = cnt > 0u ? cnt : 1u;
}

__device__ __forceinline__ void xcd_barrier(const XcdBarrier& b) {
    asm volatile("s_waitcnt vmcnt(0)" ::: "memory");
    __syncthreads();
    if (threadIdx.x == 0) {
        unsigned* bar = b.bar;
        __builtin_amdgcn_s_waitcnt(0);
        unsigned nloc = b.st[0], nx = b.st[1];
        if (nloc == 0u) { xcd_barrier_complete(bar, b.x, nloc, nx); b.st[0] = nloc; b.st[1] = nx; }
        const unsigned old = xb_add(&bar[XB_XSUB(b.x)], 1u);
        const unsigned gen = old / nloc;
        if (old + 1u == (gen + 1u) * nloc) {
            __builtin_amdgcn_fence(__ATOMIC_RELEASE, "agent");
            asm volatile("s_waitcnt vmcnt(0)" ::: "memory");
            const unsigned og = xb_add(&bar[XB_TOP], 1u);
            const unsigned tg = og / nx;
            if (og + 1u == (tg + 1u) * nx) xb_add(&bar[XB_TOPGEN], 1u);
            else XB_SPIN(xb_ld(&bar[XB_TOPGEN]) == tg, bar);
            __builtin_amdgcn_fence(__ATOMIC_ACQUIRE, "agent");
            xb_add(&bar[XB_XGEN(b.x)], 1u);
            asm volatile("s_waitcnt vmcnt(0)" ::: "memory");
        } else {
            XB_SPIN(xb_ld(&bar[XB_XGEN(b.x)]) == gen, bar);
            __builtin_amdgcn_fence(__ATOMIC_ACQUIRE, "agent");
            asm volatile("s_waitcnt vmcnt(0)" ::: "memory");
        }
    }
    __syncthreads();
}
__device__ __forceinline__ void transpose_item(const float* W, int ldw, int src_col0, int K, int ncols, bf16* WT, int dst_row0, LAS float* scr, int item, int lane) {
    asm volatile("" : "+v"(lane));
    const int nblk = ncols / 32, kb = item / nblk, nb = item % nblk, k0 = 64 * kb, n0 = 32 * nb;
#pragma unroll 8
    for (int i = 0; i < 32; ++i) { const int kk = 2 * i + (lane >> 5); scr[kk * 33 + (lane & 31)] = W[(size_t)(k0 + kk) * ldw + src_col0 + n0 + (lane & 31)]; }
    LDS_WAIT();
    const int c = lane & 7;
#pragma unroll
    for (int j = 0; j < 4; ++j) { const int n = (lane >> 3) + 8 * j; const LAS float* s = scr + (8 * c) * 33 + n;
        v4u o; o.x = pk2(s[0 * 33], s[1 * 33]); o.y = pk2(s[2 * 33], s[3 * 33]); o.z = pk2(s[4 * 33], s[5 * 33]); o.w = pk2(s[6 * 33], s[7 * 33]);
        *(v4u*)(WT + (size_t)(dst_row0 + n0 + n) * K + k0 + 8 * c) = o; }
    LDS_WAIT();
}

constexpr int WCV_MIX = 16 * ((1024 + 3072 + 1024 + 1024 + 32 + 32) / 32), WCV_ALL = WCV_MIX + 16 * ((1024 + 2048) / 32) + 3 * 512;
__device__ __forceinline__ void wconv_item(int it, const float* w_in, const float* wa, const float* wb, const float* wo, bf16* WT_IN, bf16* WT_A, bf16* WT_B, bf16* WT_O, LAS float* scr, int lane) {
    constexpr int c0 = 512, c1 = c0 + 1536, c2 = c1 + 512, c3 = c2 + 512, c4 = c3 + 16, c5 = c4 + 16, c6 = c5 + 512, c7 = c6 + 1024, c8 = c7 + 512, c9 = c8 + 512;
    static_assert(c5 == WCV_MIX && c9 + 512 == WCV_ALL, "weight conversion item list");
    if (it < c0) transpose_item(w_in, NIN, SRC_ZA, D, 1024, WT_IN, 0, scr, it, lane);
    else if (it < c1) transpose_item(w_in, NIN, SRC_QKVA, D, 3072, WT_IN, 1024, scr, it - c0, lane);
    else if (it < c2) transpose_item(w_in, NIN, SRC_QB, D, 1024, WT_IN, 4096, scr, it - c1, lane);
    else if (it < c3) transpose_item(w_in, NIN, SRC_VB, D, 1024, WT_IN, 5120, scr, it - c2, lane);
    else if (it < c4) transpose_item(w_in, NIN, SRC_AF, D, 32, WT_IN, 9216, scr, it - c3, lane);
    else if (it < c5) transpose_item(w_in, NIN, SRC_RF, D, 32, WT_IN, 9248, scr, it - c4, lane);
    else if (it < c6) transpose_item(w_in, NIN, SRC_GB, D, 1024, WT_IN, 6144, scr, it - c5, lane);
    else if (it < c7) transpose_item(w_in, NIN, SRC_GA, D, 2048, WT_IN, 7168, scr, it - c6, lane);
    else if (it < c8) transpose_item(wa, D, 0, D, D, WT_A, 0, scr, it - c7, lane);
    else if (it < c9) transpose_item(wb, D, 0, D, D, WT_B, 0, scr, it - c8, lane);
    else transpose_item(wo, D, 0, D, D, WT_O, 0, scr, it - c9, lane);
}
__device__ __forceinline__ void h_rows(const float* x, const float* w, bf16* h, int nrows, int gw, int ngw, int lane) {
    asm volatile("" : "+v"(lane));
    for (int m = gw; m < nrows; m += ngw) {
        const f32x4* xr = (const f32x4*)(x + (size_t)m * D) + lane; f32x4 v[4]; float s = 0.f;
#pragma unroll
        for (int j = 0; j < 4; ++j) { v[j] = xr[64 * j]; s += (v[j].x * v[j].x + v[j].y * v[j].y) + (v[j].z * v[j].z + v[j].w * v[j].w); }
        const float rstd = 1.0f / sqrtf(wave_sum(s) * (1.f / D) + EPS);
        unsigned long long* o8 = (unsigned long long*)(h + (size_t)m * D) + lane;
#pragma unroll
        for (int j = 0; j < 4; ++j) { const f32x4 ww = ((const f32x4*)w)[lane + 64 * j];
            o8[64 * j] = (unsigned long long)pkbf(v[j].x * rstd * ww.x, v[j].y * rstd * ww.y) | ((unsigned long long)pkbf(v[j].z * rstd * ww.z, v[j].w * rstd * ww.w) << 32); }
    }
}
__device__ __forceinline__ void h_rows_tiles(const float* x, const float* w, const pg8::Gemm& gt, int nrows, int gw, int ngw, int lane) {
    asm volatile("" : "+v"(lane));
    for (int m = gw; m < nrows; m += ngw) {
        const f32x4* xr = (const f32x4*)(x + (size_t)m * D) + lane; f32x4 v[4]; float s = 0.f;
#pragma unroll
        for (int j = 0; j < 4; ++j) { v[j] = xr[64 * j]; s += (v[j].x * v[j].x + v[j].y * v[j].y) + (v[j].z * v[j].z + v[j].w * v[j].w); }
        const float rstd = 1.0f / sqrtf(wave_sum(s) * (1.f / D) + EPS);
        unsigned long long* o8 = (unsigned long long*)(gt.atile(m >> 8, (size_t)256 * D * 2) + (size_t)(m & 255) * D * 2) + lane;
#pragma unroll
        for (int j = 0; j < 4; ++j) { const f32x4 ww = ((const f32x4*)w)[lane + 64 * j];
            o8[64 * j] = (unsigned long long)pkbf(v[j].x * rstd * ww.x, v[j].y * rstd * ww.y) | ((unsigned long long)pkbf(v[j].z * rstd * ww.z, v[j].w * rstd * ww.w) << 32); }
    }
}
__device__ __forceinline__ void final_rows(const float* x, const float* pre, const float* w, float* out, int nrows, int gw, int ngw, int lane) {
    asm volatile("" : "+v"(lane));
    for (int m = gw; m < nrows; m += ngw) {
        const f32x4* pr = (const f32x4*)(pre + (size_t)m * D) + lane; const f32x4* xr = (const f32x4*)(x + (size_t)m * D) + lane; f32x4 v[4]; float s = 0.f;
#pragma unroll
        for (int j = 0; j < 4; ++j) { v[j] = pr[64 * j]; s += (v[j].x * v[j].x + v[j].y * v[j].y) + (v[j].z * v[j].z + v[j].w * v[j].w); }
        const float rstd = 1.0f / sqrtf(wave_sum(s) * (1.f / D) + EPS);
        f32x4* orow = (f32x4*)(out + (size_t)m * D) + lane;
#pragma unroll
        for (int j = 0; j < 4; ++j) { const f32x4 ww = ((const f32x4*)w)[lane + 64 * j]; const f32x4 xv = xr[64 * j]; orow[64 * j] = xv + v[j] * rstd * ww; }
    }
}
__device__ __forceinline__ void small_unit(LAS unsigned char* lds, const bf16* h, const bf16* wsm, float* out, int unit) {
    int tid_l = threadIdx.x; asm volatile("" : "+v"(tid_l));
    const int tid = tid_l, lane = tid & 63, w = __builtin_amdgcn_readfirstlane(tid >> 6), r = lane & 31, hh = lane >> 5;
    const int ct = w & 1, kq = w >> 1;
    const bf16* ap = h + (size_t)(unit * 32 + r) * D + kq * 256 + 8 * hh;
    const bf16* bp = wsm + (size_t)(32 * ct + r) * D + kq * 256 + 8 * hh;
    f32x16 acc = zero16();
#pragma unroll 8
    for (int ks = 0; ks < 16; ++ks) acc = MFMA32(*(const bf16x8*)(ap + 16 * ks), *(const bf16x8*)(bp + 16 * ks), acc);
    LAS float* red = (LAS float*)lds + (size_t)w * 1024 + lane;
    if (kq != 0) {
#pragma unroll
        for (int i = 0; i < 16; ++i) red[i * 64] = acc[i]; }
    __syncthreads();
    if (kq == 0) {
        float* op = out + (size_t)(unit * 32 + 4 * hh) * 64 + 32 * ct + r;
#pragma unroll
        for (int i = 0; i < 16; ++i) op[((i & 3) + 8 * (i >> 2)) * 64] = ((acc[i] + red[2048 + i * 64]) + red[4096 + i * 64]) + red[6144 + i * 64]; }
    __syncthreads();
}

constexpr int NG = 2, MG = M / NG, NSEQG = BATCH / NG;
constexpr size_t KiB = 1024;
constexpr size_t WS_CTL = 0  , WS_WTIN = 320 * KiB, WS_WTA = WS_WTIN + 18560 * KiB, WS_WTB = WS_WTA + 2 * MiB, WS_WTO = WS_WTB + 2 * MiB, WS_SMALL = WS_WTO + 2 * MiB  ,
    WS_Z = WS_SMALL + 2 * MiB  , WS_PG = WS_Z + 16 * MiB  , WS_GBLOB = WS_PG + 80 * MiB  , WS_LBLOBB = WS_GBLOB + 98 * MiB  , WS_END = WS_LBLOBB + 32 * MiB;
static_assert(WS_END <= 256 * MiB, "workspace");
constexpr size_t WS_GATES = WS_GBLOB  , WS_M1 = WS_GATES + 64 * MiB  , WS_MERGED = WS_M1 + 32 * MiB  , WS_PRE = WS_MERGED + 32 * MiB  ;
static_assert(WS_PRE + 1 * MiB <= WS_END, "overlays");
constexpr size_t HT_TILE = 256 * 1024 * 2, WS_H0 = WS_WTIN, WS_H1 = WS_PG + (size_t)NSEQG * 4 * NCH * gla::BLOBA, WS_H2 = WS_SMALL, WS_H3 = WS_END;
constexpr int HT1 = 24, HT2 = 55, HT3 = 59;
static_assert(((size_t)NSEQG * 4 * NCH * gla::BLOBA) % HT_TILE == 0 && WS_H1 + (HT2 - HT1) * HT_TILE <= WS_PG + 3 * ((size_t)MG * 2048) && HT1 * HT_TILE <= (size_t)6144 * 2048 && (HT3 - HT2) * HT_TILE <= 2 * MiB && WS_H3 + (64 - HT3) * HT_TILE <= 256 * MiB, "h tiles");
constexpr size_t PGMAT = (size_t)MG * 1024 * 2;
static_assert((size_t)NSEQG * 4 * NCH * gla::BLOBA <= 3 * PGMAT && (size_t)NSEQG * 4 * NCH * 32768 <= PGMAT && (size_t)NSEQG * 8 * NCH * 16384 <= PGMAT, "overlays");
static_assert((size_t)NSEQG * 8 * NCH * gdn::BLOB <= 98 * MiB && (size_t)NSEQG * 4 * NCH * gla::BLOBB <= 32 * MiB, "blobs");
constexpr int LDS_BYTES = 160 * 1024, LDS_BAR = LDS_BYTES - 16;
static_assert(gla::L_END <= LDS_BAR && gdn::L_END <= LDS_BAR && gdn::C_END <= LDS_BAR && gla::CB_END <= LDS_BAR && pg8::STAGE_BYTES <= LDS_BAR, "LDS");
constexpr int N_PHASES = 12;

struct MegaArgs { const float* in[18]; float* out; unsigned char* ws; int ph_lo, ph_hi; };

__global__ void __launch_bounds__(512, 2) mega(MegaArgs a) {
    extern __shared__ __attribute__((aligned(16))) unsigned char lds_raw[];
    LAS unsigned char* lds = (LAS unsigned char*)lds_raw;
    const int tid = threadIdx.x, lane = tid & 63, wave = __builtin_amdgcn_readfirstlane(tid >> 6);
    const int G = gridDim.x, bid = blockIdx.x, gw = bid * 8 + wave, ngw = G * 8;
    unsigned char* ws = a.ws;
    const float* x = a.in[0]; const float* ln_pre_w = a.in[1]; const float* w_in = a.in[2]; const float* conv_w = a.in[3];
    if (tid < 4) ((LAS unsigned*)(lds + LDS_BAR))[tid] = 0u;
    __syncthreads();
    XcdBarrier bar = xcd_barrier_post((unsigned*)(ws + WS_CTL), (volatile LAS unsigned*)(lds + LDS_BAR));
    const int lo = a.ph_lo, hi = a.ph_hi;
#define IN(k) (lo <= (k) && (k) < hi)
#define SEAM(k) do { if (IN(k) && IN((k) + 1)) xcd_barrier(bar); } while (0)
#ifndef PROBE_REPEAT
#define PROBE_REPEAT 0
#endif
#ifndef PROBE_FLAGS
#define PROBE_FLAGS 0
#endif
#define PH(k) if (IN(k)) for (int rep_ = 0; rep_ <= ((PROBE_REPEAT >> (k)) & 1); ++rep_)
#define REPBAR() do { if (rep_) xcd_barrier(bar); } while (0)
    bf16* WT_IN = (bf16*)(ws + WS_WTIN); bf16* WT_A = (bf16*)(ws + WS_WTA); bf16* WT_B = (bf16*)(ws + WS_WTB); bf16* WT_O = (bf16*)(ws + WS_WTO);
    bf16* PG = (bf16*)(ws + WS_PG); float* SMALL = (float*)(ws + WS_SMALL);
    bf16* ORAWA = (bf16*)a.out; bf16* ORAWB = (bf16*)a.out + (size_t)M * 1024;
    pg8::Gemm gh{(const bf16*)(ws + WS_H0), WT_IN + (size_t)6144 * D, M, 3072, D, 0, (const bf16*)(ws + WS_H1), (const bf16*)(ws + WS_H2), (const bf16*)(ws + WS_H3), HT1, HT2, HT3};

    PH(0) { REPBAR();
        LAS float* scr = (LAS float*)lds + wave * (64 * 33);
        for (int it = gw; it < WCV_MIX; it += ngw) wconv_item(it, w_in, a.in[9], a.in[15], a.in[16], WT_IN, WT_A, WT_B, WT_O, scr, lane);
        h_rows(x, ln_pre_w, ORAWB + (size_t)MG * 1024, MG, gw, ngw, lane);
    }
    SEAM(0);
#ifdef PROBE_BARRIERS
    for (int i = 0; i < PROBE_BARRIERS; ++i) xcd_barrier(bar);
#endif
    for (int g = 0; g < NG; ++g) {
        const int pb = 1 + 4 * g;
        const size_t r0 = (size_t)g * MG;
        const bf16* hsrc = (g == 0 ? ORAWB : ORAWA) + (size_t)MG * 1024;
        PH(pb) { REPBAR();
            for (int u = bid; u < MG / 32; u += G) small_unit(lds, hsrc, WT_IN + (size_t)9216 * D, SMALL, u);
            pg8::Gemm gm{hsrc, WT_IN, MG, 6144, D, 0}; pg8::StaticOrder S; S.init(MG, 6144, G, bid);
            pg8::EpiBf16 E{(bf16*)(ws + WS_Z), 1024, 1024, (size_t)MG * 1024};
            pg8::gemm_phase<pg8::EpiBf16, pg8::StaticOrder, true, true>(lds, gm, S, E);
        }
        SEAM(pb);
        PH(pb + 1) { REPBAR();
            GdnPrepArgs pa{PG, PG + (size_t)MG * 1024, PG + (size_t)2 * MG * 1024, SMALL, conv_w, a.in[4], a.in[5], a.in[6], a.in[7], ws + WS_GBLOB, NSEQG, rep_ ? PROBE_FLAGS : 0};
            gdn_prep_phase(lds, pa, bid, G, ws + WS_CTL + 300 * KiB);
        }
        SEAM(pb + 1);
        PH(pb + 2) { REPBAR();
            GlaPrepArgs pa{PG + (size_t)3 * MG * 1024, PG + (size_t)4 * MG * 1024, SMALL, a.in[10], a.in[11], a.in[12], a.in[13], ws + WS_PG, ws + WS_LBLOBB, NSEQG, 0};
            gla_prep_phase(lds, pa, bid, G);
        }
        SEAM(pb + 2);
        PH(pb + 3) { REPBAR();
            constexpr int NGI = NSEQG * 8 * 2, NLI = NSEQG * 4 * 2;
            unsigned* gflag = (unsigned*)(ws + WS_CTL + 32 * KiB) + (size_t)g * (NSEQG * 8 * NCH * 8); unsigned* lflag = (unsigned*)(ws + WS_CTL + 96 * KiB) + (size_t)g * (NSEQG * 4 * NCH * 8);
            if (rep_) { gflag += 32 * 1024; lflag += 32 * 1024; }
            if (bid < NGI) { if (!(rep_ && (PROBE_FLAGS & 16))) { GdnChainArgs ca{ws + WS_GBLOB, ws + WS_PG + 4 * PGMAT, gflag, NSEQG, rep_ ? PROBE_FLAGS : 0}; gdn_chain_unit(lds, ca, bid); } }
            else if (bid < NGI + NLI) { if (!(rep_ && (PROBE_FLAGS & 32))) { GlaChainArgs ca{ws + WS_PG, ws + WS_LBLOBB, ws + WS_PG + 3 * PGMAT, lflag, NSEQG, rep_ ? PROBE_FLAGS : 0}; gla_chain_unit(lds, ca, bid - NGI); } }
            else if (!rep_) {
                const int wk = bid - NGI - NLI, nwk = G - NGI - NLI;
                if (g == 0) h_rows(x + (size_t)MG * D, ln_pre_w, ORAWA + (size_t)MG * 1024, MG, wk * 8 + wave, nwk * 8, lane);
                if (g == 0) { LAS float* scr = (LAS float*)lds + wave * (64 * 33);
                    for (int it = WCV_MIX + wk * 8 + wave; it < WCV_ALL; it += nwk * 8) wconv_item(it, w_in, a.in[9], a.in[15], a.in[16], WT_IN, WT_A, WT_B, WT_O, scr, lane);
                    __syncthreads(); }
                if (g == NG - 1) h_rows_tiles(x, ln_pre_w, gh, M, wk * 8 + wave, nwk * 8, lane);
            }
            if (!rep_) {
                constexpr int NPG = NSEQG * 8, NPL = NSEQG * 4;
                unsigned* qhead = (unsigned*)(ws + WS_CTL + 301 * KiB) + 64 * g;
                for (;;) {
                    if (tid == 0) ((LAS unsigned*)(lds + LDS_BAR))[3] = __hip_atomic_fetch_add(qhead, 1u, __ATOMIC_RELAXED, __HIP_MEMORY_SCOPE_AGENT);
                    __syncthreads();
                    const int j = (int)((LAS unsigned*)(lds + LDS_BAR))[3];
                    __syncthreads();
                    if (j >= NCH * (NPG + NPL)) break;
                    const int rk = j / (NPG + NPL), idx = j % (NPG + NPL), n = (rk & 1) ? (NCH / 2 - 1 - (rk >> 1)) : (NCH / 2 + (rk >> 1));
                    if (idx < NPG) { const int u = idx * NCH + n, hd = idx % 8, sq = idx / 8;
                        p4_unit<128, true>(lds, ws + WS_PG + 4 * PGMAT + (size_t)u * 16384, nullptr, (const bf16*)(ws + WS_Z) + ((size_t)sq * SEQ + n * CHUNK) * 1024 + hd * 128, a.in[8], ORAWA + (r0 + (size_t)sq * SEQ + n * CHUNK) * 1024 + hd * 128, gflag + (size_t)u * 8); }
                    else { const int pi = idx - NPG, u = pi * NCH + n, hd = pi % 4, sq = pi / 4;
                        p4_unit<256, false>(lds, ws + WS_PG + 3 * PGMAT + (size_t)u * 32768, ws + WS_LBLOBB + (size_t)u * gla::BLOBB + gla::B_INTRA, nullptr, a.in[14], ORAWB + (r0 + (size_t)sq * SEQ + n * CHUNK) * 1024 + hd * 256, lflag + (size_t)u * 8); }
                }
            }
        }
        SEAM(pb + 3);
    }
    PH(9) { REPBAR();
        const pg8::Gemm& gm = gh; pg8::StaticOrder S; S.init(M, 3072, G, bid);
        if (rep_ == 0) { pg8::EpiP1b E{ORAWB, (bf16*)(ws + WS_GATES), (size_t)M * 1024, ORAWB};
            pg8::gemm_phase<pg8::EpiP1b, pg8::StaticOrder, true, true>(lds, gm, S, E); }
        else { pg8::EpiP1b E{ORAWB, (bf16*)(ws + WS_GATES), (size_t)M * 1024, (bf16*)(ws + WS_MERGED)};
            pg8::gemm_phase<pg8::EpiP1b, pg8::StaticOrder, true, true>(lds, gm, S, E); }
    }
    SEAM(9);
    PH(10) { REPBAR();
        pg8::Gemm gm{ORAWA, WT_A, 2 * M, 2 * D, D, 0}; pg8::PairOrder S; S.init(M, D, G, bid);
        pg8::EpiMerge E{(bf16*)(ws + WS_M1), (bf16*)(ws + WS_MERGED), (const bf16*)(ws + WS_GATES), (size_t)M * 1024, M / 256, D / 256};
        pg8::gemm_phase<pg8::EpiMerge, pg8::PairOrder, true, true>(lds, gm, S, E);
    }
    SEAM(10);
    if (IN(11)) {
        pg8::Gemm gm{(const bf16*)(ws + WS_MERGED), WT_O, M, D, D, 0}; pg8::StaticOrder S; S.init(M, D, G, bid);
        pg8::EpiRmsRes E{x, a.in[17], a.out, (float*)(ws + WS_PRE), (unsigned*)(ws + WS_CTL + 304 * KiB)};
        pg8::gemm_phase<pg8::EpiRmsRes, pg8::StaticOrder, false, true>(lds, gm, S, E);
    }
#undef IN
#undef SEAM
}

#ifndef MK_N_LAUNCHES
#define MK_N_LAUNCHES 1
#endif
extern "C" void kernel_launch(void* const* d_in, const int* in_sizes, int n_in, void* d_out, int out_size, void* d_ws, size_t ws_size, hipStream_t stream) {
    static int ready = 0;
    if (!ready) {
        if (n_in != 18 || ws_size < 256 * MiB || out_size != M * D) { fprintf(stderr, "kernel_launch: unexpected problem shape / workspace (%d inputs, ws %zu)\n", n_in, ws_size); ready = -1; return; }
        if (hipFuncSetAttribute((const void*)mega, hipFuncAttributeMaxDynamicSharedMemorySize, LDS_BYTES) != hipSuccess) { fprintf(stderr, "kernel_launch: hipFuncSetAttribute failed\n"); ready = -1; return; }
        ready = 1;
    }
    if (ready < 0) return;
    (void)hipMemsetAsync((char*)d_ws + WS_CTL, 0, 320 * 1024, stream);
    MegaArgs a{};
    for (int i = 0; i < 18; ++i) a.in[i] = (const float*)d_in[i];
    a.out = (float*)d_out; a.ws = (unsigned char*)d_ws;
#if MK_N_LAUNCHES == 1
    a.ph_lo = 0; a.ph_hi = N_PHASES;
    hipLaunchKernelGGL(mega, dim3(256), dim3(512), LDS_BYTES, stream, a);
#else
    for (int p = 0; p < N_PHASES; ++p) { a.ph_lo = p; a.ph_hi = p + 1; hipLaunchKernelGGL(mega, dim3(256), dim3(512), LDS_BYTES, stream, a); }
#endif
}
```

```cpp
#include <hip/hip_runtime.h>
#include <cstdio>
#include <cstdint>

#define GAS __attribute__((address_space(1)))
#define LAS __attribute__((address_space(3)))
typedef unsigned short bf16;
typedef unsigned v4u __attribute__((ext_vector_type(4)));
typedef unsigned v2u __attribute__((ext_vector_type(2)));
typedef float f32x4 __attribute__((ext_vector_type(4)));
#define LDS_WAIT() asm volatile("s_waitcnt lgkmcnt(0)" ::: "memory")

constexpr int BATCH = 8, SEQ = 2048, D = 1024, M = BATCH * SEQ, NIN = 9280;
constexpr float EPS = 1e-6f;
constexpr size_t MiB = 1 << 20;
constexpr int SRC_QKVA = 0, SRC_ZA = 3072, SRC_AF = 4096, SRC_QB = 4128, SRC_KB = 4640, SRC_VB = 5152, SRC_GB = 6176, SRC_RF = 7200, SRC_GA = 7232, SRC_GBm = 8256;

__device__ __forceinline__ unsigned f2bf(float f) { unsigned u = __builtin_bit_cast(unsigned, f); return (u + 0x7fffu + ((u >> 16) & 1u)) >> 16; }
__device__ __forceinline__ unsigned pk2(float lo, float hi) { return f2bf(lo) | (f2bf(hi) << 16); }
__device__ __forceinline__ float bf2f(unsigned short b) { return __builtin_bit_cast(float, (unsigned)b << 16); }
__device__ __forceinline__ float bflo(unsigned w) { return __builtin_bit_cast(float, w << 16); }
__device__ __forceinline__ float bfhi(unsigned w) { return __builtin_bit_cast(float, w & 0xffff0000u); }
__device__ __forceinline__ float sigmoidf_(float x) { return 1.0f / (1.0f + __expf(-x)); }
__device__ __forceinline__ float siluf_(float x) { return x / (1.0f + __expf(-x)); }
__device__ __forceinline__ float wave_sum(float v) {
#pragma unroll
    for (int o = 1; o < 64; o <<= 1) v += __shfl_xor(v, o);
    return v;
}
namespace pg8 {
#define PG8_LAS __attribute__((address_space(3)))
typedef unsigned short bf16_t;
typedef short bf16x8 __attribute__((ext_vector_type(8)));
typedef float f32x4 __attribute__((ext_vector_type(4)));
typedef unsigned u32x4 __attribute__((ext_vector_type(4)));
constexpr int BM = 256, BK = 64, HALF = 128, HTB = HALF * BK * 2  , STAGE_BYTES = 8 * HTB, NXCD = 8, WGM = 8;

__host__ __device__ __forceinline__ int lds_byte(int r, int c) { const int st = (r >> 4) * 2 + (c >> 5), rr = r & 15, cc = c & 31, ob = rr * 64 + cc * 2; return st * 1024 + (ob ^ (((ob >> 9) & 1) << 5)); }
__host__ __device__ __forceinline__ void stage_rc(int b, int& R, int& C) { const int st = b / 1024, sb = b % 1024, swz = sb ^ (((sb >> 9) & 1) << 5); R = (st >> 1) * 16 + swz / 64; C = (st & 1) * 32 + (swz % 64) / 2; }
__host__ __device__ __forceinline__ int perm32(int rho) { const int n = rho >> 4, i = rho & 15; return 8 * (i >> 2) + 4 * n + (i & 3); }

struct Unit { int pm, pn; };
struct Gemm { const bf16_t* A; const bf16_t* Bt; int M, N, K, pad_;
    const bf16_t* A1 = nullptr; const bf16_t* A2 = nullptr; const bf16_t* A3 = nullptr; int t1 = 1 << 30, t2 = 1 << 30, t3 = 1 << 30;
    __host__ __device__ __forceinline__ const char* atile(int pm, size_t tstep) const {
        if (pm < t1) return (const char*)A + (size_t)pm * tstep;
        if (pm < t2) return (const char*)A1 + (size_t)(pm - t1) * tstep;
        if (pm < t3) return (const char*)A2 + (size_t)(pm - t2) * tstep;
        return (const char*)A3 + (size_t)(pm - t3) * tstep; }
};

struct StaticOrder {
    int nM, nN, nwg, G, c;
    __host__ __device__ void init(int M, int N, int G_, int c_) { nM = M / BM; nN = N / BM; nwg = nM * nN; G = G_; c = c_; }
    __host__ __device__ bool next(int i, Unit& u) const {
        const long L = (long)i * G + c; if (L >= nwg) return false;
        int wgid = (int)L; { const int q = nwg / NXCD, r = nwg % NXCD, xcd = wgid % NXCD, off = wgid / NXCD; wgid = (xcd < r ? xcd * (q + 1) : r * (q + 1) + (xcd - r) * q) + off; }
        const int nig = WGM * nN, gid = wgid / nig, fm = gid * WGM, gsz = (nM - fm) < WGM ? (nM - fm) : WGM;
        u.pm = fm + ((wgid % nig) % gsz); u.pn = (wgid % nig) / gsz; return true;
    }
    __device__ __forceinline__ void a_ready(const Unit&) const {}
    __device__ __forceinline__ void done(const Unit&) const {}
};

__device__ __forceinline__ unsigned cvt_pk_bf16(float lo, float hi) { unsigned r; asm volatile("v_cvt_pk_bf16_f32 %0, %1, %2" : "=v"(r) : "v"(lo), "v"(hi)); return r; }
struct EpiBf16 {
    static constexpr bool PERM = true, AFTER_DRAIN = false;
    bf16_t* O; int ldc; int split_cols; size_t split_stride;
    __device__ __forceinline__ void operator()(const f32x4 (&acc)[2][2][4][2], const Unit& u, int wr, int wc, int fr, int fq) const {
        const int row0 = u.pm * BM + wr * 64 + fr; int colt = u.pn * BM; bf16_t* base = O;
        if (split_cols) { const int t = colt / split_cols; base += (size_t)t * split_stride; colt -= t * split_cols; }
        const int col0 = colt + wc * 32 + 8 * fq;
#pragma unroll
        for (int ai = 0; ai < 2; ++ai)
#pragma unroll
            for (int m = 0; m < 4; ++m) { bf16_t* rowp = base + (size_t)(row0 + ai * HALF + m * 16) * ldc + col0;
#pragma unroll
                for (int bj = 0; bj < 2; ++bj) { const f32x4 v0 = acc[ai][bj][m][0], v1 = acc[ai][bj][m][1];
                    u32x4 w; w.x = cvt_pk_bf16(v0[0], v0[1]); w.y = cvt_pk_bf16(v0[2], v0[3]); w.z = cvt_pk_bf16(v1[0], v1[1]); w.w = cvt_pk_bf16(v1[2], v1[3]);
                    *(u32x4*)(rowp + bj * HALF) = w; } }
    }
};
template <int MODE> struct EpiGate {
    static constexpr bool PERM = true, AFTER_DRAIN = false;
    bf16_t* O; const bf16_t* G; const bf16_t* Add; int ldc, pad_;
    __device__ __forceinline__ void operator()(const f32x4 (&acc)[2][2][4][2], const Unit& u, int wr, int wc, int fr, int fq) const {
        const int row0 = u.pm * BM + wr * 64 + fr; const int col0 = u.pn * BM + wc * 32 + 8 * fq;
#pragma unroll
        for (int ai = 0; ai < 2; ++ai)
#pragma unroll
            for (int m = 0; m < 4; ++m) { const size_t ro = (size_t)(row0 + ai * HALF + m * 16) * ldc + col0;
#pragma unroll
                for (int bj = 0; bj < 2; ++bj) { const f32x4 v0 = acc[ai][bj][m][0], v1 = acc[ai][bj][m][1];
                    const u32x4 gw = *(const u32x4*)(G + ro + bj * HALF);
                    float r[8]; const float a[8] = {v0[0], v0[1], v0[2], v0[3], v1[0], v1[1], v1[2], v1[3]};
#pragma unroll
                    for (int i = 0; i < 4; ++i) { const unsigned w = gw[i]; const float g0 = __builtin_bit_cast(float, w << 16), g1 = __builtin_bit_cast(float, w & 0xffff0000u);
                        if (MODE == 0) { r[2 * i] = a[2 * i] * __builtin_amdgcn_rcpf(1.0f + __builtin_amdgcn_exp2f(-1.4426950408889634f * g0)); r[2 * i + 1] = a[2 * i + 1] * __builtin_amdgcn_rcpf(1.0f + __builtin_amdgcn_exp2f(-1.4426950408889634f * g1)); }
                        else { r[2 * i] = g0 * a[2 * i] * __builtin_amdgcn_rcpf(1.0f + __builtin_amdgcn_exp2f(-1.4426950408889634f * a[2 * i])); r[2 * i + 1] = g1 * a[2 * i + 1] * __builtin_amdgcn_rcpf(1.0f + __builtin_amdgcn_exp2f(-1.4426950408889634f * a[2 * i + 1])); } }
                    if (Add) { const u32x4 aw = *(const u32x4*)(Add + ro + bj * HALF);
#pragma unroll
                        for (int i = 0; i < 4; ++i) { const unsigned w = aw[i]; r[2 * i] += __builtin_bit_cast(float, w << 16); r[2 * i + 1] += __builtin_bit_cast(float, w & 0xffff0000u); } }
                    u32x4 w; w.x = cvt_pk_bf16(r[0], r[1]); w.y = cvt_pk_bf16(r[2], r[3]); w.z = cvt_pk_bf16(r[4], r[5]); w.w = cvt_pk_bf16(r[6], r[7]);
                    *(u32x4*)(O + ro + bj * HALF) = w; } }
    }
};
struct EpiF32 {
    static constexpr bool PERM = false, AFTER_DRAIN = false;
    float* O; int ldc, pad_;
    __device__ __forceinline__ void operator()(const f32x4 (&acc)[2][2][4][2], const Unit& u, int wr, int wc, int fr, int fq) const {
        const int row0 = u.pm * BM + wr * 64 + fr; const int col0 = u.pn * BM + wc * 32 + 4 * fq;
#pragma unroll
        for (int ai = 0; ai < 2; ++ai)
#pragma unroll
            for (int m = 0; m < 4; ++m) { float* rowp = O + (size_t)(row0 + ai * HALF + m * 16) * ldc + col0;
#pragma unroll
                for (int bj = 0; bj < 2; ++bj)
#pragma unroll
                    for (int n = 0; n < 2; ++n) *(f32x4*)(rowp + bj * HALF + n * 16) = acc[ai][bj][m][n]; }
    }
};
struct EpiP1b {
    static constexpr bool PERM = true, AFTER_DRAIN = false;
    const bf16_t* ob; bf16_t* gates; size_t gate_stride; bf16_t* ob_out;
    __device__ __forceinline__ void operator()(const f32x4 (&acc)[2][2][4][2], const Unit& u, int wr, int wc, int fr, int fq) const {
        if (u.pn < 4) { EpiGate<1> E{ob_out, ob, nullptr, 1024, 0}; E(acc, u, wr, wc, fr, fq); }
        else { Unit v = u; v.pn = (u.pn - 4) & 3; EpiBf16 E{gates + (size_t)((u.pn - 4) >> 2) * gate_stride, 1024, 0, 0}; E(acc, v, wr, wc, fr, fq); }
    }
};
struct EpiRmsRes {
    static constexpr bool PERM = false, AFTER_DRAIN = true;
    const float* xres; const float* w; float* out; float* xbuf; unsigned* cnt;
    __device__ __forceinline__ void fused(f32x4 (&acc)[2][2][4][2], const Unit& u, int wr, int wc, int fr, int fq, PG8_LAS unsigned char* lds, int wid, int lane) const {
        PG8_LAS float* P = (PG8_LAS float*)lds;
        PG8_LAS float* R = (PG8_LAS float*)(lds + 4096);
#pragma unroll
        for (int ai = 0; ai < 2; ++ai)
#pragma unroll
            for (int m = 0; m < 4; ++m) { float s = 0.f;
#pragma unroll
                for (int bj = 0; bj < 2; ++bj)
#pragma unroll
                    for (int n = 0; n < 2; ++n) { const f32x4 x = acc[ai][bj][m][n]; s += (x[0] * x[0] + x[1] * x[1]) + (x[2] * x[2] + x[3] * x[3]); }
                s += __shfl_xor(s, 16); s += __shfl_xor(s, 32);
                if (fq == 0) P[(ai * HALF + wr * 64 + m * 16 + fr) * 4 + wc] = s; }
        asm volatile("s_waitcnt lgkmcnt(0)" ::: "memory"); __builtin_amdgcn_s_barrier(); asm volatile("" ::: "memory");
        const int row = wid * 32 + (lane & 31);
        if (lane < 32) { const f32x4 p = *(const PG8_LAS f32x4*)(P + row * 4);
            __hip_atomic_store(xbuf + (size_t)(u.pm * BM + row) * 4 + u.pn, (p[0] + p[1]) + (p[2] + p[3]), __ATOMIC_RELAXED, __HIP_MEMORY_SCOPE_AGENT); }
        asm volatile("s_waitcnt vmcnt(0)" ::: "memory");
        if (lane == 0) __hip_atomic_fetch_add(cnt + 64 * u.pm, 1u, __ATOMIC_RELAXED, __HIP_MEMORY_SCOPE_AGENT);
        if (wid == 0) {
            for (unsigned sp = 0; (unsigned)__builtin_amdgcn_readfirstlane((int)__hip_atomic_load(cnt + 64 * u.pm, __ATOMIC_RELAXED, __HIP_MEMORY_SCOPE_AGENT)) < 32u && sp < (1u << 22); ++sp) __builtin_amdgcn_s_sleep(2);
        }
        asm volatile("s_waitcnt vmcnt(0) lgkmcnt(0)" ::: "memory"); __builtin_amdgcn_s_barrier(); asm volatile("" ::: "memory");
        if (lane < 32) { const float* sl = xbuf + (size_t)(u.pm * BM + row) * 4; float t = 0.f;
#pragma unroll
            for (int i = 0; i < 4; ++i) t += __hip_atomic_load(sl + i, __ATOMIC_RELAXED, __HIP_MEMORY_SCOPE_AGENT);
            R[row] = 1.0f / sqrtf(t * (1.0f / 1024.0f) + 1e-6f); }
        asm volatile("s_waitcnt vmcnt(0) lgkmcnt(0)" ::: "memory"); __builtin_amdgcn_s_barrier(); asm volatile("" ::: "memory");
        const int col0 = u.pn * BM + wc * 32 + 4 * fq;
#pragma unroll
        for (int ai = 0; ai < 2; ++ai)
#pragma unroll
            for (int m = 0; m < 4; ++m) { const int r = ai * HALF + wr * 64 + m * 16 + fr; const float rs = R[r]; const size_t off = (size_t)(u.pm * BM + r) * 1024 + col0;
#pragma unroll
                for (int bj = 0; bj < 2; ++bj)
#pragma unroll
                    for (int n = 0; n < 2; ++n) { const int c = bj * HALF + n * 16; const f32x4 xv = *(const f32x4*)(xres + off + c); const f32x4 wv = *(const f32x4*)(w + col0 + c);
                        *(f32x4*)(out + off + c) = xv + acc[ai][bj][m][n] * rs * wv; }
                if (m & 1) asm volatile("" ::: "memory"); }
    }
};
struct PairOrder {
    StaticOrder S; int nM, nN;
    __host__ __device__ void init(int M, int N, int G_, int c_) { S.init(M, N, G_, c_); nM = M / BM; nN = N / BM; }
    __host__ __device__ bool next(int i, Unit& u) const { if (i > 1) return false; Unit b; if (!S.next(0, b)) return false; u.pm = b.pm + i * nM; u.pn = b.pn + i * nN; return true; }
    __device__ __forceinline__ void a_ready(const Unit&) const {}
    __device__ __forceinline__ void done(const Unit&) const {}
};
struct EpiMerge {
    static constexpr bool PERM = true, AFTER_DRAIN = false;
    bf16_t* m1; bf16_t* merged; const bf16_t* gates; size_t gate_stride; int nM, nN;
    __device__ __forceinline__ void operator()(const f32x4 (&acc)[2][2][4][2], const Unit& u, int wr, int wc, int fr, int fq) const {
        if (u.pm < nM) { EpiGate<0> E{m1, gates, nullptr, 1024, 0}; E(acc, u, wr, wc, fr, fq); }
        else { Unit v; v.pm = u.pm - nM; v.pn = u.pn - nN; EpiGate<0> E{merged, gates + gate_stride, m1, 1024, 0}; E(acc, v, wr, wc, fr, fq); }
    }
};
template <class Epi, class Sched, bool ALIGN_EPI = false, bool SP2 = false>
__device__ __forceinline__ void gemm_phase(PG8_LAS unsigned char* lds, const Gemm g, const Sched& S, const Epi& E) {
    int tid_l = threadIdx.x; asm volatile("" : "+v"(tid_l));
    const int tid = tid_l, wid = __builtin_amdgcn_readfirstlane(tid >> 6), lane = tid & 63, wr = wid >> 2, wc = wid & 3, fr = lane & 15, fq = lane >> 4;
    const int K = g.K, nt = K / BK;
    unsigned voffA[2], voffB[2];
#pragma unroll
    for (int i = 0; i < 2; ++i) { int R, C; stage_rc(tid * 16 + i * 8192, R, C); const int Rb = Epi::PERM ? ((R & ~31) + perm32(R & 31)) : R;
        voffA[i] = (unsigned)(R * K + C) * 2u; voffB[i] = (unsigned)(Rb * K + C) * 2u; }
    const size_t kstep = (size_t)(BK * 2);
    const size_t hstep = (size_t)HALF * K * 2;
    const size_t tstep = 2 * hstep;
    const unsigned ldsw = (unsigned)wid * 1024u;
    const int aoff = lds_byte(wr * 64 + fr, fq * 8), boff = lds_byte(wc * 32 + fr, fq * 8);
#define PG8_SA(b, h) (((b) * 2 + (h)) * HTB)
#define PG8_SB(b, h) ((4 + (b) * 2 + (h)) * HTB)
#define PG8_STAGE(bufoff, gbase, voff) do { _Pragma("unroll") for (int _i = 0; _i < 2; ++_i) \
        __builtin_amdgcn_global_load_lds((const unsigned*)((const char*)(gbase) + (voff)[_i]), (PG8_LAS unsigned*)(lds + (bufoff) + ldsw + _i * 8192), 16, 0, 0); } while (0)
#define PG8_LDA(dst, b, h) do { _Pragma("unroll") for (int m = 0; m < 4; ++m) _Pragma("unroll") for (int k = 0; k < 2; ++k) dst[m][k] = *(const PG8_LAS bf16x8*)(lds + PG8_SA(b, h) + aoff + m * 2048 + k * 1024); } while (0)
#define PG8_LDB(dst, b, h) do { _Pragma("unroll") for (int n = 0; n < 2; ++n) _Pragma("unroll") for (int k = 0; k < 2; ++k) dst[n][k] = *(const PG8_LAS bf16x8*)(lds + PG8_SB(b, h) + boff + n * 2048 + k * 1024); } while (0)
#define PG8_MMA(ai, bj, At, Bt) do { __builtin_amdgcn_s_setprio(1); _Pragma("unroll") for (int m = 0; m < 4; ++m) _Pragma("unroll") for (int n = 0; n < 2; ++n) _Pragma("unroll") for (int k = 0; k < 2; ++k) \
        acc[ai][bj][m][n] = __builtin_amdgcn_mfma_f32_16x16x32_bf16(Bt[n][k], At[m][k], acc[ai][bj][m][n], 0, 0, 0); __builtin_amdgcn_s_setprio(0); } while (0)
#define PG8_WAIT_V(n) asm volatile("s_waitcnt vmcnt(" #n ")" ::: "memory")
#define PG8_WAIT_L(n) asm volatile("s_waitcnt lgkmcnt(" #n ")" ::: "memory")
#define PG8_BAR __builtin_amdgcn_s_barrier()
#define PG8_SCHED __builtin_amdgcn_sched_barrier(0)
    Unit cur, nxt; int ui = 0;
    if (!S.next(0, cur)) return;
    f32x4 acc[2][2][4][2];
#pragma unroll
    for (int a = 0; a < 2; ++a)
#pragma unroll
        for (int b = 0; b < 2; ++b)
#pragma unroll
            for (int m = 0; m < 4; ++m)
#pragma unroll
                for (int n = 0; n < 2; ++n) acc[a][b][m][n] = (f32x4){0.f, 0.f, 0.f, 0.f};
    bf16x8 At[4][2], B0[2][2], B1[2][2];
    const char* cA = g.atile(cur.pm, tstep); const char* cB = (const char*)g.Bt + (size_t)cur.pn * tstep;
    S.a_ready(cur);
    if constexpr (SP2) {
        PG8_STAGE(PG8_SB(0, 0), cB, voffB); PG8_STAGE(PG8_SB(0, 1), cB + hstep, voffB); PG8_STAGE(PG8_SA(0, 0), cA, voffA); PG8_STAGE(PG8_SA(0, 1), cA + hstep, voffA);
        if (wr == 1) PG8_BAR;
        PG8_WAIT_V(2); PG8_BAR;
        PG8_STAGE(PG8_SB(1, 0), cB + kstep, voffB); PG8_STAGE(PG8_SA(1, 0), cA + kstep, voffA); PG8_STAGE(PG8_SB(1, 1), cB + hstep + kstep, voffB);
        PG8_WAIT_V(6); PG8_BAR;
    } else {
        PG8_STAGE(PG8_SB(0, 0), cB, voffB); PG8_STAGE(PG8_SA(0, 0), cA, voffA); PG8_STAGE(PG8_SB(0, 1), cB + hstep, voffB); PG8_STAGE(PG8_SA(0, 1), cA + hstep, voffA);
        if (wr == 1) PG8_BAR;
        PG8_WAIT_V(4); PG8_BAR;
        PG8_STAGE(PG8_SB(1, 0), cB + kstep, voffB); PG8_STAGE(PG8_SA(1, 0), cA + kstep, voffA); PG8_STAGE(PG8_SB(1, 1), cB + hstep + kstep, voffB);
        PG8_WAIT_V(6); PG8_BAR;
    }
    for (;;) {
        const bool has_next = S.next(ui + 1, nxt);
        const char* nA = has_next ? g.atile(nxt.pm, tstep) : cA; const char* nB = has_next ? (const char*)g.Bt + (size_t)nxt.pn * tstep : cB;
        for (int t = 0; t < nt; t += 2) {
            const bool last = (t == nt - 2);
            const char* a1 = cA + (size_t)(t + 1) * kstep;
            const char* a2 = last ? nA : cA + (size_t)(t + 2) * kstep; const char* b2 = last ? nB : cB + (size_t)(t + 2) * kstep;
            const char* a3 = a2 + kstep; const char* b3 = b2 + kstep;
            if (last && has_next) S.a_ready(nxt);
            if constexpr (SP2) {
            PG8_LDB(B0, 0, 0); PG8_LDB(B1, 0, 1); PG8_SCHED; PG8_LDA(At, 0, 0); PG8_STAGE(PG8_SA(1, 1), a1 + hstep, voffA);
            PG8_WAIT_V(8); PG8_WAIT_L(0); PG8_BAR; PG8_MMA(0, 0, At, B0); PG8_MMA(0, 1, At, B1); PG8_BAR; PG8_SCHED;
            PG8_LDA(At, 0, 1); PG8_STAGE(PG8_SB(0, 0), b2, voffB); PG8_STAGE(PG8_SB(0, 1), b2 + hstep, voffB); PG8_STAGE(PG8_SA(0, 0), a2, voffA);
            PG8_WAIT_V(8); PG8_WAIT_L(0); PG8_BAR; PG8_MMA(1, 0, At, B0); PG8_MMA(1, 1, At, B1); PG8_BAR; PG8_SCHED;
            PG8_LDB(B0, 1, 0); PG8_LDB(B1, 1, 1); PG8_SCHED; PG8_LDA(At, 1, 0); PG8_STAGE(PG8_SA(0, 1), a2 + hstep, voffA);
            PG8_WAIT_V(8); PG8_WAIT_L(0); PG8_BAR; PG8_MMA(0, 0, At, B0); PG8_MMA(0, 1, At, B1); PG8_BAR; PG8_SCHED;
            PG8_LDA(At, 1, 1); PG8_STAGE(PG8_SB(1, 0), b3, voffB); PG8_STAGE(PG8_SB(1, 1), b3 + hstep, voffB); PG8_STAGE(PG8_SA(1, 0), a3, voffA);
            PG8_WAIT_V(8); PG8_WAIT_L(0); PG8_BAR; PG8_MMA(1, 0, At, B0); PG8_MMA(1, 1, At, B1); PG8_BAR; PG8_SCHED;
            } else {
            PG8_LDB(B0, 0, 0); PG8_SCHED; PG8_LDA(At, 0, 0); PG8_STAGE(PG8_SA(1, 1), a1 + hstep, voffA);
            PG8_WAIT_L(8); PG8_BAR; PG8_WAIT_L(0); PG8_MMA(0, 0, At, B0); PG8_BAR; PG8_SCHED;
            PG8_LDB(B1, 0, 1); PG8_STAGE(PG8_SB(0, 0), b2, voffB);
            PG8_BAR; PG8_WAIT_L(0); PG8_MMA(0, 1, At, B1); PG8_BAR;
            PG8_LDA(At, 0, 1); PG8_STAGE(PG8_SA(0, 0), a2, voffA);
            PG8_BAR; PG8_WAIT_L(0); PG8_MMA(1, 0, At, B0); PG8_BAR; PG8_SCHED;
            PG8_STAGE(PG8_SB(0, 1), b2 + hstep, voffB);
            PG8_WAIT_V(6); PG8_BAR; PG8_MMA(1, 1, At, B1); PG8_BAR;
            PG8_LDB(B0, 1, 0); PG8_SCHED; PG8_LDA(At, 1, 0); PG8_STAGE(PG8_SA(0, 1), a2 + hstep, voffA);
            PG8_WAIT_L(8); PG8_BAR; PG8_WAIT_L(0); PG8_MMA(0, 0, At, B0); PG8_BAR; PG8_SCHED;
            PG8_LDB(B1, 1, 1); PG8_STAGE(PG8_SB(1, 0), b3, voffB);
            PG8_BAR; PG8_WAIT_L(0); PG8_MMA(0, 1, At, B1); PG8_BAR;
            PG8_LDA(At, 1, 1); PG8_STAGE(PG8_SA(1, 0), a3, voffA);
            PG8_BAR; PG8_WAIT_L(0); PG8_MMA(1, 0, At, B0); PG8_BAR; PG8_SCHED;
            PG8_STAGE(PG8_SB(1, 1), b3 + hstep, voffB);
            PG8_WAIT_V(6); PG8_BAR; PG8_MMA(1, 1, At, B1); PG8_BAR;
            }
        }
        if constexpr (ALIGN_EPI) { if (wr == 0) PG8_BAR; }
        if constexpr (!Epi::AFTER_DRAIN) { E(acc, cur, wr, wc, fr, fq); S.done(cur); }
        if (!has_next) break;
#pragma unroll
        for (int a = 0; a < 2; ++a)
#pragma unroll
            for (int b = 0; b < 2; ++b)
#pragma unroll
                for (int m = 0; m < 4; ++m)
#pragma unroll
                    for (int n = 0; n < 2; ++n) acc[a][b][m][n] = (f32x4){0.f, 0.f, 0.f, 0.f};
        cur = nxt; cA = nA; cB = nB; ++ui;
        if constexpr (ALIGN_EPI) { if (wr == 1) PG8_BAR; }
    }
    PG8_WAIT_V(0);
    if constexpr (!ALIGN_EPI) { if (wr == 0) PG8_BAR; }
    PG8_BAR;
    if constexpr (Epi::AFTER_DRAIN) { E.fused(acc, cur, wr, wc, fr, fq, lds, wid, lane); S.done(cur); }
#undef PG8_SA
#undef PG8_SB
#undef PG8_STAGE
#undef PG8_LDA
#undef PG8_LDB
#undef PG8_MMA
#undef PG8_WAIT_V
#undef PG8_WAIT_L
#undef PG8_BAR
#undef PG8_SCHED
}
}
typedef __bf16 bf16x2_t __attribute__((ext_vector_type(2)));
typedef float f32x2_t __attribute__((ext_vector_type(2)));
typedef short bf16x8 __attribute__((ext_vector_type(8)));
typedef float f32x16 __attribute__((ext_vector_type(16)));
#define MFMA32(a, b, c) __builtin_amdgcn_mfma_f32_32x32x16_bf16((a), (b), (c), 0, 0, 0)
__device__ __forceinline__ unsigned pkbf(float a, float b) { bf16x2_t v = __builtin_convertvector((f32x2_t){a, b}, bf16x2_t); return __builtin_bit_cast(unsigned, v); }
__device__ __forceinline__ bf16x8 pack8(const f32x16& x, int s) { v4u p; p.x = pkbf(x[8 * s], x[8 * s + 1]); p.y = pkbf(x[8 * s + 2], x[8 * s + 3]); p.z = pkbf(x[8 * s + 4], x[8 * s + 5]); p.w = pkbf(x[8 * s + 6], x[8 * s + 7]); return __builtin_bit_cast(bf16x8, p); }
__device__ __forceinline__ f32x16 zero16() { f32x16 z;
#pragma unroll
    for (int i = 0; i < 16; ++i) z[i] = 0.f; return z; }
constexpr int CHUNK = 64, NCH = SEQ / CHUNK;
constexpr float QSCALE = 0.08838834764831845f;
__device__ __forceinline__ void glds_blocks(LAS unsigned char* dst, const unsigned char* src, int nblk, int wv, int nw, int lane) {
    for (int b = wv; b < nblk; b += nw)
        __builtin_amdgcn_global_load_lds((const unsigned*)(src + (size_t)b * 1024 + lane * 16), (LAS unsigned*)(dst + b * 1024), 16, 0, 0);
}
__device__ __forceinline__ void glds_blocks_asm(LAS unsigned char* dst, const unsigned char* src, int nblk, int wv, int nw, int lane) {
    for (int b = wv; b < nblk; b += nw) {
        const unsigned la = (unsigned)(size_t)(dst + b * 1024);
        asm volatile("s_mov_b32 m0, %1\n\ts_nop 0\n\tglobal_load_lds_dwordx4 %0, off" :: "v"(src + (size_t)b * 1024 + lane * 16), "s"(la) : "memory");
    }
}
__device__ __forceinline__ bf16x8 lds_frag(const LAS unsigned char* base, int blk, int lane) { return *(const LAS bf16x8*)(base + blk * 1024 + lane * 16); }

namespace gdn {
constexpr int B_KA = 0, B_QA = 16384, B_SC = 32768, B_KT = 34816, B_TBF = 51200, B_AF = 59392, B_TBB = 67584, B_AB = 75776, B_VT = 83968, BLOB = 100352;
constexpr int XBLK = 34, YBLK = 32;
}

__device__ __forceinline__ float row16_sum(float v) {
    v += __builtin_bit_cast(float, __builtin_amdgcn_mov_dpp(__builtin_bit_cast(int, v), 0xB1, 0xF, 0xF, true));
    v += __builtin_bit_cast(float, __builtin_amdgcn_mov_dpp(__builtin_bit_cast(int, v), 0x4E, 0xF, 0xF, true));
    v += __builtin_bit_cast(float, __builtin_amdgcn_mov_dpp(__builtin_bit_cast(int, v), 0x141, 0xF, 0xF, true));
    v += __builtin_bit_cast(float, __builtin_amdgcn_mov_dpp(__builtin_bit_cast(int, v), 0x140, 0xF, 0xF, true));
    return v;
}
__device__ __forceinline__ float quad_sum(float v) {
    v += __builtin_bit_cast(float, __builtin_amdgcn_mov_dpp(__builtin_bit_cast(int, v), 0xB1, 0xF, 0xF, true));
    v += __builtin_bit_cast(float, __builtin_amdgcn_mov_dpp(__builtin_bit_cast(int, v), 0x4E, 0xF, 0xF, true));
    return v;
}
struct GdnPrepArgs {
    const bf16 *pq, *pk, *pv;
    const float* small;
    const float* conv_w;
    const float *a_log_f, *a_log_b, *dtb_f, *dtb_b;
    unsigned char* blob;
    int nseq, pad_;
};
namespace gdn {
constexpr int L_PRE = 0, L_QN = 52224, L_KN = L_QN + 17408, L_SC = L_KN + 17408, L_LPF = L_SC + 1024, L_LPB = L_LPF + 16384, L_AF = L_LPB + 16384, L_AB = L_AF + 9216, L_TBF = L_AB + 9216, L_TBB = L_TBF + 9216, L_END = L_TBB + 9216;
static_assert(L_END <= 160 * 1024 - 256, "gdn prep LDS");
constexpr int QS_ = 272, AS_ = 144;

__device__ __forceinline__ v4u frag_rm_perm(const LAS unsigned char* img, int st, int rt, int ks, int lane) {
    const int r = lane & 31, hh = lane >> 5; const LAS unsigned char* p = img + (32 * rt + r) * st + (16 * ks + 4 * hh) * 2;
    const v2u lo = *(const LAS v2u*)p, hi = *(const LAS v2u*)(p + 16);
    return (v4u){lo.x, lo.y, hi.x, hi.y};
}
__device__ __forceinline__ v4u frag_tr_perm(const LAS unsigned char* img, int st, int rt, int ks, int lane) {
    const int r = lane & 31, hh = lane >> 5; const LAS unsigned char* p = img + (16 * ks + 4 * hh) * st + (32 * rt + r) * 2;
    unsigned short e[8];
#pragma unroll
    for (int j = 0; j < 8; ++j) e[j] = *(const LAS unsigned short*)(p + (8 * (j >> 2) + (j & 3)) * st);
    return (v4u){(unsigned)e[0] | ((unsigned)e[1] << 16), (unsigned)e[2] | ((unsigned)e[3] << 16), (unsigned)e[4] | ((unsigned)e[5] << 16), (unsigned)e[6] | ((unsigned)e[7] << 16)};
}
__device__ __forceinline__ v4u frag16_rm(const LAS unsigned char* img, int st, int rt, int ks, int lane) {
    const int r = lane & 15, q = lane >> 4; const LAS unsigned char* p = img + (16 * rt + r) * st + (32 * ks + 4 * q) * 2;
    const v2u lo = *(const LAS v2u*)p, hi = *(const LAS v2u*)(p + 32);
    return (v4u){lo.x, lo.y, hi.x, hi.y};
}
__device__ __forceinline__ v4u frag16_tr(const LAS unsigned char* img, int st, int rt, int ks, int lane) {
    const int r = lane & 15, q = lane >> 4; const LAS unsigned char* p = img + (32 * ks + 4 * q) * st + (16 * rt + r) * 2;
    unsigned short e[8];
#pragma unroll
    for (int j = 0; j < 8; ++j) e[j] = *(const LAS unsigned short*)(p + (16 * (j >> 2) + (j & 3)) * st);
    return (v4u){(unsigned)e[0] | ((unsigned)e[1] << 16), (unsigned)e[2] | ((unsigned)e[3] << 16), (unsigned)e[4] | ((unsigned)e[5] << 16), (unsigned)e[6] | ((unsigned)e[7] << 16)};
}
}

#define LBAR() do { asm volatile("s_waitcnt lgkmcnt(0)" ::: "memory"); __builtin_amdgcn_s_barrier(); asm volatile("" ::: "memory"); } while (0)
__device__ __forceinline__ void gdn_prep_issue(LAS unsigned char* lds, const GdnPrepArgs& A, int unit, int w, int lane, const unsigned char* zero_page) {
    using namespace gdn;
    const int n = unit % NCH, h = (unit / NCH) % 8, sq = unit / (NCH * 8); const size_t row0 = (size_t)sq * SEQ; const int t0 = n * CHUNK;
    for (int q4 = w; q4 < 51; q4 += 8) {
        const int seg = q4 * 4 + (lane >> 4), r = seg / 3, m = seg % 3, tl = t0 - 2 + r;
        const bf16* pmat = A.pq + (size_t)m * (size_t)(A.pk - A.pq);
        const unsigned char* src = (tl >= 0 && tl < SEQ) ? (const unsigned char*)(pmat + (row0 + tl) * 1024 + h * 128) : zero_page;
        const unsigned la = (unsigned)(size_t)(lds + L_PRE + q4 * 1024);
        asm volatile("s_mov_b32 m0, %1\n\ts_nop 0\n\tglobal_load_lds_dwordx4 %0, off" :: "v"(src + (lane & 15) * 16), "s"(la) : "memory");
    }
}
__device__ __forceinline__ f32x4 gdn_prep_scal(const GdnPrepArgs& A, int unit, int lane) {
    const int n = unit % NCH, h = (unit / NCH) % 8, sq = unit / (NCH * 8);
    const float* sm = A.small + ((size_t)sq * SEQ + n * CHUNK + lane) * 64;
    return (f32x4){sm[h], sm[8 + h], sm[16 + h], sm[24 + h]};
}
__device__ __forceinline__ void gdn_prep_block(const LAS unsigned char* lds, unsigned char* blob, int blk, int lane, int pflg) {
    using namespace gdn;
    v4u f; int off;
    if (blk < 16)      { f = frag16_rm(lds + L_KN, QS_, blk >> 2, blk & 3, lane); off = B_KA + blk * 1024; }
    else if (blk < 32) { const int b = blk - 16; f = frag16_rm(lds + L_QN, QS_, b >> 2, b & 3, lane); off = B_QA + b * 1024; }
    else if (blk < 48) { const int b = blk - 32; f = frag16_tr(lds + L_KN, QS_, b >> 1, b & 1, lane); off = B_KT + b * 1024; }
    else { const int b = blk - 48, wh = b >> 3, bb = b & 7; const int lo = wh == 0 ? L_TBF : wh == 1 ? L_AF : wh == 2 ? L_TBB : L_AB;
           f = frag16_rm(lds + lo, AS_, bb >> 1, bb & 1, lane); off = B_TBF + b * 1024; }
    if (!(pflg & 8)) *(v4u*)(blob + off + lane * 16) = f; else asm volatile("" :: "v"(f));
}
__device__ __forceinline__ void gdn_prep_s1(LAS unsigned char* lds, const GdnPrepArgs& A, int unit, const f32x4 smn, int lane, int pflg) {
    using namespace gdn;
    const int h = (unit / NCH) % 8;
    unsigned char* blob = A.blob + (size_t)unit * BLOB;
        const float xf = smn.x + A.dtb_f[h], xb = smn.y + A.dtb_b[h];
        const float spf = xf > 20.f ? xf : 0.6931471805599453f * __builtin_amdgcn_logf(1.0f + __builtin_amdgcn_exp2f(1.4426950408889634f * xf));
        const float spb = xb > 20.f ? xb : 0.6931471805599453f * __builtin_amdgcn_logf(1.0f + __builtin_amdgcn_exp2f(1.4426950408889634f * xb));
        const float gf = -__expf(A.a_log_f[h]) * spf, gb = -__expf(A.a_log_b[h]) * spb;
        float pf = gf, pb = gb;
#define SCAN_STEP(ctrl, rmask) do { pf += __builtin_bit_cast(float, __builtin_amdgcn_update_dpp(0, __builtin_bit_cast(int, pf), ctrl, rmask, 0xf, false)); \
                                     pb += __builtin_bit_cast(float, __builtin_amdgcn_update_dpp(0, __builtin_bit_cast(int, pb), ctrl, rmask, 0xf, false)); } while (0)
        SCAN_STEP(0x111, 0xf); SCAN_STEP(0x112, 0xf); SCAN_STEP(0x114, 0xf); SCAN_STEP(0x118, 0xf); SCAN_STEP(0x142, 0xa); SCAN_STEP(0x143, 0xc);
#undef SCAN_STEP
        const float totb = __builtin_bit_cast(float, __builtin_amdgcn_readlane(__builtin_bit_cast(int, pb), 63));
        const float gcf = pf, gcb = totb - pb + gb;
        LAS float* sc = (LAS float*)(lds + L_SC);
        sc[lane] = gcf; sc[64 + lane] = gcb; sc[128 + lane] = sigmoidf_(smn.z); sc[192 + lane] = sigmoidf_(smn.w);
        float* gsc = (float*)(blob + B_SC); if (pflg & 8) gsc = (float*)(lds + L_LPF);
        const float glf = __builtin_bit_cast(float, __builtin_amdgcn_readlane(__builtin_bit_cast(int, pf), 63)), glb = totb;
        gsc[lane] = gcf; gsc[64 + lane] = gcb; gsc[128 + lane] = __expf(gcf); gsc[192 + lane] = __expf(gcb); gsc[256 + lane] = __expf(glf - gcf); gsc[320 + lane] = __expf(glb - gcb);
        if (lane < 2) gsc[384 + lane] = __expf(lane ? glb : glf);
}
__device__ __forceinline__ void gdn_prep_phase(LAS unsigned char* lds, const GdnPrepArgs& A, int bid, int G, const unsigned char* zero_page) {
    using namespace gdn;
    int tid_l = threadIdx.x; asm volatile("" : "+v"(tid_l));
    const int tid = tid_l, lane = tid & 63, w = __builtin_amdgcn_readfirstlane(tid >> 6);
    const int nunits = A.nseq * 8 * NCH;
#ifdef PROBE_PREP
    const int pflg = A.pad_;
#else
    constexpr int pflg = 0;
#endif
    int unit = bid;
    f32x4 smn = (f32x4){0.f, 0.f, 0.f, 0.f};
    if (unit < nunits) { gdn_prep_issue(lds, A, unit, w, lane, zero_page); if (w == 0) smn = gdn_prep_scal(A, unit, lane); }
    if (unit < nunits && w == 0) gdn_prep_s1(lds, A, unit, smn, lane, pflg);
  for (; unit < nunits; unit += G) {
    const int h = (unit / NCH) % 8;
    unsigned char* blob = A.blob + (size_t)unit * BLOB;
    __builtin_amdgcn_s_waitcnt(0x0F70);
    __syncthreads();
    if (!(pflg & 32)) {
        const int p0 = 8 * w;
#pragma unroll
        for (int m = 0; m < 3; ++m) {
            float wc[5][2];
#pragma unroll
            for (int tau = 0; tau < 5; ++tau) { const f32x2_t t2 = *(const f32x2_t*)(A.conv_w + tau * 3072 + m * 1024 + h * 128 + 2 * lane); wc[tau][0] = t2.x; wc[tau][1] = t2.y; }
            float in[12][2];
#pragma unroll
            for (int i = 0; i < 12; ++i) { const unsigned u = *(const LAS unsigned*)(lds + L_PRE + ((p0 + i) * 3 + m) * 256 + lane * 4); in[i][0] = bflo(u); in[i][1] = bfhi(u); }
            float y[8][2];
#pragma unroll
            for (int pp = 0; pp < 8; ++pp)
#pragma unroll
                for (int c = 0; c < 2; ++c) { float s = 0.f;
#pragma unroll
                    for (int tau = 0; tau < 5; ++tau) s += wc[tau][c] * in[pp + tau][c];
                    y[pp][c] = s * __builtin_amdgcn_rcpf(1.0f + __builtin_amdgcn_exp2f(-1.4426950408889634f * s)); }
            if (m < 2) {
#pragma unroll
                for (int pp = 0; pp < 8; ++pp) { float ss = row16_sum(y[pp][0] * y[pp][0] + y[pp][1] * y[pp][1]); ss += __shfl_xor(ss, 16); ss += __shfl_xor(ss, 32); const float rn = __builtin_amdgcn_rsqf(ss + EPS);
                    *(LAS unsigned*)(lds + (m == 0 ? L_QN : L_KN) + (p0 + pp) * QS_ + lane * 4) = pkbf(y[pp][0] * rn, y[pp][1] * rn); }
            } else {
#pragma unroll
                for (int c = 0; c < 2; ++c) { v4u o; o.x = pkbf(y[0][c], y[1][c]); o.y = pkbf(y[2][c], y[3][c]); o.z = pkbf(y[4][c], y[5][c]); o.w = pkbf(y[6][c], y[7][c]);
                    if (!(pflg & 8)) *(v4u*)(blob + B_VT + (2 * lane + c) * 128 + p0 * 2) = o; }
            }
        }
    }
    __syncthreads();
    { const int un = unit + G; if (un < nunits) { gdn_prep_issue(lds, A, un, w, lane, zero_page); if (w == 0) smn = gdn_prep_scal(A, un, lane); } }
    {
        const int which = w >> 2, rt = (w >> 1) & 1, ct = w & 1, r = lane & 31, hh = lane >> 5;
        const LAS unsigned char* ia = lds + (which ? L_QN : L_KN) + (32 * rt + r) * QS_ + 16 * hh;
        const LAS unsigned char* ib = lds + L_KN + (32 * ct + r) * QS_ + 16 * hh;
        f32x16 acc = zero16();
#pragma unroll
        for (int ks = 0; ks < 8; ++ks) acc = MFMA32(*(const LAS bf16x8*)(ia + 32 * ks), *(const LAS bf16x8*)(ib + 32 * ks), acc);
        const LAS float* sc = (const LAS float*)(lds + L_SC);
        const int j = 32 * ct + r; const float gfj = sc[j], gbj = sc[64 + j];
#pragma unroll
        for (int reg = 0; reg < 16; ++reg) {
            const int i = 32 * rt + (reg & 3) + 8 * (reg >> 2) + 4 * hh; const float val = acc[reg];
            const float ef = __expf(sc[i] - gfj), eb = __expf(sc[64 + i] - gbj);
            if (which == 0) {
                const float lf = (i > j) ? sc[128 + i] * val * ef : 0.f, lb = (i < j) ? sc[192 + i] * val * eb : 0.f;
                ((LAS float*)(lds + L_LPF))[i * 64 + (j & 3) * 16 + (j >> 2)] = lf;
                const int i2 = 63 - i, j2 = 63 - j;
                ((LAS float*)(lds + L_LPB))[i2 * 64 + (j2 & 3) * 16 + (j2 >> 2)] = lb;
            } else {
                const float af = (i >= j) ? QSCALE * val * ef : 0.f, ab = (i <= j) ? QSCALE * val * eb : 0.f;
                *(LAS unsigned short*)(lds + L_AF + i * AS_ + j * 2) = (unsigned short)(pkbf(af, 0.f) & 0xffffu);
                *(LAS unsigned short*)(lds + L_AB + i * AS_ + j * 2) = (unsigned short)(pkbf(ab, 0.f) & 0xffffu);
            }
        }
    }
    LBAR();
    if (!(pflg & 16)) {
        const int dir = w >> 2, li = (w & 3) * 64 + lane, j = li >> 2, q = li & 3;
        const LAS float* LP = (const LAS float*)(lds + (dir ? L_LPB : L_LPF)) + q * 16;
        float t[16];
#pragma unroll
        for (int a = 0; a < 16; ++a) t[a] = 0.f;
        f32x4 lq[3][4];
#define SOLVE_LD(i_) do { _Pragma("unroll") for (int a4 = 0; a4 < ((i_) + 15) / 16; ++a4) lq[(i_) % 3][a4] = *(const LAS f32x4*)(LP + (i_) * 64 + 4 * a4); } while (0)
        SOLVE_LD(0); SOLVE_LD(1);
#pragma unroll
        for (int i = 0; i < 64; ++i) {
            if (i + 2 < 48) SOLVE_LD(i + 2);
            else if (i + 1 >= 48 && i + 1 < 64) SOLVE_LD(i + 1);
            float p0 = 0.f, p1 = 0.f;
#pragma unroll
            for (int a4 = 0; a4 < (i + 15) / 16; ++a4) { const f32x4 lv = lq[i % 3][a4];
                p0 = __builtin_fmaf(lv.x, t[4 * a4], p0); p1 = __builtin_fmaf(lv.y, t[4 * a4 + 1], p1); p0 = __builtin_fmaf(lv.z, t[4 * a4 + 2], p0); p1 = __builtin_fmaf(lv.w, t[4 * a4 + 3], p1); }
            float p = quad_sum(p0 + p1);
            const float ti = (i == j ? 1.f : 0.f) - p;
            if (q == (i & 3)) t[i >> 2] = ti;
            if ((i & 7) == 3 && !(pflg & 64)) {
                constexpr int kk = 0; const int k8 = i >> 3, b = w + 8 * (k8 & 1); v4u f; int off; (void)kk;
                if (k8 < 2)      { f = frag16_rm(lds + L_KN, QS_, b >> 2, b & 3, lane); off = B_KA + b * 1024; }
                else if (k8 < 4) { f = frag16_rm(lds + L_QN, QS_, b >> 2, b & 3, lane); off = B_QA + b * 1024; }
                else if (k8 < 6) { f = frag16_tr(lds + L_KN, QS_, b >> 1, b & 1, lane); off = B_KT + b * 1024; }
                else             { f = frag16_rm(lds + (k8 == 6 ? L_AF : L_AB), AS_, w >> 1, w & 1, lane); off = (k8 == 6 ? B_AF : B_AB) + w * 1024; }
                *(v4u*)(blob + off + lane * 16) = f; }
            __builtin_amdgcn_sched_barrier(0);
        }
#undef SOLVE_LD
        const LAS float* sc = (const LAS float*)(lds + L_SC);
        if (dir == 0) { const float bj = sc[128 + j];
#pragma unroll
            for (int a = 0; a < 16; ++a) *(LAS unsigned short*)(lds + L_TBF + (4 * a + q) * AS_ + j * 2) = (unsigned short)(pkbf(t[a] * bj, 0.f) & 0xffffu);
        } else { const int jo = 63 - j; const float bj = sc[192 + jo];
#pragma unroll
            for (int a = 0; a < 16; ++a) *(LAS unsigned short*)(lds + L_TBB + (63 - (4 * a + q)) * AS_ + jo * 2) = (unsigned short)(pkbf(t[a] * bj, 0.f) & 0xffffu);
        }
    }
    LBAR();
    const bool has_next = unit + G < nunits;
    if (has_next && w == 0) gdn_prep_s1(lds, A, unit + G, smn, lane, pflg);
    if (!(pflg & 64) && !(has_next && w == 0)) for (int l = has_next ? w - 1 : w; l < 16; l += has_next ? 7 : 8)
        gdn_prep_block(lds, blob, l < 8 ? 48 + l : 56 + l, lane, pflg);
    LBAR();
  }
}
struct GdnChainArgs {
    const unsigned char* blob;
    unsigned char* stg;
    unsigned* flag;
    int nseq, flags;
};
namespace gdn { constexpr int C_Y = XBLK * 1024, C_BUF = C_Y + YBLK * 1024, C_END = 2 * C_BUF; }
#define CHAIN_SPIN_CAP (1u << 22)
#define MFMA16(a, b, c) __builtin_amdgcn_mfma_f32_16x16x32_bf16((a), (b), (c), 0, 0, 0)
__device__ __forceinline__ bf16x8 pack16(const f32x4& a, const f32x4& b) { v4u p; p.x = pkbf(a.x, a.y); p.y = pkbf(a.z, a.w); p.z = pkbf(b.x, b.y); p.w = pkbf(b.z, b.w); return __builtin_bit_cast(bf16x8, p); }

__device__ __forceinline__ void gdn_chain_unit(LAS unsigned char* lds, const GdnChainArgs& A, int item, int half) {
    using namespace gdn;
    int tid_l = threadIdx.x; asm volatile("" : "+v"(tid_l));
    const int tid = tid_l, lane = tid & 63, w = __builtin_amdgcn_readfirstlane(tid >> 6);
    const int r = lane & 15, q = lane >> 4;
    const int cs = 4 * half + (w & 3), lw = w & 3;
    const int c = item & 1, h = (item >> 1) & 7, sq = item >> 4;
#ifdef MK_PROBES
    const int flags = A.flags;
#else
    constexpr int flags = 0;
#endif
    const size_t unit0 = (size_t)(sq * 8 + h) * NCH;
    const f32x4 z4 = (f32x4){0.f, 0.f, 0.f, 0.f};
    f32x4 S[8];
#pragma unroll
    for (int t = 0; t < 8; ++t) S[t] = z4;
    unsigned long long vnext[4] = {0ull, 0ull, 0ull, 0ull}, pwn[4] = {0ull, 0ull, 0ull, 0ull}; bool have = false; unsigned fnext = 0u;
    const unsigned lds0 = (unsigned)(size_t)lds;
    const bool probe = flags != 0;
#define DMA1(g_, l_) asm volatile("s_mov_b32 m0, %1\n\ts_nop 0\n\tglobal_load_lds_dwordx4 %0, off" :: "v"(g_), "s"(l_) : "memory")
#define CHUNK_OF(s_) (c ? NCH - 1 - (s_) : (s_))
#define WAITV(N_) asm volatile("s_waitcnt vmcnt(" #N_ ")" ::: "memory")
#ifndef LOADER_PACE
#define LOADER_PACE 2
#endif
    if (w >= 4) {
        const unsigned tbo = c ? B_TBB : B_TBF;
#define ISSUE_XG(s_) do { const unsigned char* g_ = A.blob + (unit0 + CHUNK_OF(s_)) * BLOB + lane * 16; const unsigned l_ = lds0 + ((s_) & 1) * C_BUF; \
        _Pragma("unroll") for (int k = 0; k < 8; ++k) { const unsigned o_ = (lw + 4 * k) * 1024; DMA1(g_ + o_, l_ + o_); __builtin_amdgcn_s_sleep(LOADER_PACE); } } while (0)
#define ISSUE_YG(s_) do { const unsigned char* g_ = A.blob + (unit0 + CHUNK_OF(s_)) * BLOB + lane * 16; const unsigned l_ = lds0 + ((s_) & 1) * C_BUF; \
        _Pragma("unroll") for (int k = 0; k < 9; ++k) { const int b_ = lw + 4 * k; if (b_ < 34) { unsigned so_, lo_; \
            if (b_ < 2) { so_ = B_SC + b_ * 1024; lo_ = so_; } else if (b_ < 18) { so_ = B_KT + (b_ - 2) * 1024; lo_ = C_Y + (b_ - 2) * 1024; } else { so_ = tbo + (b_ - 18) * 1024; lo_ = C_Y + 16384 + (b_ - 18) * 1024; } \
            DMA1(g_ + so_, l_ + lo_); __builtin_amdgcn_s_sleep(LOADER_PACE); } } } while (0)
        if (!(flags & 4)) { ISSUE_XG(0); ISSUE_YG(0); ISSUE_XG(1); }
        WAITV(0);
        LBAR();
        for (int s = 0; s < NCH; ++s) {
            if (s + 1 < NCH && !(flags & 4)) ISSUE_YG(s + 1);
            LBAR();
            if (s + 2 < NCH && !(flags & 4)) ISSUE_XG(s + 2);
            if (s <= NCH - 3 && !probe) WAITV(8); else WAITV(0);
            LBAR();
        }
#undef ISSUE_XG
#undef ISSUE_YG
        return;
    }
    __builtin_amdgcn_s_setprio(2);
#define VLOAD(s_) do { const unsigned char* vp_ = A.blob + (unit0 + CHUNK_OF(s_)) * BLOB + B_VT + (16 * cs + r) * 128 + 8 * q; \
        asm volatile("global_load_dwordx2 %0, %4, off\n\tglobal_load_dwordx2 %1, %4, off offset:32\n\tglobal_load_dwordx2 %2, %4, off offset:64\n\tglobal_load_dwordx2 %3, %4, off offset:96" \
                     : "=&v"(vnext[0]), "=&v"(vnext[1]), "=&v"(vnext[2]), "=&v"(vnext[3]) : "v"(vp_) : "memory"); } while (0)
    VLOAD(0);
    WAITV(0);
    LBAR();
    bool prev_raised = true;
    bf16x8 sb[4];
#pragma unroll
    for (int k = 0; k < 4; ++k) sb[k] = pack16(S[2 * k], S[2 * k + 1]);
    for (int s = 0; s < NCH; ++s) {
        const int n = CHUNK_OF(s);
        v2u vcur[4];
#pragma unroll
        for (int i = 0; i < 4; ++i) vcur[i] = (v2u){(unsigned)vnext[i], (unsigned)(vnext[i] >> 32)};
        unsigned long long* sp = (unsigned long long*)(A.stg + (unit0 + n) * 16384 + cs * 2048) + lane;
        unsigned* fl = A.flag + (unit0 + n) * 8 + cs;
        unsigned long long pw[4];
        if (s >= NCH / 2 && !(flags & 1)) {
            if (have) {
#pragma unroll
                for (int i = 0; i < 4; ++i) pw[i] = pwn[i];
            } else {
                for (unsigned sp_ = 0; __builtin_amdgcn_readfirstlane((int)__hip_atomic_load(fl, __ATOMIC_RELAXED, __HIP_MEMORY_SCOPE_AGENT)) == 0 && sp_ < CHAIN_SPIN_CAP; ++sp_) __builtin_amdgcn_s_sleep(2);
#pragma unroll
                for (int i = 0; i < 4; ++i) pw[i] = __hip_atomic_load(sp + i * 64, __ATOMIC_RELAXED, __HIP_MEMORY_SCOPE_AGENT);
                __builtin_amdgcn_s_waitcnt(0x0F70);
            }
        }
        const int s1 = s + 1 < NCH ? s + 1 : s, s2 = s + 2 < NCH ? s + 2 : NCH - 1;
        const bool have_next = s + 1 >= NCH / 2 && s + 1 < NCH && !(flags & 1) && __builtin_amdgcn_readfirstlane((int)fnext) != 0;
        have = have_next;
        const LAS unsigned char* X = lds + (s & 1) * C_BUF; const LAS unsigned char* Y = X + C_Y; const LAS unsigned char* YT = Y + 16384;
        const LAS float* sc = (const LAS float*)(X + B_SC);
        f32x4 KS[4], QS[4];
#pragma unroll
        for (int rt = 0; rt < 4; ++rt) { KS[rt] = z4; QS[rt] = z4; }
        bf16x8 ring2[8], ring3[8], ring4[8];
        f32x4 vf[4]; f32x4 ev1[4], ev2[4]; float egl = 1.f;
        {
            constexpr int R = 8; bf16x8 ring[R];
#define G1_LD(i_) lds_frag(X + (((i_) & 1) ? B_QA : B_KA), ((i_) >> 3) * 4 + (((i_) >> 1) & 3), lane)
#pragma unroll
            for (int i = 0; i < R; ++i) ring[i] = G1_LD(i);
#pragma unroll
            for (int i = 0; i < 32; ++i) { const int rt = i >> 3, ks = (i >> 1) & 3;
                if (i & 1) QS[rt] = MFMA16(ring[i % R], sb[ks], QS[rt]); else KS[rt] = MFMA16(ring[i % R], sb[ks], KS[rt]);
                if (i + R < 32) ring[i % R] = G1_LD(i + R);
                if (i == 0) egl = sc[384 + c];
                if (i >= 2 && i < 6) ev1[i - 2] = *(const LAS f32x4*)(sc + 128 + c * 64 + 16 * (i - 2) + 4 * q);
                if (i >= 8 && i < 12) ev2[i - 8] = *(const LAS f32x4*)(sc + 256 + c * 64 + 16 * (i - 8) + 4 * q);
                if (i >= 22 && i < 26) { const v2u vv = vcur[i - 22]; vf[i - 22] = (f32x4){bflo(vv.x), bfhi(vv.x), bflo(vv.y), bfhi(vv.y)}; }
                if (i >= 14 && i < 22) { const int t = i - 14; S[t].x *= egl; S[t].y *= egl; S[t].z *= egl; S[t].w *= egl; }
                if (i == 1) { const unsigned* f2 = A.flag + (unit0 + CHUNK_OF(s2)) * 8 + cs;
                    asm volatile("global_load_dword %0, %1, off sc1" : "=&v"(fnext) : "v"(f2) : "memory"); }
                if (i == 3 && s + 1 >= NCH / 2) { const unsigned long long* sp1 = (const unsigned long long*)(A.stg + (unit0 + CHUNK_OF(s1)) * 16384 + cs * 2048) + lane;
                    asm volatile("global_load_dwordx2 %0, %4, off sc1\n\tglobal_load_dwordx2 %1, %4, off offset:512 sc1\n\tglobal_load_dwordx2 %2, %4, off offset:1024 sc1\n\tglobal_load_dwordx2 %3, %4, off offset:1536 sc1"
                                 : "=&v"(pwn[0]), "=&v"(pwn[1]), "=&v"(pwn[2]), "=&v"(pwn[3]) : "v"(sp1) : "memory"); }
                if (i == 6) VLOAD(s1);
                if (i >= 24) ring2[i - 24] = lds_frag(YT, i - 24, lane);
                __builtin_amdgcn_sched_barrier(0); }
#undef G1_LD
        }
        LBAR();
#pragma unroll
        for (int rt = 0; rt < 4; ++rt) { const f32x4 ev = ev1[rt];
            KS[rt].x = vf[rt].x - ev.x * KS[rt].x; KS[rt].y = vf[rt].y - ev.y * KS[rt].y; KS[rt].z = vf[rt].z - ev.z * KS[rt].z; KS[rt].w = vf[rt].w - ev.w * KS[rt].w; }
        bf16x8 rb[2] = {pack16(KS[0], KS[1]), pack16(KS[2], KS[3])};
        f32x4 vn[4];
#pragma unroll
        for (int rt = 0; rt < 4; ++rt) vn[rt] = z4;
        f32x4 (&o)[4] = QS;
#pragma unroll
        for (int i = 0; i < 8; ++i) { vn[i >> 1] = MFMA16(ring2[i], rb[i & 1], vn[i >> 1]); ring3[i] = lds_frag(YT + 8192, i, lane);
            if (i < 4) { const f32x4 ev = ev1[i]; o[i].x *= QSCALE * ev.x; o[i].y *= QSCALE * ev.y; o[i].z *= QSCALE * ev.z; o[i].w *= QSCALE * ev.w; }
            __builtin_amdgcn_sched_barrier(0); }
        bf16x8 vb[2] = {pack16(vn[0], vn[1]), pack16(vn[2], vn[3])};
        bf16x8 vb2[2];
#pragma unroll
        for (int i = 0; i < 8; ++i) { o[i >> 1] = MFMA16(ring3[i], vb[i & 1], o[i >> 1]); ring4[i] = lds_frag(Y, i, lane);
            if (i < 4) { const f32x4 ev = ev2[i]; vn[i].x *= ev.x; vn[i].y *= ev.y; vn[i].z *= ev.z; vn[i].w *= ev.w; }
            if (i == 4) vb2[0] = pack16(vn[0], vn[1]);
            if (i == 5) vb2[1] = pack16(vn[2], vn[3]);
            __builtin_amdgcn_sched_barrier(0); }
        if (!(flags & 1)) {
            if (s < NCH / 2) {
#pragma unroll
                for (int rt = 0; rt < 4; ++rt) __hip_atomic_store(sp + rt * 64, (unsigned long long)pkbf(o[rt].x, o[rt].y) | ((unsigned long long)pkbf(o[rt].z, o[rt].w) << 32), __ATOMIC_RELAXED, __HIP_MEMORY_SCOPE_AGENT);
            } else {
#pragma unroll
                for (int rt = 0; rt < 4; ++rt) { const unsigned plo = (unsigned)pw[rt], phi = (unsigned)(pw[rt] >> 32);
                    __hip_atomic_store(sp + rt * 64, (unsigned long long)pkbf(o[rt].x + bflo(plo), o[rt].y + bfhi(plo)) | ((unsigned long long)pkbf(o[rt].z + bflo(phi), o[rt].w + bfhi(phi)) << 32), __ATOMIC_RELAXED, __HIP_MEMORY_SCOPE_AGENT); }
            }
        }
#pragma unroll
        for (int i = 0; i < 16; ++i) { S[i >> 1] = MFMA16(ring4[i % 8], vb2[i & 1], S[i >> 1]); if (i + 8 < 16) ring4[i % 8] = lds_frag(Y, i + 8, lane);
            if (i >= 5 && (i & 3) == 1) sb[(i - 5) >> 2] = pack16(S[(i - 5) >> 1], S[((i - 5) >> 1) + 1]);
            __builtin_amdgcn_sched_barrier(0); }
        sb[3] = pack16(S[6], S[7]);
        {
            const bool drain = probe || s >= NCH - 3 || s == NCH / 2 - 1;
            if (drain) WAITV(0); else WAITV(4);
            if (!(flags & 1) && lane == 0) {
                if (!prev_raised) __hip_atomic_store(A.flag + (unit0 + CHUNK_OF(s - 1)) * 8 + cs, s - 1 < NCH / 2 ? 1u : 2u, __ATOMIC_RELAXED, __HIP_MEMORY_SCOPE_AGENT);
                if (drain) __hip_atomic_store(fl, s < NCH / 2 ? 1u : 2u, __ATOMIC_RELAXED, __HIP_MEMORY_SCOPE_AGENT);
            }
            prev_raised = drain;
        }
        LBAR();
    }
#undef DMA1
#undef CHUNK_OF
#undef VLOAD
#undef WAITV
    __builtin_amdgcn_s_setprio(0);
}
namespace gla {
constexpr int B_QGF = 0, B_QGB = 16384, B_SC = 32768, B_KDTF = 33792, B_KDTB = 50176, BLOBA = 66560;
constexpr int B_VB = 0, B_INTRA = 32768, BLOBB = 65536;
constexpr int L_R = 0, L_QGF = 8192, L_KGF = L_QGF + 17408, L_KDF = L_KGF + 17408, L_QGB = L_KDF + 17408, L_KGB = L_QGB + 17408, L_KDB = L_KGB + 17408, L_V = L_KDB + 17408, L_TOT = L_V + 33792, L_AS = L_TOT + 4096, L_END = L_AS + 9216;
static_assert(L_END <= 160 * 1024 - 256, "gla prep LDS");
constexpr int QS_ = 272, VS_ = 528, AS_ = 144;
constexpr int C_X = 0, C_Y = 17408, C_CHAIN = 66560, C_EG = 2 * C_CHAIN, C_END = C_EG + 1024;
__device__ __forceinline__ v4u frag_tr_nat(const LAS unsigned char* img, int st, int colbase, int ks, int lane) {
    const int r = lane & 31, hh = lane >> 5; const LAS unsigned char* p = img + (16 * ks + 8 * hh) * st + (colbase + r) * 2;
    unsigned short e[8];
#pragma unroll
    for (int j = 0; j < 8; ++j) e[j] = *(const LAS unsigned short*)(p + j * st);
    return (v4u){(unsigned)e[0] | ((unsigned)e[1] << 16), (unsigned)e[2] | ((unsigned)e[3] << 16), (unsigned)e[4] | ((unsigned)e[5] << 16), (unsigned)e[6] | ((unsigned)e[7] << 16)};
}
__device__ __forceinline__ float logsig2(float x) { const float xc = fminf(fmaxf(x, -60.f), 60.f); return -__builtin_amdgcn_logf(1.0f + __builtin_amdgcn_exp2f(-1.4426950408889634f * xc)); }
}

struct GlaPrepArgs {
    const bf16* qk;
    const bf16* vb;
    const float* small;
    const float *w2f, *b2f, *w2b, *b2b;
    unsigned char* blobA;
    unsigned char* blobB;
    int nseq, pad_;
};

__device__ __forceinline__ void gla_prep_phase(LAS unsigned char* lds, const GlaPrepArgs& A, int bid, int G) {
    using namespace gla;
    int tid_l = threadIdx.x; asm volatile("" : "+v"(tid_l));
    const int tid = tid_l, lane = tid & 63, w = __builtin_amdgcn_readfirstlane(tid >> 6);
    const int nunits = A.nseq * 4 * NCH;
    f32x4 pr; v4u pv[4], pq[2], pk[2];
#define GLA_PREFETCH(u_) do { const int n_ = (u_) % NCH, h_ = ((u_) / NCH) % 4, sq_ = (u_) / (NCH * 4); const size_t r_ = (size_t)sq_ * SEQ + n_ * CHUNK; \
        pr = *(const f32x4*)(A.small + (r_ + (tid >> 3)) * 64 + 32 + (tid & 7) * 4); \
        _Pragma("unroll") for (int i = 0; i < 4; ++i) { const int id = i * 512 + tid; pv[i] = *(const v4u*)(A.vb + (r_ + (id >> 5)) * 1024 + h_ * 256 + (id & 31) * 8); } \
        _Pragma("unroll") for (int i = 0; i < 2; ++i) { const int id = i * 512 + tid; const bf16* qp_ = A.qk + (r_ + (id >> 4)) * 1024 + h_ * 128 + (id & 15) * 8; pq[i] = *(const v4u*)qp_; pk[i] = *(const v4u*)(qp_ + 512); } } while (0)
    int unit = bid;
    if (unit < nunits) GLA_PREFETCH(unit);
  for (; unit < nunits; unit += G) {
    const int h = (unit / NCH) % 4;
    unsigned char* blob = A.blobA + (size_t)unit * BLOBA; unsigned char* blobB = A.blobB + (size_t)unit * BLOBB;
    *(LAS f32x4*)(lds + L_R + (tid >> 3) * 128 + (tid & 7) * 16) = pr;
#pragma unroll
    for (int i = 0; i < 4; ++i) { const int id = i * 512 + tid; *(LAS v4u*)(lds + L_V + (id >> 5) * VS_ + (id & 31) * 16) = pv[i]; }
#pragma unroll
    for (int i = 0; i < 2; ++i) { const int id = i * 512 + tid; *(LAS v4u*)(lds + L_QGF + (id >> 4) * QS_ + (id & 15) * 16) = pq[i]; *(LAS v4u*)(lds + L_KGF + (id >> 4) * QS_ + (id & 15) * 16) = pk[i]; }
    LBAR();
    {
        const int dd = tid & 127, pg = tid >> 7, d = h * 128 + dd;
        float wf[16], wb[16];
#pragma unroll
        for (int i = 0; i < 16; ++i) { wf[i] = A.w2f[i * 512 + d]; wb[i] = A.w2b[i * 512 + d]; }
        const float bf_ = A.b2f[d], bb_ = A.b2b[d];
        float lf[16], lb[16];
#pragma unroll
        for (int pp = 0; pp < 16; ++pp) {
            const LAS float* rr = (const LAS float*)(lds + L_R) + (pg * 16 + pp) * 32;
            float xf = bf_, xb = bb_;
#pragma unroll
            for (int i4 = 0; i4 < 4; ++i4) { const f32x4 a = *(const LAS f32x4*)(rr + 4 * i4), b = *(const LAS f32x4*)(rr + 16 + 4 * i4);
                xf += a.x * wf[4 * i4] + a.y * wf[4 * i4 + 1] + a.z * wf[4 * i4 + 2] + a.w * wf[4 * i4 + 3];
                xb += b.x * wb[4 * i4] + b.y * wb[4 * i4 + 1] + b.z * wb[4 * i4 + 2] + b.w * wb[4 * i4 + 3]; }
            lf[pp] = logsig2(xf) * (1.f / 16.f); lb[pp] = logsig2(xb) * (1.f / 16.f);
        }
#pragma unroll
        for (int pp = 1; pp < 16; ++pp) lf[pp] += lf[pp - 1];
#pragma unroll
        for (int pp = 14; pp >= 0; --pp) lb[pp] += lb[pp + 1];
        LAS float* tot = (LAS float*)(lds + L_TOT);
        tot[pg * 128 + dd] = lf[15]; tot[512 + pg * 128 + dd] = lb[0];
        LBAR();
        float offf = 0.f, offb = 0.f, glf = 0.f, glb = 0.f;
#pragma unroll
        for (int g = 0; g < 4; ++g) { const float tf = tot[g * 128 + dd], tb = tot[512 + g * 128 + dd]; glf += tf; glb += tb; if (g < pg) offf += tf; if (g > pg) offb += tb; }
        const float eglf = __builtin_amdgcn_exp2f(glf), eglb = __builtin_amdgcn_exp2f(glb);
        if (pg == 0) { float* sc = (float*)(blob + B_SC); sc[dd] = eglf; sc[128 + dd] = eglb; }
#pragma unroll
        for (int pp = 0; pp < 16; ++pp) {
            const int o = (pg * 16 + pp) * QS_ + dd * 2;
            const float qv = bf2f(*(const LAS unsigned short*)(lds + L_QGF + o)) * QSCALE, kv = bf2f(*(const LAS unsigned short*)(lds + L_KGF + o));
            const float ef = __builtin_amdgcn_exp2f(lf[pp] + offf), eb = __builtin_amdgcn_exp2f(lb[pp] + offb);
            const float rf = __builtin_amdgcn_rcpf(ef), rb = __builtin_amdgcn_rcpf(eb);
            *(LAS unsigned short*)(lds + L_QGF + o) = (unsigned short)(pkbf(qv * ef, 0.f) & 0xffffu);
            *(LAS unsigned short*)(lds + L_KGF + o) = (unsigned short)(pkbf(kv * rf, 0.f) & 0xffffu);
            *(LAS unsigned short*)(lds + L_KDF + o) = (unsigned short)(pkbf(kv * rf * eglf, 0.f) & 0xffffu);
            *(LAS unsigned short*)(lds + L_QGB + o) = (unsigned short)(pkbf(qv * eb, 0.f) & 0xffffu);
            *(LAS unsigned short*)(lds + L_KGB + o) = (unsigned short)(pkbf(kv * rb, 0.f) & 0xffffu);
            *(LAS unsigned short*)(lds + L_KDB + o) = (unsigned short)(pkbf(kv * rb * eglb, 0.f) & 0xffffu);
        }
    }
    LBAR();
    { const int un = unit + G; if (un < nunits) GLA_PREFETCH(un); }
    if (w < 4) {
        const int rt = w >> 1, ct = w & 1, r = lane & 31, hh = lane >> 5;
        f32x16 af = zero16(), ab = zero16();
        if (rt >= ct) { const LAS unsigned char* ia = lds + L_QGF + (32 * rt + r) * QS_ + 16 * hh; const LAS unsigned char* ib = lds + L_KGF + (32 * ct + r) * QS_ + 16 * hh;
#pragma unroll
            for (int ks = 0; ks < 8; ++ks) af = MFMA32(*(const LAS bf16x8*)(ia + 32 * ks), *(const LAS bf16x8*)(ib + 32 * ks), af); }
        if (rt <= ct) { const LAS unsigned char* ia = lds + L_QGB + (32 * rt + r) * QS_ + 16 * hh; const LAS unsigned char* ib = lds + L_KGB + (32 * ct + r) * QS_ + 16 * hh;
#pragma unroll
            for (int ks = 0; ks < 8; ++ks) ab = MFMA32(*(const LAS bf16x8*)(ia + 32 * ks), *(const LAS bf16x8*)(ib + 32 * ks), ab); }
        const int j = 32 * ct + r;
#pragma unroll
        for (int reg = 0; reg < 16; ++reg) { const int i = 32 * rt + (reg & 3) + 8 * (reg >> 2) + 4 * hh;
            const float val = (i >= j ? af[reg] : 0.f) + (i <= j ? ab[reg] : 0.f);
            *(LAS unsigned short*)(lds + L_AS + i * AS_ + j * 2) = (unsigned short)(pkbf(val, 0.f) & 0xffffu); }
    } else {
        const int b0 = w - 4;
#pragma unroll
        for (int k = 0; k < 16; ++k) {
            const int wh = k >> 2, b = b0 + 4 * (k & 3); v4u f; int off;
            if (wh == 0)      { f = gdn::frag_rm_perm(lds + L_QGF, QS_, b >> 3, b & 7, lane); off = B_QGF; }
            else if (wh == 1) { f = gdn::frag_rm_perm(lds + L_QGB, QS_, b >> 3, b & 7, lane); off = B_QGB; }
            else if (wh == 2) { f = frag_tr_nat(lds + L_KDF, QS_, 32 * (b >> 2), b & 3, lane); off = B_KDTF; }
            else              { f = frag_tr_nat(lds + L_KDB, QS_, 32 * (b >> 2), b & 3, lane); off = B_KDTB; }
            *(v4u*)(blob + off + b * 1024 + lane * 16) = f;
        }
    }
    LBAR();
    {
        const int ct = w, r = lane & 31, hh = lane >> 5;
        f32x16 o[2] = {zero16(), zero16()};
#pragma unroll
        for (int ks = 0; ks < 4; ++ks) {
            const v4u fb = frag_tr_nat(lds + L_V, VS_, 32 * ct, ks, lane);
            *(v4u*)(blobB + B_VB + (ct * 4 + ks) * 1024 + lane * 16) = fb;
            const bf16x8 bfr = __builtin_bit_cast(bf16x8, fb);
#pragma unroll
            for (int rt = 0; rt < 2; ++rt) o[rt] = MFMA32(*(const LAS bf16x8*)(lds + L_AS + (32 * rt + r) * AS_ + (16 * ks + 8 * hh) * 2), bfr, o[rt]);
        }
        unsigned long long* ip = (unsigned long long*)(blobB + B_INTRA) + (size_t)ct * 512 + lane;
#pragma unroll
        for (int rt = 0; rt < 2; ++rt)
#pragma unroll
            for (int g = 0; g < 4; ++g) ip[(rt * 4 + g) * 64] = (unsigned long long)pkbf(o[rt][4 * g], o[rt][4 * g + 1]) | ((unsigned long long)pkbf(o[rt][4 * g + 2], o[rt][4 * g + 3]) << 32);
    }
    LBAR();
  }
#undef GLA_PREFETCH
}

struct GlaChainArgs {
    const unsigned char* blobA;
    const unsigned char* blobB;
    unsigned char* stg;
    unsigned* flag;
    int nseq, flags;
};
namespace gla { constexpr int CB_Y = 17408, CB_BUF = 66560, CB_END = 2 * CB_BUF; }
__device__ __forceinline__ void gla_chain_unit(LAS unsigned char* lds, const GlaChainArgs& A, int item, int half) {
    using namespace gla;
    int tid_l = threadIdx.x; asm volatile("" : "+v"(tid_l));
    const int tid = tid_l, lane = tid & 63, w = __builtin_amdgcn_readfirstlane(tid >> 6);
    const int hh = lane >> 5;
    const int c = item & 1, h = (item >> 1) & 3, sq = item >> 3;
#ifdef MK_PROBES
    const int flags = A.flags;
#else
    constexpr int flags = 0;
#endif
    const int ct = 4 * half + (w & 3), lw = w & 3;
    const size_t unit0 = (size_t)(sq * 4 + h) * NCH;
    const unsigned lds0 = (unsigned)(size_t)lds;
    const bool probe = flags != 0;
#define DMA1(g_, l_) asm volatile("s_mov_b32 m0, %1\n\ts_nop 0\n\tglobal_load_lds_dwordx4 %0, off" :: "v"(g_), "s"(l_) : "memory")
#define CHUNK_OF(s_) (c ? NCH - 1 - (s_) : (s_))
#define WAITV(N_) asm volatile("s_waitcnt vmcnt(" #N_ ")" ::: "memory")
    if (w >= 4) {
        const unsigned qo = c ? B_QGB : B_QGF, ko = c ? B_KDTB : B_KDTF;
#define ISSUE_XG(s_) do { const unsigned char* g_ = A.blobA + (unit0 + CHUNK_OF(s_)) * BLOBA + qo + lane * 16; const unsigned l_ = lds0 + ((s_) & 1) * CB_BUF; \
        _Pragma("unroll") for (int k = 0; k < 4; ++k) { const unsigned o_ = (lw + 4 * k) * 1024; DMA1(g_ + o_, l_ + o_); } } while (0)
#define ISSUE_YG(s_) do { const unsigned char* ga_ = A.blobA + (unit0 + CHUNK_OF(s_)) * BLOBA + lane * 16; const unsigned char* gb_ = A.blobB + (unit0 + CHUNK_OF(s_)) * BLOBB + B_VB + half * 16384 + lane * 16; \
        const unsigned l_ = lds0 + ((s_) & 1) * CB_BUF; \
        _Pragma("unroll") for (int k = 0; k < 9; ++k) { const int b_ = lw + 4 * k; if (b_ < 33) { \
            if (b_ < 16) DMA1(ga_ + ko + b_ * 1024, l_ + CB_Y + b_ * 1024); else if (b_ < 32) DMA1(gb_ + (b_ - 16) * 1024, l_ + CB_Y + 16384 + (b_ - 16) * 1024); else DMA1(ga_ + B_SC, l_ + 16384); } } } while (0)
        if (!(flags & 4)) { ISSUE_XG(0); ISSUE_YG(0); ISSUE_XG(1); }
        WAITV(0);
        LBAR();
        for (int s = 0; s < NCH; ++s) {
            if (s + 1 < NCH && !(flags & 4)) ISSUE_YG(s + 1);
            if (s <= NCH - 2 && !probe) WAITV(12); else WAITV(0);
            LBAR();
            if (s + 2 < NCH && !(flags & 4)) ISSUE_XG(s + 2);
            if (s <= NCH - 3 && !probe) WAITV(12); else WAITV(0);
            LBAR();
        }
#undef ISSUE_XG
#undef ISSUE_YG
        return;
    }
    __builtin_amdgcn_s_setprio(2);
    f32x16 S[4];
#pragma unroll
    for (int t = 0; t < 4; ++t) S[t] = zero16();
    unsigned long long pwn[8] = {0ull, 0ull, 0ull, 0ull, 0ull, 0ull, 0ull, 0ull}; bool have = false; unsigned fnext = 0u;
    LBAR();
    bool prev_raised = true;
    for (int s = 0; s < NCH; ++s) {
        const int n = CHUNK_OF(s);
        unsigned long long* sp = (unsigned long long*)(A.stg + (unit0 + n) * 32768) + (size_t)ct * 512 + lane;
        unsigned* fl = A.flag + (unit0 + n) * 8 + ct;
        unsigned long long pw[8];
        if (s >= NCH / 2 && !(flags & 1)) {
            if (have) {
#pragma unroll
                for (int i = 0; i < 8; ++i) pw[i] = pwn[i];
            } else {
                for (unsigned sp_ = 0; __builtin_amdgcn_readfirstlane((int)__hip_atomic_load(fl, __ATOMIC_RELAXED, __HIP_MEMORY_SCOPE_AGENT)) == 0 && sp_ < CHAIN_SPIN_CAP; ++sp_) __builtin_amdgcn_s_sleep(2);
#pragma unroll
                for (int i = 0; i < 8; ++i) pw[i] = __hip_atomic_load(sp + i * 64, __ATOMIC_RELAXED, __HIP_MEMORY_SCOPE_AGENT);
                __builtin_amdgcn_s_waitcnt(0x0F70);
            }
        }
        const int s1 = s + 1 < NCH ? s + 1 : s, s2 = s + 2 < NCH ? s + 2 : NCH - 1;
        have = s + 1 >= NCH / 2 && s + 1 < NCH && !(flags & 1) && __builtin_amdgcn_readfirstlane((int)fnext) != 0;
        const LAS unsigned char* X = lds + (s & 1) * CB_BUF; const LAS unsigned char* Y = X + CB_Y;
        const LAS float* EG = (const LAS float*)(X + 16384) + c * 128;
        bf16x8 sb[8];
#pragma unroll
        for (int t = 0; t < 4; ++t) { sb[2 * t] = pack8(S[t], 0); sb[2 * t + 1] = pack8(S[t], 1); }
        f32x16 o[2] = {zero16(), zero16()};
        {   constexpr int R = 6; bf16x8 ring[R];
#pragma unroll
            for (int i = 0; i < R; ++i) ring[i] = lds_frag(X, i, lane);
#pragma unroll
            for (int i = 0; i < 16; ++i) { o[i >> 3] = MFMA32(ring[i % R], sb[i & 7], o[i >> 3]); if (i + R < 16) ring[i % R] = lds_frag(X, i + R, lane);
                if (i == 1) { const unsigned* f2 = A.flag + (unit0 + CHUNK_OF(s2)) * 8 + ct;
                    asm volatile("global_load_dword %0, %1, off sc1" : "=&v"(fnext) : "v"(f2) : "memory"); }
                if (i == 3 && s + 1 >= NCH / 2) { const unsigned long long* sp1 = (const unsigned long long*)(A.stg + (unit0 + CHUNK_OF(s1)) * 32768) + (size_t)ct * 512 + lane;
                    asm volatile("global_load_dwordx2 %0, %8, off sc1\n\tglobal_load_dwordx2 %1, %8, off offset:512 sc1\n\tglobal_load_dwordx2 %2, %8, off offset:1024 sc1\n\tglobal_load_dwordx2 %3, %8, off offset:1536 sc1\n\t"
                                 "global_load_dwordx2 %4, %8, off offset:2048 sc1\n\tglobal_load_dwordx2 %5, %8, off offset:2560 sc1\n\tglobal_load_dwordx2 %6, %8, off offset:3072 sc1\n\tglobal_load_dwordx2 %7, %8, off offset:3584 sc1"
                                 : "=&v"(pwn[0]), "=&v"(pwn[1]), "=&v"(pwn[2]), "=&v"(pwn[3]), "=&v"(pwn[4]), "=&v"(pwn[5]), "=&v"(pwn[6]), "=&v"(pwn[7]) : "v"(sp1) : "memory"); }
                __builtin_amdgcn_sched_barrier(0); }
        }
        LBAR();
        if (!(flags & 1)) {
            if (s < NCH / 2) {
#pragma unroll
                for (int rt = 0; rt < 2; ++rt)
#pragma unroll
                    for (int g = 0; g < 4; ++g) __hip_atomic_store(sp + (rt * 4 + g) * 64, (unsigned long long)pkbf(o[rt][4 * g], o[rt][4 * g + 1]) | ((unsigned long long)pkbf(o[rt][4 * g + 2], o[rt][4 * g + 3]) << 32), __ATOMIC_RELAXED, __HIP_MEMORY_SCOPE_AGENT);
            } else {
#pragma unroll
                for (int rt = 0; rt < 2; ++rt)
#pragma unroll
                    for (int g = 0; g < 4; ++g) { const unsigned plo = (unsigned)pw[rt * 4 + g], phi = (unsigned)(pw[rt * 4 + g] >> 32);
                        __hip_atomic_store(sp + (rt * 4 + g) * 64, (unsigned long long)pkbf(o[rt][4 * g] + bflo(plo), o[rt][4 * g + 1] + bfhi(plo)) | ((unsigned long long)pkbf(o[rt][4 * g + 2] + bflo(phi), o[rt][4 * g + 3] + bfhi(phi)) << 32), __ATOMIC_RELAXED, __HIP_MEMORY_SCOPE_AGENT); }
            }
        }
        {
            bf16x8 bfr[4];
#pragma unroll
            for (int ks = 0; ks < 4; ++ks) bfr[ks] = lds_frag(Y + 16384, (w & 3) * 4 + ks, lane);
#pragma unroll
            for (int t = 0; t < 4; ++t)
#pragma unroll
                for (int g = 0; g < 4; ++g) { const f32x4 ev = *(const LAS f32x4*)(EG + 32 * t + 8 * g + 4 * hh);
                    S[t][4 * g] *= ev.x; S[t][4 * g + 1] *= ev.y; S[t][4 * g + 2] *= ev.z; S[t][4 * g + 3] *= ev.w; }
            constexpr int R = 5; bf16x8 ring[R];
#pragma unroll
            for (int i = 0; i < R; ++i) ring[i] = lds_frag(Y, i, lane);
#pragma unroll
            for (int i = 0; i < 16; ++i) { S[i >> 2] = MFMA32(ring[i % R], bfr[i & 3], S[i >> 2]); if (i + R < 16) ring[i % R] = lds_frag(Y, i + R, lane); __builtin_amdgcn_sched_barrier(0); }
        }
        {
            const bool drain = probe || s >= NCH - 3 || s == NCH / 2 - 1;
            if (drain) WAITV(0); else WAITV(8);
            if (!(flags & 1) && lane == 0) {
                if (!prev_raised) __hip_atomic_store(A.flag + (unit0 + CHUNK_OF(s - 1)) * 8 + ct, s - 1 < NCH / 2 ? 1u : 2u, __ATOMIC_RELAXED, __HIP_MEMORY_SCOPE_AGENT);
                if (drain) __hip_atomic_store(fl, s < NCH / 2 ? 1u : 2u, __ATOMIC_RELAXED, __HIP_MEMORY_SCOPE_AGENT);
            }
            prev_raised = drain;
        }
        LBAR();
    }
#undef DMA1
#undef CHUNK_OF
#undef WAITV
    __builtin_amdgcn_s_setprio(0);
}

template <int NC, bool S16>
__device__ __forceinline__ void p4_unit(LAS unsigned char* lds, const unsigned char* slot, const unsigned char* intra, const bf16* zg, const float* nw, bf16* out, const unsigned* done, bool valid) {
    int tid_l = threadIdx.x; asm volatile("" : "+v"(tid_l));
    const int tid = tid_l & 255, lane = tid & 63, w = __builtin_amdgcn_readfirstlane(tid >> 6), r = lane & 31, hh = lane >> 5;
    constexpr int ST = NC * 2 + 16, NB = (NC / 32) * 8, CPR = NC / 8;
    constexpr int NBW = NB / 4, NIT = (64 * CPR) / 256;
    unsigned long long ivv[NBW]; v4u zw[NIT];
    if (valid) {
    if (intra) {
#pragma unroll
        for (int k = 0; k < NBW; ++k) ivv[k] = ((const unsigned long long*)intra)[(w + 4 * k) * 64 + lane]; }
    if (zg) {
#pragma unroll
        for (int it = 0; it < NIT; ++it) { const int idx = it * 256 + tid, row = idx / CPR, ch = idx % CPR; zw[it] = *(const v4u*)(zg + (size_t)row * 1024 + ch * 8); } }
    if (done) {
        for (unsigned sp_ = 0; sp_ < (1u << 22); ++sp_) { const unsigned f = lane < 8 ? __hip_atomic_load(done + lane, __ATOMIC_RELAXED, __HIP_MEMORY_SCOPE_AGENT) : 2u; if (__all(f == 2u)) break; __builtin_amdgcn_s_sleep(8); }
    }
    unsigned long long sv[NBW];
#pragma unroll
    for (int k = 0; k < NBW; ++k) sv[k] = __hip_atomic_load((const unsigned long long*)slot + (w + 4 * k) * 64 + lane, __ATOMIC_RELAXED, __HIP_MEMORY_SCOPE_AGENT);
#pragma unroll
    for (int k = 0; k < NBW; ++k) { const int b = w + 4 * k;
        const unsigned long long v = sv[k];
        float x0 = bflo((unsigned)v), x1 = bfhi((unsigned)v), x2 = bflo((unsigned)(v >> 32)), x3 = bfhi((unsigned)(v >> 32));
        if (intra) { const unsigned long long iv = ivv[k];
            x0 += bflo((unsigned)iv); x1 += bfhi((unsigned)iv); x2 += bflo((unsigned)(iv >> 32)); x3 += bfhi((unsigned)(iv >> 32)); }
        int row, col;
        if (S16) { row = 16 * (b & 3) + 4 * (lane >> 4); col = 16 * (b >> 2) + (lane & 15); }
        else { row = 32 * ((b >> 2) & 1) + 8 * (b & 3) + 4 * hh; col = 32 * (b >> 3) + r; }
        LAS unsigned char* p = lds + row * ST + col * 2;
        const unsigned a = pkbf(x0, x1), bq = pkbf(x2, x3);
        *(LAS unsigned short*)p = (unsigned short)(a & 0xffffu); *(LAS unsigned short*)(p + ST) = (unsigned short)(a >> 16);
        *(LAS unsigned short*)(p + 2 * ST) = (unsigned short)(bq & 0xffffu); *(LAS unsigned short*)(p + 3 * ST) = (unsigned short)(bq >> 16);
    }
    }
    __syncthreads();
    if (valid) {
#pragma unroll
    for (int it = 0; it < NIT; ++it) {
        const int idx = it * 256 + tid, row = idx / CPR, ch = idx % CPR;
        const v4u xw = *(const LAS v4u*)(lds + row * ST + ch * 16);
        float x[8] = {bflo(xw.x), bfhi(xw.x), bflo(xw.y), bfhi(xw.y), bflo(xw.z), bfhi(xw.z), bflo(xw.w), bfhi(xw.w)};
        float ss = 0.f;
#pragma unroll
        for (int i = 0; i < 8; ++i) ss += x[i] * x[i];
        ss = row16_sum(ss);
        if (NC == 256) ss += __shfl_xor(ss, 16);
        const float rstd = 1.0f / sqrtf(ss * (1.0f / NC) + EPS);
        f32x4 w0 = *(const f32x4*)(nw + ch * 8), w1 = *(const f32x4*)(nw + ch * 8 + 4);
        if (zg) { const v4u zq = zw[it];
            const float z[8] = {bflo(zq.x), bfhi(zq.x), bflo(zq.y), bfhi(zq.y), bflo(zq.z), bfhi(zq.z), bflo(zq.w), bfhi(zq.w)};
            w0.x *= z[0] * __builtin_amdgcn_rcpf(1.0f + __expf(-z[0])); w0.y *= z[1] * __builtin_amdgcn_rcpf(1.0f + __expf(-z[1])); w0.z *= z[2] * __builtin_amdgcn_rcpf(1.0f + __expf(-z[2])); w0.w *= z[3] * __builtin_amdgcn_rcpf(1.0f + __expf(-z[3]));
            w1.x *= z[4] * __builtin_amdgcn_rcpf(1.0f + __expf(-z[4])); w1.y *= z[5] * __builtin_amdgcn_rcpf(1.0f + __expf(-z[5])); w1.z *= z[6] * __builtin_amdgcn_rcpf(1.0f + __expf(-z[6])); w1.w *= z[7] * __builtin_amdgcn_rcpf(1.0f + __expf(-z[7])); }
        v4u o; o.x = pkbf(x[0] * rstd * w0.x, x[1] * rstd * w0.y); o.y = pkbf(x[2] * rstd * w0.z, x[3] * rstd * w0.w); o.z = pkbf(x[4] * rstd * w1.x, x[5] * rstd * w1.y); o.w = pkbf(x[6] * rstd * w1.z, x[7] * rstd * w1.w);
        *(v4u*)(out + (size_t)row * 1024 + ch * 8) = o;
    }
    }
    __syncthreads();
}
#define XB_TMO      128
#define XB_XCNT(j)  (256  + 64 * (j))
#define XB_XSUB(j)  (1280 + 64 * (j))
#define XB_XGEN(j)  (2304 + 64 * (j))
#define XB_TOP      3328
#define XB_TOPGEN   3392
#define XCD_BAR_WORDS 3456
#define XB_SPIN_CAP (1u << 18)

__device__ __forceinline__ unsigned xb_ld(unsigned* p)              { return __hip_atomic_load(p, __ATOMIC_RELAXED, __HIP_MEMORY_SCOPE_AGENT); }
__device__ __forceinline__ unsigned xb_add(unsigned* p, unsigned v) { return __hip_atomic_fetch_add(p, v, __ATOMIC_RELAXED, __HIP_MEMORY_SCOPE_AGENT); }
__device__ __forceinline__ unsigned xb_xcc_id() { return (unsigned)__builtin_amdgcn_s_getreg((3 << 11) | 20) & 0xFu; }
#define XB_SPIN(cond, bar) do { unsigned _sp = 0; while (cond) { __builtin_amdgcn_s_sleep(1); \
    if ((++_sp & 255u) == 0u) { if (xb_ld(&(bar)[XB_TMO])) break; if (_sp > XB_SPIN_CAP) { atomicAdd(&(bar)[XB_TMO], 1u); break; } } } } while (0)

struct XcdBarrier {
    unsigned* bar; unsigned x;
    volatile LAS unsigned* st;
};

__device__ __forceinline__ XcdBarrier xcd_barrier_post(unsigned* bar, volatile LAS unsigned* st) {
    XcdBarrier b; b.bar = bar; b.x = xb_xcc_id(); b.st = st;
    if (threadIdx.x == 0) (void)xb_add(&bar[XB_XCNT(b.x)], 1u);
    return b;
}
__device__ __forceinline__ void xcd_barrier_complete(unsigned* bar, unsigned x, unsigned& nloc, unsigned& nx) {
    const unsigned G = gridDim.x * gridDim.y * gridDim.z;
    unsigned sum, cnt, mine, sp = 0u;
    for (;;) {
        sum = 0u; cnt = 0u; mine = 0u;
#pragma unroll
        for (unsigned j = 0; j < 16; ++j) { const unsigned c = xb_ld(&bar[XB_XCNT(j)]); sum += c; cnt += (c > 0u) ? 1u : 0u; mine = (j == x) ? c : mine; }
        if (sum == G) break;
        __builtin_amdgcn_s_sleep(1);
        if ((++sp & 255u) == 0u) { if (xb_ld(&bar[XB_TMO])) break; if (sp > XB_SPIN_CAP) { atomicAdd(&bar[XB_TMO], 1u); break; } }
    }
    nloc = mine > 0u ? mine : 1u; nx = cnt > 0u ? cnt : 1u;
}

__device__ __forceinline__ void xcd_barrier(const XcdBarrier& b) {
    asm volatile("s_waitcnt vmcnt(0)" ::: "memory");
    __syncthreads();
    if (threadIdx.x == 0) {
        unsigned* bar = b.bar;
        __builtin_amdgcn_s_waitcnt(0);
        unsigned nloc = b.st[0], nx = b.st[1];
        if (nloc == 0u) { xcd_barrier_complete(bar, b.x, nloc, nx); b.st[0] = nloc; b.st[1] = nx; }
        const unsigned old = xb_add(&bar[XB_XSUB(b.x)], 1u);
        const unsigned gen = old / nloc;
        if (old + 1u == (gen + 1u) * nloc) {
            __builtin_amdgcn_fence(__ATOMIC_RELEASE, "agent");
            asm volatile("s_waitcnt vmcnt(0)" ::: "memory");
            const unsigned og = xb_add(&bar[XB_TOP], 1u);
            const unsigned tg = og / nx;
            if (og + 1u == (tg + 1u) * nx) xb_add(&bar[XB_TOPGEN], 1u);
            else XB_SPIN(xb_ld(&bar[XB_TOPGEN]) == tg, bar);
            __builtin_amdgcn_fence(__ATOMIC_ACQUIRE, "agent");
            xb_add(&bar[XB_XGEN(b.x)], 1u);
            asm volatile("s_waitcnt vmcnt(0)" ::: "memory");
        } else {
            XB_SPIN(xb_ld(&bar[XB_XGEN(b.x)]) == gen, bar);
            __builtin_amdgcn_fence(__ATOMIC_ACQUIRE, "agent");
            asm volatile("s_waitcnt vmcnt(0)" ::: "memory");
        }
    }
    __syncthreads();
}
__device__ __forceinline__ void transpose_item(const float* W, int ldw, int src_col0, int K, int ncols, bf16* WT, int dst_row0, LAS float* scr, int item, int lane) {
    asm volatile("" : "+v"(lane));
    const int nblk = ncols / 32, kb = item / nblk, nb = item % nblk, k0 = 64 * kb, n0 = 32 * nb;
    float tv[32];
#pragma unroll
    for (int i = 0; i < 32; ++i) { const int kk = 2 * i + (lane >> 5); tv[i] = W[(size_t)(k0 + kk) * ldw + src_col0 + n0 + (lane & 31)]; }
#pragma unroll
    for (int i = 0; i < 32; ++i) { const int kk = 2 * i + (lane >> 5); scr[kk * 33 + (lane & 31)] = tv[i]; }
    LDS_WAIT();
    const int c = lane & 7;
#pragma unroll
    for (int j = 0; j < 4; ++j) { const int n = (lane >> 3) + 8 * j; const LAS float* s = scr + (8 * c) * 33 + n;
        v4u o; o.x = pk2(s[0 * 33], s[1 * 33]); o.y = pk2(s[2 * 33], s[3 * 33]); o.z = pk2(s[4 * 33], s[5 * 33]); o.w = pk2(s[6 * 33], s[7 * 33]);
        *(v4u*)(WT + (size_t)(dst_row0 + n0 + n) * K + k0 + 8 * c) = o; }
    LDS_WAIT();
}

constexpr int WCV_MIX = 16 * ((1024 + 3072 + 1024 + 1024 + 32 + 32) / 32), WCV_ALL = WCV_MIX + 16 * ((1024 + 2048) / 32) + 3 * 512;
__device__ __forceinline__ void wconv_item(int it, const float* w_in, const float* wa, const float* wb, const float* wo, bf16* WT_IN, bf16* WT_A, bf16* WT_B, bf16* WT_O, LAS float* scr, int lane) {
    constexpr int c0 = 512, c1 = c0 + 1536, c2 = c1 + 512, c3 = c2 + 512, c4 = c3 + 16, c5 = c4 + 16, c6 = c5 + 512, c7 = c6 + 1024, c8 = c7 + 512, c9 = c8 + 512;
    static_assert(c5 == WCV_MIX && c9 + 512 == WCV_ALL, "weight conversion item list");
    if (it < c0) transpose_item(w_in, NIN, SRC_ZA, D, 1024, WT_IN, 0, scr, it, lane);
    else if (it < c1) transpose_item(w_in, NIN, SRC_QKVA, D, 3072, WT_IN, 1024, scr, it - c0, lane);
    else if (it < c2) transpose_item(w_in, NIN, SRC_QB, D, 1024, WT_IN, 4096, scr, it - c1, lane);
    else if (it < c3) transpose_item(w_in, NIN, SRC_VB, D, 1024, WT_IN, 5120, scr, it - c2, lane);
    else if (it < c4) transpose_item(w_in, NIN, SRC_AF, D, 32, WT_IN, 9216, scr, it - c3, lane);
    else if (it < c5) transpose_item(w_in, NIN, SRC_RF, D, 32, WT_IN, 9248, scr, it - c4, lane);
    else if (it < c6) transpose_item(w_in, NIN, SRC_GB, D, 1024, WT_IN, 6144, scr, it - c5, lane);
    else if (it < c7) transpose_item(w_in, NIN, SRC_GA, D, 2048, WT_IN, 7168, scr, it - c6, lane);
    else if (it < c8) transpose_item(wa, D, 0, D, D, WT_A, 0, scr, it - c7, lane);
    else if (it < c9) transpose_item(wb, D, 0, D, D, WT_B, 0, scr, it - c8, lane);
    else transpose_item(wo, D, 0, D, D, WT_O, 0, scr, it - c9, lane);
}
template <class OutRow>
__device__ __forceinline__ void h_rows_t(const float* x, const float* w, OutRow orow, int nrows, int gw, int ngw, int lane) {
    asm volatile("" : "+v"(lane));
    f32x4 v[2][4], vn[2][4], ww[4];
#pragma unroll
    for (int j = 0; j < 4; ++j) ww[j] = ((const f32x4*)w)[(j >> 1) * 128 + 2 * lane + (j & 1)];
#pragma unroll
    for (int u = 0; u < 2; ++u) { const int m = gw + u * ngw; if (m < nrows) { const f32x4* xr = (const f32x4*)(x + (size_t)m * D) + 2 * lane;
#pragma unroll
        for (int j = 0; j < 4; ++j) v[u][j] = xr[(j >> 1) * 128 + (j & 1)]; } }
    for (int m0 = gw; m0 < nrows; m0 += 2 * ngw) {
#pragma unroll
        for (int u = 0; u < 2; ++u) { const int m = m0 + (2 + u) * ngw; if (m < nrows) { const f32x4* xr = (const f32x4*)(x + (size_t)m * D) + 2 * lane;
#pragma unroll
            for (int j = 0; j < 4; ++j) vn[u][j] = xr[(j >> 1) * 128 + (j & 1)]; } }
#pragma unroll
        for (int u = 0; u < 2; ++u) { const int m = m0 + u * ngw; if (m < nrows) {
            float s = 0.f;
#pragma unroll
            for (int j = 0; j < 4; ++j) s += (v[u][j].x * v[u][j].x + v[u][j].y * v[u][j].y) + (v[u][j].z * v[u][j].z + v[u][j].w * v[u][j].w);
            const float rstd = 1.0f / sqrtf(wave_sum(s) * (1.f / D) + EPS);
            v4u* o16 = (v4u*)orow(m) + lane;
#pragma unroll
            for (int jj = 0; jj < 2; ++jj) { const f32x4 a = v[u][2 * jj], b = v[u][2 * jj + 1], wa = ww[2 * jj], wb = ww[2 * jj + 1];
                o16[64 * jj] = (v4u){pkbf(a.x * rstd * wa.x, a.y * rstd * wa.y), pkbf(a.z * rstd * wa.z, a.w * rstd * wa.w), pkbf(b.x * rstd * wb.x, b.y * rstd * wb.y), pkbf(b.z * rstd * wb.z, b.w * rstd * wb.w)}; } } }
#pragma unroll
        for (int u = 0; u < 2; ++u)
#pragma unroll
            for (int j = 0; j < 4; ++j) v[u][j] = vn[u][j];
    }
}
__device__ __forceinline__ void h_rows(const float* x, const float* w, bf16* h, int nrows, int gw, int ngw, int lane) {
    h_rows_t(x, w, [h](int m) { return (unsigned long long*)(h + (size_t)m * D); }, nrows, gw, ngw, lane);
}
__device__ __forceinline__ void h_rows_tiles(const float* x, const float* w, const pg8::Gemm& gt, int nrows, int gw, int ngw, int lane) {
    h_rows_t(x, w, [&gt](int m) { return (unsigned long long*)(gt.atile(m >> 8, (size_t)256 * D * 2) + (size_t)(m & 255) * D * 2); }, nrows, gw, ngw, lane);
}
__device__ __forceinline__ void final_rows(const float* x, const float* pre, const float* w, float* out, int nrows, int gw, int ngw, int lane) {
    asm volatile("" : "+v"(lane));
    for (int m = gw; m < nrows; m += ngw) {
        const f32x4* pr = (const f32x4*)(pre + (size_t)m * D) + lane; const f32x4* xr = (const f32x4*)(x + (size_t)m * D) + lane; f32x4 v[4]; float s = 0.f;
#pragma unroll
        for (int j = 0; j < 4; ++j) { v[j] = pr[64 * j]; s += (v[j].x * v[j].x + v[j].y * v[j].y) + (v[j].z * v[j].z + v[j].w * v[j].w); }
        const float rstd = 1.0f / sqrtf(wave_sum(s) * (1.f / D) + EPS);
        f32x4* orow = (f32x4*)(out + (size_t)m * D) + lane;
#pragma unroll
        for (int j = 0; j < 4; ++j) { const f32x4 ww = ((const f32x4*)w)[lane + 64 * j]; const f32x4 xv = xr[64 * j]; orow[64 * j] = xv + v[j] * rstd * ww; }
    }
}
__device__ __forceinline__ void small_unit(LAS unsigned char* lds, const bf16* h, const bf16* wsm, float* out, int unit) {
    int tid_l = threadIdx.x; asm volatile("" : "+v"(tid_l));
    const int tid = tid_l, lane = tid & 63, w = __builtin_amdgcn_readfirstlane(tid >> 6), r = lane & 31, hh = lane >> 5;
    const int ct = w & 1, kq = w >> 1;
    const bf16* ap = h + (size_t)(unit * 32 + r) * D + kq * 256 + 8 * hh;
    const bf16* bp = wsm + (size_t)(32 * ct + r) * D + kq * 256 + 8 * hh;
    f32x16 acc = zero16();
#pragma unroll 8
    for (int ks = 0; ks < 16; ++ks) acc = MFMA32(*(const bf16x8*)(ap + 16 * ks), *(const bf16x8*)(bp + 16 * ks), acc);
    LAS float* red = (LAS float*)lds + (size_t)w * 1024 + lane;
    if (kq != 0) {
#pragma unroll
        for (int i = 0; i < 16; ++i) red[i * 64] = acc[i]; }
    __syncthreads();
    if (kq == 0) {
        float* op = out + (size_t)(unit * 32 + 4 * hh) * 64 + 32 * ct + r;
#pragma unroll
        for (int i = 0; i < 16; ++i) op[((i & 3) + 8 * (i >> 2)) * 64] = ((acc[i] + red[2048 + i * 64]) + red[4096 + i * 64]) + red[6144 + i * 64]; }
    __syncthreads();
}

constexpr int NG = 2, MG = M / NG, NSEQG = BATCH / NG;
constexpr size_t KiB = 1024;
constexpr size_t WS_CTL = 0  , WS_WTIN = 320 * KiB, WS_WTA = WS_WTIN + 18560 * KiB, WS_WTB = WS_WTA + 2 * MiB, WS_WTO = WS_WTB + 2 * MiB, WS_SMALL = WS_WTO + 2 * MiB  ,
    WS_Z = WS_SMALL + 2 * MiB  , WS_PG = WS_Z + 16 * MiB  , WS_GBLOB = WS_PG + 80 * MiB  , WS_LBLOBB = WS_GBLOB + 98 * MiB  , WS_END = WS_LBLOBB + 32 * MiB;
static_assert(WS_END <= 256 * MiB, "workspace");
constexpr size_t WS_GATES = WS_GBLOB  , WS_M1 = WS_GATES + 64 * MiB  , WS_MERGED = WS_M1 + 32 * MiB  , WS_PRE = WS_MERGED + 32 * MiB  ;
static_assert(WS_PRE + 1 * MiB <= WS_END, "overlays");
constexpr size_t HT_TILE = 256 * 1024 * 2, WS_H0 = WS_WTIN, WS_H1 = WS_PG + (size_t)NSEQG * 4 * NCH * gla::BLOBA, WS_H2 = WS_SMALL, WS_H3 = WS_END;
constexpr int HT1 = 24, HT2 = 55, HT3 = 59;
static_assert(((size_t)NSEQG * 4 * NCH * gla::BLOBA) % HT_TILE == 0 && WS_H1 + (HT2 - HT1) * HT_TILE <= WS_PG + 3 * ((size_t)MG * 2048) && HT1 * HT_TILE <= (size_t)6144 * 2048 && (HT3 - HT2) * HT_TILE <= 2 * MiB && WS_H3 + (64 - HT3) * HT_TILE <= 256 * MiB, "h tiles");
constexpr size_t PGMAT = (size_t)MG * 1024 * 2;
static_assert((size_t)NSEQG * 4 * NCH * gla::BLOBA <= 3 * PGMAT && (size_t)NSEQG * 4 * NCH * 32768 <= PGMAT && (size_t)NSEQG * 8 * NCH * 16384 <= PGMAT, "overlays");
static_assert((size_t)NSEQG * 8 * NCH * gdn::BLOB <= 98 * MiB && (size_t)NSEQG * 4 * NCH * gla::BLOBB <= 32 * MiB, "blobs");
constexpr int LDS_BYTES = 160 * 1024, LDS_BAR = LDS_BYTES - 16;
static_assert(2 * 34816 <= LDS_BAR && 64 * (256 * 2 + 16) <= 34816 && (NCH * (NSEQG * 8 + NSEQG * 4)) % 2 == 0 && (NSEQG * 8) % 2 == 0, "P4 half-workgroup units");
static_assert(gla::L_END <= LDS_BAR && gdn::L_END <= LDS_BAR && gdn::C_END <= LDS_BAR && gla::CB_END <= LDS_BAR && pg8::STAGE_BYTES <= LDS_BAR, "LDS");
constexpr int N_PHASES = 12;

struct MegaArgs { const float* in[18]; float* out; unsigned char* ws; int ph_lo, ph_hi; };

__global__ void __launch_bounds__(512, 2) mega(MegaArgs a) {
    extern __shared__ __attribute__((aligned(16))) unsigned char lds_raw[];
    LAS unsigned char* lds = (LAS unsigned char*)lds_raw;
    const int tid = threadIdx.x, lane = tid & 63, wave = __builtin_amdgcn_readfirstlane(tid >> 6);
    const int G = gridDim.x, bid = blockIdx.x, gw = bid * 8 + wave, ngw = G * 8;
    unsigned char* ws = a.ws;
    const float* x = a.in[0]; const float* ln_pre_w = a.in[1]; const float* w_in = a.in[2]; const float* conv_w = a.in[3];
    if (tid < 4) ((LAS unsigned*)(lds + LDS_BAR))[tid] = 0u;
    __syncthreads();
    XcdBarrier bar = xcd_barrier_post((unsigned*)(ws + WS_CTL), (volatile LAS unsigned*)(lds + LDS_BAR));
    const int lo = a.ph_lo, hi = a.ph_hi;
#define IN(k) (lo <= (k) && (k) < hi)
#define SEAM(k) do { if (IN(k) && IN((k) + 1)) xcd_barrier(bar); } while (0)
#ifndef PROBE_REPEAT
#define PROBE_REPEAT 0
#endif
#ifndef PROBE_FLAGS
#define PROBE_FLAGS 0
#endif
#define PH(k) if (IN(k)) for (int rep_ = 0; rep_ <= ((PROBE_REPEAT >> (k)) & 1); ++rep_)
#define REPBAR() do { if (rep_) xcd_barrier(bar); } while (0)
    bf16* WT_IN = (bf16*)(ws + WS_WTIN); bf16* WT_A = (bf16*)(ws + WS_WTA); bf16* WT_B = (bf16*)(ws + WS_WTB); bf16* WT_O = (bf16*)(ws + WS_WTO);
    bf16* PG = (bf16*)(ws + WS_PG); float* SMALL = (float*)(ws + WS_SMALL);
    bf16* ORAWA = (bf16*)a.out; bf16* ORAWB = (bf16*)a.out + (size_t)M * 1024;
    pg8::Gemm gh{(const bf16*)(ws + WS_H0), WT_IN + (size_t)6144 * D, M, 3072, D, 0, (const bf16*)(ws + WS_H1), (const bf16*)(ws + WS_H2), (const bf16*)(ws + WS_H3), HT1, HT2, HT3};

    PH(0) { REPBAR();
        LAS float* scr = (LAS float*)lds + wave * (64 * 33);
        for (int it = gw; it < WCV_MIX; it += ngw) wconv_item(it, w_in, a.in[9], a.in[15], a.in[16], WT_IN, WT_A, WT_B, WT_O, scr, lane);
        h_rows(x, ln_pre_w, ORAWB + (size_t)MG * 1024, MG, gw, ngw, lane);
    }
    SEAM(0);
#ifdef PROBE_BARRIERS
    for (int i = 0; i < PROBE_BARRIERS; ++i) xcd_barrier(bar);
#endif
    for (int g = 0; g < NG; ++g) {
        const int pb = 1 + 4 * g;
        const size_t r0 = (size_t)g * MG;
        const bf16* hsrc = (g == 0 ? ORAWB : ORAWA) + (size_t)MG * 1024;
        PH(pb) { REPBAR();
            for (int u = bid; u < MG / 32; u += G) small_unit(lds, hsrc, WT_IN + (size_t)9216 * D, SMALL, u);
            pg8::Gemm gm{hsrc, WT_IN, MG, 6144, D, 0}; pg8::StaticOrder S; S.init(MG, 6144, G, bid);
            pg8::EpiBf16 E{(bf16*)(ws + WS_Z), 1024, 1024, (size_t)MG * 1024};
            pg8::gemm_phase<pg8::EpiBf16, pg8::StaticOrder, true, true>(lds, gm, S, E);
        }
        SEAM(pb);
        PH(pb + 1) { REPBAR();
            GdnPrepArgs pa{PG, PG + (size_t)MG * 1024, PG + (size_t)2 * MG * 1024, SMALL, conv_w, a.in[4], a.in[5], a.in[6], a.in[7], ws + WS_GBLOB, NSEQG, rep_ ? PROBE_FLAGS : 0};
            gdn_prep_phase(lds, pa, bid, G, ws + WS_CTL + 300 * KiB);
        }
        SEAM(pb + 1);
        PH(pb + 2) { REPBAR();
            GlaPrepArgs pa{PG + (size_t)3 * MG * 1024, PG + (size_t)4 * MG * 1024, SMALL, a.in[10], a.in[11], a.in[12], a.in[13], ws + WS_PG, ws + WS_LBLOBB, NSEQG, 0};
            gla_prep_phase(lds, pa, bid, G);
        }
        SEAM(pb + 2);
        PH(pb + 3) { REPBAR();
            constexpr int NGI = NSEQG * 8 * 2 * 2, NLI = NSEQG * 4 * 2 * 2;
            unsigned* gflag = (unsigned*)(ws + WS_CTL + 32 * KiB) + (size_t)g * (NSEQG * 8 * NCH * 8); unsigned* lflag = (unsigned*)(ws + WS_CTL + 96 * KiB) + (size_t)g * (NSEQG * 4 * NCH * 8);
            if (rep_) { gflag += 32 * 1024; lflag += 32 * 1024; }
            if (bid < NGI) { if (!(rep_ && (PROBE_FLAGS & 16))) { GdnChainArgs ca{ws + WS_GBLOB, ws + WS_PG + 4 * PGMAT, gflag, NSEQG, rep_ ? PROBE_FLAGS : 0}; gdn_chain_unit(lds, ca, (bid >> 4) * 8 + (bid & 7), (bid >> 3) & 1); } }
            else if (bid < NGI + NLI) { if (!(rep_ && (PROBE_FLAGS & 32))) { GlaChainArgs ca{ws + WS_PG, ws + WS_LBLOBB, ws + WS_PG + 3 * PGMAT, lflag, NSEQG, rep_ ? PROBE_FLAGS : 0}; const int lb = bid - NGI; gla_chain_unit(lds, ca, (lb >> 4) * 8 + (lb & 7), (lb >> 3) & 1); } }
            else if (!rep_) {
                const int wk = bid - NGI - NLI, nwk = G - NGI - NLI;
                if (g == 0) h_rows(x + (size_t)MG * D, ln_pre_w, ORAWA + (size_t)MG * 1024, MG, wk * 8 + wave, nwk * 8, lane);
                if (g == 0) { LAS float* scr = (LAS float*)lds + wave * (64 * 33);
                    for (int it = WCV_MIX + wk * 8 + wave; it < WCV_ALL; it += nwk * 8) wconv_item(it, w_in, a.in[9], a.in[15], a.in[16], WT_IN, WT_A, WT_B, WT_O, scr, lane);
                    __syncthreads(); }
                if (g == NG - 1) h_rows_tiles(x, ln_pre_w, gh, M, wk * 8 + wave, nwk * 8, lane);
            }
            if (!rep_) {
                constexpr int NPG = NSEQG * 8, NPL = NSEQG * 4;
                unsigned* qhead = (unsigned*)(ws + WS_CTL + 301 * KiB) + 64 * g;
                const int hf = wave >> 2;
                LAS unsigned char* lds_h = lds + hf * 34816;
                for (;;) {
                    if (tid == 0) ((LAS unsigned*)(lds + LDS_BAR))[3] = __hip_atomic_fetch_add(qhead, 2u, __ATOMIC_RELAXED, __HIP_MEMORY_SCOPE_AGENT);
                    __syncthreads();
                    const int j0 = (int)((LAS unsigned*)(lds + LDS_BAR))[3];
                    __syncthreads();
                    if (j0 >= NCH * (NPG + NPL)) break;
                    const int j = j0 + hf; const bool valid = j < NCH * (NPG + NPL);
                    const int rk = j / (NPG + NPL), idx = j % (NPG + NPL), n = (rk & 1) ? (NCH / 2 - 1 - (rk >> 1)) : (NCH / 2 + (rk >> 1));
                    if ((j0 % (NPG + NPL)) < NPG) { const int u = idx * NCH + n, hd = idx % 8, sq = idx / 8;
                        p4_unit<128, true>(lds_h, ws + WS_PG + 4 * PGMAT + (size_t)u * 16384, nullptr, (const bf16*)(ws + WS_Z) + ((size_t)sq * SEQ + n * CHUNK) * 1024 + hd * 128, a.in[8], ORAWA + (r0 + (size_t)sq * SEQ + n * CHUNK) * 1024 + hd * 128, gflag + (size_t)u * 8, valid); }
                    else { const int pi = idx - NPG, u = pi * NCH + n, hd = pi % 4, sq = pi / 4;
                        p4_unit<256, false>(lds_h, ws + WS_PG + 3 * PGMAT + (size_t)u * 32768, ws + WS_LBLOBB + (size_t)u * gla::BLOBB + gla::B_INTRA, nullptr, a.in[14], ORAWB + (r0 + (size_t)sq * SEQ + n * CHUNK) * 1024 + hd * 256, lflag + (size_t)u * 8, valid); }
                }
            }
        }
        SEAM(pb + 3);
    }
    PH(9) { REPBAR();
        const pg8::Gemm& gm = gh; pg8::StaticOrder S; S.init(M, 3072, G, bid);
        if (rep_ == 0) { pg8::EpiP1b E{ORAWB, (bf16*)(ws + WS_GATES), (size_t)M * 1024, ORAWB};
            pg8::gemm_phase<pg8::EpiP1b, pg8::StaticOrder, true, true>(lds, gm, S, E); }
        else { pg8::EpiP1b E{ORAWB, (bf16*)(ws + WS_GATES), (size_t)M * 1024, (bf16*)(ws + WS_MERGED)};
            pg8::gemm_phase<pg8::EpiP1b, pg8::StaticOrder, true, true>(lds, gm, S, E); }
    }
    SEAM(9);
    PH(10) { REPBAR();
        pg8::Gemm gm{ORAWA, WT_A, 2 * M, 2 * D, D, 0}; pg8::PairOrder S; S.init(M, D, G, bid);
        pg8::EpiMerge E{(bf16*)(ws + WS_M1), (bf16*)(ws + WS_MERGED), (const bf16*)(ws + WS_GATES), (size_t)M * 1024, M / 256, D / 256};
        pg8::gemm_phase<pg8::EpiMerge, pg8::PairOrder, true, true>(lds, gm, S, E);
    }
    SEAM(10);
    if (IN(11)) {
        pg8::Gemm gm{(const bf16*)(ws + WS_MERGED), WT_O, M, D, D, 0}; pg8::StaticOrder S; S.init(M, D, G, bid);
        pg8::EpiRmsRes E{x, a.in[17], a.out, (float*)(ws + WS_PRE), (unsigned*)(ws + WS_CTL + 304 * KiB)};
        pg8::gemm_phase<pg8::EpiRmsRes, pg8::StaticOrder, false, true>(lds, gm, S, E);
    }
#undef IN
#undef SEAM
}

#ifndef MK_N_LAUNCHES
#define MK_N_LAUNCHES 1
#endif
extern "C" void kernel_launch(void* const* d_in, const int* in_sizes, int n_in, void* d_out, int out_size, void* d_ws, size_t ws_size, hipStream_t stream) {
    static int ready = 0;
    if (!ready) {
        if (n_in != 18 || ws_size < 256 * MiB || out_size != M * D) { fprintf(stderr, "kernel_launch: unexpected problem shape / workspace (%d inputs, ws %zu)\n", n_in, ws_size); ready = -1; return; }
        if (hipFuncSetAttribute((const void*)mega, hipFuncAttributeMaxDynamicSharedMemorySize, LDS_BYTES) != hipSuccess) { fprintf(stderr, "kernel_launch: hipFuncSetAttribute failed\n"); ready = -1; return; }
        int dev = 0, cus = 0, per_cu = 0;
        if (hipGetDevice(&dev) != hipSuccess || hipDeviceGetAttribute(&cus, hipDeviceAttributeMultiprocessorCount, dev) != hipSuccess) { fprintf(stderr, "kernel_launch: hipGetDevice / hipDeviceGetAttribute failed; nothing launched\n"); ready = -1; return; }
        if (hipOccupancyMaxActiveBlocksPerMultiprocessor(&per_cu, (const void*)mega, 512, LDS_BYTES) != hipSuccess) { per_cu = 1; fprintf(stderr, "kernel_launch: note: the occupancy query failed; going ahead with one workgroup per CU (LDS budget)\n"); }
        (void)hipGetLastError();
        if (per_cu < 1 || (long)per_cu * cus < 256) { fprintf(stderr, "kernel_launch: the 256-workgroup grid would not be resident (%d workgroups per CU x %d CUs); nothing launched\n", per_cu, cus); ready = -1; return; }
        ready = 1;
    }
    if (ready < 0) return;
    (void)hipMemsetAsync((char*)d_ws + WS_CTL, 0, 320 * 1024, stream);
    MegaArgs a{};
    for (int i = 0; i < 18; ++i) a.in[i] = (const float*)d_in[i];
    a.out = (float*)d_out; a.ws = (unsigned char*)d_ws;
#if MK_N_LAUNCHES == 1
    a.ph_lo = 0; a.ph_hi = N_PHASES;
    hipLaunchKernelGGL(mega, dim3(256), dim3(512), LDS_BYTES, stream, a);
#else
    for (int p = 0; p < N_PHASES; ++p) { a.ph_lo = p; a.ph_hi = p + 1; hipLaunchKernelGGL(mega, dim3(256), dim3(512), LDS_BYTES, stream, a); }
#endif
}
```
